# Optimizing an MI355X kernel written in HIP

```python
import math
import jax, jax.numpy as jnp
from jax import lax
import numpy as np

D_MODEL = 1024
BATCH = 4
SEQ = 8192
DEPTH = 2

N_MIXERS = 2
EPS = 1e-6
ML_H = 4
ML_DV = 2 * D_MODEL // ML_H
ML_DQK = ML_DV // 2
ML_QK = ML_H * ML_DQK
ML_V = ML_H * ML_DV
ML_PROJ = 2 * ML_QK + 2 * ML_V + 2 * ML_H
ML_CHUNK = 64
CONV_K = 4
DA_DH = 64
DA_DV = 2 * DA_DH
DA_H = D_MODEL // DA_DV
DA_QK = DA_H * 2 * DA_DH
DA_PROJ = 2 * DA_QK + DA_H * DA_DV
DA_EPS = 1e-5
Q_BLOCK = 128
N_GROUPS = 4
EXPERTS_PER_GROUP = 8
N_EXPERTS = N_GROUPS * EXPERTS_PER_GROUP
TOP_K_IN_GROUP = 2
D_EXPERT = D_MODEL // 4
TOK_BLOCK = 128

kernel_name = 'hybrid_mlstm_diffattn_hmoe'


def rmsnorm(x, g, eps=EPS):
    xf = x.astype(jnp.float32)
    y = xf * lax.rsqrt(jnp.mean(xf * xf, axis=-1, keepdims=True) + eps)
    return (y * g.astype(jnp.float32)).astype(x.dtype)


def causal_conv(u, w):
    K = w.shape[0]
    S = u.shape[1]
    up = jnp.pad(u, ((0, 0), (K - 1, 0), (0, 0)))
    return sum(up[:, j:j + S] * w[j] for j in range(K))


def mlstm_mixer(h, w_in, conv_w, b_i, b_f, norm_g, w_out):
    B, S, _ = h.shape
    f32 = jnp.float32
    p = h @ w_in
    qk = jax.nn.silu(causal_conv(p[..., :2 * ML_QK], conv_w))
    q = qk[..., :ML_QK] * (ML_DQK ** -0.5)
    k = qk[..., ML_QK:]
    v = p[..., 2 * ML_QK:2 * ML_QK + ML_V]
    o = p[..., 2 * ML_QK + ML_V:2 * ML_QK + 2 * ML_V]
    gates = p[..., 2 * ML_QK + 2 * ML_V:].astype(f32)
    i_pre = gates[..., :ML_H] + b_i.astype(f32)
    log_f = jax.nn.log_sigmoid(gates[..., ML_H:] + b_f.astype(f32))
    nc = S // ML_CHUNK

    def to_chunks(t, d):
        return t.astype(f32).reshape(B, nc, ML_CHUNK, ML_H, d).transpose(1, 0, 3, 2, 4)

    def gate_chunks(g):
        return g.reshape(B, nc, ML_CHUNK, ML_H).transpose(1, 0, 3, 2)

    qc, kc, vc = to_chunks(q, ML_DQK), to_chunks(k, ML_DQK), to_chunks(v, ML_DV)
    ic, fc = gate_chunks(i_pre), gate_chunks(log_f)
    causal = jnp.tril(jnp.ones((ML_CHUNK, ML_CHUNK), dtype=bool))

    def step(carry, inp):
        C, n, m = carry
        qt, kt, vt, it, lf = inp
        b = jnp.cumsum(lf, axis=-1)
        dmat = b[..., :, None] - b[..., None, :] + it[..., None, :]
        dmat = jnp.where(causal, dmat, -jnp.inf)
        inter_log = b + m[..., None]
        m_t = jnp.maximum(inter_log, jnp.max(dmat, axis=-1))
        wts = jnp.exp(dmat - m_t[..., None])
        scores = jnp.einsum('bhtd,bhsd->bhts', qt, kt) * wts
        inter_scale = jnp.exp(inter_log - m_t)
        num = jnp.einsum('bhts,bhsv->bhtv', scores, vt) + inter_scale[..., None] * jnp.einsum('bhvd,bhtd->bhtv', C, qt)
        den = jnp.sum(scores, axis=-1) + inter_scale * jnp.einsum('bhd,bhtd->bht', n, qt)
        h_out = num / jnp.maximum(jnp.abs(den), jnp.exp(-m_t))[..., None]
        bL = b[..., -1]
        log_w = bL[..., None] - b + it
        m_new = jnp.maximum(bL + m, jnp.max(log_w, axis=-1))
        ws = jnp.exp(log_w - m_new[..., None])
        decay = jnp.exp(bL + m - m_new)
        C_new = decay[..., None, None] * C + jnp.einsum('bhsv,bhsd->bhvd', vt * ws[..., None], kt)
        n_new = decay[..., None] * n + jnp.einsum('bhs,bhsd->bhd', ws, kt)
        return (C_new, n_new, m_new), h_out

    init = (jnp.zeros((B, ML_H, ML_DV, ML_DQK), f32), jnp.zeros((B, ML_H, ML_DQK), f32), jnp.zeros((B, ML_H), f32))
    _, hs = lax.scan(step, init, (qc, kc, vc, ic, fc))
    hs = hs.transpose(1, 0, 3, 2, 4).reshape(B, S, ML_H, ML_DV)
    hs = rmsnorm(hs, norm_g.reshape(ML_H, ML_DV)).reshape(B, S, ML_V)
    y = (hs * jax.nn.sigmoid(o.astype(f32))).astype(h.dtype)
    return y @ w_out


def diff_attention(h, w_in, lam_q1, lam_k1, lam_q2, lam_k2, norm_g, w_out, lambda_init):
    B, S, _ = h.shape
    f32 = jnp.float32
    p = (h @ w_in).astype(f32)
    q = p[..., :DA_QK].reshape(B, S, DA_H, 2, DA_DH) * (DA_DH ** -0.5)
    k = p[..., DA_QK:2 * DA_QK].reshape(B, S, DA_H, 2, DA_DH)
    v = p[..., 2 * DA_QK:].reshape(B, S, DA_H, DA_DV)
    lam = (jnp.exp(jnp.sum(lam_q1.astype(f32) * lam_k1.astype(f32)))
           - jnp.exp(jnp.sum(lam_q2.astype(f32) * lam_k2.astype(f32))) + lambda_init)
    nq = S // Q_BLOCK
    qb = q.reshape(B, nq, Q_BLOCK, DA_H, 2, DA_DH).transpose(1, 0, 2, 3, 4, 5)
    kpos = jnp.arange(S)

    def one_block(args):
        qblk, start = args
        s = jnp.einsum('bqhcd,bkhcd->bhcqk', qblk, k)
        qpos = start + jnp.arange(Q_BLOCK)
        causal = kpos[None, :] <= qpos[:, None]
        pr = jax.nn.softmax(jnp.where(causal, s, -jnp.inf), axis=-1)
        a = pr[:, :, 0] - lam * pr[:, :, 1]
        return jnp.einsum('bhqk,bkhe->bqhe', a, v)

    o = lax.map(one_block, (qb, jnp.arange(nq) * Q_BLOCK))
    o = o.transpose(1, 0, 2, 3, 4).reshape(B, S, DA_H, DA_DV)
    o = rmsnorm(o, norm_g, DA_EPS) * (1.0 - lambda_init)
    return o.reshape(B, S, DA_H * DA_DV).astype(h.dtype) @ w_out


def hier_moe(h, w_group, b_group, w_expert, b_expert, w_gu, w_down):
    B, S, D = h.shape
    T = B * S
    f32 = jnp.float32
    xt = h.reshape(T, D)
    g_logits = (xt @ w_group).astype(f32) + b_group.astype(f32)
    g_prob = jax.nn.softmax(g_logits, axis=-1)
    _, g_idx = lax.top_k(g_logits, 1)
    g_w = jnp.take_along_axis(g_prob, g_idx, axis=-1)
    e_logits = ((xt @ w_expert).astype(f32) + b_expert.astype(f32)).reshape(T, N_GROUPS, EXPERTS_PER_GROUP)
    e_logits = jnp.take_along_axis(e_logits, g_idx[:, :, None], axis=1)[:, 0]
    e_prob = jax.nn.softmax(e_logits, axis=-1)
    top_w, top_idx = lax.top_k(e_prob, TOP_K_IN_GROUP)
    top_w = top_w / jnp.sum(top_w, axis=-1, keepdims=True)
    within = jnp.sum(jax.nn.one_hot(top_idx, EXPERTS_PER_GROUP, dtype=f32) * top_w[..., None], axis=1)
    gate = (jax.nn.one_hot(g_idx[:, 0], N_GROUPS, dtype=f32)[:, :, None]
            * (g_w * within)[:, None, :]).reshape(T, N_EXPERTS)
    nb = T // TOK_BLOCK

    def expert_block(args):
        xb, gb = args
        gu = jnp.einsum('td,edf->tef', xb, w_gu)
        a = jax.nn.silu(gu[..., :D_EXPERT]) * gu[..., D_EXPERT:] * gb[..., None].astype(xb.dtype)
        return jnp.einsum('tef,efd->td', a, w_down)

    y = lax.map(expert_block, (xt.reshape(nb, TOK_BLOCK, D), gate.reshape(nb, TOK_BLOCK, N_EXPERTS)))
    return y.reshape(B, S, D)


def setup_inputs(seed: int = 0) -> dict:
    key = jax.random.key(seed)
    ks = jax.random.split(key, 32)
    n_a = (DEPTH + 1) // 2
    n_b = DEPTH // 2
    D = D_MODEL

    def nrm(k, shape, scale):
        return jax.random.normal(k, shape, jnp.float32) * scale

    return {
        'x': nrm(ks[0], (BATCH, SEQ, D), 1.0),
        'norm_mix': 1.0 + nrm(ks[1], (DEPTH, D), 0.01),
        'norm_ffn': 1.0 + nrm(ks[2], (DEPTH, D), 0.01),
        'ml_w_in': nrm(ks[3], (n_a, D, ML_PROJ), D ** -0.5),
        'ml_conv': nrm(ks[4], (n_a, CONV_K, 2 * ML_QK), 0.5),
        'ml_b_i': nrm(ks[5], (n_a, ML_H), 0.1),
        'ml_b_f': jnp.linspace(3.0, 6.0, ML_H)[None, :] + nrm(ks[6], (n_a, ML_H), 0.01),
        'ml_norm': 1.0 + nrm(ks[7], (n_a, ML_V), 0.01),
        'ml_w_out': nrm(ks[8], (n_a, ML_V, D), ML_V ** -0.5),
        'da_w_in': nrm(ks[9], (n_b, D, DA_PROJ), D ** -0.5),
        'da_lq1': nrm(ks[10], (n_b, DA_DH), 0.1),
        'da_lk1': nrm(ks[11], (n_b, DA_DH), 0.1),
        'da_lq2': nrm(ks[12], (n_b, DA_DH), 0.1),
        'da_lk2': nrm(ks[13], (n_b, DA_DH), 0.1),
        'da_norm': 1.0 + nrm(ks[14], (n_b, DA_DV), 0.01),
        'da_w_out': nrm(ks[15], (n_b, DA_H * DA_DV, D), (DA_H * DA_DV) ** -0.5),
        'moe_w_group': nrm(ks[16], (DEPTH, D, N_GROUPS), D ** -0.5),
        'moe_b_group': nrm(ks[17], (DEPTH, N_GROUPS), 0.01),
        'moe_w_expert': nrm(ks[18], (DEPTH, D, N_EXPERTS), D ** -0.5),
        'moe_b_expert': nrm(ks[19], (DEPTH, N_EXPERTS), 0.01),
        'moe_w_gu': nrm(ks[20], (DEPTH, N_EXPERTS, D, 2 * D_EXPERT), D ** -0.5),
        'moe_w_down': nrm(ks[21], (DEPTH, N_EXPERTS, D_EXPERT, D), D_EXPERT ** -0.5),
        'final_norm': 1.0 + nrm(ks[22], (D,), 0.01),
    }


def reference(x, norm_mix, norm_ffn, ml_w_in, ml_conv, ml_b_i, ml_b_f, ml_norm, ml_w_out,
              da_w_in, da_lq1, da_lk1, da_lq2, da_lk2, da_norm, da_w_out,
              moe_w_group, moe_b_group, moe_w_expert, moe_b_expert, moe_w_gu, moe_w_down,
              final_norm):
    for i in range(DEPTH):
        hn = rmsnorm(x, norm_mix[i])
        j = i // N_MIXERS
        if i % N_MIXERS == 0:
            mix = mlstm_mixer(hn, ml_w_in[j], ml_conv[j], ml_b_i[j], ml_b_f[j], ml_norm[j], ml_w_out[j])
        else:
            lambda_init = 0.8 - 0.6 * math.exp(-0.3 * i)
            mix = diff_attention(hn, da_w_in[j], da_lq1[j], da_lk1[j], da_lq2[j], da_lk2[j],
                                 da_norm[j], da_w_out[j], lambda_init)
        x = x + mix
        x = x + hier_moe(rmsnorm(x, norm_ffn[i]), moe_w_group[i], moe_b_group[i], moe_w_expert[i],
                         moe_b_expert[i], moe_w_gu[i], moe_w_down[i])
    return rmsnorm(x, final_norm)
```

```cpp
#include <hip/hip_runtime.h>
#include <hip/hip_bf16.h>
#include <cstdio>
#include <cstdint>
#include <cmath>
namespace pg8 {
#define PG8_LAS __attribute__((address_space(3)))
typedef unsigned short bf16_t;
typedef short bf16x8 __attribute__((ext_vector_type(8)));
typedef float f32x4 __attribute__((ext_vector_type(4)));
typedef unsigned u32x4 __attribute__((ext_vector_type(4)));
constexpr int BM = 256, BK = 64, HALF = 128, HTB = HALF * BK * 2  , STAGE_BYTES = 8 * HTB, NXCD = 8, WGM = 8;

__host__ __device__ __forceinline__ int lds_byte(int r, int c) { const int st = (r >> 4) * 2 + (c >> 5), rr = r & 15, cc = c & 31, ob = rr * 64 + cc * 2; return st * 1024 + (ob ^ (((ob >> 9) & 1) << 5)); }
__host__ __device__ __forceinline__ void stage_rc(int b, int& R, int& C) { const int st = b / 1024, sb = b % 1024, swz = sb ^ (((sb >> 9) & 1) << 5); R = (st >> 1) * 16 + swz / 64; C = (st & 1) * 32 + (swz % 64) / 2; }
__host__ __device__ __forceinline__ int perm32(int rho) { const int n = rho >> 4, i = rho & 15; return 8 * (i >> 2) + 4 * n + (i & 3); }

struct Unit { int pm, pn; };
struct Gemm { const bf16_t* A; const bf16_t* Bt; int M, N, K; };

struct StaticOrder {
    int nM, nN, nwg, G, c;
    __host__ __device__ void init(int M, int N, int G_, int c_) { nM = M / BM; nN = N / BM; nwg = nM * nN; G = G_; c = c_; }
    __host__ __device__ bool next(int i, Unit& u) const {
        const long L = (long)i * G + c; if (L >= nwg) return false;
        int wgid = (int)L; { const int q = nwg / NXCD, r = nwg % NXCD, xcd = wgid % NXCD, off = wgid / NXCD; wgid = (xcd < r ? xcd * (q + 1) : r * (q + 1) + (xcd - r) * q) + off; }
        const int nig = WGM * nN, gid = wgid / nig, fm = gid * WGM, gsz = (nM - fm) < WGM ? (nM - fm) : WGM;
        u.pm = fm + ((wgid % nig) % gsz); u.pn = (wgid % nig) / gsz; return true;
    }
    __device__ __forceinline__ void a_ready(const Unit&) const {}
    __device__ __forceinline__ void done(const Unit&) const {}
};

__device__ __forceinline__ unsigned cvt_pk_bf16(float lo, float hi) { unsigned r; asm volatile("v_cvt_pk_bf16_f32 %0, %1, %2" : "=v"(r) : "v"(lo), "v"(hi)); return r; }

struct EpiBf16S {
    static constexpr bool PERM = true, AFTER_DRAIN = false;
    bf16_t* O; int ldc; int split_cols; size_t split_stride; float scale0; int pn_mask; int row_skew; const float* rowscale; int dry = 0;
    __device__ __forceinline__ void operator()(const f32x4 (&acc)[2][2][4][2], const Unit& u, int wr, int wc, int fr, int fq) const {
        const int row0 = u.pm * BM + wr * 64 + fr + (u.pm >> 1) * row_skew; int colt = (u.pn & pn_mask) * BM; bf16_t* base = O;
        float sc = 1.f; if (split_cols) { const int t = colt / split_cols; base += (size_t)t * split_stride; colt -= t * split_cols; if (t == 0) sc = scale0; }
        const int col0 = colt + wc * 32 + 8 * fq;
#pragma unroll
        for (int ai = 0; ai < 2; ++ai)
#pragma unroll
            for (int m = 0; m < 4; ++m) { bf16_t* rowp = base + (size_t)(row0 + ai * HALF + m * 16) * ldc + col0; const float sr = rowscale ? sc * rowscale[u.pm * BM + wr * 64 + fr + ai * HALF + m * 16] : sc;
#pragma unroll
                for (int bj = 0; bj < 2; ++bj) { f32x4 v0 = acc[ai][bj][m][0] * sr, v1 = acc[ai][bj][m][1] * sr;
                    u32x4 w; w.x = cvt_pk_bf16(v0[0], v0[1]); w.y = cvt_pk_bf16(v0[2], v0[3]); w.z = cvt_pk_bf16(v1[0], v1[1]); w.w = cvt_pk_bf16(v1[2], v1[3]);
                    if (!dry) *(u32x4*)(rowp + bj * HALF) = w; } }
    }
};
struct EpiQKO {
    static constexpr bool PERM = true, AFTER_DRAIN = false;
    bf16_t* QK; unsigned char* OG8;
    __device__ __forceinline__ void operator()(const f32x4 (&acc)[2][2][4][2], const Unit& u, int wr, int wc, int fr, int fq) const {
        const int row0 = u.pm * BM + wr * 64 + fr; const bool gate = u.pn >= 8; const int col0 = (u.pn & 7) * BM + wc * 32 + 8 * fq;
#pragma unroll
        for (int ai = 0; ai < 2; ++ai)
#pragma unroll
            for (int m = 0; m < 4; ++m) { const size_t ro = (size_t)(row0 + ai * HALF + m * 16) * 2048 + col0;
#pragma unroll
                for (int bj = 0; bj < 2; ++bj) { const f32x4 v0 = acc[ai][bj][m][0], v1 = acc[ai][bj][m][1];
                    if (!gate) { u32x4 w; w.x = cvt_pk_bf16(v0[0], v0[1]); w.y = cvt_pk_bf16(v0[2], v0[3]); w.z = cvt_pk_bf16(v1[0], v1[1]); w.w = cvt_pk_bf16(v1[2], v1[3]);
                        *(u32x4*)(QK + ro + bj * HALF) = w; }
                    else { unsigned b[8];
#pragma unroll
                        for (int e = 0; e < 4; ++e) { b[e] = (unsigned)(255.f * __builtin_amdgcn_rcpf(1.f + __builtin_amdgcn_exp2f(-1.4426950408889634f * v0[e])) + 0.5f);
                                                      b[4 + e] = (unsigned)(255.f * __builtin_amdgcn_rcpf(1.f + __builtin_amdgcn_exp2f(-1.4426950408889634f * v1[e])) + 0.5f); }
                        typedef unsigned u32x2_t __attribute__((ext_vector_type(2)));
                        *(u32x2_t*)(OG8 + ro + bj * HALF) = (u32x2_t){b[0] | (b[1] << 8) | (b[2] << 16) | (b[3] << 24), b[4] | (b[5] << 8) | (b[6] << 16) | (b[7] << 24)}; } } }
    }
};
struct EpiResF32 {
    static constexpr bool PERM = false, AFTER_DRAIN = false;
    const float* res; float* out; int ldc;
    __device__ __forceinline__ void operator()(const f32x4 (&acc)[2][2][4][2], const Unit& u, int wr, int wc, int fr, int fq) const {
        const int row0 = u.pm * BM + wr * 64 + fr, col0 = u.pn * BM + wc * 32 + 4 * fq;
        f32x4 rb[2][2][2][2];
#define PG8_RLOAD(buf, ai, mp) do { _Pragma("unroll") for (int mm = 0; mm < 2; ++mm) { const size_t off_ = (size_t)(row0 + (ai) * HALF + (2 * (mp) + mm) * 16) * ldc + col0; \
            _Pragma("unroll") for (int bj = 0; bj < 2; ++bj) _Pragma("unroll") for (int n = 0; n < 2; ++n) rb[buf][mm][bj][n] = *(const f32x4*)(res + off_ + bj * HALF + n * 16); } } while (0)
        PG8_RLOAD(0, 0, 0);
#pragma unroll
        for (int grp = 0; grp < 4; ++grp) {
            const int ai = grp >> 1, mp = grp & 1;
            if (grp + 1 < 4) { if (((grp + 1) & 1) == 0) PG8_RLOAD(0, (grp + 1) >> 1, (grp + 1) & 1); else PG8_RLOAD(1, (grp + 1) >> 1, (grp + 1) & 1); }
            __builtin_amdgcn_sched_barrier(0);
#pragma unroll
            for (int mm = 0; mm < 2; ++mm) { const int m = 2 * mp + mm; const size_t off = (size_t)(row0 + ai * HALF + m * 16) * ldc + col0;
#pragma unroll
                for (int bj = 0; bj < 2; ++bj)
#pragma unroll
                    for (int n = 0; n < 2; ++n) *(f32x4*)(out + off + bj * HALF + n * 16) = rb[grp & 1][mm][bj][n] + acc[ai][bj][m][n]; }
            __builtin_amdgcn_sched_barrier(0);
        }
#undef PG8_RLOAD
    }
};
template <bool RES_F32> struct EpiResBf16 {
    static constexpr bool PERM = true, AFTER_DRAIN = false;
    const void* res; bf16_t* out; int ldc;
    __device__ __forceinline__ void operator()(const f32x4 (&acc)[2][2][4][2], const Unit& u, int wr, int wc, int fr, int fq) const {
        const int row0 = u.pm * BM + wr * 64 + fr, col0 = u.pn * BM + wc * 32 + 8 * fq;
        f32x4 rb[2][2][2][2];
#define PG8_RLOAD(buf, ai, mp) do { _Pragma("unroll") for (int mm = 0; mm < 2; ++mm) { const size_t off_ = (size_t)(row0 + (ai) * HALF + (2 * (mp) + mm) * 16) * ldc + col0; \
            _Pragma("unroll") for (int bj = 0; bj < 2; ++bj) { if (RES_F32) { rb[buf][mm][bj][0] = *(const f32x4*)((const float*)res + off_ + bj * HALF); rb[buf][mm][bj][1] = *(const f32x4*)((const float*)res + off_ + bj * HALF + 4); } \
                else { const u32x4 w_ = *(const u32x4*)((const bf16_t*)res + off_ + bj * HALF); \
                    rb[buf][mm][bj][0] = (f32x4){__builtin_bit_cast(float, w_.x << 16), __builtin_bit_cast(float, w_.x & 0xffff0000u), __builtin_bit_cast(float, w_.y << 16), __builtin_bit_cast(float, w_.y & 0xffff0000u)}; \
                    rb[buf][mm][bj][1] = (f32x4){__builtin_bit_cast(float, w_.z << 16), __builtin_bit_cast(float, w_.z & 0xffff0000u), __builtin_bit_cast(float, w_.w << 16), __builtin_bit_cast(float, w_.w & 0xffff0000u)}; } } } } while (0)
        PG8_RLOAD(0, 0, 0);
#pragma unroll
        for (int grp = 0; grp < 4; ++grp) {
            const int ai = grp >> 1, mp = grp & 1;
            if (grp + 1 < 4) { if (((grp + 1) & 1) == 0) PG8_RLOAD(0, (grp + 1) >> 1, (grp + 1) & 1); else PG8_RLOAD(1, (grp + 1) >> 1, (grp + 1) & 1); }
            __builtin_amdgcn_sched_barrier(0);
#pragma unroll
            for (int mm = 0; mm < 2; ++mm) { const int m = 2 * mp + mm; const size_t off = (size_t)(row0 + ai * HALF + m * 16) * ldc + col0;
#pragma unroll
                for (int bj = 0; bj < 2; ++bj) { const f32x4 v0 = rb[grp & 1][mm][bj][0] + acc[ai][bj][m][0], v1 = rb[grp & 1][mm][bj][1] + acc[ai][bj][m][1];
                    u32x4 w; w.x = cvt_pk_bf16(v0[0], v0[1]); w.y = cvt_pk_bf16(v0[2], v0[3]); w.z = cvt_pk_bf16(v1[0], v1[1]); w.w = cvt_pk_bf16(v1[2], v1[3]);
                    *(u32x4*)(out + off + bj * HALF) = w; } }
            __builtin_amdgcn_sched_barrier(0);
        }
#undef PG8_RLOAD
    }
};
struct EpiSwiGLU {
    static constexpr bool PERM = true, AFTER_DRAIN = false;
    bf16_t* O; const float* ew; const float* ers; const PG8_LAS int* eoff; int ldw;
    __device__ __forceinline__ void operator()(const f32x4 (&acc)[2][2][4][2], const Unit& u, int wr, int wc, int fr, int fq) const {
        const int row0 = u.pm * BM + wr * 64 + fr, col0 = (u.pn & 1) * 128 + wc * 32 + 8 * fq; const int e = u.pn >> 1;
        const float* roww = ew + (size_t)e * ldw - eoff[e]; const float* rowr = ers + (size_t)e * ldw - eoff[e];
        float gws[2][4], grs[2][4];
#pragma unroll
        for (int ai = 0; ai < 2; ++ai)
#pragma unroll
            for (int m = 0; m < 4; ++m) { gws[ai][m] = roww[row0 + ai * HALF + m * 16]; grs[ai][m] = rowr[row0 + ai * HALF + m * 16]; }
#pragma unroll
        for (int ai = 0; ai < 2; ++ai)
#pragma unroll
            for (int m = 0; m < 4; ++m) { const int row = row0 + ai * HALF + m * 16; const float gw = gws[ai][m], gr = grs[ai][m]; float a[8];
#pragma unroll
                for (int n = 0; n < 2; ++n)
#pragma unroll
                    for (int e4 = 0; e4 < 4; ++e4) { const float g = acc[ai][0][m][n][e4] * gr, up = acc[ai][1][m][n][e4] * gr;
                        const float sg = g * __builtin_amdgcn_rcpf(1.f + __builtin_amdgcn_exp2f(-1.4426950408889634f * g)); a[n * 4 + e4] = sg * up * gw; }
                u32x4 w; w.x = cvt_pk_bf16(a[0], a[1]); w.y = cvt_pk_bf16(a[2], a[3]); w.z = cvt_pk_bf16(a[4], a[5]); w.w = cvt_pk_bf16(a[6], a[7]);
                *(u32x4*)(O + (size_t)row * 256 + col0) = w; }
    }
};
struct MoeGather {
    static constexpr bool ON = true;
    const int* e2t; const PG8_LAS int* eoff; int shift, ld;
    __device__ __forceinline__ unsigned row(const Unit& u, int r) const { const int e = u.pn >> shift; const unsigned t = (unsigned)e2t[(size_t)e * ld + (u.pm * BM + r - eoff[e])]; return t < (unsigned)ld ? t : (unsigned)(ld - 1); }
};
struct MoeOrder {
    const PG8_LAS int* pexp; int np, shift, G, c;
    __device__ __forceinline__ bool next(int i, Unit& u) const {
        const int L = i * G + c; if (L >= (np << shift)) return false;
        const int p = L >> shift; const int e = __builtin_amdgcn_readfirstlane(pexp[p]);
        u.pm = p; u.pn = (e << shift) + (L & ((1 << shift) - 1)); return true;
    }
    __device__ __forceinline__ void a_ready(const Unit&) const {}
    __device__ __forceinline__ void done(const Unit&) const {}
};
struct NoGather { static constexpr bool ON = false; __device__ __forceinline__ unsigned row(const Unit&, int) const { return 0u; } };
template <class Epi, class Sched, bool ALIGN_EPI = false, bool SP2 = false, class AG = NoGather, bool NOLOAD = false, int NOLDS = 0>
__device__ __forceinline__ void gemm_phase(PG8_LAS unsigned char* lds, const Gemm g, const Sched& S, const Epi& E, const AG& GA = AG()) {
    static_assert(!AG::ON || SP2, "row gather is wired into the SP2 loop only");
    int tid_ = threadIdx.x; asm volatile("" : "+v"(tid_)); const int tid = tid_, wid = __builtin_amdgcn_readfirstlane(tid >> 6), lane = tid & 63, wr = wid >> 2, wc = wid & 3, fr = lane & 15, fq = lane >> 4;
    const int K = g.K, nt = K / BK;
    unsigned voffA[2], voffB[2]; int aR[2], aC[2];
#pragma unroll
    for (int i = 0; i < 2; ++i) { int R, C; stage_rc(tid * 16 + i * 8192, R, C); const int Rb = Epi::PERM ? ((R & ~31) + perm32(R & 31)) : R; aR[i] = R; aC[i] = C;
        voffA[i] = (unsigned)(R * K + C) * 2u; voffB[i] = (unsigned)(Rb * K + C) * 2u; }
    unsigned gcur0[2], gcur1[2], gnxt0[2], gnxt1[2];
#define PG8_GOFF(u, d0, d1) do { _Pragma("unroll") for (int _i = 0; _i < 2; ++_i) { d0[_i] = (GA.row(u, aR[_i]) * (unsigned)K + (unsigned)aC[_i]) * 2u; d1[_i] = (GA.row(u, HALF + aR[_i]) * (unsigned)K + (unsigned)aC[_i]) * 2u; } } while (0)
    const size_t kstep = (size_t)(BK * 2);
    const size_t hstep = (size_t)HALF * K * 2;
    const size_t tstep = 2 * hstep;
    const unsigned ldsw = (unsigned)wid * 1024u;
    const int aoff = lds_byte(wr * 64 + fr, fq * 8), boff = lds_byte(wc * 32 + fr, fq * 8);
#define PG8_SA(b, h) (((b) * 2 + (h)) * HTB)
#define PG8_SB(b, h) ((4 + (b) * 2 + (h)) * HTB)
#define PG8_STAGE(bufoff, gbase, voff) do { if (!NOLOAD) _Pragma("unroll") for (int _i = 0; _i < 2; ++_i) \
        __builtin_amdgcn_global_load_lds((const unsigned*)((const char*)(gbase) + (voff)[_i]), (PG8_LAS unsigned*)(lds + (bufoff) + ldsw + _i * 8192), 16, 0, 0); } while (0)
#define PG8_LDA(dst, b, h) do { if (!(NOLDS & 1)) _Pragma("unroll") for (int m = 0; m < 4; ++m) _Pragma("unroll") for (int k = 0; k < 2; ++k) dst[m][k] = *(const PG8_LAS bf16x8*)(lds + PG8_SA(b, h) + aoff + m * 2048 + k * 1024); } while (0)
#define PG8_LDB(dst, b, h) do { if (!(NOLDS & 2)) _Pragma("unroll") for (int n = 0; n < 2; ++n) _Pragma("unroll") for (int k = 0; k < 2; ++k) dst[n][k] = *(const PG8_LAS bf16x8*)(lds + PG8_SB(b, h) + boff + n * 2048 + k * 1024); } while (0)
#define PG8_MMA(ai, bj, At, Bt) do { __builtin_amdgcn_s_setprio(1); _Pragma("unroll") for (int m = 0; m < 4; ++m) _Pragma("unroll") for (int n = 0; n < 2; ++n) _Pragma("unroll") for (int k = 0; k < 2; ++k) \
        acc[ai][bj][m][n] = __builtin_amdgcn_mfma_f32_16x16x32_bf16(Bt[n][k], At[m][k], acc[ai][bj][m][n], 0, 0, 0); __builtin_amdgcn_s_setprio(0); } while (0)
#define PG8_WAIT_V(n) asm volatile("s_waitcnt vmcnt(" #n ")" ::: "memory")
#define PG8_WAIT_L(n) asm volatile("s_waitcnt lgkmcnt(" #n ")" ::: "memory")
#define PG8_BAR do { if (!(NOLDS & 4)) __builtin_amdgcn_s_barrier(); } while (0)
#define PG8_SCHED __builtin_amdgcn_sched_barrier(0)
    Unit cur, nxt; int ui = 0;
    if (!S.next(0, cur)) return;
    f32x4 acc[2][2][4][2];
#pragma unroll
    for (int a = 0; a < 2; ++a)
#pragma unroll
        for (int b = 0; b < 2; ++b)
#pragma unroll
            for (int m = 0; m < 4; ++m)
#pragma unroll
                for (int n = 0; n < 2; ++n) acc[a][b][m][n] = (f32x4){0.f, 0.f, 0.f, 0.f};
    bf16x8 At[4][2], B0[2][2], B1[2][2];
    if (NOLDS) { _Pragma("unroll") for (int m = 0; m < 4; ++m) _Pragma("unroll") for (int k = 0; k < 2; ++k) { At[m][k] = (bf16x8){0, 0, 0, 0, 0, 0, 0, 0}; asm volatile("" : "+v"(At[m][k])); }
        _Pragma("unroll") for (int n = 0; n < 2; ++n) _Pragma("unroll") for (int k = 0; k < 2; ++k) { B0[n][k] = (bf16x8){0, 0, 0, 0, 0, 0, 0, 0}; asm volatile("" : "+v"(B0[n][k])); B1[n][k] = B0[n][k]; asm volatile("" : "+v"(B1[n][k])); } }
    const char* cA = (const char*)g.A + (AG::ON ? (size_t)0 : (size_t)cur.pm * tstep); const char* cB = (const char*)g.Bt + (size_t)cur.pn * tstep;
    if constexpr (AG::ON) { PG8_GOFF(cur, gcur0, gcur1); gnxt0[0] = gcur0[0]; gnxt0[1] = gcur0[1]; gnxt1[0] = gcur1[0]; gnxt1[1] = gcur1[1]; }
#define PG8_STAGE_A(bufoff, base, half, G0, G1) do { if constexpr (AG::ON) { if ((half) == 0) PG8_STAGE(bufoff, base, G0); else PG8_STAGE(bufoff, base, G1); } else { PG8_STAGE(bufoff, (base) + (half) * hstep, voffA); } } while (0)
    S.a_ready(cur);
    if constexpr (SP2) {
        PG8_STAGE(PG8_SB(0, 0), cB, voffB); PG8_STAGE(PG8_SB(0, 1), cB + hstep, voffB); PG8_STAGE_A(PG8_SA(0, 0), cA, 0, gcur0, gcur1); PG8_STAGE_A(PG8_SA(0, 1), cA, 1, gcur0, gcur1);
        if (wr == 1) PG8_BAR;
        PG8_WAIT_V(2); PG8_BAR;
        PG8_STAGE(PG8_SB(1, 0), cB + kstep, voffB); PG8_STAGE_A(PG8_SA(1, 0), cA + kstep, 0, gcur0, gcur1); PG8_STAGE(PG8_SB(1, 1), cB + hstep + kstep, voffB);
        PG8_WAIT_V(6); PG8_BAR;
    } else {
        PG8_STAGE(PG8_SB(0, 0), cB, voffB); PG8_STAGE(PG8_SA(0, 0), cA, voffA); PG8_STAGE(PG8_SB(0, 1), cB + hstep, voffB); PG8_STAGE(PG8_SA(0, 1), cA + hstep, voffA);
        if (wr == 1) PG8_BAR;
        PG8_WAIT_V(4); PG8_BAR;
        PG8_STAGE(PG8_SB(1, 0), cB + kstep, voffB); PG8_STAGE(PG8_SA(1, 0), cA + kstep, voffA); PG8_STAGE(PG8_SB(1, 1), cB + hstep + kstep, voffB);
        PG8_WAIT_V(6); PG8_BAR;
    }
    for (;;) {
        const bool has_next = S.next(ui + 1, nxt);
        if constexpr (AG::ON) { if (has_next) PG8_GOFF(nxt, gnxt0, gnxt1); }
        const char* nA = (has_next && !AG::ON) ? (const char*)g.A + (size_t)nxt.pm * tstep : cA; const char* nB = has_next ? (const char*)g.Bt + (size_t)nxt.pn * tstep : cB;
        for (int t = 0; t < nt; t += 2) {
            const bool last = (t == nt - 2);
            const char* a1 = cA + (size_t)(t + 1) * kstep;
            const char* a2 = last ? nA : cA + (size_t)(t + 2) * kstep; const char* b2 = last ? nB : cB + (size_t)(t + 2) * kstep;
            const char* a3 = a2 + kstep; const char* b3 = b2 + kstep;
            if (last && has_next) S.a_ready(nxt);
            if constexpr (SP2) {
            unsigned g20[2], g21[2];
            if constexpr (AG::ON) { g20[0] = last ? gnxt0[0] : gcur0[0]; g20[1] = last ? gnxt0[1] : gcur0[1]; g21[0] = last ? gnxt1[0] : gcur1[0]; g21[1] = last ? gnxt1[1] : gcur1[1]; }
            PG8_LDB(B0, 0, 0); PG8_LDB(B1, 0, 1); PG8_SCHED; PG8_LDA(At, 0, 0); PG8_STAGE_A(PG8_SA(1, 1), a1, 1, gcur0, gcur1);
            PG8_WAIT_V(8); PG8_WAIT_L(0); PG8_BAR; PG8_MMA(0, 0, At, B0); PG8_MMA(0, 1, At, B1); PG8_BAR; PG8_SCHED;
            PG8_LDA(At, 0, 1); PG8_STAGE(PG8_SB(0, 0), b2, voffB); PG8_STAGE(PG8_SB(0, 1), b2 + hstep, voffB); PG8_STAGE_A(PG8_SA(0, 0), a2, 0, g20, g21);
            PG8_WAIT_V(8); PG8_WAIT_L(0); PG8_BAR; PG8_MMA(1, 0, At, B0); PG8_MMA(1, 1, At, B1); PG8_BAR; PG8_SCHED;
            PG8_LDB(B0, 1, 0); PG8_LDB(B1, 1, 1); PG8_SCHED; PG8_LDA(At, 1, 0); PG8_STAGE_A(PG8_SA(0, 1), a2, 1, g20, g21);
            PG8_WAIT_V(8); PG8_WAIT_L(0); PG8_BAR; PG8_MMA(0, 0, At, B0); PG8_MMA(0, 1, At, B1); PG8_BAR; PG8_SCHED;
            PG8_LDA(At, 1, 1); PG8_STAGE(PG8_SB(1, 0), b3, voffB); PG8_STAGE(PG8_SB(1, 1), b3 + hstep, voffB); PG8_STAGE_A(PG8_SA(1, 0), a3, 0, g20, g21);
            PG8_WAIT_V(8); PG8_WAIT_L(0); PG8_BAR; PG8_MMA(1, 0, At, B0); PG8_MMA(1, 1, At, B1); PG8_BAR; PG8_SCHED;
            } else {
            PG8_LDB(B0, 0, 0); PG8_SCHED; PG8_LDA(At, 0, 0); PG8_STAGE(PG8_SA(1, 1), a1 + hstep, voffA);
            PG8_WAIT_L(8); PG8_BAR; PG8_WAIT_L(0); PG8_MMA(0, 0, At, B0); PG8_BAR; PG8_SCHED;
            PG8_LDB(B1, 0, 1); PG8_STAGE(PG8_SB(0, 0), b2, voffB);
            PG8_BAR; PG8_WAIT_L(0); PG8_MMA(0, 1, At, B1); PG8_BAR;
            PG8_LDA(At, 0, 1); PG8_STAGE(PG8_SA(0, 0), a2, voffA);
            PG8_BAR; PG8_WAIT_L(0); PG8_MMA(1, 0, At, B0); PG8_BAR; PG8_SCHED;
            PG8_STAGE(PG8_SB(0, 1), b2 + hstep, voffB);
            PG8_WAIT_V(6); PG8_BAR; PG8_MMA(1, 1, At, B1); PG8_BAR;
            PG8_LDB(B0, 1, 0); PG8_SCHED; PG8_LDA(At, 1, 0); PG8_STAGE(PG8_SA(0, 1), a2 + hstep, voffA);
            PG8_WAIT_L(8); PG8_BAR; PG8_WAIT_L(0); PG8_MMA(0, 0, At, B0); PG8_BAR; PG8_SCHED;
            PG8_LDB(B1, 1, 1); PG8_STAGE(PG8_SB(1, 0), b3, voffB);
            PG8_BAR; PG8_WAIT_L(0); PG8_MMA(0, 1, At, B1); PG8_BAR;
            PG8_LDA(At, 1, 1); PG8_STAGE(PG8_SA(1, 0), a3, voffA);
            PG8_BAR; PG8_WAIT_L(0); PG8_MMA(1, 0, At, B0); PG8_BAR; PG8_SCHED;
            PG8_STAGE(PG8_SB(1, 1), b3 + hstep, voffB);
            PG8_WAIT_V(6); PG8_BAR; PG8_MMA(1, 1, At, B1); PG8_BAR;
            }
        }
        if constexpr (ALIGN_EPI) { if (wr == 0) PG8_BAR; }
        if constexpr (!Epi::AFTER_DRAIN) { E(acc, cur, wr, wc, fr, fq); S.done(cur); }
        if (!has_next) break;
#pragma unroll
        for (int a = 0; a < 2; ++a)
#pragma unroll
            for (int b = 0; b < 2; ++b)
#pragma unroll
                for (int m = 0; m < 4; ++m)
#pragma unroll
                    for (int n = 0; n < 2; ++n) acc[a][b][m][n] = (f32x4){0.f, 0.f, 0.f, 0.f};
        cur = nxt; cA = nA; cB = nB; ++ui;
        if constexpr (AG::ON) { gcur0[0] = gnxt0[0]; gcur0[1] = gnxt0[1]; gcur1[0] = gnxt1[0]; gcur1[1] = gnxt1[1]; }
        if constexpr (ALIGN_EPI) { if (wr == 1) PG8_BAR; }
    }
    PG8_WAIT_V(0);
    if constexpr (!ALIGN_EPI) { if (wr == 0) PG8_BAR; }
    PG8_BAR;
    if constexpr (Epi::AFTER_DRAIN) { E.fused(acc, cur, wr, wc, fr, fq, lds, wid, lane); S.done(cur); }
#undef PG8_SA
#undef PG8_SB
#undef PG8_STAGE
#undef PG8_STAGE_A
#undef PG8_GOFF
#undef PG8_LDA
#undef PG8_LDB
#undef PG8_MMA
#undef PG8_WAIT_V
#undef PG8_WAIT_L
#undef PG8_BAR
#undef PG8_SCHED
}
}

#include <hip/hip_bf16.h>
#include <cmath>
namespace attn_body {
using bf16=__hip_bfloat16;
using bf16x8=__attribute__((ext_vector_type(8)))short;
using s16x4=__attribute__((ext_vector_type(4)))short;
using f32x16=__attribute__((ext_vector_type(16)))float;
using u32x4=__attribute__((ext_vector_type(4)))unsigned;
constexpr int BATCH=4,NVH=32,SEQ=8192,D=64,PQ=1024,PO=1024;
constexpr int NW=8,QBLK=32,QB=QBLK*NW,KVBLK=64,NQB=SEQ/QB;
constexpr int ATTN_UNIT_ROWS=QB;
__device__ __forceinline__ int crow(int r,int hi){return (r&3)+8*(r>>2)+4*hi;}
#define SBAR() __builtin_amdgcn_sched_barrier(0)
__device__ __forceinline__ void cmask(f32x16&p0,f32x16&p1,int jb,int qrel,int hi){
  const float NEG=-INFINITY; int kb=64*jb+4*hi;
  #pragma unroll
  for(int r=0;r<16;++r){int kv=kb+(r&3)+8*(r>>2); if(kv>qrel)p0[r]=NEG; if(kv+32>qrel)p1[r]=NEG;}
}

constexpr int NSLOT=3, SLOTB=8192;
constexpr int LDS_K=0, LDS_V=NSLOT*SLOTB, LDS_WS=3*NSLOT*SLOTB, LDS_OST=LDS_WS+NW*64*4, LDS_BYTES=LDS_OST+NW*4096;
constexpr float C2=0.125f*1.4426950408889634f;
__device__ __forceinline__ void glds16(const void*gsrc,unsigned lds_dst){unsigned keep;
  asm volatile("s_mov_b32 %0, m0\n\ts_mov_b32 m0, %2\n\ts_nop 0\n\tglobal_load_lds_dwordx4 %1, off\n\ts_mov_b32 m0, %0":"=&s"(keep):"v"(gsrc),"s"(lds_dst):"memory");}
__device__ __forceinline__ float max3f(float a,float b,float c){float r;asm("v_max3_f32 %0, %1, %2, %3":"=v"(r):"v"(a),"v"(b),"v"(c));return r;}
__device__ __forceinline__ float max2f(float a,float b){float r;asm("v_max_f32_e32 %0, %1, %2":"=v"(r):"v"(a),"v"(b));return r;}
__device__ __forceinline__ float fadd_s(float a,float b){float r;asm("v_add_f32_e32 %0, %1, %2":"=v"(r):"v"(a),"v"(b));return r;}
__device__ __forceinline__ float fsub_s(float a,float b){float r;asm("v_sub_f32_e32 %0, %1, %2":"=v"(r):"v"(a),"v"(b));return r;}
typedef float f32x2_t __attribute__((ext_vector_type(2))); typedef __bf16 bf16x2_t __attribute__((ext_vector_type(2)));
__device__ __forceinline__ unsigned cvtpk_s(float lo,float hi){f32x2_t v={lo,hi};bf16x2_t b=__builtin_convertvector(v,bf16x2_t);return __builtin_bit_cast(unsigned,b);}
#define WAIT_BAR(N) asm volatile("s_waitcnt vmcnt(" #N ") lgkmcnt(0)\n\ts_barrier":::"memory")

__device__ __forceinline__ void qkt(f32x16&p0,f32x16&p1,const char*Kslot,const bf16x8*qr,const f32x16&negm,int r32,int hi){
  const char*kb=Kslot+hi*1024+r32*16;
  #pragma unroll
  for(int d0=0;d0<4;++d0){
    const bf16x8 b0=*reinterpret_cast<const bf16x8*>(kb+d0*2048);
    const bf16x8 b1=*reinterpret_cast<const bf16x8*>(kb+d0*2048+512);
    if(d0==0){p0=__builtin_amdgcn_mfma_f32_32x32x16_bf16(b0,qr[0],negm,0,0,0);p1=__builtin_amdgcn_mfma_f32_32x32x16_bf16(b1,qr[0],negm,0,0,0);}
    else{p0=__builtin_amdgcn_mfma_f32_32x32x16_bf16(b0,qr[d0],p0,0,0,0);p1=__builtin_amdgcn_mfma_f32_32x32x16_bf16(b1,qr[d0],p1,0,0,0);}}
}
typedef __attribute__((address_space(3))) const char* lds_cptr;
typedef short v4i16_t __attribute__((ext_vector_type(4)));
__device__ __forceinline__ void kload8(bf16x8*kf,lds_cptr kp){
  kf[0]=*(const __attribute__((address_space(3))) bf16x8*)(kp);      kf[1]=*(const __attribute__((address_space(3))) bf16x8*)(kp+512);
  kf[2]=*(const __attribute__((address_space(3))) bf16x8*)(kp+2048); kf[3]=*(const __attribute__((address_space(3))) bf16x8*)(kp+2560);
  kf[4]=*(const __attribute__((address_space(3))) bf16x8*)(kp+4096); kf[5]=*(const __attribute__((address_space(3))) bf16x8*)(kp+4608);
  kf[6]=*(const __attribute__((address_space(3))) bf16x8*)(kp+6144); kf[7]=*(const __attribute__((address_space(3))) bf16x8*)(kp+6656);
}
__device__ __forceinline__ void kload2(bf16x8*kf,lds_cptr kp,int j){ kf[2*j]=*(const __attribute__((address_space(3))) bf16x8*)(kp+j*2048); kf[2*j+1]=*(const __attribute__((address_space(3))) bf16x8*)(kp+j*2048+512); }
__device__ __forceinline__ s16x4 vtr(lds_cptr p){ return __builtin_bit_cast(s16x4,__builtin_amdgcn_ds_read_tr16_b64_v4i16((__attribute__((address_space(3))) v4i16_t*)p)); }
__device__ __forceinline__ float rowmax(const f32x16&p0,const f32x16&p1){
  float a=max3f(p0[0],p0[1],p1[0]),b=max3f(p0[2],p0[3],p1[1]);a=max3f(a,p1[2],p1[3]);
  #pragma unroll
  for(int r=4;r<16;r+=4){a=max3f(a,p0[r],p0[r+1]);b=max3f(b,p0[r+2],p0[r+3]);a=max3f(a,p1[r],p1[r+1]);b=max3f(b,p1[r+2],p1[r+3]);}
  const float m=max2f(a,b);
  auto rr=__builtin_amdgcn_permlane32_swap(__float_as_uint(m),__float_as_uint(m),false,false);
  return max2f(__uint_as_float(rr[0]),__uint_as_float(rr[1]));
}
__device__ __forceinline__ void pv(f32x16*o,int vb,bf16x8 pa0,bf16x8 pa1,bf16x8 pa2,bf16x8 pa3){
  #pragma unroll
  for(int d0=0;d0<4;++d0){s16x4 lo[4],hi[4];
    #pragma unroll
    for(int ks=0;ks<4;++ks){
      asm volatile("ds_read_b64_tr_b16 %0,%1 offset:%c2":"=&v"(lo[ks]):"v"(vb),"i"(d0*4096+ks*1024):"memory");
      asm volatile("ds_read_b64_tr_b16 %0,%1 offset:%c2":"=&v"(hi[ks]):"v"(vb),"i"(d0*4096+ks*1024+512):"memory");}
    asm volatile("s_waitcnt lgkmcnt(0)":::"memory");SBAR();
    #define PK(k) (bf16x8){lo[k][0],lo[k][1],lo[k][2],lo[k][3],hi[k][0],hi[k][1],hi[k][2],hi[k][3]}
    o[d0]=__builtin_amdgcn_mfma_f32_32x32x16_bf16(pa0,PK(0),o[d0],0,0,0);
    o[d0]=__builtin_amdgcn_mfma_f32_32x32x16_bf16(pa1,PK(1),o[d0],0,0,0);
    o[d0]=__builtin_amdgcn_mfma_f32_32x32x16_bf16(pa2,PK(2),o[d0],0,0,0);
    o[d0]=__builtin_amdgcn_mfma_f32_32x32x16_bf16(pa3,PK(3),o[d0],0,0,0);
    #undef PK
  }
}

#ifndef ATTN_STORE16
#define ATTN_STORE16(p,v) (*(u32x4*)(p)=(v))
#endif
template<int THRL> __device__ __forceinline__ void attn_unit(int b,int qcol,int kcol,int vcol,int ocol,int qb,const bf16*Q,const bf16*__restrict__ K,const bf16*__restrict__ V,bf16*O,bf16*O2,int mode,float lam,const __attribute__((address_space(3))) float*gn,char*shm,bool pre,bool has_next,int nb,int nkcol,int nvcol){
  int tid_=threadIdx.x; asm volatile("":"+v"(tid_)); const int tid=tid_,lane=tid&63,r32=lane&31,hi=lane>>5; const int wid=__builtin_amdgcn_readfirstlane(tid>>6);
  const long rowbase=(long)b*SEQ; const int q0=qb*QB;
  const bf16*Qw=Q+(rowbase+q0+wid*QBLK)*PQ+qcol;
  const bf16*Kh=K+rowbase*PQ+kcol,*Vh=V+rowbase*PQ+vcol;
  const unsigned lds0=(unsigned)(uintptr_t)shm;
  float*wsf=(float*)(shm+LDS_WS)+wid*64;
  const bf16*ksrc=Kh+(long)lane*PQ+wid*8;
  const bf16*vsrc=Vh+(long)(16*(wid&3)+(lane>>2))*PQ+(wid>>2)*32+(lane&3)*8;
  const unsigned kdst=lds0+LDS_K+wid*1024, vdst=lds0+LDS_V+wid*1024;
  #define DMA_K(t,slot) glds16(ksrc+(long)(t)*KVBLK*PQ,(unsigned)__builtin_amdgcn_readfirstlane(kdst+(slot)))
  #define DMA_V(t,slot) do{ glds16(vsrc+(long)(t)*KVBLK*PQ,(unsigned)__builtin_amdgcn_readfirstlane(vdst+2*(slot))); glds16(vsrc+(long)(t)*KVBLK*PQ+64,(unsigned)__builtin_amdgcn_readfirstlane(vdst+2*(slot)+8192)); }while(0)
  const int vb0=(int)(lds0+LDS_V)+((lane>>4)&1)*32+(lane&3)*8+(4*hi+((lane&15)>>2))*64;
  const char*Kbase=shm+LDS_K; bf16x8 kf[8];
  const lds_cptr shm3=(lds_cptr)shm; const lds_cptr kp0=shm3+LDS_K+hi*1024+r32*16; const lds_cptr vp0=shm3+LDS_V+((lane>>4)&1)*32+(lane&3)*8+(4*hi+((lane&15)>>2))*64;
  const int NT=(q0+QB)/KVBLK;
  if(!pre){DMA_K(0,0);DMA_V(0,0);DMA_K(1,SLOTB);}
  typedef __attribute__((address_space(3))) bf16x8 lds_bf16x8;
  lds_bf16x8*const qst=(lds_bf16x8*)(shm3+LDS_OST+wid*4096)+lane;
  { bf16x8 qr[4];
    #pragma unroll
    for(int d0=0;d0<4;++d0)qr[d0]=*reinterpret_cast<const bf16x8*>(&Qw[(long)r32*PQ+d0*16+hi*8]);
    #pragma unroll
    for(int d0=0;d0<4;++d0)qst[64*d0]=qr[d0]; }
  float mhat=0.f,l_reg=0.f;f32x16 o[4];o[0]=f32x16{};o[1]=f32x16{};o[2]=f32x16{};o[3]=f32x16{};f32x16 negm=f32x16{};asm volatile("":"+v"(negm));
  const int qrel=wid*QBLK+r32;
  #define CMASK(P0,P1,t) do{int jb_=(t)-(NT-4); if(jb_>=0)cmask(P0,P1,jb_,qrel,hi);}while(0)
  bool resc=false;
  #define START(P0,P1) do{ const float rm=rowmax(P0,P1); resc=false; \
    { const float dl=rm; mhat=fadd_s(mhat,dl); \
      _Pragma("unroll") for(int r=0;r<16;++r){P0[r]=fsub_s(P0[r],dl);P1[r]=fsub_s(P1[r],dl);} \
      _Pragma("unroll") for(int r=0;r<16;++r)negm[r]=-mhat; asm volatile("":"+v"(negm)); } \
    _Pragma("unroll") for(int r=0;r<16;++r)P0[r]=__builtin_amdgcn_exp2f(P0[r]); }while(0)
  #define RESC() do{ if(resc){ asm volatile("s_waitcnt lgkmcnt(0)":::"memory"); \
      _Pragma("unroll") for(int d_=0;d_<4;++d_) _Pragma("unroll") for(int r=0;r<16;++r)o[d_][r]*=wsf[crow(r,hi)]; } }while(0)
  f32x16 pA0,pA1,pB0,pB1;
  int sl_prev=0,sl_cur=0,sl_next=SLOTB;
  #define ROT() do{sl_prev=sl_cur;sl_cur=sl_next;sl_next=(sl_next==(NSLOT-1)*SLOTB)?0:sl_next+SLOTB;}while(0)
  if(!pre)DMA_K(2,2*SLOTB);
  WAIT_BAR(4);
  { bf16x8 qr[4];
    #pragma unroll
    for(int d0=0;d0<4;++d0)qr[d0]=qst[64*d0];
    qkt(pA0,pA1,Kbase,qr,negm,r32,hi); }
  asm volatile("s_nop 15\n\ts_nop 7":"+v"(pA0),"+v"(pA1));CMASK(pA0,pA1,0);
  START(pA0,pA1);
  _Pragma("unroll") for(int r=0;r<16;++r)pA1[r]=__builtin_amdgcn_exp2f(pA1[r]);
  WAIT_BAR(0);
  DMA_K(3,0);DMA_V(1,SLOTB);
  ROT();
  kload8(kf,kp0+sl_cur);
  WAIT_BAR(3);
  bf16x8 vf[4]; u32x4 pw0,pw1,pw2,pw3;
  #define PKW(P,B) cvtpk_s(P[B],P[B+1])
  #define PAF(k) __builtin_bit_cast(bf16x8,pw##k)
  #define VFR(i) vf[i]
  #define PIN(x) asm volatile("":"+v"(x))
  #define MX3(a,b,c) __builtin_fmaxf(__builtin_fmaxf((a),(b)),(c))
  #define GAPA(MF,A0,A1,A2,A3,W0,W1,PW) do{ MF; sacc+=A0; sacc+=A1; sacc+=A2; sacc+=A3; PIN(sacc); W0; W1; PIN(PW); SBAR(); }while(0)
  #define EX(v) __builtin_amdgcn_exp2f(v)
  #define GAPB(MF,X,B) do{ MF; X[B]=EX(X[B]); X[B+1]=EX(X[B+1]); PIN(X); SBAR(); }while(0)
  #define VRD(n) do{ const s16x4 lo_=vtr(vp_+(((n)&3)*4096+((n)>>2)*1024)), hi_=vtr(vp_+(((n)&3)*4096+((n)>>2)*1024+512)); vf[(n)&3]=__builtin_shufflevector(lo_,hi_,0,1,2,3,4,5,6,7); }while(0)
  #define KRD(G,j) do{ if(G){ kload2(kf,kp0+sl_next,j); SBAR(); } }while(0)
  #define PVM(n,X,B) GAPB(o[(n)&3]=__builtin_amdgcn_mfma_f32_32x32x16_bf16(PAFN((n)>>2),VFR((n)&3),o[(n)&3],0,0,0), X,B)
  #define PAFN(k) ((k)==0?PAF(0):(k)==1?PAF(1):(k)==2?PAF(2):PAF(3))
  #define STEP(C0,C1,P0,P1,t,GK,GV,GL) do{ SBAR(); \
    const lds_cptr vp_=vp0+2*sl_prev; \
    bf16x8 q0_=qst[0],q1_=qst[64]; SBAR(); float sacc=(P0[0]+P0[1]); \
    GAPA(C0=__builtin_amdgcn_mfma_f32_32x32x16_bf16(kf[0],q0_,negm,0,0,0), P0[2],P0[3],P0[4],P0[5],     pw0[0]=PKW(P0,0), pw0[1]=PKW(P0,2), pw0); \
    GAPA(C1=__builtin_amdgcn_mfma_f32_32x32x16_bf16(kf[1],q0_,negm,0,0,0), P0[6],P0[7],P0[8],P0[9],     pw0[2]=PKW(P0,4), pw0[3]=PKW(P0,6), pw0); \
    bf16x8 q2_=qst[128]; SBAR(); \
    GAPA(C0=__builtin_amdgcn_mfma_f32_32x32x16_bf16(kf[2],q1_,C0,0,0,0),   P0[10],P0[11],P0[12],P0[13], pw1[0]=PKW(P0,8), pw1[1]=PKW(P0,10), pw1); \
    GAPA(C1=__builtin_amdgcn_mfma_f32_32x32x16_bf16(kf[3],q1_,C1,0,0,0),   P0[14],P0[15],P1[0],P1[1],   pw1[2]=PKW(P0,12),pw1[3]=PKW(P0,14), pw1); \
    bf16x8 q3_=qst[192]; SBAR(); \
    GAPA(C0=__builtin_amdgcn_mfma_f32_32x32x16_bf16(kf[4],q2_,C0,0,0,0),   P1[2],P1[3],P1[4],P1[5],     pw2[0]=PKW(P1,0), pw2[1]=PKW(P1,2), pw2); \
    GAPA(C1=__builtin_amdgcn_mfma_f32_32x32x16_bf16(kf[5],q2_,C1,0,0,0),   P1[6],P1[7],P1[8],P1[9],     pw2[2]=PKW(P1,4), pw2[3]=PKW(P1,6), pw2); \
    VRD(0); SBAR(); \
    GAPA(C0=__builtin_amdgcn_mfma_f32_32x32x16_bf16(kf[6],q3_,C0,0,0,0),   P1[10],P1[11],P1[12],P1[13], pw3[0]=PKW(P1,8), pw3[1]=PKW(P1,10), pw3); \
    VRD(1); VRD(2); SBAR(); \
    GAPA(C1=__builtin_amdgcn_mfma_f32_32x32x16_bf16(kf[7],q3_,C1,0,0,0),   P1[14],P1[15],0.f,0.f,       pw3[2]=PKW(P1,12),pw3[3]=PKW(P1,14), pw3); \
    l_reg+=sacc; \
    if(GK){DMA_K((t)+3,sl_cur);} if(GV){DMA_V((t)+1,sl_next);} \
    CMASK(C0,C1,t); \
    { float a=MX3(C0[0],C0[1],C1[0]),b=MX3(C0[2],C0[3],C1[1]); a=MX3(a,C1[2],C1[3]); \
      _Pragma("unroll") for(int r=4;r<16;r+=4){a=MX3(a,C0[r],C0[r+1]);b=MX3(b,C0[r+2],C0[r+3]);a=MX3(a,C1[r],C1[r+1]);b=MX3(b,C1[r+2],C1[r+3]);} \
      float rm=__builtin_fmaxf(a,b); { auto rr=__builtin_amdgcn_permlane32_swap(__float_as_uint(rm),__float_as_uint(rm),false,false); rm=__builtin_fmaxf(__uint_as_float(rr[0]),__uint_as_float(rr[1])); } \
      resc=false; \
      if(__builtin_expect(__any(rm>(float)THRL),0)){ const float dl=__builtin_fmaxf(rm,0.f); mhat+=dl; \
        _Pragma("unroll") for(int r=0;r<16;++r){C0[r]-=dl;C1[r]-=dl;} \
        _Pragma("unroll") for(int r=0;r<16;++r)negm[r]=-mhat; asm volatile("":"+v"(negm)); \
        const float f=__builtin_amdgcn_exp2f(-dl); l_reg*=f; if(hi==0)wsf[r32]=f; resc=true; } } \
    SBAR(); \
    VRD(3); SBAR(); PVM(0,C0,0); \
    VRD(4); SBAR(); PVM(1,C0,2); \
    VRD(5); SBAR(); PVM(2,C0,4); \
    VRD(6); SBAR(); KRD(GL,0); PVM(3,C0,6); \
    VRD(7); SBAR(); PVM(4,C0,8); \
    VRD(8); SBAR(); KRD(GL,1); PVM(5,C0,10); \
    VRD(9); SBAR(); PVM(6,C0,12); \
    VRD(10); SBAR(); KRD(GL,2); PVM(7,C0,14); \
    VRD(11); SBAR(); PVM(8,C1,0); \
    VRD(12); SBAR(); KRD(GL,3); PVM(9,C1,2); \
    VRD(13); SBAR(); PVM(10,C1,4); \
    VRD(14); SBAR(); PVM(11,C1,6); \
    VRD(15); SBAR(); PVM(12,C1,8); \
    PVM(13,C1,10); \
    PVM(14,C1,12); \
    PVM(15,C1,14); \
    }while(0)
  int t=1;
  #undef CMASK
  #define CMASK(P0,P1,t) do{}while(0)
  for(;t+5<NT;t+=2){
    STEP(pB0,pB1,pA0,pA1,t,true,true,true);     WAIT_BAR(3); RESC(); ROT();
    STEP(pA0,pA1,pB0,pB1,t+1,true,true,true);   WAIT_BAR(3); RESC(); ROT();
  }
  #undef CMASK
  #define CMASK(P0,P1,t) do{int jb_=(t)-(NT-4); if(jb_>=0)cmask(P0,P1,jb_,qrel,hi);}while(0)
  #define ENDW(tt) do{ if((tt)+3<NT){WAIT_BAR(3);} else if((tt)+2<NT){WAIT_BAR(2);} else {WAIT_BAR(0);} }while(0)
  for(;t+1<NT;t+=2){
    STEP(pB0,pB1,pA0,pA1,t,(t+3<NT),(t+1<NT),(t+1<NT));       ENDW(t);   RESC(); ROT();
    STEP(pA0,pA1,pB0,pB1,t+1,(t+4<NT),(t+2<NT),(t+2<NT));     ENDW(t+1); RESC(); ROT();
  }
  STEP(pB0,pB1,pA0,pA1,NT-1,false,false,false); RESC();
  { float sacc=pB0[0]+pB0[1]; _Pragma("unroll") for(int r=2;r<16;++r)sacc+=pB0[r]; _Pragma("unroll") for(int r=0;r<16;++r)sacc+=pB1[r]; l_reg+=sacc;
    pw0=(u32x4){PKW(pB0,0),PKW(pB0,2),PKW(pB0,4),PKW(pB0,6)};pw1=(u32x4){PKW(pB0,8),PKW(pB0,10),PKW(pB0,12),PKW(pB0,14)};pw2=(u32x4){PKW(pB1,0),PKW(pB1,2),PKW(pB1,4),PKW(pB1,6)};pw3=(u32x4){PKW(pB1,8),PKW(pB1,10),PKW(pB1,12),PKW(pB1,14)};
    SBAR(); pv(o,vb0+2*sl_cur,PAF(0),PAF(1),PAF(2),PAF(3)); }
  asm volatile("s_waitcnt lgkmcnt(0)\n\ts_barrier":::"memory");
  if(has_next){ const bf16*Kn=K+(long)nb*SEQ*PQ+nkcol,*Vn=V+(long)nb*SEQ*PQ+nvcol;
    const bf16*ksn=Kn+(long)lane*PQ+wid*8; const bf16*vsn=Vn+(long)(16*(wid&3)+(lane>>2))*PQ+(wid>>2)*32+(lane&3)*8;
    glds16(ksn,(unsigned)__builtin_amdgcn_readfirstlane(kdst));
    glds16(vsn,(unsigned)__builtin_amdgcn_readfirstlane(vdst)); glds16(vsn+64,(unsigned)__builtin_amdgcn_readfirstlane(vdst+8192));
    glds16(ksn+(long)KVBLK*PQ,(unsigned)__builtin_amdgcn_readfirstlane(kdst+SLOTB));
    glds16(ksn+(long)2*KVBLK*PQ,(unsigned)__builtin_amdgcn_readfirstlane(kdst+2*SLOTB)); }
  #undef PKW
  #undef PAF
  #undef VFR
  #undef PIN
  #undef MX3
  #undef GAPA
  #undef GAPB
  #undef PVM
  #undef PAFN
  #undef EX
  #undef VRD
  #undef KRD
  #undef STEP
  #undef ENDW
  {auto rr=__builtin_amdgcn_permlane32_swap(__float_as_uint(l_reg),__float_as_uint(l_reg),false,false);l_reg=__uint_as_float(rr[0])+__uint_as_float(rr[1]);}
  if(hi==0)wsf[32+r32]=l_reg;asm volatile("s_waitcnt lgkmcnt(0)":::"memory");
  float rli[16];
  #pragma unroll
  for(int r=0;r<16;++r)rli[r]=__builtin_amdgcn_rcpf(wsf[32+crow(r,hi)]);
  bf16*Ow=O+(rowbase+q0+wid*QBLK)*PO+ocol;
  { bf16*stg=(bf16*)(shm+LDS_OST)+wid*2048;
    if(mode==0){
      #pragma unroll
      for(int ps=0;ps<2;++ps){
        #pragma unroll
        for(int r=0;r<16;++r){const int orow=crow(r,hi);
          #pragma unroll
          for(int d0=0;d0<2;++d0)stg[orow*64+d0*32+r32]=__float2bfloat16(o[2*ps+d0][r]*rli[r]);}
        asm volatile("s_waitcnt lgkmcnt(0)":::"memory");
        #pragma unroll
        for(int i=0;i<4;++i){const int row=i*8+(lane>>3),ch=lane&7; const u32x4 v=*(const u32x4*)(stg+row*64+ch*8); ATTN_STORE16(Ow+(long)row*PO+ps*64+ch*8,v);}
        asm volatile("s_waitcnt lgkmcnt(0)":::"memory"); }
    } else {
      bf16*O2w=O2+(rowbase+q0+wid*QBLK)*PO+ocol;
      float df[2][4][8]; float ssq[4]={0.f,0.f,0.f,0.f};
      #pragma unroll
      for(int ps=0;ps<2;++ps){
        #pragma unroll
        for(int r=0;r<16;++r){const int orow=crow(r,hi);
          #pragma unroll
          for(int d0=0;d0<2;++d0)stg[orow*64+d0*32+r32]=__float2bfloat16(o[2*ps+d0][r]*rli[r]);}
        asm volatile("s_waitcnt lgkmcnt(0)":::"memory");
        #pragma unroll
        for(int i=0;i<4;++i){const int row=i*8+(lane>>3),ch=lane&7; const u32x4 v1=*(const u32x4*)(stg+row*64+ch*8);
          const unsigned long long*p0=(const unsigned long long*)(Ow+(long)row*PO+ps*64+ch*8);
          const unsigned long long a0=__hip_atomic_load(p0,__ATOMIC_RELAXED,__HIP_MEMORY_SCOPE_AGENT),a1=__hip_atomic_load(p0+1,__ATOMIC_RELAXED,__HIP_MEMORY_SCOPE_AGENT);
          const unsigned w0[4]={(unsigned)a0,(unsigned)(a0>>32),(unsigned)a1,(unsigned)(a1>>32)};
          #pragma unroll
          for(int e=0;e<4;++e){ const float x0=__uint_as_float(w0[e]<<16)-lam*__uint_as_float(v1[e]<<16), x1=__uint_as_float(w0[e]&0xffff0000u)-lam*__uint_as_float(v1[e]&0xffff0000u);
            df[ps][i][2*e]=x0; df[ps][i][2*e+1]=x1; ssq[i]+=x0*x0+x1*x1; } }
        asm volatile("s_waitcnt lgkmcnt(0)":::"memory"); }
      #pragma unroll
      for(int i=0;i<4;++i){ float q=ssq[i]; q+=__shfl_xor(q,1); q+=__shfl_xor(q,2); q+=__shfl_xor(q,4); ssq[i]=__builtin_amdgcn_rsqf(q*(1.f/128.f)+1e-5f); }
      #pragma unroll
      for(int ps=0;ps<2;++ps){ const int ch=lane&7; const __attribute__((address_space(3))) float*gp=gn+ps*64+ch*8; float g8[8];
        #pragma unroll
        for(int e=0;e<8;++e)g8[e]=gp[e];
        #pragma unroll
        for(int i=0;i<4;++i){const int row=i*8+(lane>>3); u32x4 w;
          w[0]=cvtpk_s(df[ps][i][0]*ssq[i]*g8[0],df[ps][i][1]*ssq[i]*g8[1]); w[1]=cvtpk_s(df[ps][i][2]*ssq[i]*g8[2],df[ps][i][3]*ssq[i]*g8[3]);
          w[2]=cvtpk_s(df[ps][i][4]*ssq[i]*g8[4],df[ps][i][5]*ssq[i]*g8[5]); w[3]=cvtpk_s(df[ps][i][6]*ssq[i]*g8[6],df[ps][i][7]*ssq[i]*g8[7]);
          ATTN_STORE16(O2w+(long)row*PO+ps*64+ch*8,w);} }
    } }
  asm volatile("s_waitcnt lgkmcnt(0)\n\ts_barrier":::"memory");
  #undef DMA_K
  #undef DMA_V
  #undef CMASK
  #undef START
  #undef RESC
  #undef ROT
}
constexpr int ATTN_LDS_BYTES=LDS_BYTES;
struct AttnTensors { const bf16* Q; const bf16* K; const bf16* V; bf16* O0; bf16* O2; float lam; const __attribute__((address_space(3))) float* gn; };
struct AttnUnit { int bh; int qb; };
struct StaticOrder {
  int vcu,G;
  __device__ __forceinline__ explicit StaticOrder(int grid,int block):vcu((grid%8==0)?(block%8)*(grid/8)+block/8:block),G(grid){}
  __device__ __forceinline__ bool next(int i,AttnUnit&u)const{ const int pi=vcu+(i>>1)*G; if(pi>=BATCH*8*16)return false; const int s=pi&15; u.bh=pi>>4; u.qb=(i&1)?31-s:s; return true; }
  __device__ __forceinline__ void a_ready(const AttnUnit&)const{}
  __device__ __forceinline__ void done(const AttnUnit&)const{}
};
template<class Sched,int THRL=8> __device__ __forceinline__ void attn_phase(char*lds,const AttnTensors&T,const Sched&S){
  AttnUnit u,un; bool pre=false;
  if(!S.next(0,u))return;
  for(int i=0;;++i){ S.a_ready(u); const int b=u.bh>>3,h=u.bh&7; const bool more=S.next(i+1,un); const int nb=un.bh>>3,nh=un.bh&7;
    for(int c=0;c<2;++c) attn_unit<THRL>(b,h*128+c*64,h*128+c*64,h*128,h*128,u.qb,T.Q,T.K,T.V,T.O0,T.O2,c,T.lam,T.gn,lds,pre||c==1,c==0||more,c==0?b:nb,c==0?h*128+64:nh*128,c==0?h*128:nh*128);
    S.done(u); if(!more)break; u=un; pre=true; }
}
#undef SBAR
#undef WAIT_BAR
}


constexpr int NWAVES = 8;
constexpr int T = 32768, D = 1024, SEQ = 8192, NB = 4;
constexpr int ML_H = 4, ML_DV = 512, ML_DQK = 256, ML_QK = 1024, ML_V = 2048, ML_LD = 6152, NCH = 128;
constexpr int VT_ROWS = 544;
constexpr int NEXP = 32, DEXP = 256, MAXPANEL = 288, MAXSLOT = MAXPANEL * 256;
constexpr float LAMBDA_INIT1 = 0.35550906759f;

constexpr size_t MiB = 1u << 20;
constexpr size_t WS_CTL = 0, CTL_ZERO_BYTES = 1 * MiB;
constexpr size_t WS_GATES = 1 * MiB;
constexpr size_t WS_SA = 2 * MiB, WS_SB = WS_SA + 512 * 1024, WS_SIS = 3 * MiB, WS_SFL = WS_SIS + 512 * 1024, WS_RS = 4 * MiB, WS_QN = WS_RS + 512 * 1024;
constexpr size_t WS_CHB = 5 * MiB, WS_CHM = WS_CHB + 8192, WS_DEC = WS_CHM + 8192;
constexpr size_t WS_WR = 5 * MiB + 512 * 1024;
constexpr size_t WS_TE = 6 * MiB, WS_TW = WS_TE + 256 * 1024, WS_TPOS = WS_TW + 256 * 1024, WS_TSLOT = WS_TPOS + 256 * 1024;
constexpr size_t WS_ERS = 1 * MiB, WS_RSTD = 5 * MiB;
constexpr size_t WS_E2T = 8 * MiB, WS_EW = 12 * MiB;
constexpr size_t WS_WML_IN = 16 * MiB, WS_WML_OUT = 28 * MiB;
constexpr size_t WS_KWT = 32 * MiB;
constexpr size_t WS_WDA_IN = 504 * MiB, WS_WDA_OUT = 510 * MiB, WS_WGU = 40 * MiB, WS_WDN = 72 * MiB;
constexpr size_t WS_WGU1 = 196 * MiB, WS_WDN1 = 228 * MiB;
constexpr size_t WS_R0 = 96 * MiB;
constexpr size_t WS_QKRAW = WS_R0, WS_OG = WS_R0 + 128 * MiB, WS_VT = WS_R0 + 256 * MiB;
constexpr size_t WS_WGU0 = WS_R0 + 192 * MiB, WS_WDN0 = WS_WGU0 + 32 * MiB;
constexpr size_t WS_PG = 488 * MiB;
constexpr size_t WS_HN = WS_R0;
constexpr size_t WS_ACT = WS_R0 + 64 * MiB, WS_YS = 352 * MiB;
constexpr size_t WS_AQ = 244 * MiB, WS_AK = WS_AQ + 64 * MiB, WS_AV = WS_AK + 64 * MiB, WS_AO = WS_AV + 64 * MiB;
constexpr size_t WS_END = WS_YS + 144 * MiB;
static_assert(WS_VT + (size_t)4 * VT_ROWS * T * 2 <= 488 * MiB && WS_END <= 496 * MiB && WS_AO + (size_t)T * 1024 * 2 <= 504 * MiB && WS_WDN0 + 16 * MiB <= WS_VT && WS_WDN1 + 16 * MiB <= WS_AQ && WS_ACT + 36 * MiB <= WS_WGU1, "d_ws map");
constexpr int CW_BAR = 4096;
constexpr int CW_CNT = 16384;

constexpr int RING_OFF = 0, RING_BYTES = 131072;
constexpr int LDSCTL_OFF = RING_BYTES, MISC_OFF = LDSCTL_OFF + 320;
constexpr int TAB_OFF = LDSCTL_OFF + 1024;
constexpr int TAB_PEXP = TAB_OFF, TAB_ECNT = TAB_OFF + 1280, TAB_EOFF = TAB_ECNT + 128, TAB_NP = TAB_EOFF + 136;
constexpr int LDS_BYTES = 147456;

#define GAS __attribute__((address_space(1)))
#define LAS __attribute__((address_space(3)))
typedef unsigned short bf16;
typedef unsigned v4u __attribute__((ext_vector_type(4)));
typedef unsigned v2u __attribute__((ext_vector_type(2)));
typedef float f32x4 __attribute__((ext_vector_type(4)));
typedef float f32x2 __attribute__((ext_vector_type(2)));
typedef short bf16x8 __attribute__((ext_vector_type(8)));
typedef GAS unsigned gu32;
#define RLX_AGENT __ATOMIC_RELAXED, __HIP_MEMORY_SCOPE_AGENT
#define LDS_WAIT() asm volatile("s_waitcnt lgkmcnt(0)" ::: "memory")
__device__ __forceinline__ unsigned f2bf(float f) { unsigned u = __builtin_bit_cast(unsigned, f); return (u + 0x7fffu + ((u >> 16) & 1u)) >> 16; }
__device__ __forceinline__ unsigned pk2(float lo, float hi) { typedef float f2v_t __attribute__((ext_vector_type(2))); typedef __bf16 b2v_t __attribute__((ext_vector_type(2)));
    f2v_t v = {lo, hi}; b2v_t b = __builtin_convertvector(v, b2v_t); return __builtin_bit_cast(unsigned, b); }
__device__ __forceinline__ float bf_lo(unsigned w) { return __builtin_bit_cast(float, w << 16); }
__device__ __forceinline__ float bf_hi(unsigned w) { return __builtin_bit_cast(float, w & 0xffff0000u); }
__device__ __forceinline__ float bf1(bf16 h) { return __builtin_bit_cast(float, (unsigned)h << 16); }
__device__ __forceinline__ float wave_sum(float v) {
#pragma unroll
    for (int o = 1; o < 64; o <<= 1) v += __shfl_xor(v, o);
    return v;
}
__device__ __forceinline__ float wave_max(float v) {
#pragma unroll
    for (int o = 1; o < 64; o <<= 1) v = fmaxf(v, __shfl_xor(v, o));
    return v;
}
__device__ __forceinline__ float prefix_sum_incl(float v, int lane) {
#pragma unroll
    for (int o = 1; o < 64; o <<= 1) { const float u = __shfl_up(v, o); if (lane >= o) v += u; }
    return v;
}
__device__ __forceinline__ float prefix_max_incl(float v, int lane) {
#pragma unroll
    for (int o = 1; o < 64; o <<= 1) { const float u = __shfl_up(v, o); if (lane >= o) v = fmaxf(v, u); }
    return v;
}
__device__ __forceinline__ float log_sigmoid(float z) { return fminf(z, 0.f) - log1pf(__expf(-fabsf(z))); }
__device__ __forceinline__ float sigmoidf_(float z) { return 1.f / (1.f + __expf(-z)); }
#define XB_TMO      128
#define XB_XCNT(j)  (256  + 64 * (j))
#define XB_XSUB(j)  (1280 + 64 * (j))
#define XB_XGEN(j)  (2304 + 64 * (j))
#define XB_TOP      3328
#define XB_TOPGEN   3392
#define XCD_BAR_WORDS 3456
#define XB_SPIN_CAP (1u << 18)

__device__ __forceinline__ unsigned xb_ld(unsigned* p)              { return __hip_atomic_load(p, __ATOMIC_RELAXED, __HIP_MEMORY_SCOPE_AGENT); }
__device__ __forceinline__ unsigned xb_add(unsigned* p, unsigned v) { return __hip_atomic_fetch_add(p, v, __ATOMIC_RELAXED, __HIP_MEMORY_SCOPE_AGENT); }
__device__ __forceinline__ unsigned xb_xcc_id() { return (unsigned)__builtin_amdgcn_s_getreg((3 << 11) | 20) & 0xFu; }
#define XB_SPIN(cond, bar) do { unsigned _sp = 0; while (cond) { __builtin_amdgcn_s_sleep(1); \
    if ((++_sp & 255u) == 0u) { if (xb_ld(&(bar)[XB_TMO])) break; if (_sp > XB_SPIN_CAP) { atomicAdd(&(bar)[XB_TMO], 1u); break; } } } } while (0)

struct XcdBarrier {
    unsigned* bar; unsigned x;
    volatile LAS unsigned* st;
};

__device__ __forceinline__ XcdBarrier xcd_barrier_post(unsigned* bar, volatile LAS unsigned* st) {
    XcdBarrier b; b.bar = bar; b.x = xb_xcc_id(); b.st = st;
    if (threadIdx.x == 0) (void)xb_add(&bar[XB_XCNT(b.x)], 1u);
    return b;
}
__device__ __forceinline__ void xcd_barrier_complete(unsigned* bar, unsigned x, unsigned& nloc, unsigned& nx) {
    const unsigned G = gridDim.x * gridDim.y * gridDim.z;
    unsigned sum, cnt, mine, sp = 0u;
    for (;;) {
        sum = 0u; cnt = 0u; mine = 0u;
#pragma unroll
        for (unsigned j = 0; j < 16; ++j) { const unsigned c = xb_ld(&bar[XB_XCNT(j)]); sum += c; cnt += (c > 0u) ? 1u : 0u; mine = (j == x) ? c : mine; }
        if (sum == G) break;
        __builtin_amdgcn_s_sleep(1);
        if ((++sp & 255u) == 0u) { if (xb_ld(&bar[XB_TMO])) break; if (sp > XB_SPIN_CAP) { atomicAdd(&bar[XB_TMO], 1u); break; } }
    }
    nloc = mine > 0u ? mine : 1u; nx = cnt > 0u ? cnt : 1u;
}

__device__ __forceinline__ void xcd_barrier(const XcdBarrier& b) {
    asm volatile("s_waitcnt vmcnt(0)" ::: "memory");
    __syncthreads();
    if (threadIdx.x == 0) {
        unsigned* bar = b.bar;
        __builtin_amdgcn_s_waitcnt(0);
        unsigned nloc = b.st[0], nx = b.st[1];
        if (nloc == 0u) { xcd_barrier_complete(bar, b.x, nloc, nx); b.st[0] = nloc; b.st[1] = nx; }
        const unsigned old = xb_add(&bar[XB_XSUB(b.x)], 1u);
        const unsigned gen = old / nloc;
        if (old + 1u == (gen + 1u) * nloc) {
            __builtin_amdgcn_fence(__ATOMIC_RELEASE, "agent");
            asm volatile("s_waitcnt vmcnt(0)" ::: "memory");
            const unsigned og = xb_add(&bar[XB_TOP], 1u);
            const unsigned tg = og / nx;
            if (og + 1u == (tg + 1u) * nx) xb_add(&bar[XB_TOPGEN], 1u);
            else XB_SPIN(xb_ld(&bar[XB_TOPGEN]) == tg, bar);
            __builtin_amdgcn_fence(__ATOMIC_ACQUIRE, "agent");
            xb_add(&bar[XB_XGEN(b.x)], 1u);
            asm volatile("s_waitcnt vmcnt(0)" ::: "memory");
        } else {
            XB_SPIN(xb_ld(&bar[XB_XGEN(b.x)]) == gen, bar);
            __builtin_amdgcn_fence(__ATOMIC_ACQUIRE, "agent");
            asm volatile("s_waitcnt vmcnt(0)" ::: "memory");
        }
    }
    __syncthreads();
}


struct Ctx { LAS unsigned char* lds; int tid, lane, wave, vcu, G, gw, NGW; };

__device__ __forceinline__ void tr_item(const float* W, int ld, int K, int k0, int c0, bf16* WT, int drow0, LAS float* scr, int lane, const float* kscale = nullptr) {
    f32x4 wv[8];
#pragma unroll
    for (int i = 0; i < 8; ++i) { wv[i] = *(const GAS f32x4*)(W + (size_t)(k0 + 8 * i + (lane >> 3)) * ld + c0 + 4 * (lane & 7)); if (kscale) wv[i] = wv[i] * kscale[k0 + 8 * i + (lane >> 3)]; }
#pragma unroll
    for (int i = 0; i < 8; ++i) { LAS float* d = scr + (8 * i + (lane >> 3)) * 33 + 4 * (lane & 7); d[0] = wv[i].x; d[1] = wv[i].y; d[2] = wv[i].z; d[3] = wv[i].w; }
    LDS_WAIT(); asm volatile("" ::: "memory");
    const int c = lane & 7;
#pragma unroll
    for (int j = 0; j < 4; ++j) { const int n = (lane >> 3) + 8 * j; const LAS float* s = scr + (8 * c) * 33 + n;
        v4u o; o.x = pk2(s[0 * 33], s[1 * 33]); o.y = pk2(s[2 * 33], s[3 * 33]); o.z = pk2(s[4 * 33], s[5 * 33]); o.w = pk2(s[6 * 33], s[7 * 33]);
        *(GAS v4u*)(WT + (size_t)(drow0 + n) * K + k0 + 8 * c) = o; }
    LDS_WAIT(); asm volatile("" ::: "memory");
}
__device__ __forceinline__ void tr_load(f32x4 (&wv)[8], float (&ks)[8], const float* W, int ld, int k0, int c0, int lane, const float* kscale) {
#pragma unroll
    for (int i = 0; i < 8; ++i) { wv[i] = *(const GAS f32x4*)(W + (size_t)(k0 + 8 * i + (lane >> 3)) * ld + c0 + 4 * (lane & 7)); ks[i] = kscale ? kscale[k0 + 8 * i + (lane >> 3)] : 1.f; }
}
__device__ __forceinline__ void tr_finish(const f32x4 (&wv)[8], const float (&ks)[8], int K, int k0, bf16* WT, int drow0, LAS float* scr, int lane) {
#pragma unroll
    for (int i = 0; i < 8; ++i) { LAS float* d = scr + (8 * i + (lane >> 3)) * 33 + 4 * (lane & 7); const f32x4 w = wv[i] * ks[i]; d[0] = w.x; d[1] = w.y; d[2] = w.z; d[3] = w.w; }
    LDS_WAIT(); asm volatile("" ::: "memory");
    const int c = lane & 7;
#pragma unroll
    for (int j = 0; j < 4; ++j) { const int n = (lane >> 3) + 8 * j; const LAS float* s = scr + (8 * c) * 33 + n;
        v4u o; o.x = pk2(s[0 * 33], s[1 * 33]); o.y = pk2(s[2 * 33], s[3 * 33]); o.z = pk2(s[4 * 33], s[5 * 33]); o.w = pk2(s[6 * 33], s[7 * 33]);
        *(GAS v4u*)(WT + (size_t)(drow0 + n) * K + k0 + 8 * c) = o; }
    LDS_WAIT(); asm volatile("" ::: "memory");
}
__device__ __forceinline__ void tr_matrix_items(const Ctx& C, const float* W, int K, int N, bf16* WT, int& it0) {
    (void)C; (void)W; (void)K; (void)N; (void)WT; (void)it0;
}

__device__ __forceinline__ void conv_ml_out(const Ctx& C, const float* ml_w_out, unsigned char* ws) {
    LAS float* scr = (LAS float*)(C.lds + RING_OFF + C.wave * 16384); bf16* wml_out = (bf16*)(ws + WS_WML_OUT);
    for (int it = C.gw; it < 32 * 32; it += C.NGW) { const int kb = it / 32, nb = it % 32; tr_item(ml_w_out, D, ML_V, kb * 64, nb * 32, wml_out, nb * 32, scr, C.lane); }
}
__device__ __forceinline__ void p0_prologue(const Ctx& C, const float* x, const float* norm_mix0, const float* ml_w_in, const float* ml_w_out,
                                            const float* norm_ffn, const float* w_group, const float* w_expert, unsigned char* ws, bf16* hn0) {
    LAS float* scr = (LAS float*)(C.lds + RING_OFF + C.wave * 16384);
    bf16* wml_in = (bf16*)(ws + WS_WML_IN); bf16* wml_out = (bf16*)(ws + WS_WML_OUT);
    constexpr int I_IN = 16 * 192;
    for (int it = C.gw; it < I_IN; it += C.NGW) {
        const int kb = it / 192, nb = it % 192, c0 = nb * 32;
        const int drow = c0 < 2048 ? c0 : (c0 < 4096 ? c0 + 2048 : c0 - 2048);
        tr_item(ml_w_in, ML_LD, D, kb * 64, c0, wml_in, drow, scr, C.lane);
    }
    (void)wml_out; (void)ml_w_out;
    { bf16* WRH = (bf16*)(ws + WS_WR); bf16* WRL = WRH + 2 * 32 * 3 * 4 * 16 * 8; const int n = 2 * 32 * 3 * 4 * 16 * 8;
      for (int idx = C.gw * 64 + C.lane; idx < n; idx += C.NGW * 64) {
          int r = idx; const int j = r & 7; r >>= 3; const int c15 = r & 15; r >>= 4; const int g4 = r & 3; r >>= 2; const int ct = r % 3; r /= 3; const int ks = r & 31; const int l = r >> 5;
          const int k = 32 * ks + 8 * g4 + j, col = 16 * ct + c15;
          float w = 0.f; if (col < 4) w = w_group[((size_t)l * D + k) * 4 + col]; else if (col < 36) w = w_expert[((size_t)l * D + k) * 32 + (col - 4)];
          w *= norm_ffn[l * D + k];
          const unsigned hb = f2bf(w); const float hf = __builtin_bit_cast(float, hb << 16);
          WRH[idx] = (bf16)hb; WRL[idx] = (bf16)f2bf(w - hf); } }
    { bf16* vt = (bf16*)(ws + WS_VT); const int per_head = 32 * (T / 8);
      for (int idx = C.gw * 64 + C.lane; idx < 4 * per_head; idx += C.NGW * 64) { const int h = idx / per_head, r = idx % per_head, row = r / (T / 8), ch = r % (T / 8);
          const unsigned v = row == 0 ? 0x3f803f80u : 0u; *(GAS v4u*)(vt + ((size_t)(h * VT_ROWS + 512 + row)) * T + ch * 8) = (v4u){v, v, v, v}; } }
    { float* gates = (float*)(ws + WS_GATES);
      f32x4 gn[4]; float wg[4][4][8];
#pragma unroll
      for (int j = 0; j < 4; ++j) { gn[j] = *(const f32x4*)(norm_mix0 + 4 * C.lane + 256 * j);
#pragma unroll
          for (int e = 0; e < 4; ++e) { const float* p = ml_w_in + (size_t)(4 * C.lane + 256 * j + e) * ML_LD + 6144; const f32x4 a = *(const f32x4*)p, b = *(const f32x4*)(p + 4);
              wg[j][e][0] = a.x; wg[j][e][1] = a.y; wg[j][e][2] = a.z; wg[j][e][3] = a.w; wg[j][e][4] = b.x; wg[j][e][5] = b.y; wg[j][e][6] = b.z; wg[j][e][7] = b.w; } }
      f32x4 v[4], vn[4];
      if (C.gw < T) {
#pragma unroll
          for (int j = 0; j < 4; ++j) vn[j] = ((const GAS f32x4*)(x + (size_t)C.gw * D) + C.lane)[64 * j]; }
      for (int m = C.gw; m < T; m += C.NGW) {
#pragma unroll
          for (int j = 0; j < 4; ++j) v[j] = vn[j];
          if (m + C.NGW < T) {
#pragma unroll
              for (int j = 0; j < 4; ++j) vn[j] = ((const GAS f32x4*)(x + (size_t)(m + C.NGW) * D) + C.lane)[64 * j]; }
          float ss = 0.f;
#pragma unroll
          for (int j = 0; j < 4; ++j) ss += (v[j].x * v[j].x + v[j].y * v[j].y) + (v[j].z * v[j].z + v[j].w * v[j].w);
          const float rstd = rsqrtf(wave_sum(ss) * (1.f / D) + 1e-6f);
          GAS unsigned long long* o8 = (GAS unsigned long long*)(hn0 + (size_t)m * D) + C.lane;
          float ga[8];
#pragma unroll
          for (int c = 0; c < 8; ++c) ga[c] = 0.f;
#pragma unroll
          for (int j = 0; j < 4; ++j) { v[j] = v[j] * rstd * gn[j];
              o8[64 * j] = (unsigned long long)pk2(v[j].x, v[j].y) | ((unsigned long long)pk2(v[j].z, v[j].w) << 32);
#pragma unroll
              for (int c = 0; c < 8; ++c) ga[c] += (v[j].x * wg[j][0][c] + v[j].y * wg[j][1][c]) + (v[j].z * wg[j][2][c] + v[j].w * wg[j][3][c]); }
          float h4[4], h2[2], h1;
          { const bool up = (C.lane & 32) != 0;
#pragma unroll
            for (int c = 0; c < 4; ++c) { const float keep = up ? ga[c + 4] : ga[c], give = up ? ga[c] : ga[c + 4]; h4[c] = keep + __shfl_xor(give, 32); } }
          { const bool up = (C.lane & 16) != 0;
#pragma unroll
            for (int c = 0; c < 2; ++c) { const float keep = up ? h4[c + 2] : h4[c], give = up ? h4[c] : h4[c + 2]; h2[c] = keep + __shfl_xor(give, 16); } }
          { const bool up = (C.lane & 8) != 0; const float keep = up ? h2[1] : h2[0], give = up ? h2[0] : h2[1]; h1 = keep + __shfl_xor(give, 8); }
          h1 += __shfl_xor(h1, 4); h1 += __shfl_xor(h1, 2); h1 += __shfl_xor(h1, 1);
          if ((C.lane & 7) == 0) gates[(size_t)m * 8 + (((C.lane >> 5) & 1) << 2 | ((C.lane >> 4) & 1) << 1 | ((C.lane >> 3) & 1))] = h1;
      } }
}

__device__ __forceinline__ void p1_gate_chunks(const Ctx& C, const float* b_i, const float* b_f, unsigned char* ws) {
    const float* gates = (const float*)(ws + WS_GATES); float* chb = (float*)(ws + WS_CHB); float* chm = (float*)(ws + WS_CHM);
    for (int it = C.gw; it < 16 * NCH; it += C.NGW) {
        const int bh = it >> 7, c = it & 127, b = bh >> 2, h = bh & 3; const size_t t = (size_t)b * SEQ + c * 64 + C.lane;
        const float gi = gates[t * 8 + h] + b_i[h]; const float lf = log_sigmoid(gates[t * 8 + 4 + h] + b_f[h]);
        const float bc = prefix_sum_incl(lf, C.lane); const float bL = __shfl(bc, 63);
        const float mx = wave_max(bL - bc + gi);
        if (C.lane == 0) { chb[it] = bL; chm[it] = mx; }
    }
}

__device__ __forceinline__ void p2_conv(const Ctx& C, const float* b_i, const float* b_f, const float* conv_w, unsigned char* ws, bf16* Qo, bf16* Ko) {
    const float* gates = (const float*)(ws + WS_GATES); const float* chb = (const float*)(ws + WS_CHB); const float* chm = (const float*)(ws + WS_CHM);
    float* SA = (float*)(ws + WS_SA); float* SB = (float*)(ws + WS_SB); float* SIS = (float*)(ws + WS_SIS); float* SFL = (float*)(ws + WS_SFL); float* DEC = (float*)(ws + WS_DEC);
    const bf16* raw = (const bf16*)(ws + WS_QKRAW); bf16* kwt = (bf16*)(ws + WS_KWT);
    LAS float* wsl = (LAS float*)(C.lds + RING_OFF);
    const int rg = C.tid >> 8, ct = C.tid & 255; const bool isk = (C.wave & 2) != 0;
    float w[4][8];
#pragma unroll
    for (int j = 0; j < 4; ++j) { const f32x4 a = *(const f32x4*)(conv_w + j * 2048 + 8 * ct), b = *(const f32x4*)(conv_w + j * 2048 + 8 * ct + 4);
        w[j][0] = a.x; w[j][1] = a.y; w[j][2] = a.z; w[j][3] = a.w; w[j][4] = b.x; w[j][5] = b.y; w[j][6] = b.z; w[j][7] = b.w; }
    for (int item = C.vcu; item < NB * NCH; item += C.G) {
        const int b = item >> 7, c = item & 127; const size_t t0 = (size_t)b * SEQ + c * 64;
        if (C.wave < 4) {
            const int h = C.wave, bh = b * 4 + h;
            float a0 = chb[bh * 128 + C.lane], m0 = chm[bh * 128 + C.lane], a1 = chb[bh * 128 + 64 + C.lane], m1 = chm[bh * 128 + 64 + C.lane];
#pragma unroll
            for (int o = 1; o < 64; o <<= 1) { const float pa0 = __shfl_up(a0, o), pm0 = __shfl_up(m0, o), pa1 = __shfl_up(a1, o), pm1 = __shfl_up(m1, o);
                if (C.lane >= o) { m0 = fmaxf(pm0 + a0, m0); a0 += pa0; m1 = fmaxf(pm1 + a1, m1); a1 += pa1; } }
            const float mA = fmaxf(a0, m0);
            const float m64 = __shfl(mA, 63);
            const float mB = fmaxf(m64 + a1, m1);
            const float mc_a = __shfl(mA, (c + 63) & 63), mc_b = __shfl(mB, (c + 63) & 63);
            const float mc = c == 0 ? 0.f : (c <= 64 ? mc_a : mc_b);
            const float mn_a = __shfl(mA, c & 63), mn_b = __shfl(mB, c & 63);
            const float mn = c < 64 ? mn_a : mn_b;
            const size_t t = t0 + C.lane;
            const float gi = gates[t * 8 + h] + b_i[h]; const float lf = log_sigmoid(gates[t * 8 + 4 + h] + b_f[h]);
            const float bc = prefix_sum_incl(lf, C.lane); const float bL = __shfl(bc, 63);
            const float Bv = gi - bc; const float cmx = prefix_max_incl(Bv, C.lane);
            const float Aa = -fmaxf(mc, cmx);
            SA[t * 4 + h] = Aa; SB[t * 4 + h] = Bv; SIS[t * 4 + h] = __expf(mc + Aa); SFL[t * 4 + h] = __expf(Aa - bc);
            wsl[h * 64 + C.lane] = __expf(bL + Bv - mn);
            if (C.lane == 0) DEC[bh * 128 + c] = __expf(bL + mc - mn);
        }
        __syncthreads();
        float x3[8], x2[8], x1[8];
        {   const int sb = c * 64 + 32 * rg - 3;
            const bf16* rp = raw + (t0 + 32 * rg - 3) * 2048 + 8 * ct;
            v4u r3 = (v4u){0u, 0u, 0u, 0u}, r2 = r3, r1 = r3;
            if (sb >= 0) r3 = *(const GAS v4u*)(rp); if (sb + 1 >= 0) r2 = *(const GAS v4u*)(rp + 2048); if (sb + 2 >= 0) r1 = *(const GAS v4u*)(rp + 4096);
#pragma unroll
            for (int e = 0; e < 4; ++e) { x3[2 * e] = bf_lo(r3[e]); x3[2 * e + 1] = bf_hi(r3[e]); x2[2 * e] = bf_lo(r2[e]); x2[2 * e + 1] = bf_hi(r2[e]); x1[2 * e] = bf_lo(r1[e]); x1[2 * e + 1] = bf_hi(r1[e]); } }
        const int kh = (ct - 128) >> 5;
        const bf16* rbase = raw + (t0 + 32 * rg) * 2048 + 8 * ct;
        v4u rr[8];
#pragma unroll
        for (int r = 0; r < 8; ++r) rr[r] = *(const GAS v4u*)(rbase + (size_t)r * 2048);
        for (int blk = 0; blk < 4; ++blk) {
            v4u rc[8];
#pragma unroll
            for (int r = 0; r < 8; ++r) rc[r] = rr[r];
            if (blk < 3) {
#pragma unroll
                for (int r = 0; r < 8; ++r) rr[r] = *(const GAS v4u*)(rbase + (size_t)((blk + 1) * 8 + r) * 2048);
            }
            float yy[8][8];
#pragma unroll
            for (int r = 0; r < 8; ++r) {
                float cur[8];
#pragma unroll
                for (int e = 0; e < 4; ++e) { cur[2 * e] = bf_lo(rc[r][e]); cur[2 * e + 1] = bf_hi(rc[r][e]); }
#pragma unroll
                for (int e = 0; e < 8; ++e) { const float sv = (w[0][e] * x3[e] + w[1][e] * x2[e]) + (w[2][e] * x1[e] + w[3][e] * cur[e]);
                    yy[r][e] = sv * __builtin_amdgcn_rcpf(1.f + __builtin_amdgcn_exp2f(-1.4426950408889634f * sv));     x3[e] = x2[e]; x2[e] = x1[e]; x1[e] = cur[e]; }
            }
            if (!isk) {
#pragma unroll
                for (int r = 0; r < 8; ++r) { const int row = 32 * rg + blk * 8 + r; const float* y = yy[r];
                    *(GAS v4u*)(Qo + (t0 + row) * 1024 + 8 * ct) = (v4u){pk2(y[0] * 0.0625f, y[1] * 0.0625f), pk2(y[2] * 0.0625f, y[3] * 0.0625f), pk2(y[4] * 0.0625f, y[5] * 0.0625f), pk2(y[6] * 0.0625f, y[7] * 0.0625f)}; }
            } else {
#pragma unroll
                for (int r = 0; r < 8; ++r) { const int row = 32 * rg + blk * 8 + r; const float* y = yy[r];
                    *(GAS v4u*)(Ko + (t0 + row) * 1024 + 8 * (ct - 128)) = (v4u){pk2(y[0], y[1]), pk2(y[2], y[3]), pk2(y[4], y[5]), pk2(y[6], y[7])}; }
                float wv[8];
#pragma unroll
                for (int r = 0; r < 8; ++r) wv[r] = wsl[kh * 64 + 32 * rg + blk * 8 + r];
#pragma unroll
                for (int e = 0; e < 8; ++e)
                    *(GAS v4u*)(kwt + ((size_t)((b * 4 + kh) * NCH + c) * 256 + ((8 * (ct - 128) + e) & 255)) * 64 + 32 * rg + blk * 8) =
                        (v4u){pk2(yy[0][e] * wv[0], yy[1][e] * wv[1]), pk2(yy[2][e] * wv[2], yy[3][e] * wv[3]), pk2(yy[4][e] * wv[4], yy[5][e] * wv[5]), pk2(yy[6][e] * wv[6], yy[7][e] * wv[7])};
            }
        }
        __syncthreads();
    }
}

__device__ __forceinline__ unsigned cvtpk(float lo, float hi);
#define MFMA16(a, b, c) __builtin_amdgcn_mfma_f32_16x16x32_bf16((a), (b), (c), 0, 0, 0)
__device__ __forceinline__ void p3a_scores(const Ctx& C, unsigned char* ws, const bf16* Q, const bf16* K, int first, int stride) {
    const float* SA = (const float*)(ws + WS_SA); const float* SB = (const float*)(ws + WS_SB); float* RS = (float*)(ws + WS_RS); bf16* Pg = (bf16*)(ws + WS_PG);
    LAS float* rsum = (LAS float*)(C.lds + RING_OFF + 92160);
    const int l15 = C.lane & 15, g = C.lane >> 4, tb = C.wave & 3, sh = C.wave >> 2;
    for (int item = first; item < 16 * NCH; item += stride) {
        const int bh = item >> 7, c = item & 127, b = bh >> 2, h = bh & 3; const size_t t0 = (size_t)b * SEQ + c * 64;
        bf16* Pi = Pg + (size_t)item * 4096;
        const int t = tb * 16 + l15;
        bf16x8 qa[8], ka[2][8]; float At = 0.f, Bs[2][4];
        const bool need0 = 2 * sh <= tb, need1 = 2 * sh + 1 <= tb;
        if (need0) {
            const bf16* qp = Q + (t0 + tb * 16 + l15) * 1024 + h * 256 + 8 * g;
#pragma unroll
            for (int ks = 0; ks < 8; ++ks) qa[ks] = *(const GAS bf16x8*)(qp + 32 * ks);
            At = SA[(t0 + t) * 4 + h];
#pragma unroll
            for (int sbi = 0; sbi < 2; ++sbi) { if (sbi == 0 || need1) { const int sb = 2 * sh + sbi; const bf16* kp = K + (t0 + sb * 16 + l15) * 1024 + h * 256 + 8 * g;
#pragma unroll
                for (int ks = 0; ks < 8; ++ks) ka[sbi][ks] = *(const GAS bf16x8*)(kp + 32 * ks);
#pragma unroll
                for (int r = 0; r < 4; ++r) Bs[sbi][r] = SB[(t0 + sb * 16 + 4 * g + r) * 4 + h]; } }
        }
#pragma unroll
        for (int sbi = 0; sbi < 2; ++sbi) {
            const int sb = 2 * sh + sbi;
            if (sb > tb) { *(GAS v2u*)(Pi + t * 64 + sb * 16 + 4 * g) = (v2u){0u, 0u}; if (g == 0) rsum[sb * 64 + t] = 0.f; }
            else {
                f32x4 acc = (f32x4){0.f, 0.f, 0.f, 0.f};
#pragma unroll
                for (int ks = 0; ks < 8; ++ks) acc = MFMA16(ka[sbi][ks], qa[ks], acc);
                float p[4], q = 0.f;
#pragma unroll
                for (int r = 0; r < 4; ++r) { const int s_ = sb * 16 + 4 * g + r; p[r] = (s_ <= t) ? acc[r] * __expf(At + Bs[sbi][r]) : 0.f; q += p[r]; }
                *(GAS v2u*)(Pi + t * 64 + sb * 16 + 4 * g) = (v2u){cvtpk(p[0], p[1]), cvtpk(p[2], p[3])};
                q += __shfl_xor(q, 16); q += __shfl_xor(q, 32);
                if (g == 0) rsum[sb * 64 + t] = q;
            }
        }
        asm volatile("s_waitcnt lgkmcnt(0)\n\ts_barrier" ::: "memory");
        if (C.tid < 64) RS[(t0 + C.tid) * 4 + h] = (rsum[C.tid] + rsum[64 + C.tid]) + (rsum[128 + C.tid] + rsum[192 + C.tid]);
        asm volatile("s_waitcnt lgkmcnt(0)\n\ts_barrier" ::: "memory");
    }
}

template <bool DRY>
__device__ __forceinline__ void p3_intra(const Ctx& C, unsigned char* ws, const float* ml_norm) {
    const float* SA = (const float*)(ws + WS_SA); const float* RS = (const float*)(ws + WS_RS); const bf16* Pg = (const bf16*)(ws + WS_PG);
    const bf16* vt = (const bf16*)(ws + WS_VT); bf16* H = (bf16*)(ws + WS_QKRAW); const unsigned char* OG = (const unsigned char*)(ws + WS_OG);
    const float* SIS = (const float*)(ws + WS_SIS); const float* QN = (const float*)(ws + WS_QN); const float* SFL = (const float*)(ws + WS_SFL);
    LAS float* ssum = (LAS float*)(C.lds + RING_OFF + 9216 + 256);
    const int l15 = C.lane & 15, g = C.lane >> 4;
    for (int item = C.vcu; item < 16 * NCH; item += C.G) {
        const int bh = item >> 7, c = item & 127, b = bh >> 2, h = bh & 3; const size_t t0 = (size_t)b * SEQ + c * 64;
        bf16x8 vfr[2][4], pfr[2][4]; v4u holdr[8]; v2u ogr[8]; float sis8[8], qn8[8], sfl8[8], rs8[8];
#pragma unroll
        for (int ks = 0; ks < 2; ++ks)
#pragma unroll
            for (int vtile = 0; vtile < 4; ++vtile) vfr[ks][vtile] = *(const GAS bf16x8*)(vt + (size_t)(h * VT_ROWS + 64 * C.wave + vtile * 16 + l15) * T + t0 + 32 * ks + 8 * g);
#pragma unroll
        for (int i = 0; i < 8; ++i) { const size_t tr = t0 + 8 * i + (C.lane >> 3); const size_t ho = tr * 2048 + h * 512 + 64 * C.wave + 8 * (C.lane & 7);
            holdr[i] = *(const GAS v4u*)(H + ho); ogr[i] = *(const GAS v2u*)(OG + ho); sis8[i] = SIS[tr * 4 + h]; qn8[i] = QN[tr * 4 + h]; sfl8[i] = SFL[tr * 4 + h]; rs8[i] = RS[tr * 4 + h]; }
#pragma unroll
        for (int ks = 0; ks < 2; ++ks)
#pragma unroll
            for (int t4 = 0; t4 < 4; ++t4) pfr[ks][t4] = *(const GAS bf16x8*)(Pg + (size_t)item * 4096 + (t4 * 16 + l15) * 64 + 32 * ks + 8 * g);
        __builtin_amdgcn_sched_barrier(0);
        const bool skip = DRY && SA[0] < 1e30f;
        f32x4 acc2[4][4];
#pragma unroll
        for (int vtile = 0; vtile < 4; ++vtile)
#pragma unroll
            for (int t4 = 0; t4 < 4; ++t4) acc2[vtile][t4] = (f32x4){0.f, 0.f, 0.f, 0.f};
#pragma unroll
        for (int ks = 0; ks < 2; ++ks) {
#pragma unroll
            for (int vtile = 0; vtile < 4; ++vtile)
#pragma unroll
                for (int t4 = 0; t4 < 4; ++t4) acc2[vtile][t4] = MFMA16(vfr[ks][vtile], pfr[ks][t4], acc2[vtile][t4]);
        }
        LAS unsigned char* stg = C.lds + RING_OFF + 16384 + C.wave * 9216;
#pragma unroll
        for (int vtile = 0; vtile < 4; ++vtile)
#pragma unroll
            for (int t4 = 0; t4 < 4; ++t4) { const f32x4 a = acc2[vtile][t4]; *(LAS v2u*)(stg + (t4 * 16 + l15) * 144 + (vtile * 16 + 4 * g) * 2) = (v2u){cvtpk(a[0], a[1]), cvtpk(a[2], a[3])}; }
        float hh[8][8], ssq8[8];
#pragma unroll
        for (int i = 0; i < 8; ++i) { const int row = 8 * i + (C.lane >> 3); const v4u sv = *(const LAS v4u*)(stg + row * 144 + (C.lane & 7) * 16);
            const float den = rs8[i] + sis8[i] * qn8[i]; const float inv = 1.f / fmaxf(fabsf(den), sfl8[i]); float q = 0.f;
#pragma unroll
            for (int e = 0; e < 4; ++e) { const float a = (bf_lo(sv[e]) + bf_lo(holdr[i][e])) * inv, b = (bf_hi(sv[e]) + bf_hi(holdr[i][e])) * inv; hh[i][2 * e] = a; hh[i][2 * e + 1] = b; q += a * a + b * b; }
            q += __shfl_xor(q, 1); q += __shfl_xor(q, 2); q += __shfl_xor(q, 4); ssq8[i] = q;
            if ((C.lane & 7) == 0) ssum[C.wave * 64 + row] = q; }
        asm volatile("s_waitcnt lgkmcnt(0)\n\ts_barrier" ::: "memory");
        const f32x4 gn0 = *(const f32x4*)(ml_norm + h * 512 + 64 * C.wave + 8 * (C.lane & 7)), gn1 = *(const f32x4*)(ml_norm + h * 512 + 64 * C.wave + 8 * (C.lane & 7) + 4);
        const float gn8[8] = {gn0[0], gn0[1], gn0[2], gn0[3], gn1[0], gn1[1], gn1[2], gn1[3]};
#pragma unroll
        for (int i = 0; i < 8; ++i) { const int row = 8 * i + (C.lane >> 3); float q = 0.f;
#pragma unroll
            for (int w = 0; w < 8; ++w) q += ssum[w * 64 + row];
            const float r = rsqrtf(q * (1.f / 512.f) + 1e-6f); float y[8];
#pragma unroll
            for (int e = 0; e < 8; ++e) y[e] = hh[i][e] * r * gn8[e] * ((float)((ogr[i][e >> 2] >> (8 * (e & 3))) & 255u) * (1.f / 255.f));
            if (!skip) *(GAS v4u*)(H + (t0 + row) * 2048 + h * 512 + 64 * C.wave + 8 * (C.lane & 7)) = (v4u){cvtpk(y[0], y[1]), cvtpk(y[2], y[3]), cvtpk(y[4], y[5]), cvtpk(y[6], y[7])}; }
        asm volatile("s_waitcnt lgkmcnt(0)\n\ts_barrier" ::: "memory");
    }
}

__device__ __forceinline__ unsigned p4_qslot(int t, int c) { return (unsigned)(t * 32 + ((c & 16) | ((c ^ t) & 15))); }
__device__ __forceinline__ unsigned p4_kslot(int row, int c) { return (unsigned)(row * 8 + (c ^ ((((row >> 4) & 1) << 2) | (((row >> 1) & 1) << 1)))); }
__device__ __forceinline__ unsigned cvtpk(float lo, float hi) { typedef float f2_t __attribute__((ext_vector_type(2))); typedef __bf16 b2_t __attribute__((ext_vector_type(2)));
    f2_t v = {lo, hi}; b2_t b = __builtin_convertvector(v, b2_t); return __builtin_bit_cast(unsigned, b); }
template <bool DRY>
__device__ __forceinline__ void p4_scan(const Ctx& C, unsigned char* ws, const bf16* Q) {
    const float* SIS = (const float*)(ws + WS_SIS); const float* DEC = (const float*)(ws + WS_DEC); float* QN = (float*)(ws + WS_QN);
    const bf16* vt = (const bf16*)(ws + WS_VT); const bf16* kwt = (const bf16*)(ws + WS_KWT); bf16* H = (bf16*)(ws + WS_QKRAW);
    const int l15 = C.lane & 15, g = C.lane >> 4;
    const unsigned lds0 = (unsigned)(uintptr_t)(C.lds + RING_OFF);
    for (int id = (int)blockIdx.x; id < 144; id += C.G) {
        const int bh = (id & 7) * 2 + (id < 128 ? (id >> 6) : ((id - 128) >> 3)); const int vblk = id < 128 ? (((id >> 3) & 7) * 4 + C.wave) : 32;
        const bool active = id < 128 ? (C.wave < 4) : (C.wave == 0);
        const bool loader = C.wave >= 4;
        const int b = bh >> 2, h = bh & 3;
        unsigned qoff[8], koff[8];
#pragma unroll
        for (int i = 0; i < 8; ++i) { const int sg = 64 * (8 * (C.wave & 3) + i) + C.lane;
            { const int t = sg >> 5, cp = sg & 31, c = (cp & 16) | ((cp ^ t) & 15); qoff[i] = (unsigned)((t * 1024 + c * 8) * 2); }
            { const int row = sg >> 3, cp = sg & 7, c = cp ^ ((((row >> 4) & 1) << 2) | (((row >> 1) & 1) << 1)); koff[i] = (unsigned)((row * 64 + c * 8) * 2); } }
        const char* qsrc = (const char*)(Q + (size_t)b * SEQ * 1024 + h * 256); const char* ksrc = (const char*)(kwt + (size_t)bh * NCH * 16384);
#define P4_DMA(cc, buf) do { if (loader) { _Pragma("unroll") for (int i_ = 0; i_ < 8; ++i_) \
            attn_body::glds16(qsrc + (size_t)(cc) * (64 * 1024 * 2) + qoff[i_], (unsigned)__builtin_amdgcn_readfirstlane(lds0 + (buf) * 65536 + (8 * (C.wave & 3) + i_) * 1024)); \
            _Pragma("unroll") for (int i_ = 0; i_ < 8; ++i_) \
            attn_body::glds16(ksrc + (size_t)(cc) * (16384 * 2) + koff[i_], (unsigned)__builtin_amdgcn_readfirstlane(lds0 + (buf) * 65536 + 32768 + (8 * (C.wave & 3) + i_) * 1024)); } } while (0)
        P4_DMA(0, 0);
        const bf16* vbase = vt + (size_t)(h * VT_ROWS + vblk * 16 + l15) * T + (size_t)b * SEQ + 8 * g;
        f32x4 X[16];
#pragma unroll
        for (int db = 0; db < 16; ++db) X[db] = (f32x4){0.f, 0.f, 0.f, 0.f};
        bf16x8 vcur[2]; vcur[0] = vcur[1] = (bf16x8){0, 0, 0, 0, 0, 0, 0, 0};
        float isc[4] = {0.f, 0.f, 0.f, 0.f}, dec = 0.f;
        if (active) { vcur[0] = *(const GAS bf16x8*)(vbase); vcur[1] = *(const GAS bf16x8*)(vbase + 32);
#pragma unroll
            for (int t4 = 0; t4 < 4; ++t4) isc[t4] = SIS[((size_t)b * SEQ + 16 * t4 + l15) * 4 + h];
            dec = DEC[bh * 128]; }
        asm volatile("s_waitcnt vmcnt(0)\n\ts_barrier" ::: "memory");
        bf16x8 vodd[2]; vodd[0] = vcur[0]; vodd[1] = vcur[1]; float decodd = 0.f;
        auto chunk = [&](const int c, bf16x8 (&vc)[2], bf16x8 (&vn)[2], float& dc, float& dn) __attribute__((always_inline)) {
            const int buf = c & 1;
            if (c + 1 < NCH) P4_DMA(c + 1, buf ^ 1);
            if (active) {
                const size_t t0 = (size_t)b * SEQ + c * 64;
                const LAS unsigned char* qb = C.lds + RING_OFF + buf * 65536 + l15 * 512; const LAS unsigned char* kb = C.lds + RING_OFF + buf * 65536 + 32768 + (8 * (l15 >> 2) + (l15 & 3)) * 128;
                int qx[4];
#pragma unroll
                for (int k3 = 0; k3 < 4; ++k3) qx[k3] = (((4 * k3 + g) ^ l15) & 15) * 16;
                const int hl = (((l15 >> 3) & 1) << 2) | (((l15 >> 1) & 1) << 1); const int kx0 = (g ^ hl) * 16, kx1 = kx0 ^ 64;
                f32x4 hi[4];
#pragma unroll
                for (int t4 = 0; t4 < 4; ++t4) hi[t4] = (f32x4){0.f, 0.f, 0.f, 0.f};
                bf16x8 qf[2][4];
#pragma unroll
                for (int t4 = 0; t4 < 4; ++t4) qf[0][t4] = *(const LAS bf16x8*)(qb + qx[0] + t4 * 8192);
#pragma unroll
                for (int ks = 0; ks < 8; ++ks) {
                    if (ks + 1 < 8) {
#pragma unroll
                        for (int t4 = 0; t4 < 4; ++t4) qf[(ks + 1) & 1][t4] = *(const LAS bf16x8*)(qb + qx[(ks + 1) & 3] + t4 * 8192 + ((ks + 1) >> 2) * 256);
                    }
                    const f32x4 lo = X[2 * ks], up = X[2 * ks + 1];
                    const bf16x8 xfr = __builtin_bit_cast(bf16x8, (v4u){cvtpk(lo[0], lo[1]), cvtpk(lo[2], lo[3]), cvtpk(up[0], up[1]), cvtpk(up[2], up[3])});
                    __builtin_amdgcn_sched_barrier(0);
#pragma unroll
                    for (int t4 = 0; t4 < 4; ++t4) hi[t4] = MFMA16(xfr, qf[ks & 1][t4], hi[t4]);
                    __builtin_amdgcn_sched_barrier(0);
                }
                asm volatile("" :: "v"(dc), "v"(vc[0]), "v"(vc[1]));
                if (DRY && DEC[0] < 1e30f) { }
                else if (vblk < 32) {
#pragma unroll
                    for (int t4 = 0; t4 < 4; ++t4) { const f32x4 o = hi[t4] * isc[t4];
                        *(GAS v2u*)(H + (t0 + 16 * t4 + l15) * 2048 + h * 512 + vblk * 16 + 4 * g) = (v2u){cvtpk(o[0], o[1]), cvtpk(o[2], o[3])}; }
                } else if (g == 0) {
#pragma unroll
                    for (int t4 = 0; t4 < 4; ++t4) QN[(t0 + 16 * t4 + l15) * 4 + h] = hi[t4][0];
                }
                if (c + 1 < NCH) { vn[0] = *(const GAS bf16x8*)(vbase + (c + 1) * 64); vn[1] = *(const GAS bf16x8*)(vbase + (c + 1) * 64 + 32);
#pragma unroll
                    for (int t4 = 0; t4 < 4; ++t4) isc[t4] = SIS[(t0 + 64 + 16 * t4 + l15) * 4 + h];
                    dn = DEC[bh * 128 + c + 1]; }
                bf16x8 kf[2][4];
#define P4_KOFF(db) ((32 * ((db) >> 1) + 4 * ((db) & 1)) * 128)
                kf[0][0] = *(const LAS bf16x8*)(kb + kx0 + P4_KOFF(0)); kf[0][1] = *(const LAS bf16x8*)(kb + kx1 + P4_KOFF(0));
                kf[0][2] = *(const LAS bf16x8*)(kb + kx0 + P4_KOFF(1)); kf[0][3] = *(const LAS bf16x8*)(kb + kx1 + P4_KOFF(1));
#pragma unroll
                for (int dp = 0; dp < 8; ++dp) {
                    if (dp + 1 < 8) {
                        kf[(dp + 1) & 1][0] = *(const LAS bf16x8*)(kb + kx0 + P4_KOFF(2 * dp + 2)); kf[(dp + 1) & 1][1] = *(const LAS bf16x8*)(kb + kx1 + P4_KOFF(2 * dp + 2));
                        kf[(dp + 1) & 1][2] = *(const LAS bf16x8*)(kb + kx0 + P4_KOFF(2 * dp + 3)); kf[(dp + 1) & 1][3] = *(const LAS bf16x8*)(kb + kx1 + P4_KOFF(2 * dp + 3));
                    }
                    f32x4 xa = X[2 * dp] * dc, xb = X[2 * dp + 1] * dc;
                    __builtin_amdgcn_sched_barrier(0);
                    xa = MFMA16(kf[dp & 1][0], vc[0], xa); xb = MFMA16(kf[dp & 1][2], vc[0], xb);
                    xa = MFMA16(kf[dp & 1][1], vc[1], xa); xb = MFMA16(kf[dp & 1][3], vc[1], xb);
                    __builtin_amdgcn_sched_barrier(0);
                    X[2 * dp] = xa; X[2 * dp + 1] = xb;
                }
#undef P4_KOFF
            }
            if (loader) asm volatile("s_waitcnt vmcnt(0)\n\ts_barrier" ::: "memory");
            else asm volatile("s_waitcnt lgkmcnt(0)\n\ts_barrier" ::: "memory");
        };
        for (int c = 0; c < NCH; c += 2) { chunk(c, vcur, vodd, dec, decodd); chunk(c + 1, vodd, vcur, decodd, dec); }
#undef P4_DMA
    }
}

template <bool DRY>
__device__ __forceinline__ void p5_headnorm(const Ctx& C, unsigned char* ws, const float* ml_norm) {
    const float* RS = (const float*)(ws + WS_RS); const float* SIS = (const float*)(ws + WS_SIS); const float* QN = (const float*)(ws + WS_QN); const float* SFL = (const float*)(ws + WS_SFL);
    bf16* H = (bf16*)(ws + WS_QKRAW); const bf16* OG = (const bf16*)(ws + WS_OG);
    for (int idx = C.gw; idx < T * 4; idx += C.NGW) {
        const int h = idx & 3; const size_t t = idx >> 2;
        const float den = RS[idx] + SIS[idx] * QN[idx]; const float inv = 1.f / fmaxf(fabsf(den), SFL[idx]);
        bf16* hp = H + t * 2048 + h * 512 + 8 * C.lane;
        const v4u hv = *(const GAS v4u*)hp; const v4u ov = *(const GAS v4u*)(OG + t * 2048 + h * 512 + 8 * C.lane);
        float x[8], o[8]; float ss = 0.f;
#pragma unroll
        for (int e = 0; e < 4; ++e) { x[2 * e] = bf_lo(hv[e]) * inv; x[2 * e + 1] = bf_hi(hv[e]) * inv; o[2 * e] = bf_lo(ov[e]); o[2 * e + 1] = bf_hi(ov[e]); }
#pragma unroll
        for (int e = 0; e < 8; ++e) ss += x[e] * x[e];
        const float rstd = rsqrtf(wave_sum(ss) * (1.f / 512.f) + 1e-6f);
        const f32x4 g0 = *(const f32x4*)(ml_norm + h * 512 + 8 * C.lane), g1 = *(const f32x4*)(ml_norm + h * 512 + 8 * C.lane + 4);
        const float gn[8] = {g0.x, g0.y, g0.z, g0.w, g1.x, g1.y, g1.z, g1.w};
        float y[8];
#pragma unroll
        for (int e = 0; e < 8; ++e) y[e] = x[e] * rstd * gn[e] * sigmoidf_(o[e]);
        if (!(DRY && RS[0] < 1e30f)) *(GAS v4u*)hp = (v4u){pk2(y[0], y[1]), pk2(y[2], y[3]), pk2(y[4], y[5]), pk2(y[6], y[7])};
    }
}

__device__ __forceinline__ void conv_moe_weights(const Ctx& C, const float* w_gu_l, const float* w_down_l, bf16* wgu, bf16* wdn, const float* gffn) {
    LAS float* scr = (LAS float*)(C.lds + RING_OFF + C.wave * 16384);
    constexpr int I_GU = 32 * 16 * 16, I_DN = 32 * 4 * 32;
#define MOE_SRC(it, W_, ld_, k0_, c0_, ksc_) do { if ((it) < I_GU) { const int e_ = (it) >> 8, r_ = (it) & 255; W_ = w_gu_l + (size_t)e_ * 1024 * 512; ld_ = 512; k0_ = (r_ >> 4) * 64; c0_ = (r_ & 15) * 32; ksc_ = gffn; } \
        else { const int r0_ = (it) - I_GU, e_ = r0_ >> 7, r_ = r0_ & 127; W_ = w_down_l + (size_t)e_ * 256 * 1024; ld_ = 1024; k0_ = (r_ >> 5) * 64; c0_ = (r_ & 31) * 32; ksc_ = nullptr; } } while (0)
    int it = C.gw; if (it >= I_GU + I_DN) return;
    f32x4 wv[8]; float ks[8];
    { const float* W_; int ld_, k0_, c0_; const float* ksc_; MOE_SRC(it, W_, ld_, k0_, c0_, ksc_); tr_load(wv, ks, W_, ld_, k0_, c0_, C.lane, ksc_); }
    for (;;) {
        const int nx = it + C.NGW; const bool more = nx < I_GU + I_DN;
        f32x4 wn[8]; float kn[8];
#pragma unroll
        for (int i = 0; i < 8; ++i) { wn[i] = wv[i]; kn[i] = ks[i]; }
        if (more) { const float* W_; int ld_, k0_, c0_; const float* ksc_; MOE_SRC(nx, W_, ld_, k0_, c0_, ksc_); tr_load(wn, kn, W_, ld_, k0_, c0_, C.lane, ksc_); }
        if (it < I_GU) { const int e = it >> 8, r = it & 255, kb = r >> 4, nb = r & 15, n0 = nb * 32;
            const int half = n0 >> 8, jj = (n0 & 255) >> 7, i0 = n0 & 127;
            tr_finish(wv, ks, 1024, kb * 64, wgu, e * 512 + jj * 256 + half * 128 + i0, scr, C.lane); }
        else { const int r0 = it - I_GU, e = r0 >> 7, r = r0 & 127, kb = r >> 5, nb = r & 31;
            tr_finish(wv, ks, 256, kb * 64, wdn, e * 1024 + nb * 32, scr, C.lane); }
        if (!more) break;
#pragma unroll
        for (int i = 0; i < 8; ++i) { wv[i] = wn[i]; ks[i] = kn[i]; }
        it = nx;
    }
#undef MOE_SRC
}
__device__ __forceinline__ void conv_da_weights(const Ctx& C, const float* da_w_in, const float* da_w_out, unsigned char* ws, const float* gmix) {
    LAS float* scr = (LAS float*)(C.lds + RING_OFF + C.wave * 16384);
    bf16* win = (bf16*)(ws + WS_WDA_IN); bf16* wout = (bf16*)(ws + WS_WDA_OUT);
    constexpr int I_IN = 16 * 96, I_OUT = 16 * 32;
    for (int it = C.gw; it < I_IN + I_OUT; it += C.NGW) {
        if (it < I_IN) { const int kb = it / 96, nb = it % 96; tr_item(da_w_in, 3072, 1024, kb * 64, nb * 32, win, nb * 32, scr, C.lane, gmix); }
        else { const int r = it - I_IN, kb = r >> 5, nb = r & 31; tr_item(da_w_out, 1024, 1024, kb * 64, nb * 32, wout, nb * 32, scr, C.lane); }
    }
}

__device__ __forceinline__ void p7_route(const Ctx& C, const bf16* xres, const float* norm_g, const float* b_group, const float* b_expert, int layer, unsigned char* ws, int cbank) {
    const bf16* WRH = (const bf16*)(ws + WS_WR) + (size_t)layer * (32 * 3 * 4 * 16 * 8); const bf16* WRL = WRH + 2 * 32 * 3 * 4 * 16 * 8;
    int* TE = (int*)(ws + WS_TE); int* TPOS = (int*)(ws + WS_TPOS); int* E2T = (int*)(ws + WS_E2T); float* EW = (float*)(ws + WS_EW); float* ERS = (float*)(ws + WS_ERS);
    unsigned* CNT = (unsigned*)(ws + WS_CTL) + CW_CNT + 64 * cbank;
    LAS float* lg = (LAS float*)(C.lds + RING_OFF + C.wave * 3072);
    LAS int* lcnt = (LAS int*)(C.lds + RING_OFF + 32768); LAS int* lbase = lcnt + 32;
    const int l15 = C.lane & 15, g = C.lane >> 4;
    for (int base = 0; base < T / 16; base += C.NGW) {
        const int grp = base + C.gw; const bool valid = grp < T / 16;
        if (C.tid < 32) lcnt[C.tid] = 0;
        __syncthreads();
        int E1 = 0, E2 = 0, lp1 = 0, lp2 = 0; float w1 = 0.f, w2 = 0.f, rstd = 0.f;
        const size_t row = (size_t)(valid ? grp : 0) * 16 + l15;
        if (valid) {
            f32x4 acc[3]; acc[0] = acc[1] = acc[2] = (f32x4){0.f, 0.f, 0.f, 0.f}; float ss = 0.f;
            const bf16* xq = xres + row * D + 8 * g;
            const bf16* wh = WRH + (size_t)(g * 16 + l15) * 8; const bf16* wl = WRL + (size_t)(g * 16 + l15) * 8;
#pragma unroll 4
            for (int ks = 0; ks < 32; ++ks) {
                const v4u xv = *(const GAS v4u*)(xq + 32 * ks);
                bf16x8 bh[3], bl[3];
#pragma unroll
                for (int ctile = 0; ctile < 3; ++ctile) { bh[ctile] = *(const GAS bf16x8*)(wh + (size_t)(ks * 3 + ctile) * 512); bl[ctile] = *(const GAS bf16x8*)(wl + (size_t)(ks * 3 + ctile) * 512); }
#pragma unroll
                for (int e = 0; e < 4; ++e) { const float a = bf_lo(xv[e]), b = bf_hi(xv[e]); ss += a * a + b * b; }
                const bf16x8 ah = __builtin_bit_cast(bf16x8, xv);
#pragma unroll
                for (int ctile = 0; ctile < 3; ++ctile) { acc[ctile] = MFMA16(ah, bh[ctile], acc[ctile]); acc[ctile] = MFMA16(ah, bl[ctile], acc[ctile]); }
            }
            ss += __shfl_xor(ss, 16); ss += __shfl_xor(ss, 32);
            rstd = rsqrtf(ss * (1.f / D) + 1e-6f);
#pragma unroll
            for (int ctile = 0; ctile < 3; ++ctile)
#pragma unroll
                for (int r = 0; r < 4; ++r) lg[(4 * g + r) * 48 + ctile * 16 + l15] = acc[ctile][r];
            LDS_WAIT(); asm volatile("" ::: "memory");
            if (C.lane < 16) {
                const LAS float* my = lg + C.lane * 48;
                float gl[4]; int gi = 0; float gmax;
#pragma unroll
                for (int j = 0; j < 4; ++j) gl[j] = rstd * my[j] + b_group[layer * 4 + j];
                gmax = gl[0];
#pragma unroll
                for (int j = 1; j < 4; ++j) if (gl[j] > gmax) { gmax = gl[j]; gi = j; }
                float gsum = 0.f;
#pragma unroll
                for (int j = 0; j < 4; ++j) gsum += __expf(gl[j] - gmax);
                const float g_w = 1.f / gsum;
                float el[8];
#pragma unroll
                for (int j = 0; j < 8; ++j) el[j] = rstd * my[4 + gi * 8 + j] + b_expert[layer * 32 + gi * 8 + j];
                int i1 = 0; float e1 = el[0];
#pragma unroll
                for (int j = 1; j < 8; ++j) if (el[j] > e1) { e1 = el[j]; i1 = j; }
                int i2 = -1; float e2 = -INFINITY;
#pragma unroll
                for (int j = 0; j < 8; ++j) if (j != i1 && el[j] > e2) { e2 = el[j]; i2 = j; }
                const float r2 = __expf(e2 - e1); const float p1 = 1.f / (1.f + r2), p2 = r2 * p1;
                w1 = g_w * p1; w2 = g_w * p2; E1 = gi * 8 + i1; E2 = gi * 8 + i2;
                lp1 = __hip_atomic_fetch_add(lcnt + E1, 1, __ATOMIC_RELAXED, __HIP_MEMORY_SCOPE_WORKGROUP);
                lp2 = __hip_atomic_fetch_add(lcnt + E2, 1, __ATOMIC_RELAXED, __HIP_MEMORY_SCOPE_WORKGROUP);
            }
        }
        __syncthreads();
        if (C.tid < 32) { const int n = lcnt[C.tid]; lbase[C.tid] = n ? (int)__hip_atomic_fetch_add(CNT + C.tid, (unsigned)n, RLX_AGENT) : 0; }
        __syncthreads();
        if (valid) {
            if (C.lane < 16) { const int p1 = lbase[E1] + lp1, p2 = lbase[E2] + lp2; TE[row * 2] = E1; TE[row * 2 + 1] = E2; TPOS[row * 2] = p1; TPOS[row * 2 + 1] = p2;
                E2T[(size_t)E1 * T + p1] = (int)row; E2T[(size_t)E2 * T + p2] = (int)row; EW[(size_t)E1 * T + p1] = w1; EW[(size_t)E2 * T + p2] = w2; ERS[(size_t)E1 * T + p1] = rstd; ERS[(size_t)E2 * T + p2] = rstd; }
        }
        __syncthreads();
    }
}

__device__ __forceinline__ void moe_tables(const Ctx& C, int layer, unsigned char* ws) {
    const unsigned* CNT = (const unsigned*)(ws + WS_CTL) + CW_CNT + 64 * layer;
    LAS int* pexp = (LAS int*)(C.lds + TAB_PEXP); LAS int* eoff = (LAS int*)(C.lds + TAB_EOFF); LAS int* npp = (LAS int*)(C.lds + TAB_NP);
    if (C.tid == 0) { int off = 0, p = 0;
        for (int e = 0; e < NEXP; ++e) { const int n = (int)__hip_atomic_load(CNT + e, RLX_AGENT); eoff[e] = off; const int np_e = (n + 255) >> 8;
            for (int q = 0; q < np_e && p < MAXPANEL; ++q) pexp[p++] = e; off += np_e << 8; }
        eoff[NEXP] = off; npp[0] = p; }
    __syncthreads();
}

template <bool FINAL, bool DRY>
__device__ __forceinline__ void p11_combine(const Ctx& C, bf16* xio, float* fout, const float* gnorm, unsigned char* ws) {
    float* rstd_out = (float*)(ws + WS_RSTD);
    const int* TE = (const int*)(ws + WS_TE); const int* TPOS = (const int*)(ws + WS_TPOS); const LAS int* eoff = (const LAS int*)(C.lds + TAB_EOFF); const bf16* YS = (const bf16*)(ws + WS_YS);
    f32x4 gn[4];
#pragma unroll
    for (int j = 0; j < 4; ++j) gn[j] = *(const f32x4*)(gnorm + 4 * C.lane + 256 * j);
    v2u xn[4], an[4], bn[4];
#define P11_LOAD(tt) do { const int s0_ = eoff[TE[(tt) * 2]] + TPOS[(tt) * 2], s1_ = eoff[TE[(tt) * 2 + 1]] + TPOS[(tt) * 2 + 1]; \
        const GAS v2u* xr_ = (const GAS v2u*)(xio + (size_t)(tt) * D) + C.lane; const GAS v2u* y0_ = (const GAS v2u*)(YS + (size_t)s0_ * D) + C.lane; const GAS v2u* y1_ = (const GAS v2u*)(YS + (size_t)s1_ * D) + C.lane; \
        _Pragma("unroll") for (int j = 0; j < 4; ++j) { xn[j] = xr_[64 * j]; an[j] = y0_[64 * j]; bn[j] = y1_[64 * j]; } } while (0)
    if (C.gw < T) P11_LOAD(C.gw);
    for (int t = C.gw; t < T; t += C.NGW) {
        GAS v2u* xr = (GAS v2u*)(xio + (size_t)t * D) + C.lane; GAS f32x4* fr_ = (GAS f32x4*)(fout + (size_t)t * D) + C.lane;
        f32x4 v[4]; v2u ya[4], yb[4]; float ss = 0.f;
#pragma unroll
        for (int j = 0; j < 4; ++j) { v[j] = (f32x4){bf_lo(xn[j].x), bf_hi(xn[j].x), bf_lo(xn[j].y), bf_hi(xn[j].y)}; ya[j] = an[j]; yb[j] = bn[j]; }
        if (t + C.NGW < T) P11_LOAD(t + C.NGW);
#pragma unroll
        for (int j = 0; j < 4; ++j) { const v2u a = ya[j], b = yb[j];
            v[j].x += bf_lo(a.x) + bf_lo(b.x); v[j].y += bf_hi(a.x) + bf_hi(b.x); v[j].z += bf_lo(a.y) + bf_lo(b.y); v[j].w += bf_hi(a.y) + bf_hi(b.y);
            ss += (v[j].x * v[j].x + v[j].y * v[j].y) + (v[j].z * v[j].z + v[j].w * v[j].w); }
        const float rstd = rsqrtf(wave_sum(ss) * (1.f / D) + 1e-6f);
        if (DRY && gnorm[0] < 1e30f) { }
        else if (FINAL) {
#pragma unroll
            for (int j = 0; j < 4; ++j) fr_[64 * j] = v[j] * rstd * gn[j];
        } else {
#pragma unroll
            for (int j = 0; j < 4; ++j) xr[64 * j] = (v2u){pk2(v[j].x, v[j].y), pk2(v[j].z, v[j].w)};
            if (C.lane == 0) rstd_out[t] = rstd;
        }
    }
}

#undef P11_LOAD
__device__ __forceinline__ void p14_diffnorm(const Ctx& C, const float* lq1, const float* lk1, const float* lq2, const float* lk2, const float* da_norm, unsigned char* ws) {
    const bf16* O = (const bf16*)(ws + WS_AO); bf16* A2 = (bf16*)(ws + WS_HN);
    const float lam = __expf(wave_sum(lq1[C.lane] * lk1[C.lane])) - __expf(wave_sum(lq2[C.lane] * lk2[C.lane])) + LAMBDA_INIT1;
    const float g0 = da_norm[2 * C.lane] * (1.f - LAMBDA_INIT1), g1 = da_norm[2 * C.lane + 1] * (1.f - LAMBDA_INIT1);
    for (int t = C.gw; t < T; t += C.NGW) {
#pragma unroll
        for (int h = 0; h < 8; ++h) {
            const unsigned a = *(const GAS unsigned*)(O + (size_t)t * 2048 + h * 256 + 2 * C.lane), b = *(const GAS unsigned*)(O + (size_t)t * 2048 + h * 256 + 128 + 2 * C.lane);
            const float d0 = bf_lo(a) - lam * bf_lo(b), d1 = bf_hi(a) - lam * bf_hi(b);
            const float rstd = rsqrtf(wave_sum(d0 * d0 + d1 * d1) * (1.f / 128.f) + 1e-5f);
            *(GAS unsigned*)(A2 + (size_t)t * D + h * 128 + 2 * C.lane) = pk2(d0 * rstd * g0, d1 * rstd * g1);
        }
    }
}

__device__ __forceinline__ Ctx make_ctx(unsigned char* lds) {
    Ctx C; int t = threadIdx.x; asm volatile("" : "+v"(t));
    C.lds = (LAS unsigned char*)lds;
    C.tid = t; C.lane = t & 63; C.wave = __builtin_amdgcn_readfirstlane(t >> 6);
    C.G = gridDim.x; { const int bx = blockIdx.x; C.vcu = (C.G % 8 == 0) ? (bx % 8) * (C.G / 8) + bx / 8 : bx; }
    C.gw = C.vcu * NWAVES + C.wave; C.NGW = C.G * NWAVES;
    return C;
}
struct Args { const float* in[23]; float* out; unsigned char* ws; };
#ifndef MK_DUP
#define MK_DUP 0
#endif
#define DUP(k) ((MK_DUP >> (k)) & 1)
#ifndef MK_PHASE_LO
#define MK_PHASE_LO 0
#endif
#ifndef MK_PHASE_HI
#define MK_PHASE_HI 99
#endif
__global__ void __launch_bounds__(NWAVES * 64, 2) mk_fwd(Args args) {
    extern __shared__ __attribute__((aligned(16))) unsigned char lds[];
    Ctx C = make_ctx(lds);
#define FRESH() C = make_ctx(lds); LOADARGS()
    typedef const __attribute__((address_space(4))) Args* ArgP;
#define LOADARGS() ArgP A_ = (ArgP)__builtin_amdgcn_kernarg_segment_ptr(); asm volatile("" : "+s"(A_)); unsigned char* const ws = A_->ws; float* const out = A_->out; (void)out
#define xin (A_->in[0])
#define norm_mix (A_->in[1])
#define norm_ffn (A_->in[2])
#define ml_w_in (A_->in[3])
#define ml_conv (A_->in[4])
#define ml_b_i (A_->in[5])
#define ml_b_f (A_->in[6])
#define ml_norm (A_->in[7])
#define ml_w_out (A_->in[8])
#define da_w_in (A_->in[9])
#define da_lq1 (A_->in[10])
#define da_lk1 (A_->in[11])
#define da_lq2 (A_->in[12])
#define da_lk2 (A_->in[13])
#define da_norm (A_->in[14])
#define da_w_out (A_->in[15])
#define moe_w_group (A_->in[16])
#define moe_b_group (A_->in[17])
#define moe_w_expert (A_->in[18])
#define moe_b_expert (A_->in[19])
#define moe_w_gu (A_->in[20])
#define moe_w_down (A_->in[21])
#define final_norm (A_->in[22])
    for (int u = C.tid; u < (LDS_BYTES - LDSCTL_OFF) / 4; u += NWAVES * 64) ((LAS unsigned*)(C.lds + LDSCTL_OFF))[u] = 0u;
    __syncthreads();
    volatile LAS unsigned* MISC = (volatile LAS unsigned*)(C.lds + MISC_OFF);
    XcdBarrier bar; { LOADARGS(); bar = xcd_barrier_post((unsigned*)(ws + WS_CTL) + CW_BAR, MISC + 8); }
#define GRID_BAR() xcd_barrier(bar)
#define PH(k) ((k) <= MK_PHASE_HI && (k) >= MK_PHASE_LO)
#define MFMA_SPIN(k) if (DUP(k)) { typedef short b8_ __attribute__((ext_vector_type(8))); f32x4 s0_ = {0.f, 0.f, 0.f, 0.f}, s1_ = s0_, s2_ = s0_, s3_ = s0_; b8_ xx_ = {0, 0, 0, 0, 0, 0, 0, 0}; asm volatile("" : "+v"(xx_)); \
        for (int i_ = 0; i_ < 5000; ++i_) { s0_ = __builtin_amdgcn_mfma_f32_16x16x32_bf16(xx_, xx_, s0_, 0, 0, 0); s1_ = __builtin_amdgcn_mfma_f32_16x16x32_bf16(xx_, xx_, s1_, 0, 0, 0); \
            s2_ = __builtin_amdgcn_mfma_f32_16x16x32_bf16(xx_, xx_, s2_, 0, 0, 0); s3_ = __builtin_amdgcn_mfma_f32_16x16x32_bf16(xx_, xx_, s3_, 0, 0, 0); } \
        asm volatile("" :: "v"(s0_), "v"(s1_), "v"(s2_), "v"(s3_)); GRID_BAR(); }
#define hn0 ((bf16*)out)
#define Qm ((bf16*)out)
#define Km ((bf16*)out + (size_t)T * 1024)
#define HN ((bf16*)(ws + WS_HN))
#define XB ((bf16*)out)
#define XB2 ((bf16*)(ws + WS_AQ))
    const int bx = (int)blockIdx.x;

#ifndef MK_NO_P0
    { FRESH();
    p0_prologue(C, xin, norm_mix, ml_w_in, ml_w_out, norm_ffn, moe_w_group, moe_w_expert, ws, hn0); }
#define P0ONCE { GRID_BAR(); FRESH(); p0_prologue(C, xin, norm_mix, ml_w_in, ml_w_out, norm_ffn, moe_w_group, moe_w_expert, ws, hn0); }
    if (DUP(0)) { P0ONCE P0ONCE P0ONCE P0ONCE }
#endif
    GRID_BAR();
    MFMA_SPIN(22)
    if (PH(1)) { FRESH();
        p1_gate_chunks(C, ml_b_i, ml_b_f, ws);
        { pg8::Gemm g{hn0, (const bf16*)(ws + WS_WML_IN), T, 4096, D}; pg8::StaticOrder S; S.init(T, 4096, C.G, bx);
          pg8::EpiQKO E{(bf16*)(ws + WS_QKRAW), (unsigned char*)(ws + WS_OG)};
          pg8::gemm_phase<pg8::EpiQKO, pg8::StaticOrder, true, true>(C.lds + RING_OFF, g, S, E); }
        { pg8::Gemm g{(const bf16*)(ws + WS_WML_IN) + (size_t)4096 * D, hn0, 2048, T, D}; pg8::StaticOrder S; S.init(2048, T, C.G, bx);
          pg8::EpiBf16S E{(bf16*)(ws + WS_VT), T, 0, 0, 1.f, 0x7fffffff, VT_ROWS - 512, nullptr};
          pg8::gemm_phase<pg8::EpiBf16S, pg8::StaticOrder, true, true>(C.lds + RING_OFF, g, S, E); }
        if (DUP(1)) {
        { pg8::Gemm g{hn0, (const bf16*)(ws + WS_WML_IN), T, 4096, D}; pg8::StaticOrder S; S.init(T, 4096, C.G, bx);
          pg8::EpiQKO E{(bf16*)(ws + WS_QKRAW), (unsigned char*)(ws + WS_OG)};
          pg8::gemm_phase<pg8::EpiQKO, pg8::StaticOrder, true, true>(C.lds + RING_OFF, g, S, E); }
        { pg8::Gemm g{(const bf16*)(ws + WS_WML_IN) + (size_t)4096 * D, hn0, 2048, T, D}; pg8::StaticOrder S; S.init(2048, T, C.G, bx);
          pg8::EpiBf16S E{(bf16*)(ws + WS_VT), T, 0, 0, 1.f, 0x7fffffff, VT_ROWS - 512, nullptr};
          pg8::gemm_phase<pg8::EpiBf16S, pg8::StaticOrder, true, true>(C.lds + RING_OFF, g, S, E); }
        }
        GRID_BAR();
    }
    if (PH(2)) { FRESH(); p2_conv(C, ml_b_i, ml_b_f, ml_conv, ws, Qm, Km); GRID_BAR(); }
#define P2ONCE { FRESH(); p2_conv(C, ml_b_i, ml_b_f, ml_conv, ws, Qm, Km); GRID_BAR(); }
    if (DUP(2)) { P2ONCE P2ONCE P2ONCE P2ONCE }
    if (DUP(4)) { FRESH(); p4_scan<true>(C, ws, Qm); GRID_BAR(); }
    if (DUP(28)) { FRESH(); p4_scan<false>(C, ws, Qm); GRID_BAR(); }
    if (DUP(27)) { FRESH();
        if (C.G > 144) { if ((int)blockIdx.x >= 144) { p3a_scores(C, ws, Qm, Km, (int)blockIdx.x - 144, C.G - 144);
                Ctx Cf = C; Cf.gw = ((int)blockIdx.x - 144) * NWAVES + C.wave; Cf.NGW = (C.G - 144) * NWAVES; conv_da_weights(Cf, da_w_in, da_w_out, ws, norm_mix + D); conv_ml_out(Cf, ml_w_out, ws); conv_moe_weights(Cf, moe_w_gu, moe_w_down, (bf16*)(ws + WS_WGU0), (bf16*)(ws + WS_WDN0), norm_ffn); }
            else p4_scan<false>(C, ws, Qm); }
        else { p4_scan<false>(C, ws, Qm); p3a_scores(C, ws, Qm, Km, (int)blockIdx.x, C.G); conv_da_weights(C, da_w_in, da_w_out, ws, norm_mix + D); conv_ml_out(C, ml_w_out, ws); conv_moe_weights(C, moe_w_gu, moe_w_down, (bf16*)(ws + WS_WGU0), (bf16*)(ws + WS_WDN0), norm_ffn); }
        GRID_BAR(); }
    if (PH(4)) { FRESH();
        if (C.G > 144) { if ((int)blockIdx.x >= 144) { p3a_scores(C, ws, Qm, Km, (int)blockIdx.x - 144, C.G - 144);
                Ctx Cf = C; Cf.gw = ((int)blockIdx.x - 144) * NWAVES + C.wave; Cf.NGW = (C.G - 144) * NWAVES; conv_da_weights(Cf, da_w_in, da_w_out, ws, norm_mix + D); conv_ml_out(Cf, ml_w_out, ws); conv_moe_weights(Cf, moe_w_gu, moe_w_down, (bf16*)(ws + WS_WGU0), (bf16*)(ws + WS_WDN0), norm_ffn); }
            else p4_scan<false>(C, ws, Qm); }
        else { p4_scan<false>(C, ws, Qm); p3a_scores(C, ws, Qm, Km, (int)blockIdx.x, C.G); conv_da_weights(C, da_w_in, da_w_out, ws, norm_mix + D); conv_ml_out(C, ml_w_out, ws); conv_moe_weights(C, moe_w_gu, moe_w_down, (bf16*)(ws + WS_WGU0), (bf16*)(ws + WS_WDN0), norm_ffn); }
        GRID_BAR(); }
    if (DUP(23)) { FRESH();
        if ((int)blockIdx.x >= 144) { if (DUP(24)) p3a_scores(C, ws, Qm, Km, (int)blockIdx.x - 144, C.G - 144);
            Ctx Cf = C; Cf.gw = ((int)blockIdx.x - 144) * NWAVES + C.wave; Cf.NGW = (C.G - 144) * NWAVES; if (DUP(25)) { conv_da_weights(Cf, da_w_in, da_w_out, ws, norm_mix + D); conv_ml_out(Cf, ml_w_out, ws); } if (DUP(26)) conv_moe_weights(Cf, moe_w_gu, moe_w_down, (bf16*)(ws + WS_WGU0), (bf16*)(ws + WS_WDN0), norm_ffn); }
        GRID_BAR(); }
#define P3ONCE { FRESH(); p3_intra<true>(C, ws, ml_norm); GRID_BAR(); }
    if (DUP(3)) { P3ONCE P3ONCE P3ONCE P3ONCE }
    if (PH(3)) { FRESH(); p3_intra<false>(C, ws, ml_norm); }
    if (PH(5)) { GRID_BAR(); }
    if (PH(6)) { FRESH();
        pg8::Gemm g{(const bf16*)(ws + WS_QKRAW), (const bf16*)(ws + WS_WML_OUT), T, D, ML_V}; pg8::StaticOrder S; S.init(T, D, C.G, bx);
        pg8::EpiResBf16<true> E{xin, XB, D};
        pg8::gemm_phase<pg8::EpiResBf16<true>, pg8::StaticOrder, true, true>(C.lds + RING_OFF, g, S, E);
        if (DUP(6)) pg8::gemm_phase<pg8::EpiResBf16<true>, pg8::StaticOrder, true, true>(C.lds + RING_OFF, g, S, E);
        GRID_BAR();
    }
#define MOE_LAYER(L, PBASE, FINAL_, GNEXT, WGU_, WDN_, XR_)                                                                                                              \
    if (PH(PBASE)) { FRESH(); p7_route(C, (XR_), norm_ffn + (L) * D, moe_b_group, moe_b_expert, (L), ws, (L)); if (DUP(7)) p7_route(C, (XR_), norm_ffn + (L) * D, moe_b_group, moe_b_expert, (L), ws, (L) + 2); GRID_BAR(); }                                                \
    if (PH(PBASE + 2)) { FRESH(); moe_tables(C, (L), ws);                                                                                               \
        const int np = __builtin_amdgcn_readfirstlane(*(LAS int*)(C.lds + TAB_NP));                                                                      \
        pg8::Gemm g{(const bf16*)(XR_), (const bf16*)(ws + (WGU_)), np * 256, NEXP * 512, D};                                                   \
        pg8::MoeOrder S{(const LAS int*)(C.lds + TAB_PEXP), np, 1, C.G, bx};                                                                             \
        pg8::EpiSwiGLU E{(bf16*)(ws + WS_ACT), (const float*)(ws + WS_EW), (const float*)(ws + WS_ERS), (const LAS int*)(C.lds + TAB_EOFF), T};                                       \
        pg8::MoeGather GA{(const int*)(ws + WS_E2T), (const LAS int*)(C.lds + TAB_EOFF), 1, T};                                                          \
        pg8::gemm_phase<pg8::EpiSwiGLU, pg8::MoeOrder, true, true, pg8::MoeGather>(C.lds + RING_OFF, g, S, E, GA);                                      \
        if (DUP(9)) pg8::gemm_phase<pg8::EpiSwiGLU, pg8::MoeOrder, true, true, pg8::MoeGather>(C.lds + RING_OFF, g, S, E, GA);                          \
        if ((L) == 0) {     \
            const int r9 = (2 * np) % C.G; const bool few = (C.G - r9) * 2 < C.G; const int k9 = (r9 == 0 || few) ? bx : bx - r9, n9 = (r9 == 0 || few) ? C.G : C.G - r9;  \
            if (k9 >= 0) { Ctx Cf = C; Cf.gw = k9 * NWAVES + C.wave; Cf.NGW = n9 * NWAVES;                                                                 \
                conv_moe_weights(Cf, moe_w_gu + (size_t)NEXP * D * 512, moe_w_down + (size_t)NEXP * DEXP * D, (bf16*)(ws + WS_WGU1), (bf16*)(ws + WS_WDN1), norm_ffn + D); } }  \
        GRID_BAR(); }                                                                                                                                    \
    if (PH(PBASE + 3)) { FRESH();                                                                                                                        \
        const int np = __builtin_amdgcn_readfirstlane(*(LAS int*)(C.lds + TAB_NP));                                                                      \
        int kdn = DEXP; asm volatile("" : "+s"(kdn));                                                                                                    \
        pg8::Gemm g{(const bf16*)(ws + WS_ACT), (const bf16*)(ws + (WDN_)), np * 256, NEXP * 1024, kdn};                                               \
        pg8::MoeOrder S{(const LAS int*)(C.lds + TAB_PEXP), np, 2, C.G, bx};                                                                             \
        pg8::EpiBf16S E{(bf16*)(ws + WS_YS), D, 0, 0, 1.f, 3, 0, nullptr};                                                                                        \
        pg8::gemm_phase<pg8::EpiBf16S, pg8::MoeOrder, true, true>(C.lds + RING_OFF, g, S, E);                                                           \
        if (DUP(10)) pg8::gemm_phase<pg8::EpiBf16S, pg8::MoeOrder, true, true>(C.lds + RING_OFF, g, S, E);                                              \
        GRID_BAR(); }                                                                                                                                    \
    if (PH(PBASE + 4)) { FRESH(); if (DUP(11)) p11_combine<FINAL_, true>(C, (XR_), out, (GNEXT), ws); p11_combine<FINAL_, false>(C, (XR_), out, (GNEXT), ws); }

    MOE_LAYER(0, 7, false, norm_mix + D, WS_WGU0, WS_WDN0, XB)
    if (PH(11)) { GRID_BAR(); }
    if (PH(12)) { FRESH();
        pg8::Gemm g{XB, (const bf16*)(ws + WS_WDA_IN), T, 3072, D}; pg8::StaticOrder S; S.init(T, 3072, C.G, bx);
        pg8::EpiBf16S E{(bf16*)(ws + WS_AQ), 1024, 1024, (size_t)(WS_AK - WS_AQ) / 2, attn_body::C2, 0x7fffffff, 0, (const float*)(ws + WS_RSTD)};
        pg8::gemm_phase<pg8::EpiBf16S, pg8::StaticOrder, true, true>(C.lds + RING_OFF, g, S, E);
        if (DUP(12)) pg8::gemm_phase<pg8::EpiBf16S, pg8::StaticOrder, true, true>(C.lds + RING_OFF, g, S, E);
        GRID_BAR();
    }
    MFMA_SPIN(21)
    if (PH(13)) { FRESH();
        static_assert(attn_body::ATTN_LDS_BYTES <= RING_BYTES, "attention LDS");
        LAS float* gnl = (LAS float*)(C.lds + TAB_OFF + 2048);
        float s1 = 0.f, s2 = 0.f;
        for (int i = 0; i < 64; ++i) { s1 += da_lq1[i] * da_lk1[i]; s2 += da_lq2[i] * da_lk2[i]; }
        const float lam = __int_as_float(__builtin_amdgcn_readfirstlane(__float_as_int(__expf(s1) - __expf(s2) + LAMBDA_INIT1)));
        if (C.tid < 128) gnl[C.tid] = da_norm[C.tid] * (1.f - LAMBDA_INIT1);
        __syncthreads();
        const attn_body::AttnTensors AT{(const attn_body::bf16*)(ws + WS_AQ), (const attn_body::bf16*)(ws + WS_AK), (const attn_body::bf16*)(ws + WS_AV), (attn_body::bf16*)(ws + WS_AO), (attn_body::bf16*)(ws + WS_HN), lam, (const LAS float*)(C.lds + TAB_OFF + 2048)};
        const attn_body::StaticOrder S((int)C.G, bx);
        attn_body::attn_phase<attn_body::StaticOrder>((char*)lds + RING_OFF, AT, S);
        GRID_BAR();
        if (DUP(13)) { attn_body::attn_phase<attn_body::StaticOrder>((char*)lds + RING_OFF, AT, S); GRID_BAR(); }
    }
    if (PH(15)) { FRESH();
        pg8::Gemm g{HN, (const bf16*)(ws + WS_WDA_OUT), T, D, D}; pg8::StaticOrder S; S.init(T, D, C.G, bx);
        pg8::EpiResBf16<false> E{XB, XB2, D};
        pg8::gemm_phase<pg8::EpiResBf16<false>, pg8::StaticOrder, true, true>(C.lds + RING_OFF, g, S, E);
        GRID_BAR();
    }
    if (DUP(20)) { for (int rep_ = 0; rep_ < 20; ++rep_) GRID_BAR(); }
    MOE_LAYER(1, 16, true, final_norm, WS_WGU1, WS_WDN1, XB2)
#if MK_PHASE_HI < 20
    { if (MK_PHASE_HI == 11 || MK_PHASE_HI < 1) { } GRID_BAR(); FRESH();
      const float* src = MK_PHASE_HI >= 6 ? out : xin;
      f32x4 gn[4];
#pragma unroll
      for (int j = 0; j < 4; ++j) gn[j] = *(const f32x4*)(final_norm + 4 * C.lane + 256 * j);
      for (int t = C.gw; t < T; t += C.NGW) { const GAS f32x4* xr = (const GAS f32x4*)(src + (size_t)t * D) + C.lane; GAS f32x4* orow = (GAS f32x4*)(out + (size_t)t * D) + C.lane;
          f32x4 v[4]; float ss = 0.f;
#pragma unroll
          for (int j = 0; j < 4; ++j) { v[j] = xr[64 * j]; ss += (v[j].x * v[j].x + v[j].y * v[j].y) + (v[j].z * v[j].z + v[j].w * v[j].w); }
          const float rstd = rsqrtf(wave_sum(ss) * (1.f / D) + 1e-6f);
#pragma unroll
          for (int j = 0; j < 4; ++j) orow[64 * j] = v[j] * rstd * gn[j]; } }
#endif
}

#undef xin
#undef norm_mix
#undef norm_ffn
#undef ml_w_in
#undef ml_conv
#undef ml_b_i
#undef ml_b_f
#undef ml_norm
#undef ml_w_out
#undef da_w_in
#undef da_lq1
#undef da_lk1
#undef da_lq2
#undef da_lk2
#undef da_norm
#undef da_w_out
#undef moe_w_group
#undef moe_b_group
#undef moe_w_expert
#undef moe_b_expert
#undef moe_w_gu
#undef moe_w_down
#undef final_norm
#undef hn0
#undef Qm
#undef Km
#undef HN
#undef XB
#undef XB2
extern "C" void kernel_launch(void* const* d_in, const int* in_sizes, int n_in, void* d_out, int out_size, void* d_ws, size_t ws_size, hipStream_t stream) {
    static int grid = 0;
    if (grid == 0) {
        if (n_in != 23 || out_size != T * D || ws_size < (size_t)512 * MiB) { fprintf(stderr, "kernel_launch: unexpected shapes (n_in %d out %d ws %zu)\n", n_in, out_size, ws_size); grid = -1; return; }
        int dev = 0, cus = 0, per_cu = 0;
        if (hipGetDevice(&dev) != hipSuccess || hipDeviceGetAttribute(&cus, hipDeviceAttributeMultiprocessorCount, dev) != hipSuccess) { grid = -1; return; }
        if (hipFuncSetAttribute((const void*)mk_fwd, hipFuncAttributeMaxDynamicSharedMemorySize, LDS_BYTES) != hipSuccess) { fprintf(stderr, "kernel_launch: hipFuncSetAttribute failed\n"); grid = -1; return; }
        if (hipOccupancyMaxActiveBlocksPerMultiprocessor(&per_cu, (const void*)mk_fwd, NWAVES * 64, LDS_BYTES) != hipSuccess || per_cu < 1) { fprintf(stderr, "kernel_launch: occupancy query says %d\n", per_cu); }
        (void)hipGetLastError();
        grid = cus;
    }
    if (grid < 0) return;
    if (hipMemsetAsync((char*)d_ws + WS_CTL, 0, CTL_ZERO_BYTES, stream) != hipSuccess) return;
    Args a{};
    for (int i = 0; i < 23; ++i) a.in[i] = (const float*)d_in[i];
    a.out = (float*)d_out; a.ws = (unsigned char*)d_ws;
    hipLaunchKernelGGL(mk_fwd, dim3(grid), dim3(NWAVES * 64), LDS_BYTES, stream, a);
}
```

```cpp
#include <hip/hip_runtime.h>
#include <hip/hip_bf16.h>
#include <cstdio>
#include <cstdint>
#include <cmath>
namespace pg8 {
#define PG8_LAS __attribute__((address_space(3)))
typedef unsigned short bf16_t;
typedef short bf16x8 __attribute__((ext_vector_type(8)));
typedef float f32x4 __attribute__((ext_vector_type(4)));
typedef unsigned u32x4 __attribute__((ext_vector_type(4)));
constexpr int BM = 256, BK = 64, HALF = 128, HTB = HALF * BK * 2  , STAGE_BYTES = 8 * HTB, NXCD = 8, WGM = 8;

__host__ __device__ __forceinline__ int lds_byte(int r, int c) { const int st = (r >> 4) * 2 + (c >> 5), rr = r & 15, cc = c & 31, ob = rr * 64 + cc * 2; return st * 1024 + (ob ^ (((ob >> 9) & 1) << 5)); }
__host__ __device__ __forceinline__ void stage_rc(int b, int& R, int& C) { const int st = b / 1024, sb = b % 1024, swz = sb ^ (((sb >> 9) & 1) << 5); R = (st >> 1) * 16 + swz / 64; C = (st & 1) * 32 + (swz % 64) / 2; }
__host__ __device__ __forceinline__ int perm32(int rho) { const int n = rho >> 4, i = rho & 15; return 8 * (i >> 2) + 4 * n + (i & 3); }

struct Unit { int pm, pn; };
struct Gemm { const bf16_t* A; const bf16_t* Bt; int M, N, K; };

struct StaticOrder {
    int nM, nN, nwg, G, c;
    __host__ __device__ void init(int M, int N, int G_, int c_) { nM = M / BM; nN = N / BM; nwg = nM * nN; G = G_; c = c_; }
    __host__ __device__ bool next(int i, Unit& u) const {
        const long L = (long)i * G + c; if (L >= nwg) return false;
        int wgid = (int)L; { const int q = nwg / NXCD, r = nwg % NXCD, xcd = wgid % NXCD, off = wgid / NXCD; wgid = (xcd < r ? xcd * (q + 1) : r * (q + 1) + (xcd - r) * q) + off; }
        const int nig = WGM * nN, gid = wgid / nig, fm = gid * WGM, gsz = (nM - fm) < WGM ? (nM - fm) : WGM;
        u.pm = fm + ((wgid % nig) % gsz); u.pn = (wgid % nig) / gsz; return true;
    }
    __device__ __forceinline__ void a_ready(const Unit&) const {}
    __device__ __forceinline__ void done(const Unit&) const {}
};

__device__ __forceinline__ unsigned cvt_pk_bf16(float lo, float hi) { unsigned r; asm volatile("v_cvt_pk_bf16_f32 %0, %1, %2" : "=v"(r) : "v"(lo), "v"(hi)); return r; }

struct EpiBf16S {
    static constexpr bool PERM = true, AFTER_DRAIN = false;
    bf16_t* O; int ldc; int split_cols; size_t split_stride; float scale0; int pn_mask; int row_skew; const float* rowscale; int dry = 0;
    __device__ __forceinline__ void operator()(const f32x4 (&acc)[2][2][4][2], const Unit& u, int wr, int wc, int fr, int fq) const {
        const int row0 = u.pm * BM + wr * 64 + fr + (u.pm >> 1) * row_skew; int colt = (u.pn & pn_mask) * BM; bf16_t* base = O;
        float sc = 1.f; if (split_cols) { const int t = colt / split_cols; base += (size_t)t * split_stride; colt -= t * split_cols; if (t == 0) sc = scale0; }
        const int col0 = colt + wc * 32 + 8 * fq;
#pragma unroll
        for (int ai = 0; ai < 2; ++ai)
#pragma unroll
            for (int m = 0; m < 4; ++m) { bf16_t* rowp = base + (size_t)(row0 + ai * HALF + m * 16) * ldc + col0; const float sr = rowscale ? sc * rowscale[u.pm * BM + wr * 64 + fr + ai * HALF + m * 16] : sc;
#pragma unroll
                for (int bj = 0; bj < 2; ++bj) { f32x4 v0 = acc[ai][bj][m][0] * sr, v1 = acc[ai][bj][m][1] * sr;
                    u32x4 w; w.x = cvt_pk_bf16(v0[0], v0[1]); w.y = cvt_pk_bf16(v0[2], v0[3]); w.z = cvt_pk_bf16(v1[0], v1[1]); w.w = cvt_pk_bf16(v1[2], v1[3]);
                    if (!dry) *(u32x4*)(rowp + bj * HALF) = w; } }
    }
};
struct EpiQKO {
    static constexpr bool PERM = true, AFTER_DRAIN = false;
    bf16_t* QK; unsigned char* OG8;
    __device__ __forceinline__ void operator()(const f32x4 (&acc)[2][2][4][2], const Unit& u, int wr, int wc, int fr, int fq) const {
        const int row0 = u.pm * BM + wr * 64 + fr; const bool gate = u.pn >= 8; const int col0 = (u.pn & 7) * BM + wc * 32 + 8 * fq;
#pragma unroll
        for (int ai = 0; ai < 2; ++ai)
#pragma unroll
            for (int m = 0; m < 4; ++m) { const size_t ro = (size_t)(row0 + ai * HALF + m * 16) * 2048 + col0;
#pragma unroll
                for (int bj = 0; bj < 2; ++bj) { const f32x4 v0 = acc[ai][bj][m][0], v1 = acc[ai][bj][m][1];
                    if (!gate) { u32x4 w; w.x = cvt_pk_bf16(v0[0], v0[1]); w.y = cvt_pk_bf16(v0[2], v0[3]); w.z = cvt_pk_bf16(v1[0], v1[1]); w.w = cvt_pk_bf16(v1[2], v1[3]);
                        *(u32x4*)(QK + ro + bj * HALF) = w; }
                    else { unsigned b[8];
#pragma unroll
                        for (int e = 0; e < 4; ++e) { b[e] = (unsigned)(255.f * __builtin_amdgcn_rcpf(1.f + __builtin_amdgcn_exp2f(-1.4426950408889634f * v0[e])) + 0.5f);
                                                      b[4 + e] = (unsigned)(255.f * __builtin_amdgcn_rcpf(1.f + __builtin_amdgcn_exp2f(-1.4426950408889634f * v1[e])) + 0.5f); }
                        typedef unsigned u32x2_t __attribute__((ext_vector_type(2)));
                        *(u32x2_t*)(OG8 + ro + bj * HALF) = (u32x2_t){b[0] | (b[1] << 8) | (b[2] << 16) | (b[3] << 24), b[4] | (b[5] << 8) | (b[6] << 16) | (b[7] << 24)}; } } }
    }
};
struct EpiResF32 {
    static constexpr bool PERM = false, AFTER_DRAIN = false;
    const float* res; float* out; int ldc;
    __device__ __forceinline__ void operator()(const f32x4 (&acc)[2][2][4][2], const Unit& u, int wr, int wc, int fr, int fq) const {
        const int row0 = u.pm * BM + wr * 64 + fr, col0 = u.pn * BM + wc * 32 + 4 * fq;
        f32x4 rb[2][2][2][2];
#define PG8_RLOAD(buf, ai, mp) do { _Pragma("unroll") for (int mm = 0; mm < 2; ++mm) { const size_t off_ = (size_t)(row0 + (ai) * HALF + (2 * (mp) + mm) * 16) * ldc + col0; \
            _Pragma("unroll") for (int bj = 0; bj < 2; ++bj) _Pragma("unroll") for (int n = 0; n < 2; ++n) rb[buf][mm][bj][n] = *(const f32x4*)(res + off_ + bj * HALF + n * 16); } } while (0)
        PG8_RLOAD(0, 0, 0);
#pragma unroll
        for (int grp = 0; grp < 4; ++grp) {
            const int ai = grp >> 1, mp = grp & 1;
            if (grp + 1 < 4) { if (((grp + 1) & 1) == 0) PG8_RLOAD(0, (grp + 1) >> 1, (grp + 1) & 1); else PG8_RLOAD(1, (grp + 1) >> 1, (grp + 1) & 1); }
            __builtin_amdgcn_sched_barrier(0);
#pragma unroll
            for (int mm = 0; mm < 2; ++mm) { const int m = 2 * mp + mm; const size_t off = (size_t)(row0 + ai * HALF + m * 16) * ldc + col0;
#pragma unroll
                for (int bj = 0; bj < 2; ++bj)
#pragma unroll
                    for (int n = 0; n < 2; ++n) *(f32x4*)(out + off + bj * HALF + n * 16) = rb[grp & 1][mm][bj][n] + acc[ai][bj][m][n]; }
            __builtin_amdgcn_sched_barrier(0);
        }
#undef PG8_RLOAD
    }
};
template <bool RES_F32> struct EpiResBf16 {
    static constexpr bool PERM = true, AFTER_DRAIN = false;
    const void* res; bf16_t* out; int ldc;
    __device__ __forceinline__ void operator()(const f32x4 (&acc)[2][2][4][2], const Unit& u, int wr, int wc, int fr, int fq) const {
        const int row0 = u.pm * BM + wr * 64 + fr, col0 = u.pn * BM + wc * 32 + 8 * fq;
        f32x4 rb[2][2][2][2];
#define PG8_RLOAD(buf, ai, mp) do { _Pragma("unroll") for (int mm = 0; mm < 2; ++mm) { const size_t off_ = (size_t)(row0 + (ai) * HALF + (2 * (mp) + mm) * 16) * ldc + col0; \
            _Pragma("unroll") for (int bj = 0; bj < 2; ++bj) { if (RES_F32) { rb[buf][mm][bj][0] = *(const f32x4*)((const float*)res + off_ + bj * HALF); rb[buf][mm][bj][1] = *(const f32x4*)((const float*)res + off_ + bj * HALF + 4); } \
                else { const u32x4 w_ = *(const u32x4*)((const bf16_t*)res + off_ + bj * HALF); \
                    rb[buf][mm][bj][0] = (f32x4){__builtin_bit_cast(float, w_.x << 16), __builtin_bit_cast(float, w_.x & 0xffff0000u), __builtin_bit_cast(float, w_.y << 16), __builtin_bit_cast(float, w_.y & 0xffff0000u)}; \
                    rb[buf][mm][bj][1] = (f32x4){__builtin_bit_cast(float, w_.z << 16), __builtin_bit_cast(float, w_.z & 0xffff0000u), __builtin_bit_cast(float, w_.w << 16), __builtin_bit_cast(float, w_.w & 0xffff0000u)}; } } } } while (0)
        PG8_RLOAD(0, 0, 0);
#pragma unroll
        for (int grp = 0; grp < 4; ++grp) {
            const int ai = grp >> 1, mp = grp & 1;
            if (grp + 1 < 4) { if (((grp + 1) & 1) == 0) PG8_RLOAD(0, (grp + 1) >> 1, (grp + 1) & 1); else PG8_RLOAD(1, (grp + 1) >> 1, (grp + 1) & 1); }
            __builtin_amdgcn_sched_barrier(0);
#pragma unroll
            for (int mm = 0; mm < 2; ++mm) { const int m = 2 * mp + mm; const size_t off = (size_t)(row0 + ai * HALF + m * 16) * ldc + col0;
#pragma unroll
                for (int bj = 0; bj < 2; ++bj) { const f32x4 v0 = rb[grp & 1][mm][bj][0] + acc[ai][bj][m][0], v1 = rb[grp & 1][mm][bj][1] + acc[ai][bj][m][1];
                    u32x4 w; w.x = cvt_pk_bf16(v0[0], v0[1]); w.y = cvt_pk_bf16(v0[2], v0[3]); w.z = cvt_pk_bf16(v1[0], v1[1]); w.w = cvt_pk_bf16(v1[2], v1[3]);
                    *(u32x4*)(out + off + bj * HALF) = w; } }
            __builtin_amdgcn_sched_barrier(0);
        }
#undef PG8_RLOAD
    }
};
struct EpiSwiGLU {
    static constexpr bool PERM = true, AFTER_DRAIN = false;
    bf16_t* O; const float* ew; const float* ers; const PG8_LAS int* eoff; int ldw;
    __device__ __forceinline__ void operator()(const f32x4 (&acc)[2][2][4][2], const Unit& u, int wr, int wc, int fr, int fq) const {
        const int row0 = u.pm * BM + wr * 64 + fr, col0 = (u.pn & 1) * 128 + wc * 32 + 8 * fq; const int e = u.pn >> 1;
        const float* roww = ew + (size_t)e * ldw - eoff[e]; const float* rowr = ers + (size_t)e * ldw - eoff[e];
        float gws[2][4], grs[2][4];
#pragma unroll
        for (int ai = 0; ai < 2; ++ai)
#pragma unroll
            for (int m = 0; m < 4; ++m) { gws[ai][m] = roww[row0 + ai * HALF + m * 16]; grs[ai][m] = rowr[row0 + ai * HALF + m * 16]; }
#pragma unroll
        for (int ai = 0; ai < 2; ++ai)
#pragma unroll
            for (int m = 0; m < 4; ++m) { const int row = row0 + ai * HALF + m * 16; const float gw = gws[ai][m], gr = grs[ai][m]; float a[8];
#pragma unroll
                for (int n = 0; n < 2; ++n)
#pragma unroll
                    for (int e4 = 0; e4 < 4; ++e4) { const float g = acc[ai][0][m][n][e4] * gr, up = acc[ai][1][m][n][e4] * gr;
                        const float sg = g * __builtin_amdgcn_rcpf(1.f + __builtin_amdgcn_exp2f(-1.4426950408889634f * g)); a[n * 4 + e4] = sg * up * gw; }
                u32x4 w; w.x = cvt_pk_bf16(a[0], a[1]); w.y = cvt_pk_bf16(a[2], a[3]); w.z = cvt_pk_bf16(a[4], a[5]); w.w = cvt_pk_bf16(a[6], a[7]);
                *(u32x4*)(O + (size_t)row * 256 + col0) = w; }
    }
};
struct MoeGather {
    static constexpr bool ON = true;
    const int* e2t; const PG8_LAS int* eoff; int shift, ld;
    __device__ __forceinline__ unsigned row(const Unit& u, int r) const { const int e = u.pn >> shift; const unsigned t = (unsigned)e2t[(size_t)e * ld + (u.pm * BM + r - eoff[e])]; return t < (unsigned)ld ? t : (unsigned)(ld - 1); }
};
struct MoeOrder {
    const PG8_LAS int* pexp; int np, shift, G, c; int lo = 0, hi = 0x7fffffff;
    __device__ __forceinline__ bool next(int i, Unit& u) const {
        const int L = lo + i * G + c; if (c < 0 || L >= hi || L >= (np << shift)) return false;
        const int p = L >> shift; const int e = __builtin_amdgcn_readfirstlane(pexp[p]);
        u.pm = p; u.pn = (e << shift) + (L & ((1 << shift) - 1)); return true;
    }
    __device__ __forceinline__ void a_ready(const Unit&) const {}
    __device__ __forceinline__ void done(const Unit&) const {}
};
struct NoGather { static constexpr bool ON = false; __device__ __forceinline__ unsigned row(const Unit&, int) const { return 0u; } };
template <class Epi, class Sched, bool ALIGN_EPI = false, bool SP2 = false, class AG = NoGather, bool NOLOAD = false, int NOLDS = 0>
__device__ __forceinline__ void gemm_phase(PG8_LAS unsigned char* lds, const Gemm g, const Sched& S, const Epi& E, const AG& GA = AG()) {
    static_assert(!AG::ON || SP2, "row gather is wired into the SP2 loop only");
    int tid_ = threadIdx.x; asm volatile("" : "+v"(tid_)); const int tid = tid_, wid = __builtin_amdgcn_readfirstlane(tid >> 6), lane = tid & 63, wr = wid >> 2, wc = wid & 3, fr = lane & 15, fq = lane >> 4;
    const int K = g.K, nt = K / BK;
    unsigned voffA[2], voffB[2]; int aR[2], aC[2];
#pragma unroll
    for (int i = 0; i < 2; ++i) { int R, C; stage_rc(tid * 16 + i * 8192, R, C); const int Rb = Epi::PERM ? ((R & ~31) + perm32(R & 31)) : R; aR[i] = R; aC[i] = C;
        voffA[i] = (unsigned)(R * K + C) * 2u; voffB[i] = (unsigned)(Rb * K + C) * 2u; }
    unsigned gcur0[2], gcur1[2], gnxt0[2], gnxt1[2];
#define PG8_GOFF(u, d0, d1) do { _Pragma("unroll") for (int _i = 0; _i < 2; ++_i) { d0[_i] = (GA.row(u, aR[_i]) * (unsigned)K + (unsigned)aC[_i]) * 2u; d1[_i] = (GA.row(u, HALF + aR[_i]) * (unsigned)K + (unsigned)aC[_i]) * 2u; } } while (0)
    const size_t kstep = (size_t)(BK * 2);
    const size_t hstep = (size_t)HALF * K * 2;
    const size_t tstep = 2 * hstep;
    const unsigned ldsw = (unsigned)wid * 1024u;
    const int aoff = lds_byte(wr * 64 + fr, fq * 8), boff = lds_byte(wc * 32 + fr, fq * 8);
#define PG8_SA(b, h) (((b) * 2 + (h)) * HTB)
#define PG8_SB(b, h) ((4 + (b) * 2 + (h)) * HTB)
#define PG8_STAGE(bufoff, gbase, voff) do { if (!NOLOAD) _Pragma("unroll") for (int _i = 0; _i < 2; ++_i) \
        __builtin_amdgcn_global_load_lds((const unsigned*)((const char*)(gbase) + (voff)[_i]), (PG8_LAS unsigned*)(lds + (bufoff) + ldsw + _i * 8192), 16, 0, 0); } while (0)
#define PG8_LDA(dst, b, h) do { if (!(NOLDS & 1)) _Pragma("unroll") for (int m = 0; m < 4; ++m) _Pragma("unroll") for (int k = 0; k < 2; ++k) dst[m][k] = *(const PG8_LAS bf16x8*)(lds + PG8_SA(b, h) + aoff + m * 2048 + k * 1024); } while (0)
#define PG8_LDB(dst, b, h) do { if (!(NOLDS & 2)) _Pragma("unroll") for (int n = 0; n < 2; ++n) _Pragma("unroll") for (int k = 0; k < 2; ++k) dst[n][k] = *(const PG8_LAS bf16x8*)(lds + PG8_SB(b, h) + boff + n * 2048 + k * 1024); } while (0)
#define PG8_MMA(ai, bj, At, Bt) do { __builtin_amdgcn_s_setprio(1); _Pragma("unroll") for (int m = 0; m < 4; ++m) _Pragma("unroll") for (int n = 0; n < 2; ++n) _Pragma("unroll") for (int k = 0; k < 2; ++k) \
        acc[ai][bj][m][n] = __builtin_amdgcn_mfma_f32_16x16x32_bf16(Bt[n][k], At[m][k], acc[ai][bj][m][n], 0, 0, 0); __builtin_amdgcn_s_setprio(0); } while (0)
#define PG8_WAIT_V(n) asm volatile("s_waitcnt vmcnt(" #n ")" ::: "memory")
#define PG8_WAIT_L(n) asm volatile("s_waitcnt lgkmcnt(" #n ")" ::: "memory")
#define PG8_BAR do { if (!(NOLDS & 4)) __builtin_amdgcn_s_barrier(); } while (0)
#define PG8_SCHED __builtin_amdgcn_sched_barrier(0)
    Unit cur, nxt; int ui = 0;
    if (!S.next(0, cur)) return;
    f32x4 acc[2][2][4][2];
#pragma unroll
    for (int a = 0; a < 2; ++a)
#pragma unroll
        for (int b = 0; b < 2; ++b)
#pragma unroll
            for (int m = 0; m < 4; ++m)
#pragma unroll
                for (int n = 0; n < 2; ++n) acc[a][b][m][n] = (f32x4){0.f, 0.f, 0.f, 0.f};
    bf16x8 At[4][2], B0[2][2], B1[2][2];
    if (NOLDS) { _Pragma("unroll") for (int m = 0; m < 4; ++m) _Pragma("unroll") for (int k = 0; k < 2; ++k) { At[m][k] = (bf16x8){0, 0, 0, 0, 0, 0, 0, 0}; asm volatile("" : "+v"(At[m][k])); }
        _Pragma("unroll") for (int n = 0; n < 2; ++n) _Pragma("unroll") for (int k = 0; k < 2; ++k) { B0[n][k] = (bf16x8){0, 0, 0, 0, 0, 0, 0, 0}; asm volatile("" : "+v"(B0[n][k])); B1[n][k] = B0[n][k]; asm volatile("" : "+v"(B1[n][k])); } }
    const char* cA = (const char*)g.A + (AG::ON ? (size_t)0 : (size_t)cur.pm * tstep); const char* cB = (const char*)g.Bt + (size_t)cur.pn * tstep;
    if constexpr (AG::ON) { PG8_GOFF(cur, gcur0, gcur1); gnxt0[0] = gcur0[0]; gnxt0[1] = gcur0[1]; gnxt1[0] = gcur1[0]; gnxt1[1] = gcur1[1]; }
#define PG8_STAGE_A(bufoff, base, half, G0, G1) do { if constexpr (AG::ON) { if ((half) == 0) PG8_STAGE(bufoff, base, G0); else PG8_STAGE(bufoff, base, G1); } else { PG8_STAGE(bufoff, (base) + (half) * hstep, voffA); } } while (0)
    S.a_ready(cur);
    if constexpr (SP2) {
        PG8_STAGE(PG8_SB(0, 0), cB, voffB); PG8_STAGE(PG8_SB(0, 1), cB + hstep, voffB); PG8_STAGE_A(PG8_SA(0, 0), cA, 0, gcur0, gcur1); PG8_STAGE_A(PG8_SA(0, 1), cA, 1, gcur0, gcur1);
        if (wr == 1) PG8_BAR;
        PG8_WAIT_V(2); PG8_BAR;
        PG8_STAGE(PG8_SB(1, 0), cB + kstep, voffB); PG8_STAGE_A(PG8_SA(1, 0), cA + kstep, 0, gcur0, gcur1); PG8_STAGE(PG8_SB(1, 1), cB + hstep + kstep, voffB);
        PG8_WAIT_V(6); PG8_BAR;
    } else {
        PG8_STAGE(PG8_SB(0, 0), cB, voffB); PG8_STAGE(PG8_SA(0, 0), cA, voffA); PG8_STAGE(PG8_SB(0, 1), cB + hstep, voffB); PG8_STAGE(PG8_SA(0, 1), cA + hstep, voffA);
        if (wr == 1) PG8_BAR;
        PG8_WAIT_V(4); PG8_BAR;
        PG8_STAGE(PG8_SB(1, 0), cB + kstep, voffB); PG8_STAGE(PG8_SA(1, 0), cA + kstep, voffA); PG8_STAGE(PG8_SB(1, 1), cB + hstep + kstep, voffB);
        PG8_WAIT_V(6); PG8_BAR;
    }
    for (;;) {
        const bool has_next = S.next(ui + 1, nxt);
        if constexpr (AG::ON) { if (has_next) PG8_GOFF(nxt, gnxt0, gnxt1); }
        const char* nA = (has_next && !AG::ON) ? (const char*)g.A + (size_t)nxt.pm * tstep : cA; const char* nB = has_next ? (const char*)g.Bt + (size_t)nxt.pn * tstep : cB;
        for (int t = 0; t < nt; t += 2) {
            const bool last = (t == nt - 2);
            const char* a1 = cA + (size_t)(t + 1) * kstep;
            const char* a2 = last ? nA : cA + (size_t)(t + 2) * kstep; const char* b2 = last ? nB : cB + (size_t)(t + 2) * kstep;
            const char* a3 = a2 + kstep; const char* b3 = b2 + kstep;
            if (last && has_next) S.a_ready(nxt);
            if constexpr (SP2) {
            unsigned g20[2], g21[2];
            if constexpr (AG::ON) { g20[0] = last ? gnxt0[0] : gcur0[0]; g20[1] = last ? gnxt0[1] : gcur0[1]; g21[0] = last ? gnxt1[0] : gcur1[0]; g21[1] = last ? gnxt1[1] : gcur1[1]; }
            PG8_LDB(B0, 0, 0); PG8_LDB(B1, 0, 1); PG8_SCHED; PG8_LDA(At, 0, 0); PG8_STAGE_A(PG8_SA(1, 1), a1, 1, gcur0, gcur1);
            PG8_WAIT_V(8); PG8_WAIT_L(0); PG8_BAR; PG8_MMA(0, 0, At, B0); PG8_MMA(0, 1, At, B1); PG8_BAR; PG8_SCHED;
            PG8_LDA(At, 0, 1); PG8_STAGE(PG8_SB(0, 0), b2, voffB); PG8_STAGE(PG8_SB(0, 1), b2 + hstep, voffB); PG8_STAGE_A(PG8_SA(0, 0), a2, 0, g20, g21);
            PG8_WAIT_V(8); PG8_WAIT_L(0); PG8_BAR; PG8_MMA(1, 0, At, B0); PG8_MMA(1, 1, At, B1); PG8_BAR; PG8_SCHED;
            PG8_LDB(B0, 1, 0); PG8_LDB(B1, 1, 1); PG8_SCHED; PG8_LDA(At, 1, 0); PG8_STAGE_A(PG8_SA(0, 1), a2, 1, g20, g21);
            PG8_WAIT_V(8); PG8_WAIT_L(0); PG8_BAR; PG8_MMA(0, 0, At, B0); PG8_MMA(0, 1, At, B1); PG8_BAR; PG8_SCHED;
            PG8_LDA(At, 1, 1); PG8_STAGE(PG8_SB(1, 0), b3, voffB); PG8_STAGE(PG8_SB(1, 1), b3 + hstep, voffB); PG8_STAGE_A(PG8_SA(1, 0), a3, 0, g20, g21);
            PG8_WAIT_V(8); PG8_WAIT_L(0); PG8_BAR; PG8_MMA(1, 0, At, B0); PG8_MMA(1, 1, At, B1); PG8_BAR; PG8_SCHED;
            } else {
            PG8_LDB(B0, 0, 0); PG8_SCHED; PG8_LDA(At, 0, 0); PG8_STAGE(PG8_SA(1, 1), a1 + hstep, voffA);
            PG8_WAIT_L(8); PG8_BAR; PG8_WAIT_L(0); PG8_MMA(0, 0, At, B0); PG8_BAR; PG8_SCHED;
            PG8_LDB(B1, 0, 1); PG8_STAGE(PG8_SB(0, 0), b2, voffB);
            PG8_BAR; PG8_WAIT_L(0); PG8_MMA(0, 1, At, B1); PG8_BAR;
            PG8_LDA(At, 0, 1); PG8_STAGE(PG8_SA(0, 0), a2, voffA);
            PG8_BAR; PG8_WAIT_L(0); PG8_MMA(1, 0, At, B0); PG8_BAR; PG8_SCHED;
            PG8_STAGE(PG8_SB(0, 1), b2 + hstep, voffB);
            PG8_WAIT_V(6); PG8_BAR; PG8_MMA(1, 1, At, B1); PG8_BAR;
            PG8_LDB(B0, 1, 0); PG8_SCHED; PG8_LDA(At, 1, 0); PG8_STAGE(PG8_SA(0, 1), a2 + hstep, voffA);
            PG8_WAIT_L(8); PG8_BAR; PG8_WAIT_L(0); PG8_MMA(0, 0, At, B0); PG8_BAR; PG8_SCHED;
            PG8_LDB(B1, 1, 1); PG8_STAGE(PG8_SB(1, 0), b3, voffB);
            PG8_BAR; PG8_WAIT_L(0); PG8_MMA(0, 1, At, B1); PG8_BAR;
            PG8_LDA(At, 1, 1); PG8_STAGE(PG8_SA(1, 0), a3, voffA);
            PG8_BAR; PG8_WAIT_L(0); PG8_MMA(1, 0, At, B0); PG8_BAR; PG8_SCHED;
            PG8_STAGE(PG8_SB(1, 1), b3 + hstep, voffB);
            PG8_WAIT_V(6); PG8_BAR; PG8_MMA(1, 1, At, B1); PG8_BAR;
            }
        }
        if constexpr (ALIGN_EPI) { if (wr == 0) PG8_BAR; }
        if constexpr (!Epi::AFTER_DRAIN) { E(acc, cur, wr, wc, fr, fq); S.done(cur); }
        if (!has_next) break;
#pragma unroll
        for (int a = 0; a < 2; ++a)
#pragma unroll
            for (int b = 0; b < 2; ++b)
#pragma unroll
                for (int m = 0; m < 4; ++m)
#pragma unroll
                    for (int n = 0; n < 2; ++n) acc[a][b][m][n] = (f32x4){0.f, 0.f, 0.f, 0.f};
        cur = nxt; cA = nA; cB = nB; ++ui;
        if constexpr (AG::ON) { gcur0[0] = gnxt0[0]; gcur0[1] = gnxt0[1]; gcur1[0] = gnxt1[0]; gcur1[1] = gnxt1[1]; }
        if constexpr (ALIGN_EPI) { if (wr == 1) PG8_BAR; }
    }
    PG8_WAIT_V(0);
    if constexpr (!ALIGN_EPI) { if (wr == 0) PG8_BAR; }
    PG8_BAR;
    if constexpr (Epi::AFTER_DRAIN) { E.fused(acc, cur, wr, wc, fr, fq, lds, wid, lane); S.done(cur); }
#undef PG8_SA
#undef PG8_SB
#undef PG8_STAGE
#undef PG8_STAGE_A
#undef PG8_GOFF
#undef PG8_LDA
#undef PG8_LDB
#undef PG8_MMA
#undef PG8_WAIT_V
#undef PG8_WAIT_L
#undef PG8_BAR
#undef PG8_SCHED
}
}

#include <hip/hip_bf16.h>
#include <cmath>
namespace attn_body {
using bf16=__hip_bfloat16;
using bf16x8=__attribute__((ext_vector_type(8)))short;
using s16x4=__attribute__((ext_vector_type(4)))short;
using f32x16=__attribute__((ext_vector_type(16)))float;
using u32x4=__attribute__((ext_vector_type(4)))unsigned;
constexpr int BATCH=4,NVH=32,SEQ=8192,D=64,PQ=1024,PO=1024;
constexpr int NW=8,QBLK=32,QB=QBLK*NW,KVBLK=64,NQB=SEQ/QB;
constexpr int ATTN_UNIT_ROWS=QB;
__device__ __forceinline__ int crow(int r,int hi){return (r&3)+8*(r>>2)+4*hi;}
#define SBAR() __builtin_amdgcn_sched_barrier(0)
__device__ __forceinline__ void cmask(f32x16&p0,f32x16&p1,int jb,int qrel,int hi){
  const float NEG=-INFINITY; int kb=64*jb+4*hi;
  #pragma unroll
  for(int r=0;r<16;++r){int kv=kb+(r&3)+8*(r>>2); if(kv>qrel)p0[r]=NEG; if(kv+32>qrel)p1[r]=NEG;}
}

constexpr int NSLOT=3, SLOTB=8192;
constexpr int LDS_K=0, LDS_V=NSLOT*SLOTB, LDS_WS=3*NSLOT*SLOTB, LDS_OST=LDS_WS+NW*64*4, LDS_BYTES=LDS_OST+NW*4096;
constexpr float C2=0.125f*1.4426950408889634f;
__device__ __forceinline__ void glds16(const void*gsrc,unsigned lds_dst){unsigned keep;
  asm volatile("s_mov_b32 %0, m0\n\ts_mov_b32 m0, %2\n\ts_nop 0\n\tglobal_load_lds_dwordx4 %1, off\n\ts_mov_b32 m0, %0":"=&s"(keep):"v"(gsrc),"s"(lds_dst):"memory");}
__device__ __forceinline__ float max3f(float a,float b,float c){float r;asm("v_max3_f32 %0, %1, %2, %3":"=v"(r):"v"(a),"v"(b),"v"(c));return r;}
__device__ __forceinline__ float max2f(float a,float b){float r;asm("v_max_f32_e32 %0, %1, %2":"=v"(r):"v"(a),"v"(b));return r;}
__device__ __forceinline__ float fadd_s(float a,float b){float r;asm("v_add_f32_e32 %0, %1, %2":"=v"(r):"v"(a),"v"(b));return r;}
__device__ __forceinline__ float fsub_s(float a,float b){float r;asm("v_sub_f32_e32 %0, %1, %2":"=v"(r):"v"(a),"v"(b));return r;}
typedef float f32x2_t __attribute__((ext_vector_type(2))); typedef __bf16 bf16x2_t __attribute__((ext_vector_type(2)));
__device__ __forceinline__ unsigned cvtpk_s(float lo,float hi){f32x2_t v={lo,hi};bf16x2_t b=__builtin_convertvector(v,bf16x2_t);return __builtin_bit_cast(unsigned,b);}
#define WAIT_BAR(N) asm volatile("s_waitcnt vmcnt(" #N ") lgkmcnt(0)\n\ts_barrier":::"memory")

__device__ __forceinline__ void qkt(f32x16&p0,f32x16&p1,const char*Kslot,const bf16x8*qr,const f32x16&negm,int r32,int hi){
  const char*kb=Kslot+hi*1024+r32*16;
  #pragma unroll
  for(int d0=0;d0<4;++d0){
    const bf16x8 b0=*reinterpret_cast<const bf16x8*>(kb+d0*2048);
    const bf16x8 b1=*reinterpret_cast<const bf16x8*>(kb+d0*2048+512);
    if(d0==0){p0=__builtin_amdgcn_mfma_f32_32x32x16_bf16(b0,qr[0],negm,0,0,0);p1=__builtin_amdgcn_mfma_f32_32x32x16_bf16(b1,qr[0],negm,0,0,0);}
    else{p0=__builtin_amdgcn_mfma_f32_32x32x16_bf16(b0,qr[d0],p0,0,0,0);p1=__builtin_amdgcn_mfma_f32_32x32x16_bf16(b1,qr[d0],p1,0,0,0);}}
}
typedef __attribute__((address_space(3))) const char* lds_cptr;
typedef short v4i16_t __attribute__((ext_vector_type(4)));
__device__ __forceinline__ void kload8(bf16x8*kf,lds_cptr kp){
  kf[0]=*(const __attribute__((address_space(3))) bf16x8*)(kp);      kf[1]=*(const __attribute__((address_space(3))) bf16x8*)(kp+512);
  kf[2]=*(const __attribute__((address_space(3))) bf16x8*)(kp+2048); kf[3]=*(const __attribute__((address_space(3))) bf16x8*)(kp+2560);
  kf[4]=*(const __attribute__((address_space(3))) bf16x8*)(kp+4096); kf[5]=*(const __attribute__((address_space(3))) bf16x8*)(kp+4608);
  kf[6]=*(const __attribute__((address_space(3))) bf16x8*)(kp+6144); kf[7]=*(const __attribute__((address_space(3))) bf16x8*)(kp+6656);
}
__device__ __forceinline__ void kload2(bf16x8*kf,lds_cptr kp,int j){ kf[2*j]=*(const __attribute__((address_space(3))) bf16x8*)(kp+j*2048); kf[2*j+1]=*(const __attribute__((address_space(3))) bf16x8*)(kp+j*2048+512); }
__device__ __forceinline__ s16x4 vtr(lds_cptr p){ return __builtin_bit_cast(s16x4,__builtin_amdgcn_ds_read_tr16_b64_v4i16((__attribute__((address_space(3))) v4i16_t*)p)); }
__device__ __forceinline__ float rowmax(const f32x16&p0,const f32x16&p1){
  float a=max3f(p0[0],p0[1],p1[0]),b=max3f(p0[2],p0[3],p1[1]);a=max3f(a,p1[2],p1[3]);
  #pragma unroll
  for(int r=4;r<16;r+=4){a=max3f(a,p0[r],p0[r+1]);b=max3f(b,p0[r+2],p0[r+3]);a=max3f(a,p1[r],p1[r+1]);b=max3f(b,p1[r+2],p1[r+3]);}
  const float m=max2f(a,b);
  auto rr=__builtin_amdgcn_permlane32_swap(__float_as_uint(m),__float_as_uint(m),false,false);
  return max2f(__uint_as_float(rr[0]),__uint_as_float(rr[1]));
}
__device__ __forceinline__ void pv(f32x16*o,int vb,bf16x8 pa0,bf16x8 pa1,bf16x8 pa2,bf16x8 pa3){
  #pragma unroll
  for(int d0=0;d0<4;++d0){s16x4 lo[4],hi[4];
    #pragma unroll
    for(int ks=0;ks<4;++ks){
      asm volatile("ds_read_b64_tr_b16 %0,%1 offset:%c2":"=&v"(lo[ks]):"v"(vb),"i"(d0*4096+ks*1024):"memory");
      asm volatile("ds_read_b64_tr_b16 %0,%1 offset:%c2":"=&v"(hi[ks]):"v"(vb),"i"(d0*4096+ks*1024+512):"memory");}
    asm volatile("s_waitcnt lgkmcnt(0)":::"memory");SBAR();
    #define PK(k) (bf16x8){lo[k][0],lo[k][1],lo[k][2],lo[k][3],hi[k][0],hi[k][1],hi[k][2],hi[k][3]}
    o[d0]=__builtin_amdgcn_mfma_f32_32x32x16_bf16(pa0,PK(0),o[d0],0,0,0);
    o[d0]=__builtin_amdgcn_mfma_f32_32x32x16_bf16(pa1,PK(1),o[d0],0,0,0);
    o[d0]=__builtin_amdgcn_mfma_f32_32x32x16_bf16(pa2,PK(2),o[d0],0,0,0);
    o[d0]=__builtin_amdgcn_mfma_f32_32x32x16_bf16(pa3,PK(3),o[d0],0,0,0);
    #undef PK
  }
}

#ifndef ATTN_STORE16
#define ATTN_STORE16(p,v) (*(u32x4*)(p)=(v))
#endif
template<int THRL> __device__ __forceinline__ void attn_unit(int b,int qcol,int kcol,int vcol,int ocol,int qb,const bf16*Q,const bf16*__restrict__ K,const bf16*__restrict__ V,bf16*O,bf16*O2,int mode,float lam,const __attribute__((address_space(3))) float*gn,char*shm,bool pre,bool has_next,int nb,int nkcol,int nvcol){
  int tid_=threadIdx.x; asm volatile("":"+v"(tid_)); const int tid=tid_,lane=tid&63,r32=lane&31,hi=lane>>5; const int wid=__builtin_amdgcn_readfirstlane(tid>>6);
  const long rowbase=(long)b*SEQ; const int q0=qb*QB;
  const bf16*Qw=Q+(rowbase+q0+wid*QBLK)*PQ+qcol;
  const bf16*Kh=K+rowbase*PQ+kcol,*Vh=V+rowbase*PQ+vcol;
  const unsigned lds0=(unsigned)(uintptr_t)shm;
  float*wsf=(float*)(shm+LDS_WS)+wid*64;
  const bf16*ksrc=Kh+(long)lane*PQ+wid*8;
  const bf16*vsrc=Vh+(long)(16*(wid&3)+(lane>>2))*PQ+(wid>>2)*32+(lane&3)*8;
  const unsigned kdst=lds0+LDS_K+wid*1024, vdst=lds0+LDS_V+wid*1024;
  #define DMA_K(t,slot) glds16(ksrc+(long)(t)*KVBLK*PQ,(unsigned)__builtin_amdgcn_readfirstlane(kdst+(slot)))
  #define DMA_V(t,slot) do{ glds16(vsrc+(long)(t)*KVBLK*PQ,(unsigned)__builtin_amdgcn_readfirstlane(vdst+2*(slot))); glds16(vsrc+(long)(t)*KVBLK*PQ+64,(unsigned)__builtin_amdgcn_readfirstlane(vdst+2*(slot)+8192)); }while(0)
  const int vb0=(int)(lds0+LDS_V)+((lane>>4)&1)*32+(lane&3)*8+(4*hi+((lane&15)>>2))*64;
  const char*Kbase=shm+LDS_K; bf16x8 kf[8];
  const lds_cptr shm3=(lds_cptr)shm; const lds_cptr kp0=shm3+LDS_K+hi*1024+r32*16; const lds_cptr vp0=shm3+LDS_V+((lane>>4)&1)*32+(lane&3)*8+(4*hi+((lane&15)>>2))*64;
  const int NT=(q0+QB)/KVBLK;
  if(!pre){DMA_K(0,0);DMA_V(0,0);DMA_K(1,SLOTB);}
  typedef __attribute__((address_space(3))) bf16x8 lds_bf16x8;
  lds_bf16x8*const qst=(lds_bf16x8*)(shm3+LDS_OST+wid*4096)+lane;
  { bf16x8 qr[4];
    #pragma unroll
    for(int d0=0;d0<4;++d0)qr[d0]=*reinterpret_cast<const bf16x8*>(&Qw[(long)r32*PQ+d0*16+hi*8]);
    #pragma unroll
    for(int d0=0;d0<4;++d0)qst[64*d0]=qr[d0]; }
  float mhat=0.f,l_reg=0.f;f32x16 o[4];o[0]=f32x16{};o[1]=f32x16{};o[2]=f32x16{};o[3]=f32x16{};f32x16 negm=f32x16{};asm volatile("":"+v"(negm));
  const int qrel=wid*QBLK+r32;
  #define CMASK(P0,P1,t) do{int jb_=(t)-(NT-4); if(jb_>=0)cmask(P0,P1,jb_,qrel,hi);}while(0)
  bool resc=false;
  #define START(P0,P1) do{ const float rm=rowmax(P0,P1); resc=false; \
    { const float dl=rm; mhat=fadd_s(mhat,dl); \
      _Pragma("unroll") for(int r=0;r<16;++r){P0[r]=fsub_s(P0[r],dl);P1[r]=fsub_s(P1[r],dl);} \
      _Pragma("unroll") for(int r=0;r<16;++r)negm[r]=-mhat; asm volatile("":"+v"(negm)); } \
    _Pragma("unroll") for(int r=0;r<16;++r)P0[r]=__builtin_amdgcn_exp2f(P0[r]); }while(0)
  #define RESC() do{ if(resc){ asm volatile("s_waitcnt lgkmcnt(0)":::"memory"); \
      _Pragma("unroll") for(int d_=0;d_<4;++d_) _Pragma("unroll") for(int r=0;r<16;++r)o[d_][r]*=wsf[crow(r,hi)]; } }while(0)
  f32x16 pA0,pA1,pB0,pB1;
  int sl_prev=0,sl_cur=0,sl_next=SLOTB;
  #define ROT() do{sl_prev=sl_cur;sl_cur=sl_next;sl_next=(sl_next==(NSLOT-1)*SLOTB)?0:sl_next+SLOTB;}while(0)
  if(!pre)DMA_K(2,2*SLOTB);
  WAIT_BAR(4);
  { bf16x8 qr[4];
    #pragma unroll
    for(int d0=0;d0<4;++d0)qr[d0]=qst[64*d0];
    qkt(pA0,pA1,Kbase,qr,negm,r32,hi); }
  asm volatile("s_nop 15\n\ts_nop 7":"+v"(pA0),"+v"(pA1));CMASK(pA0,pA1,0);
  START(pA0,pA1);
  _Pragma("unroll") for(int r=0;r<16;++r)pA1[r]=__builtin_amdgcn_exp2f(pA1[r]);
  WAIT_BAR(0);
  DMA_K(3,0);DMA_V(1,SLOTB);
  ROT();
  kload8(kf,kp0+sl_cur);
  WAIT_BAR(3);
  bf16x8 vf[4]; u32x4 pw0,pw1,pw2,pw3;
  #define PKW(P,B) cvtpk_s(P[B],P[B+1])
  #define PAF(k) __builtin_bit_cast(bf16x8,pw##k)
  #define VFR(i) vf[i]
  #define PIN(x) asm volatile("":"+v"(x))
  #define MX3(a,b,c) __builtin_fmaxf(__builtin_fmaxf((a),(b)),(c))
  #define GAPA(MF,A0,A1,A2,A3,W0,W1,PW) do{ MF; sacc+=A0; sacc+=A1; sacc+=A2; sacc+=A3; PIN(sacc); W0; W1; PIN(PW); SBAR(); }while(0)
  #define EX(v) __builtin_amdgcn_exp2f(v)
  #define GAPB(MF,X,B) do{ MF; X[B]=EX(X[B]); X[B+1]=EX(X[B+1]); PIN(X); SBAR(); }while(0)
  #define VRD(n) do{ const s16x4 lo_=vtr(vp_+(((n)&3)*4096+((n)>>2)*1024)), hi_=vtr(vp_+(((n)&3)*4096+((n)>>2)*1024+512)); vf[(n)&3]=__builtin_shufflevector(lo_,hi_,0,1,2,3,4,5,6,7); }while(0)
  #define KRD(G,j) do{ if(G){ kload2(kf,kp0+sl_next,j); SBAR(); } }while(0)
  #define PVM(n,X,B) GAPB(o[(n)&3]=__builtin_amdgcn_mfma_f32_32x32x16_bf16(PAFN((n)>>2),VFR((n)&3),o[(n)&3],0,0,0), X,B)
  #define PAFN(k) ((k)==0?PAF(0):(k)==1?PAF(1):(k)==2?PAF(2):PAF(3))
  #define STEP(C0,C1,P0,P1,t,GK,GV,GL) do{ SBAR(); \
    const lds_cptr vp_=vp0+2*sl_prev; \
    bf16x8 q0_=qst[0],q1_=qst[64]; SBAR(); float sacc=(P0[0]+P0[1]); \
    GAPA(C0=__builtin_amdgcn_mfma_f32_32x32x16_bf16(kf[0],q0_,negm,0,0,0), P0[2],P0[3],P0[4],P0[5],     pw0[0]=PKW(P0,0), pw0[1]=PKW(P0,2), pw0); \
    GAPA(C1=__builtin_amdgcn_mfma_f32_32x32x16_bf16(kf[1],q0_,negm,0,0,0), P0[6],P0[7],P0[8],P0[9],     pw0[2]=PKW(P0,4), pw0[3]=PKW(P0,6), pw0); \
    bf16x8 q2_=qst[128]; SBAR(); \
    GAPA(C0=__builtin_amdgcn_mfma_f32_32x32x16_bf16(kf[2],q1_,C0,0,0,0),   P0[10],P0[11],P0[12],P0[13], pw1[0]=PKW(P0,8), pw1[1]=PKW(P0,10), pw1); \
    GAPA(C1=__builtin_amdgcn_mfma_f32_32x32x16_bf16(kf[3],q1_,C1,0,0,0),   P0[14],P0[15],P1[0],P1[1],   pw1[2]=PKW(P0,12),pw1[3]=PKW(P0,14), pw1); \
    bf16x8 q3_=qst[192]; SBAR(); \
    GAPA(C0=__builtin_amdgcn_mfma_f32_32x32x16_bf16(kf[4],q2_,C0,0,0,0),   P1[2],P1[3],P1[4],P1[5],     pw2[0]=PKW(P1,0), pw2[1]=PKW(P1,2), pw2); \
    GAPA(C1=__builtin_amdgcn_mfma_f32_32x32x16_bf16(kf[5],q2_,C1,0,0,0),   P1[6],P1[7],P1[8],P1[9],     pw2[2]=PKW(P1,4), pw2[3]=PKW(P1,6), pw2); \
    VRD(0); SBAR(); \
    GAPA(C0=__builtin_amdgcn_mfma_f32_32x32x16_bf16(kf[6],q3_,C0,0,0,0),   P1[10],P1[11],P1[12],P1[13], pw3[0]=PKW(P1,8), pw3[1]=PKW(P1,10), pw3); \
    VRD(1); VRD(2); SBAR(); \
    GAPA(C1=__builtin_amdgcn_mfma_f32_32x32x16_bf16(kf[7],q3_,C1,0,0,0),   P1[14],P1[15],0.f,0.f,       pw3[2]=PKW(P1,12),pw3[3]=PKW(P1,14), pw3); \
    l_reg+=sacc; \
    if(GK){DMA_K((t)+3,sl_cur);} if(GV){DMA_V((t)+1,sl_next);} \
    CMASK(C0,C1,t); \
    { float a=MX3(C0[0],C0[1],C1[0]),b=MX3(C0[2],C0[3],C1[1]); a=MX3(a,C1[2],C1[3]); \
      _Pragma("unroll") for(int r=4;r<16;r+=4){a=MX3(a,C0[r],C0[r+1]);b=MX3(b,C0[r+2],C0[r+3]);a=MX3(a,C1[r],C1[r+1]);b=MX3(b,C1[r+2],C1[r+3]);} \
      float rm=__builtin_fmaxf(a,b); { auto rr=__builtin_amdgcn_permlane32_swap(__float_as_uint(rm),__float_as_uint(rm),false,false); rm=__builtin_fmaxf(__uint_as_float(rr[0]),__uint_as_float(rr[1])); } \
      resc=false; \
      if(__builtin_expect(__any(rm>(float)THRL),0)){ const float dl=__builtin_fmaxf(rm,0.f); mhat+=dl; \
        _Pragma("unroll") for(int r=0;r<16;++r){C0[r]-=dl;C1[r]-=dl;} \
        _Pragma("unroll") for(int r=0;r<16;++r)negm[r]=-mhat; asm volatile("":"+v"(negm)); \
        const float f=__builtin_amdgcn_exp2f(-dl); l_reg*=f; if(hi==0)wsf[r32]=f; resc=true; } } \
    SBAR(); \
    VRD(3); SBAR(); PVM(0,C0,0); \
    VRD(4); SBAR(); PVM(1,C0,2); \
    VRD(5); SBAR(); PVM(2,C0,4); \
    VRD(6); SBAR(); KRD(GL,0); PVM(3,C0,6); \
    VRD(7); SBAR(); PVM(4,C0,8); \
    VRD(8); SBAR(); KRD(GL,1); PVM(5,C0,10); \
    VRD(9); SBAR(); PVM(6,C0,12); \
    VRD(10); SBAR(); KRD(GL,2); PVM(7,C0,14); \
    VRD(11); SBAR(); PVM(8,C1,0); \
    VRD(12); SBAR(); KRD(GL,3); PVM(9,C1,2); \
    VRD(13); SBAR(); PVM(10,C1,4); \
    VRD(14); SBAR(); PVM(11,C1,6); \
    VRD(15); SBAR(); PVM(12,C1,8); \
    PVM(13,C1,10); \
    PVM(14,C1,12); \
    PVM(15,C1,14); \
    }while(0)
  int t=1;
  #undef CMASK
  #define CMASK(P0,P1,t) do{}while(0)
  for(;t+5<NT;t+=2){
    STEP(pB0,pB1,pA0,pA1,t,true,true,true);     WAIT_BAR(3); RESC(); ROT();
    STEP(pA0,pA1,pB0,pB1,t+1,true,true,true);   WAIT_BAR(3); RESC(); ROT();
  }
  #undef CMASK
  #define CMASK(P0,P1,t) do{int jb_=(t)-(NT-4); if(jb_>=0)cmask(P0,P1,jb_,qrel,hi);}while(0)
  #define ENDW(tt) do{ if((tt)+3<NT){WAIT_BAR(3);} else if((tt)+2<NT){WAIT_BAR(2);} else {WAIT_BAR(0);} }while(0)
  for(;t+1<NT;t+=2){
    STEP(pB0,pB1,pA0,pA1,t,(t+3<NT),(t+1<NT),(t+1<NT));       ENDW(t);   RESC(); ROT();
    STEP(pA0,pA1,pB0,pB1,t+1,(t+4<NT),(t+2<NT),(t+2<NT));     ENDW(t+1); RESC(); ROT();
  }
  STEP(pB0,pB1,pA0,pA1,NT-1,false,false,false); RESC();
  { float sacc=pB0[0]+pB0[1]; _Pragma("unroll") for(int r=2;r<16;++r)sacc+=pB0[r]; _Pragma("unroll") for(int r=0;r<16;++r)sacc+=pB1[r]; l_reg+=sacc;
    pw0=(u32x4){PKW(pB0,0),PKW(pB0,2),PKW(pB0,4),PKW(pB0,6)};pw1=(u32x4){PKW(pB0,8),PKW(pB0,10),PKW(pB0,12),PKW(pB0,14)};pw2=(u32x4){PKW(pB1,0),PKW(pB1,2),PKW(pB1,4),PKW(pB1,6)};pw3=(u32x4){PKW(pB1,8),PKW(pB1,10),PKW(pB1,12),PKW(pB1,14)};
    SBAR(); pv(o,vb0+2*sl_cur,PAF(0),PAF(1),PAF(2),PAF(3)); }
  asm volatile("s_waitcnt lgkmcnt(0)\n\ts_barrier":::"memory");
  if(has_next){ const bf16*Kn=K+(long)nb*SEQ*PQ+nkcol,*Vn=V+(long)nb*SEQ*PQ+nvcol;
    const bf16*ksn=Kn+(long)lane*PQ+wid*8; const bf16*vsn=Vn+(long)(16*(wid&3)+(lane>>2))*PQ+(wid>>2)*32+(lane&3)*8;
    glds16(ksn,(unsigned)__builtin_amdgcn_readfirstlane(kdst));
    glds16(vsn,(unsigned)__builtin_amdgcn_readfirstlane(vdst)); glds16(vsn+64,(unsigned)__builtin_amdgcn_readfirstlane(vdst+8192));
    glds16(ksn+(long)KVBLK*PQ,(unsigned)__builtin_amdgcn_readfirstlane(kdst+SLOTB));
    glds16(ksn+(long)2*KVBLK*PQ,(unsigned)__builtin_amdgcn_readfirstlane(kdst+2*SLOTB)); }
  #undef PKW
  #undef PAF
  #undef VFR
  #undef PIN
  #undef MX3
  #undef GAPA
  #undef GAPB
  #undef PVM
  #undef PAFN
  #undef EX
  #undef VRD
  #undef KRD
  #undef STEP
  #undef ENDW
  {auto rr=__builtin_amdgcn_permlane32_swap(__float_as_uint(l_reg),__float_as_uint(l_reg),false,false);l_reg=__uint_as_float(rr[0])+__uint_as_float(rr[1]);}
  if(hi==0)wsf[32+r32]=l_reg;asm volatile("s_waitcnt lgkmcnt(0)":::"memory");
  float rli[16];
  #pragma unroll
  for(int r=0;r<16;++r)rli[r]=__builtin_amdgcn_rcpf(wsf[32+crow(r,hi)]);
  bf16*Ow=O+(rowbase+q0+wid*QBLK)*PO+ocol;
  { bf16*stg=(bf16*)(shm+LDS_OST)+wid*2048;
    if(mode==0){
      #pragma unroll
      for(int ps=0;ps<2;++ps){
        #pragma unroll
        for(int r=0;r<16;++r){const int orow=crow(r,hi);
          #pragma unroll
          for(int d0=0;d0<2;++d0)stg[orow*64+d0*32+r32]=__float2bfloat16(o[2*ps+d0][r]*rli[r]);}
        asm volatile("s_waitcnt lgkmcnt(0)":::"memory");
        #pragma unroll
        for(int i=0;i<4;++i){const int row=i*8+(lane>>3),ch=lane&7; const u32x4 v=*(const u32x4*)(stg+row*64+ch*8); ATTN_STORE16(Ow+(long)row*PO+ps*64+ch*8,v);}
        asm volatile("s_waitcnt lgkmcnt(0)":::"memory"); }
    } else {
      bf16*O2w=O2+(rowbase+q0+wid*QBLK)*PO+ocol;
      float df[2][4][8]; float ssq[4]={0.f,0.f,0.f,0.f};
      #pragma unroll
      for(int ps=0;ps<2;++ps){
        #pragma unroll
        for(int r=0;r<16;++r){const int orow=crow(r,hi);
          #pragma unroll
          for(int d0=0;d0<2;++d0)stg[orow*64+d0*32+r32]=__float2bfloat16(o[2*ps+d0][r]*rli[r]);}
        asm volatile("s_waitcnt lgkmcnt(0)":::"memory");
        #pragma unroll
        for(int i=0;i<4;++i){const int row=i*8+(lane>>3),ch=lane&7; const u32x4 v1=*(const u32x4*)(stg+row*64+ch*8);
          const unsigned long long*p0=(const unsigned long long*)(Ow+(long)row*PO+ps*64+ch*8);
          const unsigned long long a0=__hip_atomic_load(p0,__ATOMIC_RELAXED,__HIP_MEMORY_SCOPE_AGENT),a1=__hip_atomic_load(p0+1,__ATOMIC_RELAXED,__HIP_MEMORY_SCOPE_AGENT);
          const unsigned w0[4]={(unsigned)a0,(unsigned)(a0>>32),(unsigned)a1,(unsigned)(a1>>32)};
          #pragma unroll
          for(int e=0;e<4;++e){ const float x0=__uint_as_float(w0[e]<<16)-lam*__uint_as_float(v1[e]<<16), x1=__uint_as_float(w0[e]&0xffff0000u)-lam*__uint_as_float(v1[e]&0xffff0000u);
            df[ps][i][2*e]=x0; df[ps][i][2*e+1]=x1; ssq[i]+=x0*x0+x1*x1; } }
        asm volatile("s_waitcnt lgkmcnt(0)":::"memory"); }
      #pragma unroll
      for(int i=0;i<4;++i){ float q=ssq[i]; q+=__shfl_xor(q,1); q+=__shfl_xor(q,2); q+=__shfl_xor(q,4); ssq[i]=__builtin_amdgcn_rsqf(q*(1.f/128.f)+1e-5f); }
      #pragma unroll
      for(int ps=0;ps<2;++ps){ const int ch=lane&7; const __attribute__((address_space(3))) float*gp=gn+ps*64+ch*8; float g8[8];
        #pragma unroll
        for(int e=0;e<8;++e)g8[e]=gp[e];
        #pragma unroll
        for(int i=0;i<4;++i){const int row=i*8+(lane>>3); u32x4 w;
          w[0]=cvtpk_s(df[ps][i][0]*ssq[i]*g8[0],df[ps][i][1]*ssq[i]*g8[1]); w[1]=cvtpk_s(df[ps][i][2]*ssq[i]*g8[2],df[ps][i][3]*ssq[i]*g8[3]);
          w[2]=cvtpk_s(df[ps][i][4]*ssq[i]*g8[4],df[ps][i][5]*ssq[i]*g8[5]); w[3]=cvtpk_s(df[ps][i][6]*ssq[i]*g8[6],df[ps][i][7]*ssq[i]*g8[7]);
          ATTN_STORE16(O2w+(long)row*PO+ps*64+ch*8,w);} }
    } }
  asm volatile("s_waitcnt lgkmcnt(0)\n\ts_barrier":::"memory");
  #undef DMA_K
  #undef DMA_V
  #undef CMASK
  #undef START
  #undef RESC
  #undef ROT
}
constexpr int ATTN_LDS_BYTES=LDS_BYTES;
struct AttnTensors { const bf16* Q; const bf16* K; const bf16* V; bf16* O0; bf16* O2; float lam; const __attribute__((address_space(3))) float* gn; };
struct AttnUnit { int bh; int qb; };
struct StaticOrder {
  int vcu,G;
  __device__ __forceinline__ explicit StaticOrder(int grid,int block):vcu((grid%8==0)?(block%8)*(grid/8)+block/8:block),G(grid){}
  __device__ __forceinline__ bool next(int i,AttnUnit&u)const{ const int pi=vcu+(i>>1)*G; if(pi>=BATCH*8*16)return false; const int s=pi&15; u.bh=pi>>4; u.qb=(i&1)?31-s:s; return true; }
  __device__ __forceinline__ void a_ready(const AttnUnit&)const{}
  __device__ __forceinline__ void done(const AttnUnit&)const{}
};
template<class Sched,int THRL=8> __device__ __forceinline__ void attn_phase(char*lds,const AttnTensors&T,const Sched&S){
  AttnUnit u,un; bool pre=false;
  if(!S.next(0,u))return;
  for(int i=0;;++i){ S.a_ready(u); const int b=u.bh>>3,h=u.bh&7; const bool more=S.next(i+1,un); const int nb=un.bh>>3,nh=un.bh&7;
    for(int c=0;c<2;++c) attn_unit<THRL>(b,h*128+c*64,h*128+c*64,h*128,h*128,u.qb,T.Q,T.K,T.V,T.O0,T.O2,c,T.lam,T.gn,lds,pre||c==1,c==0||more,c==0?b:nb,c==0?h*128+64:nh*128,c==0?h*128:nh*128);
    S.done(u); if(!more)break; u=un; pre=true; }
}
#undef SBAR
#undef WAIT_BAR
}


#ifndef MK_P4_HALFLDS
#define MK_P4_HALFLDS 0
#endif

constexpr int NWAVES = 8;
constexpr int T = 32768, D = 1024, SEQ = 8192, NB = 4;
constexpr int ML_H = 4, ML_DV = 512, ML_DQK = 256, ML_QK = 1024, ML_V = 2048, ML_LD = 6152, NCH = 128;
constexpr int VT_ROWS = 544;
constexpr int NEXP = 32, DEXP = 256, MAXPANEL = 288, MAXSLOT = MAXPANEL * 256;
constexpr float LAMBDA_INIT1 = 0.35550906759f;

constexpr size_t MiB = 1u << 20;
constexpr size_t WS_CTL = 0, CTL_ZERO_BYTES = 1 * MiB;
constexpr size_t WS_GATES = 1 * MiB;
constexpr size_t WS_SA = 2 * MiB, WS_SB = WS_SA + 512 * 1024, WS_SIS = 3 * MiB, WS_SFL = WS_SIS + 512 * 1024, WS_RS = 4 * MiB, WS_QN = WS_RS + 512 * 1024;
constexpr size_t WS_CHB = 5 * MiB, WS_CHM = WS_CHB + 8192, WS_DEC = WS_CHM + 8192;
constexpr size_t WS_WR = 5 * MiB + 512 * 1024;
constexpr size_t WS_TE = 6 * MiB, WS_TW = WS_TE + 256 * 1024, WS_TPOS = WS_TW + 256 * 1024, WS_TSLOT = WS_TPOS + 256 * 1024;
constexpr size_t WS_ERS = 1 * MiB, WS_RSTD = 5 * MiB;
constexpr size_t WS_E2T = 8 * MiB, WS_EW = 12 * MiB;
constexpr size_t WS_WML_IN = 16 * MiB, WS_WML_OUT = 28 * MiB;
constexpr size_t WS_KWT = 32 * MiB;
constexpr size_t WS_WDA_IN = 504 * MiB, WS_WDA_OUT = 510 * MiB, WS_WGU = 40 * MiB, WS_WDN = 72 * MiB;
constexpr size_t WS_WGU1 = 196 * MiB, WS_WDN1 = 228 * MiB;
constexpr size_t WS_R0 = 96 * MiB;
constexpr size_t WS_QKRAW = WS_R0, WS_OG = WS_R0 + 128 * MiB, WS_VT = WS_R0 + 256 * MiB;
constexpr size_t WS_WGU0 = WS_R0 + 192 * MiB, WS_WDN0 = WS_WGU0 + 32 * MiB;
constexpr size_t WS_PG = 488 * MiB;
constexpr size_t WS_HN = WS_R0;
constexpr size_t WS_ACT = WS_R0 + 64 * MiB, WS_YS = 352 * MiB;
constexpr size_t WS_AQ = 244 * MiB, WS_AK = WS_AQ + 64 * MiB, WS_AV = WS_AK + 64 * MiB, WS_AO = WS_AV + 64 * MiB;
constexpr size_t WS_END = WS_YS + 144 * MiB;
static_assert(WS_VT + (size_t)4 * VT_ROWS * T * 2 <= 488 * MiB && WS_END <= 496 * MiB && WS_AO + (size_t)T * 1024 * 2 <= 504 * MiB && WS_WDN0 + 16 * MiB <= WS_VT && WS_WDN1 + 16 * MiB <= WS_AQ && WS_ACT + 36 * MiB <= WS_WGU1, "d_ws map");
constexpr int CW_BAR = 4096;
constexpr int CW_CNT = 16384;

constexpr int RING_OFF = 0, RING_BYTES = 131072;
constexpr int LDSCTL_OFF = RING_BYTES, MISC_OFF = LDSCTL_OFF + 320;
constexpr int TAB_OFF = LDSCTL_OFF + 1024;
constexpr int TAB_PEXP = TAB_OFF, TAB_ECNT = TAB_OFF + 1280, TAB_EOFF = TAB_ECNT + 128, TAB_NP = TAB_EOFF + 136;
constexpr int LDS_BYTES = 147456;

#define GAS __attribute__((address_space(1)))
#define LAS __attribute__((address_space(3)))
typedef unsigned short bf16;
typedef unsigned v4u __attribute__((ext_vector_type(4)));
typedef unsigned v2u __attribute__((ext_vector_type(2)));
typedef float f32x4 __attribute__((ext_vector_type(4)));
typedef float f32x2 __attribute__((ext_vector_type(2)));
typedef short bf16x8 __attribute__((ext_vector_type(8)));
typedef GAS unsigned gu32;
#define RLX_AGENT __ATOMIC_RELAXED, __HIP_MEMORY_SCOPE_AGENT
#define LDS_WAIT() asm volatile("s_waitcnt lgkmcnt(0)" ::: "memory")
__device__ __forceinline__ unsigned f2bf(float f) { unsigned u = __builtin_bit_cast(unsigned, f); return (u + 0x7fffu + ((u >> 16) & 1u)) >> 16; }
__device__ __forceinline__ unsigned pk2(float lo, float hi) { typedef float f2v_t __attribute__((ext_vector_type(2))); typedef __bf16 b2v_t __attribute__((ext_vector_type(2)));
    f2v_t v = {lo, hi}; b2v_t b = __builtin_convertvector(v, b2v_t); return __builtin_bit_cast(unsigned, b); }
__device__ __forceinline__ float bf_lo(unsigned w) { return __builtin_bit_cast(float, w << 16); }
__device__ __forceinline__ float bf_hi(unsigned w) { return __builtin_bit_cast(float, w & 0xffff0000u); }
__device__ __forceinline__ float bf1(bf16 h) { return __builtin_bit_cast(float, (unsigned)h << 16); }
__device__ __forceinline__ float wave_sum(float v) {
#pragma unroll
    for (int o = 1; o < 64; o <<= 1) v += __shfl_xor(v, o);
    return v;
}
__device__ __forceinline__ float wave_max(float v) {
#pragma unroll
    for (int o = 1; o < 64; o <<= 1) v = fmaxf(v, __shfl_xor(v, o));
    return v;
}
__device__ __forceinline__ float prefix_sum_incl(float v, int lane) {
#pragma unroll
    for (int o = 1; o < 64; o <<= 1) { const float u = __shfl_up(v, o); if (lane >= o) v += u; }
    return v;
}
__device__ __forceinline__ float prefix_max_incl(float v, int lane) {
#pragma unroll
    for (int o = 1; o < 64; o <<= 1) { const float u = __shfl_up(v, o); if (lane >= o) v = fmaxf(v, u); }
    return v;
}
__device__ __forceinline__ float log_sigmoid(float z) { return fminf(z, 0.f) - log1pf(__expf(-fabsf(z))); }
__device__ __forceinline__ float sigmoidf_(float z) { return 1.f / (1.f + __expf(-z)); }
#define XB_TMO      128
#define XB_XCNT(j)  (256  + 64 * (j))
#define XB_XSUB(j)  (1280 + 64 * (j))
#define XB_XGEN(j)  (2304 + 64 * (j))
#define XB_TOP      3328
#define XB_TOPGEN   3392
#define XCD_BAR_WORDS 3456
#define XB_SPIN_CAP (1u << 18)

__device__ __forceinline__ unsigned xb_ld(unsigned* p)              { return __hip_atomic_load(p, __ATOMIC_RELAXED, __HIP_MEMORY_SCOPE_AGENT); }
__device__ __forceinline__ unsigned xb_add(unsigned* p, unsigned v) { return __hip_atomic_fetch_add(p, v, __ATOMIC_RELAXED, __HIP_MEMORY_SCOPE_AGENT); }
__device__ __forceinline__ unsigned xb_xcc_id() { return (unsigned)__builtin_amdgcn_s_getreg((3 << 11) | 20) & 0xFu; }
#define XB_SPIN(cond, bar) do { unsigned _sp = 0; while (cond) { __builtin_amdgcn_s_sleep(1); \
    if ((++_sp & 255u) == 0u) { if (xb_ld(&(bar)[XB_TMO])) break; if (_sp > XB_SPIN_CAP) { atomicAdd(&(bar)[XB_TMO], 1u); break; } } } } while (0)

struct XcdBarrier {
    unsigned* bar; unsigned x;
    volatile LAS unsigned* st;
};

__device__ __forceinline__ XcdBarrier xcd_barrier_post(unsigned* bar, volatile LAS unsigned* st) {
    XcdBarrier b; b.bar = bar; b.x = xb_xcc_id(); b.st = st;
    if (threadIdx.x == 0) (void)xb_add(&bar[XB_XCNT(b.x)], 1u);
    return b;
}
__device__ __forceinline__ void xcd_barrier_complete(unsigned* bar, unsigned x, unsigned& nloc, unsigned& nx) {
    const unsigned G = gridDim.x * gridDim.y * gridDim.z;
    unsigned sum, cnt, mine, sp = 0u;
    for (;;) {
        sum = 0u; cnt = 0u; mine = 0u;
#pragma unroll
        for (unsigned j = 0; j < 16; ++j) { const unsigned c = xb_ld(&bar[XB_XCNT(j)]); sum += c; cnt += (c > 0u) ? 1u : 0u; mine = (j == x) ? c : mine; }
        if (sum == G) break;
        __builtin_amdgcn_s_sleep(1);
        if ((++sp & 255u) == 0u) { if (xb_ld(&bar[XB_TMO])) break; if (sp > XB_SPIN_CAP) { atomicAdd(&bar[XB_TMO], 1u); break; } }
    }
    nloc = mine > 0u ? mine : 1u; nx = cnt > 0u ? cnt : 1u;
}

__device__ __forceinline__ void xcd_barrier(const XcdBarrier& b) {
    asm volatile("s_waitcnt vmcnt(0)" ::: "memory");
    __syncthreads();
    if (threadIdx.x == 0) {
        unsigned* bar = b.bar;
        __builtin_amdgcn_s_waitcnt(0);
        unsigned nloc = b.st[0], nx = b.st[1];
        if (nloc == 0u) { xcd_barrier_complete(bar, b.x, nloc, nx); b.st[0] = nloc; b.st[1] = nx; }
        const unsigned old = xb_add(&bar[XB_XSUB(b.x)], 1u);
        const unsigned gen = old / nloc;
        if (old + 1u == (gen + 1u) * nloc) {
            __builtin_amdgcn_fence(__ATOMIC_RELEASE, "agent");
            asm volatile("s_waitcnt vmcnt(0)" ::: "memory");
            const unsigned og = xb_add(&bar[XB_TOP], 1u);
            const unsigned tg = og / nx;
            if (og + 1u == (tg + 1u) * nx) xb_add(&bar[XB_TOPGEN], 1u);
            else XB_SPIN(xb_ld(&bar[XB_TOPGEN]) == tg, bar);
            __builtin_amdgcn_fence(__ATOMIC_ACQUIRE, "agent");
            xb_add(&bar[XB_XGEN(b.x)], 1u);
            asm volatile("s_waitcnt vmcnt(0)" ::: "memory");
        } else {
            XB_SPIN(xb_ld(&bar[XB_XGEN(b.x)]) == gen, bar);
            __builtin_amdgcn_fence(__ATOMIC_ACQUIRE, "agent");
            asm volatile("s_waitcnt vmcnt(0)" ::: "memory");
        }
    }
    __syncthreads();
}


struct Ctx { LAS unsigned char* lds; int tid, lane, wave, vcu, G, gw, NGW; };

__device__ __forceinline__ void tr_item(const float* W, int ld, int K, int k0, int c0, bf16* WT, int drow0, LAS float* scr, int lane, const float* kscale = nullptr) {
    f32x4 wv[8];
#pragma unroll
    for (int i = 0; i < 8; ++i) { wv[i] = *(const GAS f32x4*)(W + (size_t)(k0 + 8 * i + (lane >> 3)) * ld + c0 + 4 * (lane & 7)); if (kscale) wv[i] = wv[i] * kscale[k0 + 8 * i + (lane >> 3)]; }
#pragma unroll
    for (int i = 0; i < 8; ++i) { LAS float* d = scr + (8 * i + (lane >> 3)) * 33 + 4 * (lane & 7); d[0] = wv[i].x; d[1] = wv[i].y; d[2] = wv[i].z; d[3] = wv[i].w; }
    LDS_WAIT(); asm volatile("" ::: "memory");
    const int c = lane & 7;
#pragma unroll
    for (int j = 0; j < 4; ++j) { const int n = (lane >> 3) + 8 * j; const LAS float* s = scr + (8 * c) * 33 + n;
        v4u o; o.x = pk2(s[0 * 33], s[1 * 33]); o.y = pk2(s[2 * 33], s[3 * 33]); o.z = pk2(s[4 * 33], s[5 * 33]); o.w = pk2(s[6 * 33], s[7 * 33]);
        *(GAS v4u*)(WT + (size_t)(drow0 + n) * K + k0 + 8 * c) = o; }
    LDS_WAIT(); asm volatile("" ::: "memory");
}
__device__ __forceinline__ void tr_load(f32x4 (&wv)[8], float (&ks)[8], const float* W, int ld, int k0, int c0, int lane, const float* kscale) {
#pragma unroll
    for (int i = 0; i < 8; ++i) { wv[i] = *(const GAS f32x4*)(W + (size_t)(k0 + 8 * i + (lane >> 3)) * ld + c0 + 4 * (lane & 7)); ks[i] = kscale ? kscale[k0 + 8 * i + (lane >> 3)] : 1.f; }
}
__device__ __forceinline__ void tr_finish(const f32x4 (&wv)[8], const float (&ks)[8], int K, int k0, bf16* WT, int drow0, LAS float* scr, int lane) {
#pragma unroll
    for (int i = 0; i < 8; ++i) { LAS float* d = scr + (8 * i + (lane >> 3)) * 33 + 4 * (lane & 7); const f32x4 w = wv[i] * ks[i]; d[0] = w.x; d[1] = w.y; d[2] = w.z; d[3] = w.w; }
    LDS_WAIT(); asm volatile("" ::: "memory");
    const int c = lane & 7;
#pragma unroll
    for (int j = 0; j < 4; ++j) { const int n = (lane >> 3) + 8 * j; const LAS float* s = scr + (8 * c) * 33 + n;
        v4u o; o.x = pk2(s[0 * 33], s[1 * 33]); o.y = pk2(s[2 * 33], s[3 * 33]); o.z = pk2(s[4 * 33], s[5 * 33]); o.w = pk2(s[6 * 33], s[7 * 33]);
        *(GAS v4u*)(WT + (size_t)(drow0 + n) * K + k0 + 8 * c) = o; }
    LDS_WAIT(); asm volatile("" ::: "memory");
}
__device__ __forceinline__ void tr_matrix_items(const Ctx& C, const float* W, int K, int N, bf16* WT, int& it0) {
    (void)C; (void)W; (void)K; (void)N; (void)WT; (void)it0;
}

__device__ __forceinline__ void conv_ml_out(const Ctx& C, const float* ml_w_out, unsigned char* ws) {
    LAS float* scr = (LAS float*)(C.lds + RING_OFF + C.wave * 16384); bf16* wml_out = (bf16*)(ws + WS_WML_OUT);
    for (int it = C.gw; it < 32 * 32; it += C.NGW) { const int kb = it / 32, nb = it % 32; tr_item(ml_w_out, D, ML_V, kb * 64, nb * 32, wml_out, nb * 32, scr, C.lane); }
}
__device__ __forceinline__ void p0_prologue(const Ctx& C, const float* x, const float* norm_mix0, const float* ml_w_in, const float* ml_w_out,
                                            const float* norm_ffn, const float* w_group, const float* w_expert, unsigned char* ws, bf16* hn0) {
    LAS float* scr = (LAS float*)(C.lds + RING_OFF + C.wave * 16384);
    bf16* wml_in = (bf16*)(ws + WS_WML_IN); bf16* wml_out = (bf16*)(ws + WS_WML_OUT);
    constexpr int I_IN = 16 * 192;
    for (int it = C.gw; it < I_IN; it += C.NGW) {
        const int kb = it / 192, nb = it % 192, c0 = nb * 32;
        const int drow = c0 < 2048 ? c0 : (c0 < 4096 ? c0 + 2048 : c0 - 2048);
        tr_item(ml_w_in, ML_LD, D, kb * 64, c0, wml_in, drow, scr, C.lane);
    }
    (void)wml_out; (void)ml_w_out;
    { bf16* WRH = (bf16*)(ws + WS_WR); bf16* WRL = WRH + 2 * 32 * 3 * 4 * 16 * 8; const int n = 2 * 32 * 3 * 4 * 16 * 8;
      for (int idx = C.gw * 64 + C.lane; idx < n; idx += C.NGW * 64) {
          int r = idx; const int j = r & 7; r >>= 3; const int c15 = r & 15; r >>= 4; const int g4 = r & 3; r >>= 2; const int ct = r % 3; r /= 3; const int ks = r & 31; const int l = r >> 5;
          const int k = 32 * ks + 8 * g4 + j, col = 16 * ct + c15;
          float w = 0.f; if (col < 4) w = w_group[((size_t)l * D + k) * 4 + col]; else if (col < 36) w = w_expert[((size_t)l * D + k) * 32 + (col - 4)];
          w *= norm_ffn[l * D + k];
          const unsigned hb = f2bf(w); const float hf = __builtin_bit_cast(float, hb << 16);
          WRH[idx] = (bf16)hb; WRL[idx] = (bf16)f2bf(w - hf); } }
    { bf16* vt = (bf16*)(ws + WS_VT); const int per_head = 32 * (T / 8);
      for (int idx = C.gw * 64 + C.lane; idx < 4 * per_head; idx += C.NGW * 64) { const int h = idx / per_head, r = idx % per_head, row = r / (T / 8), ch = r % (T / 8);
          const unsigned v = row == 0 ? 0x3f803f80u : 0u; *(GAS v4u*)(vt + ((size_t)(h * VT_ROWS + 512 + row)) * T + ch * 8) = (v4u){v, v, v, v}; } }
    { float* gates = (float*)(ws + WS_GATES);
      f32x4 gn[4]; float wg[4][4][8];
#pragma unroll
      for (int j = 0; j < 4; ++j) { gn[j] = *(const f32x4*)(norm_mix0 + 4 * C.lane + 256 * j);
#pragma unroll
          for (int e = 0; e < 4; ++e) { const float* p = ml_w_in + (size_t)(4 * C.lane + 256 * j + e) * ML_LD + 6144; const f32x4 a = *(const f32x4*)p, b = *(const f32x4*)(p + 4);
              wg[j][e][0] = a.x; wg[j][e][1] = a.y; wg[j][e][2] = a.z; wg[j][e][3] = a.w; wg[j][e][4] = b.x; wg[j][e][5] = b.y; wg[j][e][6] = b.z; wg[j][e][7] = b.w; } }
      f32x4 v[4], vn[4];
      if (C.gw < T) {
#pragma unroll
          for (int j = 0; j < 4; ++j) vn[j] = ((const GAS f32x4*)(x + (size_t)C.gw * D) + C.lane)[64 * j]; }
      for (int m = C.gw; m < T; m += C.NGW) {
#pragma unroll
          for (int j = 0; j < 4; ++j) v[j] = vn[j];
          if (m + C.NGW < T) {
#pragma unroll
              for (int j = 0; j < 4; ++j) vn[j] = ((const GAS f32x4*)(x + (size_t)(m + C.NGW) * D) + C.lane)[64 * j]; }
          float ss = 0.f;
#pragma unroll
          for (int j = 0; j < 4; ++j) ss += (v[j].x * v[j].x + v[j].y * v[j].y) + (v[j].z * v[j].z + v[j].w * v[j].w);
          const float rstd = rsqrtf(wave_sum(ss) * (1.f / D) + 1e-6f);
          GAS unsigned long long* o8 = (GAS unsigned long long*)(hn0 + (size_t)m * D) + C.lane;
          float ga[8];
#pragma unroll
          for (int c = 0; c < 8; ++c) ga[c] = 0.f;
#pragma unroll
          for (int j = 0; j < 4; ++j) { v[j] = v[j] * rstd * gn[j];
              o8[64 * j] = (unsigned long long)pk2(v[j].x, v[j].y) | ((unsigned long long)pk2(v[j].z, v[j].w) << 32);
#pragma unroll
              for (int c = 0; c < 8; ++c) ga[c] += (v[j].x * wg[j][0][c] + v[j].y * wg[j][1][c]) + (v[j].z * wg[j][2][c] + v[j].w * wg[j][3][c]); }
          float h4[4], h2[2], h1;
          { const bool up = (C.lane & 32) != 0;
#pragma unroll
            for (int c = 0; c < 4; ++c) { const float keep = up ? ga[c + 4] : ga[c], give = up ? ga[c] : ga[c + 4]; h4[c] = keep + __shfl_xor(give, 32); } }
          { const bool up = (C.lane & 16) != 0;
#pragma unroll
            for (int c = 0; c < 2; ++c) { const float keep = up ? h4[c + 2] : h4[c], give = up ? h4[c] : h4[c + 2]; h2[c] = keep + __shfl_xor(give, 16); } }
          { const bool up = (C.lane & 8) != 0; const float keep = up ? h2[1] : h2[0], give = up ? h2[0] : h2[1]; h1 = keep + __shfl_xor(give, 8); }
          h1 += __shfl_xor(h1, 4); h1 += __shfl_xor(h1, 2); h1 += __shfl_xor(h1, 1);
          if ((C.lane & 7) == 0) gates[(size_t)m * 8 + (((C.lane >> 5) & 1) << 2 | ((C.lane >> 4) & 1) << 1 | ((C.lane >> 3) & 1))] = h1;
      } }
}

__device__ __forceinline__ void p1_gate_chunks(const Ctx& C, const float* b_i, const float* b_f, unsigned char* ws) {
    const float* gates = (const float*)(ws + WS_GATES); float* chb = (float*)(ws + WS_CHB); float* chm = (float*)(ws + WS_CHM);
    for (int it = C.gw; it < 16 * NCH; it += C.NGW) {
        const int bh = it >> 7, c = it & 127, b = bh >> 2, h = bh & 3; const size_t t = (size_t)b * SEQ + c * 64 + C.lane;
        const float gi = gates[t * 8 + h] + b_i[h]; const float lf = log_sigmoid(gates[t * 8 + 4 + h] + b_f[h]);
        const float bc = prefix_sum_incl(lf, C.lane); const float bL = __shfl(bc, 63);
        const float mx = wave_max(bL - bc + gi);
        if (C.lane == 0) { chb[it] = bL; chm[it] = mx; }
    }
}

__device__ __forceinline__ void p2_conv(const Ctx& C, const float* b_i, const float* b_f, const float* conv_w, unsigned char* ws, bf16* Qo, bf16* Ko) {
    const float* gates = (const float*)(ws + WS_GATES); const float* chb = (const float*)(ws + WS_CHB); const float* chm = (const float*)(ws + WS_CHM);
    float* SA = (float*)(ws + WS_SA); float* SB = (float*)(ws + WS_SB); float* SIS = (float*)(ws + WS_SIS); float* SFL = (float*)(ws + WS_SFL); float* DEC = (float*)(ws + WS_DEC);
    const bf16* raw = (const bf16*)(ws + WS_QKRAW); bf16* kwt = (bf16*)(ws + WS_KWT);
    LAS float* wsl = (LAS float*)(C.lds + RING_OFF);
    const int rg = C.tid >> 8, ct = C.tid & 255; const bool isk = (C.wave & 2) != 0;
    float w[4][8];
#pragma unroll
    for (int j = 0; j < 4; ++j) { const f32x4 a = *(const f32x4*)(conv_w + j * 2048 + 8 * ct), b = *(const f32x4*)(conv_w + j * 2048 + 8 * ct + 4);
        w[j][0] = a.x; w[j][1] = a.y; w[j][2] = a.z; w[j][3] = a.w; w[j][4] = b.x; w[j][5] = b.y; w[j][6] = b.z; w[j][7] = b.w; }
    for (int item = C.vcu; item < NB * NCH; item += C.G) {
        const int b = item >> 7, c = item & 127; const size_t t0 = (size_t)b * SEQ + c * 64;
        if (C.wave < 4) {
            const int h = C.wave, bh = b * 4 + h;
            float a0 = chb[bh * 128 + C.lane], m0 = chm[bh * 128 + C.lane], a1 = chb[bh * 128 + 64 + C.lane], m1 = chm[bh * 128 + 64 + C.lane];
#pragma unroll
            for (int o = 1; o < 64; o <<= 1) { const float pa0 = __shfl_up(a0, o), pm0 = __shfl_up(m0, o), pa1 = __shfl_up(a1, o), pm1 = __shfl_up(m1, o);
                if (C.lane >= o) { m0 = fmaxf(pm0 + a0, m0); a0 += pa0; m1 = fmaxf(pm1 + a1, m1); a1 += pa1; } }
            const float mA = fmaxf(a0, m0);
            const float m64 = __shfl(mA, 63);
            const float mB = fmaxf(m64 + a1, m1);
            const float mc_a = __shfl(mA, (c + 63) & 63), mc_b = __shfl(mB, (c + 63) & 63);
            const float mc = c == 0 ? 0.f : (c <= 64 ? mc_a : mc_b);
            const float mn_a = __shfl(mA, c & 63), mn_b = __shfl(mB, c & 63);
            const float mn = c < 64 ? mn_a : mn_b;
            const size_t t = t0 + C.lane;
            const float gi = gates[t * 8 + h] + b_i[h]; const float lf = log_sigmoid(gates[t * 8 + 4 + h] + b_f[h]);
            const float bc = prefix_sum_incl(lf, C.lane); const float bL = __shfl(bc, 63);
            const float Bv = gi - bc; const float cmx = prefix_max_incl(Bv, C.lane);
            const float Aa = -fmaxf(mc, cmx);
            SA[t * 4 + h] = Aa; SB[t * 4 + h] = Bv; SIS[t * 4 + h] = __expf(mc + Aa); SFL[t * 4 + h] = __expf(Aa - bc);
            wsl[h * 64 + C.lane] = __expf(bL + Bv - mn);
            if (C.lane == 0) DEC[bh * 128 + c] = __expf(bL + mc - mn);
        }
        __syncthreads();
        float x3[8], x2[8], x1[8];
        {   const int sb = c * 64 + 32 * rg - 3;
            const bf16* rp = raw + (t0 + 32 * rg - 3) * 2048 + 8 * ct;
            v4u r3 = (v4u){0u, 0u, 0u, 0u}, r2 = r3, r1 = r3;
            if (sb >= 0) r3 = *(const GAS v4u*)(rp); if (sb + 1 >= 0) r2 = *(const GAS v4u*)(rp + 2048); if (sb + 2 >= 0) r1 = *(const GAS v4u*)(rp + 4096);
#pragma unroll
            for (int e = 0; e < 4; ++e) { x3[2 * e] = bf_lo(r3[e]); x3[2 * e + 1] = bf_hi(r3[e]); x2[2 * e] = bf_lo(r2[e]); x2[2 * e + 1] = bf_hi(r2[e]); x1[2 * e] = bf_lo(r1[e]); x1[2 * e + 1] = bf_hi(r1[e]); } }
        const int kh = (ct - 128) >> 5;
        const bf16* rbase = raw + (t0 + 32 * rg) * 2048 + 8 * ct;
        v4u rr[8];
#pragma unroll
        for (int r = 0; r < 8; ++r) rr[r] = *(const GAS v4u*)(rbase + (size_t)r * 2048);
        for (int blk = 0; blk < 4; ++blk) {
            v4u rc[8];
#pragma unroll
            for (int r = 0; r < 8; ++r) rc[r] = rr[r];
            if (blk < 3) {
#pragma unroll
                for (int r = 0; r < 8; ++r) rr[r] = *(const GAS v4u*)(rbase + (size_t)((blk + 1) * 8 + r) * 2048);
            }
            float yy[8][8];
#pragma unroll
            for (int r = 0; r < 8; ++r) {
                float cur[8];
#pragma unroll
                for (int e = 0; e < 4; ++e) { cur[2 * e] = bf_lo(rc[r][e]); cur[2 * e + 1] = bf_hi(rc[r][e]); }
#pragma unroll
                for (int e = 0; e < 8; ++e) { const float sv = (w[0][e] * x3[e] + w[1][e] * x2[e]) + (w[2][e] * x1[e] + w[3][e] * cur[e]);
                    yy[r][e] = sv * __builtin_amdgcn_rcpf(1.f + __builtin_amdgcn_exp2f(-1.4426950408889634f * sv));     x3[e] = x2[e]; x2[e] = x1[e]; x1[e] = cur[e]; }
            }
            if (!isk) {
#pragma unroll
                for (int r = 0; r < 8; ++r) { const int row = 32 * rg + blk * 8 + r; const float* y = yy[r];
                    *(GAS v4u*)(Qo + (t0 + row) * 1024 + 8 * ct) = (v4u){pk2(y[0] * 0.0625f, y[1] * 0.0625f), pk2(y[2] * 0.0625f, y[3] * 0.0625f), pk2(y[4] * 0.0625f, y[5] * 0.0625f), pk2(y[6] * 0.0625f, y[7] * 0.0625f)}; }
            } else {
#pragma unroll
                for (int r = 0; r < 8; ++r) { const int row = 32 * rg + blk * 8 + r; const float* y = yy[r];
                    *(GAS v4u*)(Ko + (t0 + row) * 1024 + 8 * (ct - 128)) = (v4u){pk2(y[0], y[1]), pk2(y[2], y[3]), pk2(y[4], y[5]), pk2(y[6], y[7])}; }
                float wv[8];
#pragma unroll
                for (int r = 0; r < 8; ++r) wv[r] = wsl[kh * 64 + 32 * rg + blk * 8 + r];
#pragma unroll
                for (int e = 0; e < 8; ++e)
                    *(GAS v4u*)(kwt + ((size_t)((b * 4 + kh) * NCH + c) * 256 + ((8 * (ct - 128) + e) & 255)) * 64 + 32 * rg + blk * 8) =
                        (v4u){pk2(yy[0][e] * wv[0], yy[1][e] * wv[1]), pk2(yy[2][e] * wv[2], yy[3][e] * wv[3]), pk2(yy[4][e] * wv[4], yy[5][e] * wv[5]), pk2(yy[6][e] * wv[6], yy[7][e] * wv[7])};
            }
        }
        __syncthreads();
    }
}

__device__ __forceinline__ unsigned cvtpk(float lo, float hi);
#define MFMA16(a, b, c) __builtin_amdgcn_mfma_f32_16x16x32_bf16((a), (b), (c), 0, 0, 0)
__device__ __forceinline__ void p3a_scores(const Ctx& C, unsigned char* ws, const bf16* Q, const bf16* K, int first, int stride) {
    const float* SA = (const float*)(ws + WS_SA); const float* SB = (const float*)(ws + WS_SB); float* RS = (float*)(ws + WS_RS); bf16* Pg = (bf16*)(ws + WS_PG);
    LAS float* rsum = (LAS float*)(C.lds + RING_OFF + 92160);
    const int l15 = C.lane & 15, g = C.lane >> 4, tb = C.wave & 3, sh = C.wave >> 2;
    for (int item = first; item < 16 * NCH; item += stride) {
        const int bh = item >> 7, c = item & 127, b = bh >> 2, h = bh & 3; const size_t t0 = (size_t)b * SEQ + c * 64;
        bf16* Pi = Pg + (size_t)item * 4096;
        const int t = tb * 16 + l15;
        bf16x8 qa[8], ka[2][8]; float At = 0.f, Bs[2][4];
        const bool need0 = 2 * sh <= tb, need1 = 2 * sh + 1 <= tb;
        if (need0) {
            const bf16* qp = Q + (t0 + tb * 16 + l15) * 1024 + h * 256 + 8 * g;
#pragma unroll
            for (int ks = 0; ks < 8; ++ks) qa[ks] = *(const GAS bf16x8*)(qp + 32 * ks);
            At = SA[(t0 + t) * 4 + h];
#pragma unroll
            for (int sbi = 0; sbi < 2; ++sbi) { if (sbi == 0 || need1) { const int sb = 2 * sh + sbi; const bf16* kp = K + (t0 + sb * 16 + l15) * 1024 + h * 256 + 8 * g;
#pragma unroll
                for (int ks = 0; ks < 8; ++ks) ka[sbi][ks] = *(const GAS bf16x8*)(kp + 32 * ks);
#pragma unroll
                for (int r = 0; r < 4; ++r) Bs[sbi][r] = SB[(t0 + sb * 16 + 4 * g + r) * 4 + h]; } }
        }
#pragma unroll
        for (int sbi = 0; sbi < 2; ++sbi) {
            const int sb = 2 * sh + sbi;
            if (sb > tb) { *(GAS v2u*)(Pi + t * 64 + sb * 16 + 4 * g) = (v2u){0u, 0u}; if (g == 0) rsum[sb * 64 + t] = 0.f; }
            else {
                f32x4 acc = (f32x4){0.f, 0.f, 0.f, 0.f};
#pragma unroll
                for (int ks = 0; ks < 8; ++ks) acc = MFMA16(ka[sbi][ks], qa[ks], acc);
                float p[4], q = 0.f;
#pragma unroll
                for (int r = 0; r < 4; ++r) { const int s_ = sb * 16 + 4 * g + r; p[r] = (s_ <= t) ? acc[r] * __expf(At + Bs[sbi][r]) : 0.f; q += p[r]; }
                *(GAS v2u*)(Pi + t * 64 + sb * 16 + 4 * g) = (v2u){cvtpk(p[0], p[1]), cvtpk(p[2], p[3])};
                q += __shfl_xor(q, 16); q += __shfl_xor(q, 32);
                if (g == 0) rsum[sb * 64 + t] = q;
            }
        }
        asm volatile("s_waitcnt lgkmcnt(0)\n\ts_barrier" ::: "memory");
        if (C.tid < 64) RS[(t0 + C.tid) * 4 + h] = (rsum[C.tid] + rsum[64 + C.tid]) + (rsum[128 + C.tid] + rsum[192 + C.tid]);
        asm volatile("s_waitcnt lgkmcnt(0)\n\ts_barrier" ::: "memory");
    }
}

template <bool DRY>
__device__ __forceinline__ void p3_intra(const Ctx& C, unsigned char* ws, const float* ml_norm) {
    const float* SA = (const float*)(ws + WS_SA); const float* RS = (const float*)(ws + WS_RS); const bf16* Pg = (const bf16*)(ws + WS_PG);
    const bf16* vt = (const bf16*)(ws + WS_VT); bf16* H = (bf16*)(ws + WS_QKRAW); const unsigned char* OG = (const unsigned char*)(ws + WS_OG);
    const float* SIS = (const float*)(ws + WS_SIS); const float* QN = (const float*)(ws + WS_QN); const float* SFL = (const float*)(ws + WS_SFL);
    LAS float* ssum = (LAS float*)(C.lds + RING_OFF + 9216 + 256);
    const int l15 = C.lane & 15, g = C.lane >> 4;
    for (int item = C.vcu; item < 16 * NCH; item += C.G) {
        const int bh = item >> 7, c = item & 127, b = bh >> 2, h = bh & 3; const size_t t0 = (size_t)b * SEQ + c * 64;
        bf16x8 vfr[2][4], pfr[2][4]; v4u holdr[8]; v2u ogr[8]; float sis8[8], qn8[8], sfl8[8], rs8[8];
#pragma unroll
        for (int ks = 0; ks < 2; ++ks)
#pragma unroll
            for (int vtile = 0; vtile < 4; ++vtile) vfr[ks][vtile] = *(const GAS bf16x8*)(vt + (size_t)(h * VT_ROWS + 64 * C.wave + vtile * 16 + l15) * T + t0 + 32 * ks + 8 * g);
#pragma unroll
        for (int i = 0; i < 8; ++i) { const size_t tr = t0 + 8 * i + (C.lane >> 3); const size_t ho = tr * 2048 + h * 512 + 64 * C.wave + 8 * (C.lane & 7);
            holdr[i] = *(const GAS v4u*)(H + ho); ogr[i] = *(const GAS v2u*)(OG + ho); sis8[i] = SIS[tr * 4 + h]; qn8[i] = QN[tr * 4 + h]; sfl8[i] = SFL[tr * 4 + h]; rs8[i] = RS[tr * 4 + h]; }
#pragma unroll
        for (int ks = 0; ks < 2; ++ks)
#pragma unroll
            for (int t4 = 0; t4 < 4; ++t4) pfr[ks][t4] = *(const GAS bf16x8*)(Pg + (size_t)item * 4096 + (t4 * 16 + l15) * 64 + 32 * ks + 8 * g);
        __builtin_amdgcn_sched_barrier(0);
        const bool skip = DRY && SA[0] < 1e30f;
        f32x4 acc2[4][4];
#pragma unroll
        for (int vtile = 0; vtile < 4; ++vtile)
#pragma unroll
            for (int t4 = 0; t4 < 4; ++t4) acc2[vtile][t4] = (f32x4){0.f, 0.f, 0.f, 0.f};
#pragma unroll
        for (int ks = 0; ks < 2; ++ks) {
#pragma unroll
            for (int vtile = 0; vtile < 4; ++vtile)
#pragma unroll
                for (int t4 = 0; t4 < 4; ++t4) acc2[vtile][t4] = MFMA16(vfr[ks][vtile], pfr[ks][t4], acc2[vtile][t4]);
        }
        LAS unsigned char* stg = C.lds + RING_OFF + 16384 + C.wave * 9216;
#pragma unroll
        for (int vtile = 0; vtile < 4; ++vtile)
#pragma unroll
            for (int t4 = 0; t4 < 4; ++t4) { const f32x4 a = acc2[vtile][t4]; *(LAS v2u*)(stg + (t4 * 16 + l15) * 144 + (vtile * 16 + 4 * g) * 2) = (v2u){cvtpk(a[0], a[1]), cvtpk(a[2], a[3])}; }
        float hh[8][8], ssq8[8];
#pragma unroll
        for (int i = 0; i < 8; ++i) { const int row = 8 * i + (C.lane >> 3); const v4u sv = *(const LAS v4u*)(stg + row * 144 + (C.lane & 7) * 16);
            const float den = rs8[i] + sis8[i] * qn8[i]; const float inv = 1.f / fmaxf(fabsf(den), sfl8[i]); float q = 0.f;
#pragma unroll
            for (int e = 0; e < 4; ++e) { const float a = (bf_lo(sv[e]) + bf_lo(holdr[i][e])) * inv, b = (bf_hi(sv[e]) + bf_hi(holdr[i][e])) * inv; hh[i][2 * e] = a; hh[i][2 * e + 1] = b; q += a * a + b * b; }
            q += __shfl_xor(q, 1); q += __shfl_xor(q, 2); q += __shfl_xor(q, 4); ssq8[i] = q;
            if ((C.lane & 7) == 0) ssum[C.wave * 64 + row] = q; }
        asm volatile("s_waitcnt lgkmcnt(0)\n\ts_barrier" ::: "memory");
        const f32x4 gn0 = *(const f32x4*)(ml_norm + h * 512 + 64 * C.wave + 8 * (C.lane & 7)), gn1 = *(const f32x4*)(ml_norm + h * 512 + 64 * C.wave + 8 * (C.lane & 7) + 4);
        const float gn8[8] = {gn0[0], gn0[1], gn0[2], gn0[3], gn1[0], gn1[1], gn1[2], gn1[3]};
#pragma unroll
        for (int i = 0; i < 8; ++i) { const int row = 8 * i + (C.lane >> 3); float q = 0.f;
#pragma unroll
            for (int w = 0; w < 8; ++w) q += ssum[w * 64 + row];
            const float r = rsqrtf(q * (1.f / 512.f) + 1e-6f); float y[8];
#pragma unroll
            for (int e = 0; e < 8; ++e) y[e] = hh[i][e] * r * gn8[e] * ((float)((ogr[i][e >> 2] >> (8 * (e & 3))) & 255u) * (1.f / 255.f));
            if (!skip) *(GAS v4u*)(H + (t0 + row) * 2048 + h * 512 + 64 * C.wave + 8 * (C.lane & 7)) = (v4u){cvtpk(y[0], y[1]), cvtpk(y[2], y[3]), cvtpk(y[4], y[5]), cvtpk(y[6], y[7])}; }
        asm volatile("s_waitcnt lgkmcnt(0)\n\ts_barrier" ::: "memory");
    }
}

__device__ __forceinline__ unsigned p4_qslot(int t, int c) { return (unsigned)(t * 32 + ((c & 16) | ((c ^ t) & 15))); }
__device__ __forceinline__ unsigned p4_kslot(int row, int c) { return (unsigned)(row * 8 + (c ^ ((((row >> 4) & 1) << 2) | (((row >> 1) & 1) << 1)))); }
__device__ __forceinline__ unsigned cvtpk(float lo, float hi) { typedef float f2_t __attribute__((ext_vector_type(2))); typedef __bf16 b2_t __attribute__((ext_vector_type(2)));
    f2_t v = {lo, hi}; b2_t b = __builtin_convertvector(v, b2_t); return __builtin_bit_cast(unsigned, b); }
template <bool DRY>
__device__ __forceinline__ void p4_scan(const Ctx& C, unsigned char* ws, const bf16* Q) {
    const float* SIS = (const float*)(ws + WS_SIS); const float* DEC = (const float*)(ws + WS_DEC); float* QN = (float*)(ws + WS_QN);
    const bf16* vt = (const bf16*)(ws + WS_VT); const bf16* kwt = (const bf16*)(ws + WS_KWT); bf16* H = (bf16*)(ws + WS_QKRAW);
    const int l15 = C.lane & 15, g = C.lane >> 4;
    const unsigned lds0 = (unsigned)(uintptr_t)(C.lds + RING_OFF);
    for (int id = (int)blockIdx.x; id < 144; id += C.G) {
        const int bh = (id & 7) * 2 + (id < 128 ? (id >> 6) : ((id - 128) >> 3)); const int vblk = id < 128 ? (((id >> 3) & 7) * 4 + C.wave) : 32;
        const bool active = id < 128 ? (C.wave < 4) : (C.wave == 0);
        const bool loader = C.wave >= 4;
        const int b = bh >> 2, h = bh & 3;
        unsigned qoff[8], koff[8];
#pragma unroll
        for (int i = 0; i < 8; ++i) { const int sg = 64 * (8 * (C.wave & 3) + i) + C.lane;
            { const int t = sg >> 5, cp = sg & 31, c = (cp & 16) | ((cp ^ t) & 15); qoff[i] = (unsigned)((t * 1024 + c * 8) * 2); }
            { const int row = sg >> 3, cp = sg & 7, c = cp ^ ((((row >> 4) & 1) << 2) | (((row >> 1) & 1) << 1)); koff[i] = (unsigned)((row * 64 + c * 8) * 2); } }
        const char* qsrc = (const char*)(Q + (size_t)b * SEQ * 1024 + h * 256); const char* ksrc = (const char*)(kwt + (size_t)bh * NCH * 16384);
#define P4_DMA(cc, buf) do { if (loader) { _Pragma("unroll") for (int i_ = 0; i_ < 8; ++i_) \
            attn_body::glds16(qsrc + (size_t)(cc) * (64 * 1024 * 2) + qoff[i_], (unsigned)__builtin_amdgcn_readfirstlane(lds0 + (buf) * 65536 + (8 * (C.wave & 3) + i_) * 1024)); \
            _Pragma("unroll") for (int i_ = 0; i_ < 8; ++i_) \
            attn_body::glds16(ksrc + (size_t)(cc) * (16384 * 2) + koff[i_], (unsigned)__builtin_amdgcn_readfirstlane(lds0 + (buf) * 65536 + 32768 + (8 * (C.wave & 3) + i_) * 1024)); } } while (0)
        P4_DMA(0, 0);
        const bf16* vbase = vt + (size_t)(h * VT_ROWS + vblk * 16 + l15) * T + (size_t)b * SEQ + 8 * g;
        f32x4 X[16];
#pragma unroll
        for (int db = 0; db < 16; ++db) X[db] = (f32x4){0.f, 0.f, 0.f, 0.f};
        bf16x8 vcur[2]; vcur[0] = vcur[1] = (bf16x8){0, 0, 0, 0, 0, 0, 0, 0};
        float isc[4] = {0.f, 0.f, 0.f, 0.f}, dec = 0.f;
        if (active) { vcur[0] = *(const GAS bf16x8*)(vbase); vcur[1] = *(const GAS bf16x8*)(vbase + 32);
#pragma unroll
            for (int t4 = 0; t4 < 4; ++t4) isc[t4] = SIS[((size_t)b * SEQ + 16 * t4 + l15) * 4 + h];
            dec = DEC[bh * 128]; }
        asm volatile("s_waitcnt vmcnt(0)\n\ts_barrier" ::: "memory");
        bf16x8 vodd[2]; vodd[0] = vcur[0]; vodd[1] = vcur[1]; float decodd = 0.f;
        auto chunk = [&](const int c, bf16x8 (&vc)[2], bf16x8 (&vn)[2], float& dc, float& dn) __attribute__((always_inline)) {
            const int buf = c & 1;
            if (c + 1 < NCH && !(DRY && MK_P4_HALFLDS > 1)) P4_DMA(c + 1, buf ^ 1);
            if (active) {
                const size_t t0 = (size_t)b * SEQ + c * 64;
                const LAS unsigned char* qb = C.lds + RING_OFF + buf * 65536 + l15 * 512; const LAS unsigned char* kb = C.lds + RING_OFF + buf * 65536 + 32768 + (8 * (l15 >> 2) + (l15 & 3)) * 128;
                int qx[4];
#pragma unroll
                for (int k3 = 0; k3 < 4; ++k3) qx[k3] = (((4 * k3 + g) ^ l15) & 15) * 16;
                const int hl = (((l15 >> 3) & 1) << 2) | (((l15 >> 1) & 1) << 1); const int kx0 = (g ^ hl) * 16, kx1 = kx0 ^ 64;
                f32x4 hi[4];
#pragma unroll
                for (int t4 = 0; t4 < 4; ++t4) hi[t4] = (f32x4){0.f, 0.f, 0.f, 0.f};
                bf16x8 qf[2][4];
#pragma unroll
                for (int t4 = 0; t4 < 4; ++t4) qf[0][t4] = *(const LAS bf16x8*)(qb + qx[0] + t4 * 8192);
#pragma unroll
                for (int ks = 0; ks < 8; ++ks) {
                    if (ks + 1 < 8 && !(DRY && MK_P4_HALFLDS)) {
#pragma unroll
                        for (int t4 = 0; t4 < 4; ++t4) qf[(ks + 1) & 1][t4] = *(const LAS bf16x8*)(qb + qx[(ks + 1) & 3] + t4 * 8192 + ((ks + 1) >> 2) * 256);
                    }
                    const f32x4 lo = X[2 * ks], up = X[2 * ks + 1];
                    const bf16x8 xfr = __builtin_bit_cast(bf16x8, (v4u){cvtpk(lo[0], lo[1]), cvtpk(lo[2], lo[3]), cvtpk(up[0], up[1]), cvtpk(up[2], up[3])});
                    __builtin_amdgcn_sched_barrier(0);
#pragma unroll
                    for (int t4 = 0; t4 < 4; ++t4) hi[t4] = MFMA16(xfr, qf[ks & 1][t4], hi[t4]);
                    __builtin_amdgcn_sched_barrier(0);
                }
                asm volatile("" :: "v"(dc), "v"(vc[0]), "v"(vc[1]));
                if (DRY && DEC[0] < 1e30f) { }
                else if (vblk < 32) {
#pragma unroll
                    for (int t4 = 0; t4 < 4; ++t4) { const f32x4 o = hi[t4] * isc[t4];
                        *(GAS v2u*)(H + (t0 + 16 * t4 + l15) * 2048 + h * 512 + vblk * 16 + 4 * g) = (v2u){cvtpk(o[0], o[1]), cvtpk(o[2], o[3])}; }
                } else if (g == 0) {
#pragma unroll
                    for (int t4 = 0; t4 < 4; ++t4) QN[(t0 + 16 * t4 + l15) * 4 + h] = hi[t4][0];
                }
                if (c + 1 < NCH) { vn[0] = *(const GAS bf16x8*)(vbase + (c + 1) * 64); vn[1] = *(const GAS bf16x8*)(vbase + (c + 1) * 64 + 32);
#pragma unroll
                    for (int t4 = 0; t4 < 4; ++t4) isc[t4] = SIS[(t0 + 64 + 16 * t4 + l15) * 4 + h];
                    dn = DEC[bh * 128 + c + 1]; }
                bf16x8 kf[2][4];
#define P4_KOFF(db) ((32 * ((db) >> 1) + 4 * ((db) & 1)) * 128)
                kf[0][0] = *(const LAS bf16x8*)(kb + kx0 + P4_KOFF(0)); kf[0][1] = *(const LAS bf16x8*)(kb + kx1 + P4_KOFF(0));
                kf[0][2] = *(const LAS bf16x8*)(kb + kx0 + P4_KOFF(1)); kf[0][3] = *(const LAS bf16x8*)(kb + kx1 + P4_KOFF(1));
#pragma unroll
                for (int dp = 0; dp < 8; ++dp) {
                    if (dp + 1 < 8 && !(DRY && MK_P4_HALFLDS)) {
                        kf[(dp + 1) & 1][0] = *(const LAS bf16x8*)(kb + kx0 + P4_KOFF(2 * dp + 2)); kf[(dp + 1) & 1][1] = *(const LAS bf16x8*)(kb + kx1 + P4_KOFF(2 * dp + 2));
                        kf[(dp + 1) & 1][2] = *(const LAS bf16x8*)(kb + kx0 + P4_KOFF(2 * dp + 3)); kf[(dp + 1) & 1][3] = *(const LAS bf16x8*)(kb + kx1 + P4_KOFF(2 * dp + 3));
                    }
                    f32x4 xa = X[2 * dp] * dc, xb = X[2 * dp + 1] * dc;
                    __builtin_amdgcn_sched_barrier(0);
                    xa = MFMA16(kf[dp & 1][0], vc[0], xa); xb = MFMA16(kf[dp & 1][2], vc[0], xb);
                    xa = MFMA16(kf[dp & 1][1], vc[1], xa); xb = MFMA16(kf[dp & 1][3], vc[1], xb);
                    __builtin_amdgcn_sched_barrier(0);
                    X[2 * dp] = xa; X[2 * dp + 1] = xb;
                }
#undef P4_KOFF
            }
            if (loader) asm volatile("s_waitcnt vmcnt(0)\n\ts_barrier" ::: "memory");
            else asm volatile("s_waitcnt lgkmcnt(0)\n\ts_barrier" ::: "memory");
        };
        for (int c = 0; c < NCH; c += 2) { chunk(c, vcur, vodd, dec, decodd); chunk(c + 1, vodd, vcur, decodd, dec); }
#undef P4_DMA
    }
}

template <bool DRY>
__device__ __forceinline__ void p5_headnorm(const Ctx& C, unsigned char* ws, const float* ml_norm) {
    const float* RS = (const float*)(ws + WS_RS); const float* SIS = (const float*)(ws + WS_SIS); const float* QN = (const float*)(ws + WS_QN); const float* SFL = (const float*)(ws + WS_SFL);
    bf16* H = (bf16*)(ws + WS_QKRAW); const bf16* OG = (const bf16*)(ws + WS_OG);
    for (int idx = C.gw; idx < T * 4; idx += C.NGW) {
        const int h = idx & 3; const size_t t = idx >> 2;
        const float den = RS[idx] + SIS[idx] * QN[idx]; const float inv = 1.f / fmaxf(fabsf(den), SFL[idx]);
        bf16* hp = H + t * 2048 + h * 512 + 8 * C.lane;
        const v4u hv = *(const GAS v4u*)hp; const v4u ov = *(const GAS v4u*)(OG + t * 2048 + h * 512 + 8 * C.lane);
        float x[8], o[8]; float ss = 0.f;
#pragma unroll
        for (int e = 0; e < 4; ++e) { x[2 * e] = bf_lo(hv[e]) * inv; x[2 * e + 1] = bf_hi(hv[e]) * inv; o[2 * e] = bf_lo(ov[e]); o[2 * e + 1] = bf_hi(ov[e]); }
#pragma unroll
        for (int e = 0; e < 8; ++e) ss += x[e] * x[e];
        const float rstd = rsqrtf(wave_sum(ss) * (1.f / 512.f) + 1e-6f);
        const f32x4 g0 = *(const f32x4*)(ml_norm + h * 512 + 8 * C.lane), g1 = *(const f32x4*)(ml_norm + h * 512 + 8 * C.lane + 4);
        const float gn[8] = {g0.x, g0.y, g0.z, g0.w, g1.x, g1.y, g1.z, g1.w};
        float y[8];
#pragma unroll
        for (int e = 0; e < 8; ++e) y[e] = x[e] * rstd * gn[e] * sigmoidf_(o[e]);
        if (!(DRY && RS[0] < 1e30f)) *(GAS v4u*)hp = (v4u){pk2(y[0], y[1]), pk2(y[2], y[3]), pk2(y[4], y[5]), pk2(y[6], y[7])};
    }
}

__device__ __forceinline__ void conv_moe_weights(const Ctx& C, const float* w_gu_l, const float* w_down_l, bf16* wgu, bf16* wdn, const float* gffn) {
    LAS float* scr = (LAS float*)(C.lds + RING_OFF + C.wave * 16384);
    constexpr int I_GU = 32 * 16 * 16, I_DN = 32 * 4 * 32;
#define MOE_SRC(it, W_, ld_, k0_, c0_, ksc_) do { if ((it) < I_GU) { const int e_ = (it) >> 8, r_ = (it) & 255; W_ = w_gu_l + (size_t)e_ * 1024 * 512; ld_ = 512; k0_ = (r_ >> 4) * 64; c0_ = (r_ & 15) * 32; ksc_ = gffn; } \
        else { const int r0_ = (it) - I_GU, e_ = r0_ >> 7, r_ = r0_ & 127; W_ = w_down_l + (size_t)e_ * 256 * 1024; ld_ = 1024; k0_ = (r_ >> 5) * 64; c0_ = (r_ & 31) * 32; ksc_ = nullptr; } } while (0)
    int it = C.gw; if (it >= I_GU + I_DN) return;
    f32x4 wv[8]; float ks[8];
    { const float* W_; int ld_, k0_, c0_; const float* ksc_; MOE_SRC(it, W_, ld_, k0_, c0_, ksc_); tr_load(wv, ks, W_, ld_, k0_, c0_, C.lane, ksc_); }
    for (;;) {
        const int nx = it + C.NGW; const bool more = nx < I_GU + I_DN;
        f32x4 wn[8]; float kn[8];
#pragma unroll
        for (int i = 0; i < 8; ++i) { wn[i] = wv[i]; kn[i] = ks[i]; }
        if (more) { const float* W_; int ld_, k0_, c0_; const float* ksc_; MOE_SRC(nx, W_, ld_, k0_, c0_, ksc_); tr_load(wn, kn, W_, ld_, k0_, c0_, C.lane, ksc_); }
        if (it < I_GU) { const int e = it >> 8, r = it & 255, kb = r >> 4, nb = r & 15, n0 = nb * 32;
            const int half = n0 >> 8, jj = (n0 & 255) >> 7, i0 = n0 & 127;
            tr_finish(wv, ks, 1024, kb * 64, wgu, e * 512 + jj * 256 + half * 128 + i0, scr, C.lane); }
        else { const int r0 = it - I_GU, e = r0 >> 7, r = r0 & 127, kb = r >> 5, nb = r & 31;
            tr_finish(wv, ks, 256, kb * 64, wdn, e * 1024 + nb * 32, scr, C.lane); }
        if (!more) break;
#pragma unroll
        for (int i = 0; i < 8; ++i) { wv[i] = wn[i]; ks[i] = kn[i]; }
        it = nx;
    }
#undef MOE_SRC
}
__device__ __forceinline__ void conv_da_weights(const Ctx& C, const float* da_w_in, const float* da_w_out, unsigned char* ws, const float* gmix) {
    LAS float* scr = (LAS float*)(C.lds + RING_OFF + C.wave * 16384);
    bf16* win = (bf16*)(ws + WS_WDA_IN); bf16* wout = (bf16*)(ws + WS_WDA_OUT);
    constexpr int I_IN = 16 * 96, I_OUT = 16 * 32;
    for (int it = C.gw; it < I_IN + I_OUT; it += C.NGW) {
        if (it < I_IN) { const int kb = it / 96, nb = it % 96; tr_item(da_w_in, 3072, 1024, kb * 64, nb * 32, win, nb * 32, scr, C.lane, gmix); }
        else { const int r = it - I_IN, kb = r >> 5, nb = r & 31; tr_item(da_w_out, 1024, 1024, kb * 64, nb * 32, wout, nb * 32, scr, C.lane); }
    }
}

__device__ __forceinline__ void p7_route(const Ctx& C, const bf16* xres, const float* norm_g, const float* b_group, const float* b_expert, int layer, unsigned char* ws, int cbank) {
    const bf16* WRH = (const bf16*)(ws + WS_WR) + (size_t)layer * (32 * 3 * 4 * 16 * 8); const bf16* WRL = WRH + 2 * 32 * 3 * 4 * 16 * 8;
    int* TE = (int*)(ws + WS_TE); int* TPOS = (int*)(ws + WS_TPOS); int* E2T = (int*)(ws + WS_E2T); float* EW = (float*)(ws + WS_EW); float* ERS = (float*)(ws + WS_ERS);
    unsigned* CNT = (unsigned*)(ws + WS_CTL) + CW_CNT + 64 * cbank;
    LAS float* lg = (LAS float*)(C.lds + RING_OFF + C.wave * 3072);
    LAS int* lcnt = (LAS int*)(C.lds + RING_OFF + 32768); LAS int* lbase = lcnt + 32;
    const int l15 = C.lane & 15, g = C.lane >> 4;
    for (int base = 0; base < T / 16; base += C.NGW) {
        const int grp = base + C.gw; const bool valid = grp < T / 16;
        if (C.tid < 32) lcnt[C.tid] = 0;
        __syncthreads();
        int E1 = 0, E2 = 0, lp1 = 0, lp2 = 0; float w1 = 0.f, w2 = 0.f, rstd = 0.f;
        const size_t row = (size_t)(valid ? grp : 0) * 16 + l15;
        if (valid) {
            f32x4 acc[3]; acc[0] = acc[1] = acc[2] = (f32x4){0.f, 0.f, 0.f, 0.f}; float ss = 0.f;
            const bf16* xq = xres + row * D + 8 * g;
            const bf16* wh = WRH + (size_t)(g * 16 + l15) * 8; const bf16* wl = WRL + (size_t)(g * 16 + l15) * 8;
#pragma unroll 4
            for (int ks = 0; ks < 32; ++ks) {
                const v4u xv = *(const GAS v4u*)(xq + 32 * ks);
                bf16x8 bh[3], bl[3];
#pragma unroll
                for (int ctile = 0; ctile < 3; ++ctile) { bh[ctile] = *(const GAS bf16x8*)(wh + (size_t)(ks * 3 + ctile) * 512); bl[ctile] = *(const GAS bf16x8*)(wl + (size_t)(ks * 3 + ctile) * 512); }
#pragma unroll
                for (int e = 0; e < 4; ++e) { const float a = bf_lo(xv[e]), b = bf_hi(xv[e]); ss += a * a + b * b; }
                const bf16x8 ah = __builtin_bit_cast(bf16x8, xv);
#pragma unroll
                for (int ctile = 0; ctile < 3; ++ctile) { acc[ctile] = MFMA16(ah, bh[ctile], acc[ctile]); acc[ctile] = MFMA16(ah, bl[ctile], acc[ctile]); }
            }
            ss += __shfl_xor(ss, 16); ss += __shfl_xor(ss, 32);
            rstd = rsqrtf(ss * (1.f / D) + 1e-6f);
#pragma unroll
            for (int ctile = 0; ctile < 3; ++ctile)
#pragma unroll
                for (int r = 0; r < 4; ++r) lg[(4 * g + r) * 48 + ctile * 16 + l15] = acc[ctile][r];
            LDS_WAIT(); asm volatile("" ::: "memory");
            if (C.lane < 16) {
                const LAS float* my = lg + C.lane * 48;
                float gl[4]; int gi = 0; float gmax;
#pragma unroll
                for (int j = 0; j < 4; ++j) gl[j] = rstd * my[j] + b_group[layer * 4 + j];
                gmax = gl[0];
#pragma unroll
                for (int j = 1; j < 4; ++j) if (gl[j] > gmax) { gmax = gl[j]; gi = j; }
                float gsum = 0.f;
#pragma unroll
                for (int j = 0; j < 4; ++j) gsum += __expf(gl[j] - gmax);
                const float g_w = 1.f / gsum;
                float el[8];
#pragma unroll
                for (int j = 0; j < 8; ++j) el[j] = rstd * my[4 + gi * 8 + j] + b_expert[layer * 32 + gi * 8 + j];
                int i1 = 0; float e1 = el[0];
#pragma unroll
                for (int j = 1; j < 8; ++j) if (el[j] > e1) { e1 = el[j]; i1 = j; }
                int i2 = -1; float e2 = -INFINITY;
#pragma unroll
                for (int j = 0; j < 8; ++j) if (j != i1 && el[j] > e2) { e2 = el[j]; i2 = j; }
                const float r2 = __expf(e2 - e1); const float p1 = 1.f / (1.f + r2), p2 = r2 * p1;
                w1 = g_w * p1; w2 = g_w * p2; E1 = gi * 8 + i1; E2 = gi * 8 + i2;
                lp1 = __hip_atomic_fetch_add(lcnt + E1, 1, __ATOMIC_RELAXED, __HIP_MEMORY_SCOPE_WORKGROUP);
                lp2 = __hip_atomic_fetch_add(lcnt + E2, 1, __ATOMIC_RELAXED, __HIP_MEMORY_SCOPE_WORKGROUP);
            }
        }
        __syncthreads();
        if (C.tid < 32) { const int n = lcnt[C.tid]; lbase[C.tid] = n ? (int)__hip_atomic_fetch_add(CNT + C.tid, (unsigned)n, RLX_AGENT) : 0; }
        __syncthreads();
        if (valid) {
            if (C.lane < 16) { const int p1 = lbase[E1] + lp1, p2 = lbase[E2] + lp2; TE[row * 2] = E1; TE[row * 2 + 1] = E2; TPOS[row * 2] = p1; TPOS[row * 2 + 1] = p2;
                E2T[(size_t)E1 * T + p1] = (int)row; E2T[(size_t)E2 * T + p2] = (int)row; EW[(size_t)E1 * T + p1] = w1; EW[(size_t)E2 * T + p2] = w2; ERS[(size_t)E1 * T + p1] = rstd; ERS[(size_t)E2 * T + p2] = rstd; }
        }
        __syncthreads();
    }
}

__device__ __forceinline__ void moe_tables(const Ctx& C, int layer, unsigned char* ws) {
    const unsigned* CNT = (const unsigned*)(ws + WS_CTL) + CW_CNT + 64 * layer;
    LAS int* pexp = (LAS int*)(C.lds + TAB_PEXP); LAS int* eoff = (LAS int*)(C.lds + TAB_EOFF); LAS int* npp = (LAS int*)(C.lds + TAB_NP);
    if (C.tid == 0) { int off = 0, p = 0;
        for (int e = 0; e < NEXP; ++e) { const int n = (int)__hip_atomic_load(CNT + e, RLX_AGENT); eoff[e] = off; const int np_e = (n + 255) >> 8;
            for (int q = 0; q < np_e && p < MAXPANEL; ++q) pexp[p++] = e; off += np_e << 8; }
        eoff[NEXP] = off; npp[0] = p; }
    __syncthreads();
}

template <bool FINAL, bool DRY>
__device__ __forceinline__ void p11_combine(const Ctx& C, bf16* xio, float* fout, const float* gnorm, unsigned char* ws) {
    float* rstd_out = (float*)(ws + WS_RSTD);
    const int* TE = (const int*)(ws + WS_TE); const int* TPOS = (const int*)(ws + WS_TPOS); const LAS int* eoff = (const LAS int*)(C.lds + TAB_EOFF); const bf16* YS = (const bf16*)(ws + WS_YS);
    f32x4 gn[4];
#pragma unroll
    for (int j = 0; j < 4; ++j) gn[j] = *(const f32x4*)(gnorm + 4 * C.lane + 256 * j);
    v2u xn[4], an[4], bn[4];
#define P11_LOAD(tt) do { const int s0_ = eoff[TE[(tt) * 2]] + TPOS[(tt) * 2], s1_ = eoff[TE[(tt) * 2 + 1]] + TPOS[(tt) * 2 + 1]; \
        const GAS v2u* xr_ = (const GAS v2u*)(xio + (size_t)(tt) * D) + C.lane; const GAS v2u* y0_ = (const GAS v2u*)(YS + (size_t)s0_ * D) + C.lane; const GAS v2u* y1_ = (const GAS v2u*)(YS + (size_t)s1_ * D) + C.lane; \
        _Pragma("unroll") for (int j = 0; j < 4; ++j) { xn[j] = xr_[64 * j]; an[j] = y0_[64 * j]; bn[j] = y1_[64 * j]; } } while (0)
    if (C.gw < T) P11_LOAD(C.gw);
    for (int t = C.gw; t < T; t += C.NGW) {
        GAS v2u* xr = (GAS v2u*)(xio + (size_t)t * D) + C.lane; GAS f32x4* fr_ = (GAS f32x4*)(fout + (size_t)t * D) + C.lane;
        f32x4 v[4]; v2u ya[4], yb[4]; float ss = 0.f;
#pragma unroll
        for (int j = 0; j < 4; ++j) { v[j] = (f32x4){bf_lo(xn[j].x), bf_hi(xn[j].x), bf_lo(xn[j].y), bf_hi(xn[j].y)}; ya[j] = an[j]; yb[j] = bn[j]; }
        if (t + C.NGW < T) P11_LOAD(t + C.NGW);
#pragma unroll
        for (int j = 0; j < 4; ++j) { const v2u a = ya[j], b = yb[j];
            v[j].x += bf_lo(a.x) + bf_lo(b.x); v[j].y += bf_hi(a.x) + bf_hi(b.x); v[j].z += bf_lo(a.y) + bf_lo(b.y); v[j].w += bf_hi(a.y) + bf_hi(b.y);
            ss += (v[j].x * v[j].x + v[j].y * v[j].y) + (v[j].z * v[j].z + v[j].w * v[j].w); }
        const float rstd = rsqrtf(wave_sum(ss) * (1.f / D) + 1e-6f);
        if (DRY && gnorm[0] < 1e30f) { }
        else if (FINAL) {
#pragma unroll
            for (int j = 0; j < 4; ++j) fr_[64 * j] = v[j] * rstd * gn[j];
        } else {
#pragma unroll
            for (int j = 0; j < 4; ++j) xr[64 * j] = (v2u){pk2(v[j].x, v[j].y), pk2(v[j].z, v[j].w)};
            if (C.lane == 0) rstd_out[t] = rstd;
        }
    }
}

#undef P11_LOAD
__device__ __forceinline__ void p14_diffnorm(const Ctx& C, const float* lq1, const float* lk1, const float* lq2, const float* lk2, const float* da_norm, unsigned char* ws) {
    const bf16* O = (const bf16*)(ws + WS_AO); bf16* A2 = (bf16*)(ws + WS_HN);
    const float lam = __expf(wave_sum(lq1[C.lane] * lk1[C.lane])) - __expf(wave_sum(lq2[C.lane] * lk2[C.lane])) + LAMBDA_INIT1;
    const float g0 = da_norm[2 * C.lane] * (1.f - LAMBDA_INIT1), g1 = da_norm[2 * C.lane + 1] * (1.f - LAMBDA_INIT1);
    for (int t = C.gw; t < T; t += C.NGW) {
#pragma unroll
        for (int h = 0; h < 8; ++h) {
            const unsigned a = *(const GAS unsigned*)(O + (size_t)t * 2048 + h * 256 + 2 * C.lane), b = *(const GAS unsigned*)(O + (size_t)t * 2048 + h * 256 + 128 + 2 * C.lane);
            const float d0 = bf_lo(a) - lam * bf_lo(b), d1 = bf_hi(a) - lam * bf_hi(b);
            const float rstd = rsqrtf(wave_sum(d0 * d0 + d1 * d1) * (1.f / 128.f) + 1e-5f);
            *(GAS unsigned*)(A2 + (size_t)t * D + h * 128 + 2 * C.lane) = pk2(d0 * rstd * g0, d1 * rstd * g1);
        }
    }
}

__device__ __forceinline__ Ctx make_ctx(unsigned char* lds) {
    Ctx C; int t = threadIdx.x; asm volatile("" : "+v"(t));
    C.lds = (LAS unsigned char*)lds;
    C.tid = t; C.lane = t & 63; C.wave = __builtin_amdgcn_readfirstlane(t >> 6);
    C.G = gridDim.x; { const int bx = blockIdx.x; C.vcu = (C.G % 8 == 0) ? (bx % 8) * (C.G / 8) + bx / 8 : bx; }
    C.gw = C.vcu * NWAVES + C.wave; C.NGW = C.G * NWAVES;
    return C;
}
struct Args { const float* in[23]; float* out; unsigned char* ws; };
#ifndef MK_DUP
#define MK_DUP 0
#endif
#define DUP(k) ((MK_DUP >> (k)) & 1)
#ifndef MK_PHASE_LO
#define MK_PHASE_LO 0
#endif
#ifndef MK_PHASE_HI
#define MK_PHASE_HI 99
#endif
__global__ void __launch_bounds__(NWAVES * 64, 2) mk_fwd(Args args) {
    extern __shared__ __attribute__((aligned(16))) unsigned char lds[];
    Ctx C = make_ctx(lds);
#define FRESH() C = make_ctx(lds); LOADARGS()
    typedef const __attribute__((address_space(4))) Args* ArgP;
#define LOADARGS() ArgP A_ = (ArgP)__builtin_amdgcn_kernarg_segment_ptr(); asm volatile("" : "+s"(A_)); unsigned char* const ws = A_->ws; float* const out = A_->out; (void)out
#define xin (A_->in[0])
#define norm_mix (A_->in[1])
#define norm_ffn (A_->in[2])
#define ml_w_in (A_->in[3])
#define ml_conv (A_->in[4])
#define ml_b_i (A_->in[5])
#define ml_b_f (A_->in[6])
#define ml_norm (A_->in[7])
#define ml_w_out (A_->in[8])
#define da_w_in (A_->in[9])
#define da_lq1 (A_->in[10])
#define da_lk1 (A_->in[11])
#define da_lq2 (A_->in[12])
#define da_lk2 (A_->in[13])
#define da_norm (A_->in[14])
#define da_w_out (A_->in[15])
#define moe_w_group (A_->in[16])
#define moe_b_group (A_->in[17])
#define moe_w_expert (A_->in[18])
#define moe_b_expert (A_->in[19])
#define moe_w_gu (A_->in[20])
#define moe_w_down (A_->in[21])
#define final_norm (A_->in[22])
    for (int u = C.tid; u < (LDS_BYTES - LDSCTL_OFF) / 4; u += NWAVES * 64) ((LAS unsigned*)(C.lds + LDSCTL_OFF))[u] = 0u;
    __syncthreads();
    volatile LAS unsigned* MISC = (volatile LAS unsigned*)(C.lds + MISC_OFF);
    XcdBarrier bar; { LOADARGS(); bar = xcd_barrier_post((unsigned*)(ws + WS_CTL) + CW_BAR, MISC + 8); }
#define GRID_BAR() xcd_barrier(bar)
#define PH(k) ((k) <= MK_PHASE_HI && (k) >= MK_PHASE_LO)
#define MFMA_SPIN(k) if (DUP(k)) { typedef short b8_ __attribute__((ext_vector_type(8))); f32x4 s0_ = {0.f, 0.f, 0.f, 0.f}, s1_ = s0_, s2_ = s0_, s3_ = s0_; b8_ xx_ = {0, 0, 0, 0, 0, 0, 0, 0}; asm volatile("" : "+v"(xx_)); \
        for (int i_ = 0; i_ < 5000; ++i_) { s0_ = __builtin_amdgcn_mfma_f32_16x16x32_bf16(xx_, xx_, s0_, 0, 0, 0); s1_ = __builtin_amdgcn_mfma_f32_16x16x32_bf16(xx_, xx_, s1_, 0, 0, 0); \
            s2_ = __builtin_amdgcn_mfma_f32_16x16x32_bf16(xx_, xx_, s2_, 0, 0, 0); s3_ = __builtin_amdgcn_mfma_f32_16x16x32_bf16(xx_, xx_, s3_, 0, 0, 0); } \
        asm volatile("" :: "v"(s0_), "v"(s1_), "v"(s2_), "v"(s3_)); GRID_BAR(); }
#define hn0 ((bf16*)out)
#define Qm ((bf16*)out)
#define Km ((bf16*)out + (size_t)T * 1024)
#define HN ((bf16*)(ws + WS_HN))
#define XB ((bf16*)out)
#define XB2 ((bf16*)(ws + WS_AQ))
    const int bx = (int)blockIdx.x;

#ifndef MK_NO_P0
    { FRESH();
    p0_prologue(C, xin, norm_mix, ml_w_in, ml_w_out, norm_ffn, moe_w_group, moe_w_expert, ws, hn0); }
#define P0ONCE { GRID_BAR(); FRESH(); p0_prologue(C, xin, norm_mix, ml_w_in, ml_w_out, norm_ffn, moe_w_group, moe_w_expert, ws, hn0); }
    if (DUP(0)) { P0ONCE P0ONCE P0ONCE P0ONCE }
#endif
    GRID_BAR();
    MFMA_SPIN(22)
    if (PH(1)) { FRESH();
        p1_gate_chunks(C, ml_b_i, ml_b_f, ws);
        { pg8::Gemm g{hn0, (const bf16*)(ws + WS_WML_IN), T, 4096, D}; pg8::StaticOrder S; S.init(T, 4096, C.G, bx);
          pg8::EpiQKO E{(bf16*)(ws + WS_QKRAW), (unsigned char*)(ws + WS_OG)};
          pg8::gemm_phase<pg8::EpiQKO, pg8::StaticOrder, true, true>(C.lds + RING_OFF, g, S, E); }
        { pg8::Gemm g{(const bf16*)(ws + WS_WML_IN) + (size_t)4096 * D, hn0, 2048, T, D}; pg8::StaticOrder S; S.init(2048, T, C.G, bx);
          pg8::EpiBf16S E{(bf16*)(ws + WS_VT), T, 0, 0, 1.f, 0x7fffffff, VT_ROWS - 512, nullptr};
          pg8::gemm_phase<pg8::EpiBf16S, pg8::StaticOrder, true, true>(C.lds + RING_OFF, g, S, E); }
        if (DUP(1)) {
        { pg8::Gemm g{hn0, (const bf16*)(ws + WS_WML_IN), T, 4096, D}; pg8::StaticOrder S; S.init(T, 4096, C.G, bx);
          pg8::EpiQKO E{(bf16*)(ws + WS_QKRAW), (unsigned char*)(ws + WS_OG)};
          pg8::gemm_phase<pg8::EpiQKO, pg8::StaticOrder, true, true>(C.lds + RING_OFF, g, S, E); }
        { pg8::Gemm g{(const bf16*)(ws + WS_WML_IN) + (size_t)4096 * D, hn0, 2048, T, D}; pg8::StaticOrder S; S.init(2048, T, C.G, bx);
          pg8::EpiBf16S E{(bf16*)(ws + WS_VT), T, 0, 0, 1.f, 0x7fffffff, VT_ROWS - 512, nullptr};
          pg8::gemm_phase<pg8::EpiBf16S, pg8::StaticOrder, true, true>(C.lds + RING_OFF, g, S, E); }
        }
        GRID_BAR();
    }
    if (PH(2)) { FRESH(); p2_conv(C, ml_b_i, ml_b_f, ml_conv, ws, Qm, Km); GRID_BAR(); }
#define P2ONCE { FRESH(); p2_conv(C, ml_b_i, ml_b_f, ml_conv, ws, Qm, Km); GRID_BAR(); }
    if (DUP(2)) { P2ONCE P2ONCE P2ONCE P2ONCE }
    if (DUP(4)) { { FRESH(); p4_scan<true>(C, ws, Qm); GRID_BAR(); } { FRESH(); p4_scan<true>(C, ws, Qm); GRID_BAR(); } }
    if (DUP(28)) { FRESH(); p4_scan<false>(C, ws, Qm); GRID_BAR(); }
    if (DUP(27)) { FRESH();
        if (C.G > 144) { if ((int)blockIdx.x >= 144) { p3a_scores(C, ws, Qm, Km, (int)blockIdx.x - 144, C.G - 144);
                Ctx Cf = C; Cf.gw = ((int)blockIdx.x - 144) * NWAVES + C.wave; Cf.NGW = (C.G - 144) * NWAVES; conv_da_weights(Cf, da_w_in, da_w_out, ws, norm_mix + D); conv_ml_out(Cf, ml_w_out, ws); conv_moe_weights(Cf, moe_w_gu, moe_w_down, (bf16*)(ws + WS_WGU0), (bf16*)(ws + WS_WDN0), norm_ffn); }
            else p4_scan<false>(C, ws, Qm); }
        else { p4_scan<false>(C, ws, Qm); p3a_scores(C, ws, Qm, Km, (int)blockIdx.x, C.G); conv_da_weights(C, da_w_in, da_w_out, ws, norm_mix + D); conv_ml_out(C, ml_w_out, ws); conv_moe_weights(C, moe_w_gu, moe_w_down, (bf16*)(ws + WS_WGU0), (bf16*)(ws + WS_WDN0), norm_ffn); }
        GRID_BAR(); }
    if (PH(4)) { FRESH();
        if (C.G > 144) { if ((int)blockIdx.x >= 144) { p3a_scores(C, ws, Qm, Km, (int)blockIdx.x - 144, C.G - 144);
                Ctx Cf = C; Cf.gw = ((int)blockIdx.x - 144) * NWAVES + C.wave; Cf.NGW = (C.G - 144) * NWAVES; conv_da_weights(Cf, da_w_in, da_w_out, ws, norm_mix + D); conv_ml_out(Cf, ml_w_out, ws); conv_moe_weights(Cf, moe_w_gu, moe_w_down, (bf16*)(ws + WS_WGU0), (bf16*)(ws + WS_WDN0), norm_ffn); }
            else p4_scan<false>(C, ws, Qm); }
        else { p4_scan<false>(C, ws, Qm); p3a_scores(C, ws, Qm, Km, (int)blockIdx.x, C.G); conv_da_weights(C, da_w_in, da_w_out, ws, norm_mix + D); conv_ml_out(C, ml_w_out, ws); conv_moe_weights(C, moe_w_gu, moe_w_down, (bf16*)(ws + WS_WGU0), (bf16*)(ws + WS_WDN0), norm_ffn); }
        GRID_BAR(); }
    if (DUP(23)) { FRESH();
        if ((int)blockIdx.x >= 144) { if (DUP(24)) p3a_scores(C, ws, Qm, Km, (int)blockIdx.x - 144, C.G - 144);
            Ctx Cf = C; Cf.gw = ((int)blockIdx.x - 144) * NWAVES + C.wave; Cf.NGW = (C.G - 144) * NWAVES; if (DUP(25)) { conv_da_weights(Cf, da_w_in, da_w_out, ws, norm_mix + D); conv_ml_out(Cf, ml_w_out, ws); } if (DUP(26)) conv_moe_weights(Cf, moe_w_gu, moe_w_down, (bf16*)(ws + WS_WGU0), (bf16*)(ws + WS_WDN0), norm_ffn); }
        GRID_BAR(); }
#define P3ONCE { FRESH(); p3_intra<true>(C, ws, ml_norm); GRID_BAR(); }
    if (DUP(3)) { P3ONCE P3ONCE P3ONCE P3ONCE }
    if (PH(3)) { FRESH(); p3_intra<false>(C, ws, ml_norm); }
    if (PH(5)) { GRID_BAR(); }
    if (PH(6)) { FRESH();
        pg8::Gemm g{(const bf16*)(ws + WS_QKRAW), (const bf16*)(ws + WS_WML_OUT), T, D, ML_V}; pg8::StaticOrder S; S.init(T, D, C.G, bx);
        pg8::EpiResBf16<true> E{xin, XB, D};
        pg8::gemm_phase<pg8::EpiResBf16<true>, pg8::StaticOrder, true, true>(C.lds + RING_OFF, g, S, E);
        if (DUP(6)) pg8::gemm_phase<pg8::EpiResBf16<true>, pg8::StaticOrder, true, true>(C.lds + RING_OFF, g, S, E);
        GRID_BAR();
    }
#define MOE_LAYER(L, PBASE, FINAL_, GNEXT, WGU_, WDN_, XR_)                                                                                                              \
    if (PH(PBASE)) { FRESH(); p7_route(C, (XR_), norm_ffn + (L) * D, moe_b_group, moe_b_expert, (L), ws, (L)); if (DUP(7)) p7_route(C, (XR_), norm_ffn + (L) * D, moe_b_group, moe_b_expert, (L), ws, (L) + 2); GRID_BAR(); }                                                \
    if ((L) == 1 && PH(PBASE + 2)) {     \
      { FRESH(); moe_tables(C, (L), ws);                                                                                                                \
        const int np = __builtin_amdgcn_readfirstlane(*(LAS int*)(C.lds + TAB_NP));                                                                      \
        pg8::Gemm g{(const bf16*)(XR_), (const bf16*)(ws + (WGU_)), np * 256, NEXP * 512, D};                                                   \
        pg8::MoeOrder S{(const LAS int*)(C.lds + TAB_PEXP), np, 1, C.G, bx, 0, 2 * C.G};                                                                 \
        pg8::EpiSwiGLU E{(bf16*)(ws + WS_ACT), (const float*)(ws + WS_EW), (const float*)(ws + WS_ERS), (const LAS int*)(C.lds + TAB_EOFF), T};                                       \
        pg8::MoeGather GA{(const int*)(ws + WS_E2T), (const LAS int*)(C.lds + TAB_EOFF), 1, T};                                                          \
        pg8::gemm_phase<pg8::EpiSwiGLU, pg8::MoeOrder, true, true, pg8::MoeGather>(C.lds + RING_OFF, g, S, E, GA);                                      \
        GRID_BAR(); }                                                                                                                                    \
      { FRESH();                                                                                                                                         \
        const int np = __builtin_amdgcn_readfirstlane(*(LAS int*)(C.lds + TAB_NP));                                                                      \
        const int ntail = 2 * np > 2 * C.G ? 2 * np - 2 * C.G : 0; const int npa = np < C.G ? np : C.G;     \
        { pg8::Gemm g{(const bf16*)(XR_), (const bf16*)(ws + (WGU_)), np * 256, NEXP * 512, D};                                                 \
          pg8::MoeOrder S{(const LAS int*)(C.lds + TAB_PEXP), np, 1, C.G, bx, 2 * C.G, 0x7fffffff};                                                      \
          pg8::EpiSwiGLU E{(bf16*)(ws + WS_ACT), (const float*)(ws + WS_EW), (const float*)(ws + WS_ERS), (const LAS int*)(C.lds + TAB_EOFF), T};                                     \
          pg8::MoeGather GA{(const int*)(ws + WS_E2T), (const LAS int*)(C.lds + TAB_EOFF), 1, T};                                                        \
          pg8::gemm_phase<pg8::EpiSwiGLU, pg8::MoeOrder, true, true, pg8::MoeGather>(C.lds + RING_OFF, g, S, E, GA); }                                  \
        int kdn = DEXP; asm volatile("" : "+s"(kdn));                                                                                                    \
        pg8::Gemm gd{(const bf16*)(ws + WS_ACT), (const bf16*)(ws + (WDN_)), np * 256, NEXP * 1024, kdn};                                              \
        pg8::EpiBf16S Ed{(bf16*)(ws + WS_YS), D, 0, 0, 1.f, 3, 0, nullptr};                                                                               \
        { pg8::MoeOrder S{(const LAS int*)(C.lds + TAB_PEXP), npa, 2, C.G - ntail, bx - ntail, 0, 0x7fffffff};                                           \
          pg8::gemm_phase<pg8::EpiBf16S, pg8::MoeOrder, true, true>(C.lds + RING_OFF, gd, S, Ed); }                                                     \
        GRID_BAR();                                                                                                                                      \
        { pg8::MoeOrder S{(const LAS int*)(C.lds + TAB_PEXP), np, 2, C.G, bx, 4 * C.G, 0x7fffffff};                                                      \
          pg8::gemm_phase<pg8::EpiBf16S, pg8::MoeOrder, true, true>(C.lds + RING_OFF, gd, S, Ed); }                                                     \
        GRID_BAR(); } }                                                                                                                                  \
    if ((L) != 1 && PH(PBASE + 2)) { FRESH(); moe_tables(C, (L), ws);                                                                                               \
        const int np = __builtin_amdgcn_readfirstlane(*(LAS int*)(C.lds + TAB_NP));                                                                      \
        pg8::Gemm g{(const bf16*)(XR_), (const bf16*)(ws + (WGU_)), np * 256, NEXP * 512, D};                                                   \
        pg8::MoeOrder S{(const LAS int*)(C.lds + TAB_PEXP), np, 1, C.G, bx};                                                                             \
        pg8::EpiSwiGLU E{(bf16*)(ws + WS_ACT), (const float*)(ws + WS_EW), (const float*)(ws + WS_ERS), (const LAS int*)(C.lds + TAB_EOFF), T};                                       \
        pg8::MoeGather GA{(const int*)(ws + WS_E2T), (const LAS int*)(C.lds + TAB_EOFF), 1, T};                                                          \
        pg8::gemm_phase<pg8::EpiSwiGLU, pg8::MoeOrder, true, true, pg8::MoeGather>(C.lds + RING_OFF, g, S, E, GA);                                      \
        if (DUP(9)) pg8::gemm_phase<pg8::EpiSwiGLU, pg8::MoeOrder, true, true, pg8::MoeGather>(C.lds + RING_OFF, g, S, E, GA);                          \
        if ((L) == 0) {     \
            const int r9 = (2 * np) % C.G; const bool few = (C.G - r9) * 2 < C.G; const int k9 = (r9 == 0 || few) ? bx : bx - r9, n9 = (r9 == 0 || few) ? C.G : C.G - r9;  \
            if (k9 >= 0) { Ctx Cf = C; Cf.gw = k9 * NWAVES + C.wave; Cf.NGW = n9 * NWAVES;                                                                 \
                conv_moe_weights(Cf, moe_w_gu + (size_t)NEXP * D * 512, moe_w_down + (size_t)NEXP * DEXP * D, (bf16*)(ws + WS_WGU1), (bf16*)(ws + WS_WDN1), norm_ffn + D); } }  \
        GRID_BAR(); }                                                                                                                                    \
    if ((L) != 1 && PH(PBASE + 3)) { FRESH();                                                                                                            \
        const int np = __builtin_amdgcn_readfirstlane(*(LAS int*)(C.lds + TAB_NP));                                                                      \
        int kdn = DEXP; asm volatile("" : "+s"(kdn));                                                                                                    \
        pg8::Gemm g{(const bf16*)(ws + WS_ACT), (const bf16*)(ws + (WDN_)), np * 256, NEXP * 1024, kdn};                                               \
        pg8::MoeOrder S{(const LAS int*)(C.lds + TAB_PEXP), np, 2, C.G, bx};                                                                             \
        pg8::EpiBf16S E{(bf16*)(ws + WS_YS), D, 0, 0, 1.f, 3, 0, nullptr};                                                                                        \
        pg8::gemm_phase<pg8::EpiBf16S, pg8::MoeOrder, true, true>(C.lds + RING_OFF, g, S, E);                                                           \
        if (DUP(10)) pg8::gemm_phase<pg8::EpiBf16S, pg8::MoeOrder, true, true>(C.lds + RING_OFF, g, S, E);                                              \
        GRID_BAR(); }                                                                                                                                    \
    if (PH(PBASE + 4)) { FRESH(); if (DUP(11)) p11_combine<FINAL_, true>(C, (XR_), out, (GNEXT), ws); p11_combine<FINAL_, false>(C, (XR_), out, (GNEXT), ws); }

    MOE_LAYER(0, 7, false, norm_mix + D, WS_WGU0, WS_WDN0, XB)
    if (PH(11)) { GRID_BAR(); }
    if (PH(12)) { FRESH();
        pg8::Gemm g{XB, (const bf16*)(ws + WS_WDA_IN), T, 3072, D}; pg8::StaticOrder S; S.init(T, 3072, C.G, bx);
        pg8::EpiBf16S E{(bf16*)(ws + WS_AQ), 1024, 1024, (size_t)(WS_AK - WS_AQ) / 2, attn_body::C2, 0x7fffffff, 0, (const float*)(ws + WS_RSTD)};
        pg8::gemm_phase<pg8::EpiBf16S, pg8::StaticOrder, true, true>(C.lds + RING_OFF, g, S, E);
        if (DUP(12)) pg8::gemm_phase<pg8::EpiBf16S, pg8::StaticOrder, true, true>(C.lds + RING_OFF, g, S, E);
        GRID_BAR();
    }
    MFMA_SPIN(21)
    if (PH(13)) { FRESH();
        static_assert(attn_body::ATTN_LDS_BYTES <= RING_BYTES, "attention LDS");
        LAS float* gnl = (LAS float*)(C.lds + TAB_OFF + 2048);
        float s1 = 0.f, s2 = 0.f;
        for (int i = 0; i < 64; ++i) { s1 += da_lq1[i] * da_lk1[i]; s2 += da_lq2[i] * da_lk2[i]; }
        const float lam = __int_as_float(__builtin_amdgcn_readfirstlane(__float_as_int(__expf(s1) - __expf(s2) + LAMBDA_INIT1)));
        if (C.tid < 128) gnl[C.tid] = da_norm[C.tid] * (1.f - LAMBDA_INIT1);
        __syncthreads();
        const attn_body::AttnTensors AT{(const attn_body::bf16*)(ws + WS_AQ), (const attn_body::bf16*)(ws + WS_AK), (const attn_body::bf16*)(ws + WS_AV), (attn_body::bf16*)(ws + WS_AO), (attn_body::bf16*)(ws + WS_HN), lam, (const LAS float*)(C.lds + TAB_OFF + 2048)};
        const attn_body::StaticOrder S((int)C.G, bx);
        attn_body::attn_phase<attn_body::StaticOrder>((char*)lds + RING_OFF, AT, S);
        GRID_BAR();
        if (DUP(13)) { attn_body::attn_phase<attn_body::StaticOrder>((char*)lds + RING_OFF, AT, S); GRID_BAR(); }
    }
    if (PH(15)) { FRESH();
        pg8::Gemm g{HN, (const bf16*)(ws + WS_WDA_OUT), T, D, D}; pg8::StaticOrder S; S.init(T, D, C.G, bx);
        pg8::EpiResBf16<false> E{XB, XB2, D};
        pg8::gemm_phase<pg8::EpiResBf16<false>, pg8::StaticOrder, true, true>(C.lds + RING_OFF, g, S, E);
        GRID_BAR();
    }
    if (DUP(20)) { for (int rep_ = 0; rep_ < 20; ++rep_) GRID_BAR(); }
    MOE_LAYER(1, 16, true, final_norm, WS_WGU1, WS_WDN1, XB2)
#if MK_PHASE_HI < 20
    { if (MK_PHASE_HI == 11 || MK_PHASE_HI < 1) { } GRID_BAR(); FRESH();
      const float* src = MK_PHASE_HI >= 6 ? out : xin;
      f32x4 gn[4];
#pragma unroll
      for (int j = 0; j < 4; ++j) gn[j] = *(const f32x4*)(final_norm + 4 * C.lane + 256 * j);
      for (int t = C.gw; t < T; t += C.NGW) { const GAS f32x4* xr = (const GAS f32x4*)(src + (size_t)t * D) + C.lane; GAS f32x4* orow = (GAS f32x4*)(out + (size_t)t * D) + C.lane;
          f32x4 v[4]; float ss = 0.f;
#pragma unroll
          for (int j = 0; j < 4; ++j) { v[j] = xr[64 * j]; ss += (v[j].x * v[j].x + v[j].y * v[j].y) + (v[j].z * v[j].z + v[j].w * v[j].w); }
          const float rstd = rsqrtf(wave_sum(ss) * (1.f / D) + 1e-6f);
#pragma unroll
          for (int j = 0; j < 4; ++j) orow[64 * j] = v[j] * rstd * gn[j]; } }
#endif
}

#undef xin
#undef norm_mix
#undef norm_ffn
#undef ml_w_in
#undef ml_conv
#undef ml_b_i
#undef ml_b_f
#undef ml_norm
#undef ml_w_out
#undef da_w_in
#undef da_lq1
#undef da_lk1
#undef da_lq2
#undef da_lk2
#undef da_norm
#undef da_w_out
#undef moe_w_group
#undef moe_b_group
#undef moe_w_expert
#undef moe_b_expert
#undef moe_w_gu
#undef moe_w_down
#undef final_norm
#undef hn0
#undef Qm
#undef Km
#undef HN
#undef XB
#undef XB2
extern "C" void kernel_launch(void* const* d_in, const int* in_sizes, int n_in, void* d_out, int out_size, void* d_ws, size_t ws_size, hipStream_t stream) {
    static int grid = 0;
    if (grid == 0) {
        if (n_in != 23 || out_size != T * D || ws_size < (size_t)512 * MiB) { fprintf(stderr, "kernel_launch: unexpected shapes (n_in %d out %d ws %zu)\n", n_in, out_size, ws_size); grid = -1; return; }
        int dev = 0, cus = 0, per_cu = 0;
        if (hipGetDevice(&dev) != hipSuccess || hipDeviceGetAttribute(&cus, hipDeviceAttributeMultiprocessorCount, dev) != hipSuccess) { grid = -1; return; }
        if (hipFuncSetAttribute((const void*)mk_fwd, hipFuncAttributeMaxDynamicSharedMemorySize, LDS_BYTES) != hipSuccess) { fprintf(stderr, "kernel_launch: hipFuncSetAttribute failed\n"); grid = -1; return; }
        if (hipOccupancyMaxActiveBlocksPerMultiprocessor(&per_cu, (const void*)mk_fwd, NWAVES * 64, LDS_BYTES) != hipSuccess || per_cu < 1) { fprintf(stderr, "kernel_launch: occupancy query says %d\n", per_cu); }
        (void)hipGetLastError();
        grid = cus;
    }
    if (grid < 0) return;
    if (hipMemsetAsync((char*)d_ws + WS_CTL, 0, CTL_ZERO_BYTES, stream) != hipSuccess) return;
    Args a{};
    for (int i = 0; i < 23; ++i) a.in[i] = (const float*)d_in[i];
    a.out = (float*)d_out; a.ws = (unsigned char*)d_ws;
    hipLaunchKernelGGL(mk_fwd, dim3(grid), dim3(NWAVES * 64), LDS_BYTES, stream, a);
}
```

```cpp
#include <hip/hip_runtime.h>
#include <hip/hip_bf16.h>
#include <cstdio>
#include <cstdint>
#include <cmath>
#define MK_P2_PROBE 0
namespace pg8 {
#define PG8_LAS __attribute__((address_space(3)))
typedef unsigned short bf16_t;
typedef short bf16x8 __attribute__((ext_vector_type(8)));
typedef float f32x4 __attribute__((ext_vector_type(4)));
typedef unsigned u32x4 __attribute__((ext_vector_type(4)));
constexpr int BM = 256, BK = 64, HALF = 128, HTB = HALF * BK * 2  , STAGE_BYTES = 8 * HTB, NXCD = 8, WGM = 8;

__host__ __device__ __forceinline__ int lds_byte(int r, int c) { const int st = (r >> 4) * 2 + (c >> 5), rr = r & 15, cc = c & 31, ob = rr * 64 + cc * 2; return st * 1024 + (ob ^ (((ob >> 9) & 1) << 5)); }
__host__ __device__ __forceinline__ void stage_rc(int b, int& R, int& C) { const int st = b / 1024, sb = b % 1024, swz = sb ^ (((sb >> 9) & 1) << 5); R = (st >> 1) * 16 + swz / 64; C = (st & 1) * 32 + (swz % 64) / 2; }
__host__ __device__ __forceinline__ int perm32(int rho) { const int n = rho >> 4, i = rho & 15; return 8 * (i >> 2) + 4 * n + (i & 3); }

struct Unit { int pm, pn; };
struct Gemm { const bf16_t* A; const bf16_t* Bt; int M, N, K; };

struct StaticOrder {
    int nM, nN, nwg, G, c;
    __host__ __device__ void init(int M, int N, int G_, int c_) { nM = M / BM; nN = N / BM; nwg = nM * nN; G = G_; c = c_; }
    __host__ __device__ bool next(int i, Unit& u) const {
        const long L = (long)i * G + c; if (L >= nwg) return false;
        int wgid = (int)L; { const int q = nwg / NXCD, r = nwg % NXCD, xcd = wgid % NXCD, off = wgid / NXCD; wgid = (xcd < r ? xcd * (q + 1) : r * (q + 1) + (xcd - r) * q) + off; }
        const int nig = WGM * nN, gid = wgid / nig, fm = gid * WGM, gsz = (nM - fm) < WGM ? (nM - fm) : WGM;
        u.pm = fm + ((wgid % nig) % gsz); u.pn = (wgid % nig) / gsz; return true;
    }
    __device__ __forceinline__ void a_ready(const Unit&) const {}
    __device__ __forceinline__ void done(const Unit&) const {}
};

__device__ __forceinline__ unsigned cvt_pk_bf16(float lo, float hi) { unsigned r; asm volatile("v_cvt_pk_bf16_f32 %0, %1, %2" : "=v"(r) : "v"(lo), "v"(hi)); return r; }

struct EpiBf16S {
    static constexpr bool PERM = true, AFTER_DRAIN = false;
    bf16_t* O; int ldc; int split_cols; size_t split_stride; float scale0; int pn_mask; int row_skew; const float* rowscale; int dry = 0;
    __device__ __forceinline__ void operator()(const f32x4 (&acc)[2][2][4][2], const Unit& u, int wr, int wc, int fr, int fq) const {
        const int row0 = u.pm * BM + wr * 64 + fr + (u.pm >> 1) * row_skew; int colt = (u.pn & pn_mask) * BM; bf16_t* base = O;
        float sc = 1.f; if (split_cols) { const int t = colt / split_cols; base += (size_t)t * split_stride; colt -= t * split_cols; if (t == 0) sc = scale0; }
        const int col0 = colt + wc * 32 + 8 * fq;
#pragma unroll
        for (int ai = 0; ai < 2; ++ai)
#pragma unroll
            for (int m = 0; m < 4; ++m) { bf16_t* rowp = base + (size_t)(row0 + ai * HALF + m * 16) * ldc + col0; const float sr = rowscale ? sc * rowscale[u.pm * BM + wr * 64 + fr + ai * HALF + m * 16] : sc;
#pragma unroll
                for (int bj = 0; bj < 2; ++bj) { f32x4 v0 = acc[ai][bj][m][0] * sr, v1 = acc[ai][bj][m][1] * sr;
                    u32x4 w; w.x = cvt_pk_bf16(v0[0], v0[1]); w.y = cvt_pk_bf16(v0[2], v0[3]); w.z = cvt_pk_bf16(v1[0], v1[1]); w.w = cvt_pk_bf16(v1[2], v1[3]);
                    if (!dry) *(u32x4*)(rowp + bj * HALF) = w; } }
    }
};
struct EpiQKO {
    static constexpr bool PERM = true, AFTER_DRAIN = false;
    bf16_t* QK; unsigned char* OG8;
    __device__ __forceinline__ void operator()(const f32x4 (&acc)[2][2][4][2], const Unit& u, int wr, int wc, int fr, int fq) const {
        const int row0 = u.pm * BM + wr * 64 + fr; const bool gate = u.pn >= 8; const int col0 = (u.pn & 7) * BM + wc * 32 + 8 * fq;
#pragma unroll
        for (int ai = 0; ai < 2; ++ai)
#pragma unroll
            for (int m = 0; m < 4; ++m) { const size_t ro = (size_t)(row0 + ai * HALF + m * 16) * 2048 + col0;
#pragma unroll
                for (int bj = 0; bj < 2; ++bj) { const f32x4 v0 = acc[ai][bj][m][0], v1 = acc[ai][bj][m][1];
                    if (!gate) { u32x4 w; w.x = cvt_pk_bf16(v0[0], v0[1]); w.y = cvt_pk_bf16(v0[2], v0[3]); w.z = cvt_pk_bf16(v1[0], v1[1]); w.w = cvt_pk_bf16(v1[2], v1[3]);
                        *(u32x4*)(QK + ro + bj * HALF) = w; }
                    else { unsigned b[8];
#pragma unroll
                        for (int e = 0; e < 4; ++e) { b[e] = (unsigned)(255.f * __builtin_amdgcn_rcpf(1.f + __builtin_amdgcn_exp2f(-1.4426950408889634f * v0[e])) + 0.5f);
                                                      b[4 + e] = (unsigned)(255.f * __builtin_amdgcn_rcpf(1.f + __builtin_amdgcn_exp2f(-1.4426950408889634f * v1[e])) + 0.5f); }
                        typedef unsigned u32x2_t __attribute__((ext_vector_type(2)));
                        *(u32x2_t*)(OG8 + ro + bj * HALF) = (u32x2_t){b[0] | (b[1] << 8) | (b[2] << 16) | (b[3] << 24), b[4] | (b[5] << 8) | (b[6] << 16) | (b[7] << 24)}; } } }
    }
};
struct EpiResF32 {
    static constexpr bool PERM = false, AFTER_DRAIN = false;
    const float* res; float* out; int ldc;
    __device__ __forceinline__ void operator()(const f32x4 (&acc)[2][2][4][2], const Unit& u, int wr, int wc, int fr, int fq) const {
        const int row0 = u.pm * BM + wr * 64 + fr, col0 = u.pn * BM + wc * 32 + 4 * fq;
        f32x4 rb[2][2][2][2];
#define PG8_RLOAD(buf, ai, mp) do { _Pragma("unroll") for (int mm = 0; mm < 2; ++mm) { const size_t off_ = (size_t)(row0 + (ai) * HALF + (2 * (mp) + mm) * 16) * ldc + col0; \
            _Pragma("unroll") for (int bj = 0; bj < 2; ++bj) _Pragma("unroll") for (int n = 0; n < 2; ++n) rb[buf][mm][bj][n] = *(const f32x4*)(res + off_ + bj * HALF + n * 16); } } while (0)
        PG8_RLOAD(0, 0, 0);
#pragma unroll
        for (int grp = 0; grp < 4; ++grp) {
            const int ai = grp >> 1, mp = grp & 1;
            if (grp + 1 < 4) { if (((grp + 1) & 1) == 0) PG8_RLOAD(0, (grp + 1) >> 1, (grp + 1) & 1); else PG8_RLOAD(1, (grp + 1) >> 1, (grp + 1) & 1); }
            __builtin_amdgcn_sched_barrier(0);
#pragma unroll
            for (int mm = 0; mm < 2; ++mm) { const int m = 2 * mp + mm; const size_t off = (size_t)(row0 + ai * HALF + m * 16) * ldc + col0;
#pragma unroll
                for (int bj = 0; bj < 2; ++bj)
#pragma unroll
                    for (int n = 0; n < 2; ++n) *(f32x4*)(out + off + bj * HALF + n * 16) = rb[grp & 1][mm][bj][n] + acc[ai][bj][m][n]; }
            __builtin_amdgcn_sched_barrier(0);
        }
#undef PG8_RLOAD
    }
};
template <bool RES_F32> struct EpiResBf16 {
    static constexpr bool PERM = true, AFTER_DRAIN = false;
    const void* res; bf16_t* out; int ldc;
    __device__ __forceinline__ void operator()(const f32x4 (&acc)[2][2][4][2], const Unit& u, int wr, int wc, int fr, int fq) const {
        const int row0 = u.pm * BM + wr * 64 + fr, col0 = u.pn * BM + wc * 32 + 8 * fq;
        f32x4 rb[2][2][2][2];
#define PG8_RLOAD(buf, ai, mp) do { _Pragma("unroll") for (int mm = 0; mm < 2; ++mm) { const size_t off_ = (size_t)(row0 + (ai) * HALF + (2 * (mp) + mm) * 16) * ldc + col0; \
            _Pragma("unroll") for (int bj = 0; bj < 2; ++bj) { if (RES_F32) { rb[buf][mm][bj][0] = *(const f32x4*)((const float*)res + off_ + bj * HALF); rb[buf][mm][bj][1] = *(const f32x4*)((const float*)res + off_ + bj * HALF + 4); } \
                else { const u32x4 w_ = *(const u32x4*)((const bf16_t*)res + off_ + bj * HALF); \
                    rb[buf][mm][bj][0] = (f32x4){__builtin_bit_cast(float, w_.x << 16), __builtin_bit_cast(float, w_.x & 0xffff0000u), __builtin_bit_cast(float, w_.y << 16), __builtin_bit_cast(float, w_.y & 0xffff0000u)}; \
                    rb[buf][mm][bj][1] = (f32x4){__builtin_bit_cast(float, w_.z << 16), __builtin_bit_cast(float, w_.z & 0xffff0000u), __builtin_bit_cast(float, w_.w << 16), __builtin_bit_cast(float, w_.w & 0xffff0000u)}; } } } } while (0)
        PG8_RLOAD(0, 0, 0);
#pragma unroll
        for (int grp = 0; grp < 4; ++grp) {
            const int ai = grp >> 1, mp = grp & 1;
            if (grp + 1 < 4) { if (((grp + 1) & 1) == 0) PG8_RLOAD(0, (grp + 1) >> 1, (grp + 1) & 1); else PG8_RLOAD(1, (grp + 1) >> 1, (grp + 1) & 1); }
            __builtin_amdgcn_sched_barrier(0);
#pragma unroll
            for (int mm = 0; mm < 2; ++mm) { const int m = 2 * mp + mm; const size_t off = (size_t)(row0 + ai * HALF + m * 16) * ldc + col0;
#pragma unroll
                for (int bj = 0; bj < 2; ++bj) { const f32x4 v0 = rb[grp & 1][mm][bj][0] + acc[ai][bj][m][0], v1 = rb[grp & 1][mm][bj][1] + acc[ai][bj][m][1];
                    u32x4 w; w.x = cvt_pk_bf16(v0[0], v0[1]); w.y = cvt_pk_bf16(v0[2], v0[3]); w.z = cvt_pk_bf16(v1[0], v1[1]); w.w = cvt_pk_bf16(v1[2], v1[3]);
                    *(u32x4*)(out + off + bj * HALF) = w; } }
            __builtin_amdgcn_sched_barrier(0);
        }
#undef PG8_RLOAD
    }
};
struct EpiSwiGLU {
    static constexpr bool PERM = true, AFTER_DRAIN = false;
    bf16_t* O; const float* ew; const float* ers; const PG8_LAS int* eoff; int ldw;
    __device__ __forceinline__ void operator()(const f32x4 (&acc)[2][2][4][2], const Unit& u, int wr, int wc, int fr, int fq) const {
        const int row0 = u.pm * BM + wr * 64 + fr, col0 = (u.pn & 1) * 128 + wc * 32 + 8 * fq; const int e = u.pn >> 1;
        const float* roww = ew + (size_t)e * ldw - eoff[e]; const float* rowr = ers + (size_t)e * ldw - eoff[e];
        float gws[2][4], grs[2][4];
#pragma unroll
        for (int ai = 0; ai < 2; ++ai)
#pragma unroll
            for (int m = 0; m < 4; ++m) { gws[ai][m] = roww[row0 + ai * HALF + m * 16]; grs[ai][m] = rowr[row0 + ai * HALF + m * 16]; }
#pragma unroll
        for (int ai = 0; ai < 2; ++ai)
#pragma unroll
            for (int m = 0; m < 4; ++m) { const int row = row0 + ai * HALF + m * 16; const float gw = gws[ai][m], gr = grs[ai][m]; float a[8];
#pragma unroll
                for (int n = 0; n < 2; ++n)
#pragma unroll
                    for (int e4 = 0; e4 < 4; ++e4) { const float g = acc[ai][0][m][n][e4] * gr, up = acc[ai][1][m][n][e4] * gr;
                        const float sg = g * __builtin_amdgcn_rcpf(1.f + __builtin_amdgcn_exp2f(-1.4426950408889634f * g)); a[n * 4 + e4] = sg * up * gw; }
                u32x4 w; w.x = cvt_pk_bf16(a[0], a[1]); w.y = cvt_pk_bf16(a[2], a[3]); w.z = cvt_pk_bf16(a[4], a[5]); w.w = cvt_pk_bf16(a[6], a[7]);
                *(u32x4*)(O + (size_t)row * 256 + col0) = w; }
    }
};
struct MoeGather {
    static constexpr bool ON = true;
    const int* e2t; const PG8_LAS int* eoff; int shift, ld;
    __device__ __forceinline__ unsigned row(const Unit& u, int r) const { const int e = u.pn >> shift; const unsigned t = (unsigned)e2t[(size_t)e * ld + (u.pm * BM + r - eoff[e])]; return t < (unsigned)ld ? t : (unsigned)(ld - 1); }
};
struct MoeOrder {
    const PG8_LAS int* pexp; int np, shift, G, c; int lo = 0, hi = 0x7fffffff;
    __device__ __forceinline__ bool next(int i, Unit& u) const {
        const int L = lo + i * G + c; if (c < 0 || L >= hi || L >= (np << shift)) return false;
        const int p = L >> shift; const int e = __builtin_amdgcn_readfirstlane(pexp[p]);
        u.pm = p; u.pn = (e << shift) + (L & ((1 << shift) - 1)); return true;
    }
    __device__ __forceinline__ void a_ready(const Unit&) const {}
    __device__ __forceinline__ void done(const Unit&) const {}
};
struct NoGather { static constexpr bool ON = false; __device__ __forceinline__ unsigned row(const Unit&, int) const { return 0u; } };
template <class Epi, class Sched, bool ALIGN_EPI = false, bool SP2 = false, class AG = NoGather, bool NOLOAD = false, int NOLDS = 0>
__device__ __forceinline__ void gemm_phase(PG8_LAS unsigned char* lds, const Gemm g, const Sched& S, const Epi& E, const AG& GA = AG()) {
    static_assert(!AG::ON || SP2, "row gather is wired into the SP2 loop only");
    int tid_ = threadIdx.x; asm volatile("" : "+v"(tid_)); const int tid = tid_, wid = __builtin_amdgcn_readfirstlane(tid >> 6), lane = tid & 63, wr = wid >> 2, wc = wid & 3, fr = lane & 15, fq = lane >> 4;
    const int K = g.K, nt = K / BK;
    unsigned voffA[2], voffB[2]; int aR[2], aC[2];
#pragma unroll
    for (int i = 0; i < 2; ++i) { int R, C; stage_rc(tid * 16 + i * 8192, R, C); const int Rb = Epi::PERM ? ((R & ~31) + perm32(R & 31)) : R; aR[i] = R; aC[i] = C;
        voffA[i] = (unsigned)(R * K + C) * 2u; voffB[i] = (unsigned)(Rb * K + C) * 2u; }
    unsigned gcur0[2], gcur1[2], gnxt0[2], gnxt1[2];
#define PG8_GOFF(u, d0, d1) do { _Pragma("unroll") for (int _i = 0; _i < 2; ++_i) { d0[_i] = (GA.row(u, aR[_i]) * (unsigned)K + (unsigned)aC[_i]) * 2u; d1[_i] = (GA.row(u, HALF + aR[_i]) * (unsigned)K + (unsigned)aC[_i]) * 2u; } } while (0)
    const size_t kstep = (size_t)(BK * 2);
    const size_t hstep = (size_t)HALF * K * 2;
    const size_t tstep = 2 * hstep;
    const unsigned ldsw = (unsigned)wid * 1024u;
    const int aoff = lds_byte(wr * 64 + fr, fq * 8), boff = lds_byte(wc * 32 + fr, fq * 8);
#define PG8_SA(b, h) (((b) * 2 + (h)) * HTB)
#define PG8_SB(b, h) ((4 + (b) * 2 + (h)) * HTB)
#define PG8_STAGE(bufoff, gbase, voff) do { if (!NOLOAD) _Pragma("unroll") for (int _i = 0; _i < 2; ++_i) \
        __builtin_amdgcn_global_load_lds((const unsigned*)((const char*)(gbase) + (voff)[_i]), (PG8_LAS unsigned*)(lds + (bufoff) + ldsw + _i * 8192), 16, 0, 0); } while (0)
#define PG8_LDA(dst, b, h) do { if (!(NOLDS & 1)) _Pragma("unroll") for (int m = 0; m < 4; ++m) _Pragma("unroll") for (int k = 0; k < 2; ++k) dst[m][k] = *(const PG8_LAS bf16x8*)(lds + PG8_SA(b, h) + aoff + m * 2048 + k * 1024); } while (0)
#define PG8_LDB(dst, b, h) do { if (!(NOLDS & 2)) _Pragma("unroll") for (int n = 0; n < 2; ++n) _Pragma("unroll") for (int k = 0; k < 2; ++k) dst[n][k] = *(const PG8_LAS bf16x8*)(lds + PG8_SB(b, h) + boff + n * 2048 + k * 1024); } while (0)
#define PG8_MMA(ai, bj, At, Bt) do { __builtin_amdgcn_s_setprio(1); _Pragma("unroll") for (int m = 0; m < 4; ++m) _Pragma("unroll") for (int n = 0; n < 2; ++n) _Pragma("unroll") for (int k = 0; k < 2; ++k) \
        acc[ai][bj][m][n] = __builtin_amdgcn_mfma_f32_16x16x32_bf16(Bt[n][k], At[m][k], acc[ai][bj][m][n], 0, 0, 0); __builtin_amdgcn_s_setprio(0); } while (0)
#define PG8_WAIT_V(n) asm volatile("s_waitcnt vmcnt(" #n ")" ::: "memory")
#define PG8_WAIT_L(n) asm volatile("s_waitcnt lgkmcnt(" #n ")" ::: "memory")
#define PG8_BAR do { if (!(NOLDS & 4)) __builtin_amdgcn_s_barrier(); } while (0)
#define PG8_SCHED __builtin_amdgcn_sched_barrier(0)
    Unit cur, nxt; int ui = 0;
    if (!S.next(0, cur)) return;
    f32x4 acc[2][2][4][2];
#pragma unroll
    for (int a = 0; a < 2; ++a)
#pragma unroll
        for (int b = 0; b < 2; ++b)
#pragma unroll
            for (int m = 0; m < 4; ++m)
#pragma unroll
                for (int n = 0; n < 2; ++n) acc[a][b][m][n] = (f32x4){0.f, 0.f, 0.f, 0.f};
    bf16x8 At[4][2], B0[2][2], B1[2][2];
    if (NOLDS) { _Pragma("unroll") for (int m = 0; m < 4; ++m) _Pragma("unroll") for (int k = 0; k < 2; ++k) { At[m][k] = (bf16x8){0, 0, 0, 0, 0, 0, 0, 0}; asm volatile("" : "+v"(At[m][k])); }
        _Pragma("unroll") for (int n = 0; n < 2; ++n) _Pragma("unroll") for (int k = 0; k < 2; ++k) { B0[n][k] = (bf16x8){0, 0, 0, 0, 0, 0, 0, 0}; asm volatile("" : "+v"(B0[n][k])); B1[n][k] = B0[n][k]; asm volatile("" : "+v"(B1[n][k])); } }
    const char* cA = (const char*)g.A + (AG::ON ? (size_t)0 : (size_t)cur.pm * tstep); const char* cB = (const char*)g.Bt + (size_t)cur.pn * tstep;
    if constexpr (AG::ON) { PG8_GOFF(cur, gcur0, gcur1); gnxt0[0] = gcur0[0]; gnxt0[1] = gcur0[1]; gnxt1[0] = gcur1[0]; gnxt1[1] = gcur1[1]; }
#define PG8_STAGE_A(bufoff, base, half, G0, G1) do { if constexpr (AG::ON) { if ((half) == 0) PG8_STAGE(bufoff, base, G0); else PG8_STAGE(bufoff, base, G1); } else { PG8_STAGE(bufoff, (base) + (half) * hstep, voffA); } } while (0)
    S.a_ready(cur);
    if constexpr (SP2) {
        PG8_STAGE(PG8_SB(0, 0), cB, voffB); PG8_STAGE(PG8_SB(0, 1), cB + hstep, voffB); PG8_STAGE_A(PG8_SA(0, 0), cA, 0, gcur0, gcur1); PG8_STAGE_A(PG8_SA(0, 1), cA, 1, gcur0, gcur1);
        if (wr == 1) PG8_BAR;
        PG8_WAIT_V(2); PG8_BAR;
        PG8_STAGE(PG8_SB(1, 0), cB + kstep, voffB); PG8_STAGE_A(PG8_SA(1, 0), cA + kstep, 0, gcur0, gcur1); PG8_STAGE(PG8_SB(1, 1), cB + hstep + kstep, voffB);
        PG8_WAIT_V(6); PG8_BAR;
    } else {
        PG8_STAGE(PG8_SB(0, 0), cB, voffB); PG8_STAGE(PG8_SA(0, 0), cA, voffA); PG8_STAGE(PG8_SB(0, 1), cB + hstep, voffB); PG8_STAGE(PG8_SA(0, 1), cA + hstep, voffA);
        if (wr == 1) PG8_BAR;
        PG8_WAIT_V(4); PG8_BAR;
        PG8_STAGE(PG8_SB(1, 0), cB + kstep, voffB); PG8_STAGE(PG8_SA(1, 0), cA + kstep, voffA); PG8_STAGE(PG8_SB(1, 1), cB + hstep + kstep, voffB);
        PG8_WAIT_V(6); PG8_BAR;
    }
    for (;;) {
        const bool has_next = S.next(ui + 1, nxt);
        if constexpr (AG::ON) { if (has_next) PG8_GOFF(nxt, gnxt0, gnxt1); }
        const char* nA = (has_next && !AG::ON) ? (const char*)g.A + (size_t)nxt.pm * tstep : cA; const char* nB = has_next ? (const char*)g.Bt + (size_t)nxt.pn * tstep : cB;
        for (int t = 0; t < nt; t += 2) {
            const bool last = (t == nt - 2);
            const char* a1 = cA + (size_t)(t + 1) * kstep;
            const char* a2 = last ? nA : cA + (size_t)(t + 2) * kstep; const char* b2 = last ? nB : cB + (size_t)(t + 2) * kstep;
            const char* a3 = a2 + kstep; const char* b3 = b2 + kstep;
            if (last && has_next) S.a_ready(nxt);
            if constexpr (SP2) {
            unsigned g20[2], g21[2];
            if constexpr (AG::ON) { g20[0] = last ? gnxt0[0] : gcur0[0]; g20[1] = last ? gnxt0[1] : gcur0[1]; g21[0] = last ? gnxt1[0] : gcur1[0]; g21[1] = last ? gnxt1[1] : gcur1[1]; }
            PG8_LDB(B0, 0, 0); PG8_LDB(B1, 0, 1); PG8_SCHED; PG8_LDA(At, 0, 0); PG8_STAGE_A(PG8_SA(1, 1), a1, 1, gcur0, gcur1);
            PG8_WAIT_V(8); PG8_WAIT_L(0); PG8_BAR; PG8_MMA(0, 0, At, B0); PG8_MMA(0, 1, At, B1); PG8_BAR; PG8_SCHED;
            PG8_LDA(At, 0, 1); PG8_STAGE(PG8_SB(0, 0), b2, voffB); PG8_STAGE(PG8_SB(0, 1), b2 + hstep, voffB); PG8_STAGE_A(PG8_SA(0, 0), a2, 0, g20, g21);
            PG8_WAIT_V(8); PG8_WAIT_L(0); PG8_BAR; PG8_MMA(1, 0, At, B0); PG8_MMA(1, 1, At, B1); PG8_BAR; PG8_SCHED;
            PG8_LDB(B0, 1, 0); PG8_LDB(B1, 1, 1); PG8_SCHED; PG8_LDA(At, 1, 0); PG8_STAGE_A(PG8_SA(0, 1), a2, 1, g20, g21);
            PG8_WAIT_V(8); PG8_WAIT_L(0); PG8_BAR; PG8_MMA(0, 0, At, B0); PG8_MMA(0, 1, At, B1); PG8_BAR; PG8_SCHED;
            PG8_LDA(At, 1, 1); PG8_STAGE(PG8_SB(1, 0), b3, voffB); PG8_STAGE(PG8_SB(1, 1), b3 + hstep, voffB); PG8_STAGE_A(PG8_SA(1, 0), a3, 0, g20, g21);
            PG8_WAIT_V(8); PG8_WAIT_L(0); PG8_BAR; PG8_MMA(1, 0, At, B0); PG8_MMA(1, 1, At, B1); PG8_BAR; PG8_SCHED;
            } else {
            PG8_LDB(B0, 0, 0); PG8_SCHED; PG8_LDA(At, 0, 0); PG8_STAGE(PG8_SA(1, 1), a1 + hstep, voffA);
            PG8_WAIT_L(8); PG8_BAR; PG8_WAIT_L(0); PG8_MMA(0, 0, At, B0); PG8_BAR; PG8_SCHED;
            PG8_LDB(B1, 0, 1); PG8_STAGE(PG8_SB(0, 0), b2, voffB);
            PG8_BAR; PG8_WAIT_L(0); PG8_MMA(0, 1, At, B1); PG8_BAR;
            PG8_LDA(At, 0, 1); PG8_STAGE(PG8_SA(0, 0), a2, voffA);
            PG8_BAR; PG8_WAIT_L(0); PG8_MMA(1, 0, At, B0); PG8_BAR; PG8_SCHED;
            PG8_STAGE(PG8_SB(0, 1), b2 + hstep, voffB);
            PG8_WAIT_V(6); PG8_BAR; PG8_MMA(1, 1, At, B1); PG8_BAR;
            PG8_LDB(B0, 1, 0); PG8_SCHED; PG8_LDA(At, 1, 0); PG8_STAGE(PG8_SA(0, 1), a2 + hstep, voffA);
            PG8_WAIT_L(8); PG8_BAR; PG8_WAIT_L(0); PG8_MMA(0, 0, At, B0); PG8_BAR; PG8_SCHED;
            PG8_LDB(B1, 1, 1); PG8_STAGE(PG8_SB(1, 0), b3, voffB);
            PG8_BAR; PG8_WAIT_L(0); PG8_MMA(0, 1, At, B1); PG8_BAR;
            PG8_LDA(At, 1, 1); PG8_STAGE(PG8_SA(1, 0), a3, voffA);
            PG8_BAR; PG8_WAIT_L(0); PG8_MMA(1, 0, At, B0); PG8_BAR; PG8_SCHED;
            PG8_STAGE(PG8_SB(1, 1), b3 + hstep, voffB);
            PG8_WAIT_V(6); PG8_BAR; PG8_MMA(1, 1, At, B1); PG8_BAR;
            }
        }
        if constexpr (ALIGN_EPI) { if (wr == 0) PG8_BAR; }
        if constexpr (!Epi::AFTER_DRAIN) { E(acc, cur, wr, wc, fr, fq); S.done(cur); }
        if (!has_next) break;
#pragma unroll
        for (int a = 0; a < 2; ++a)
#pragma unroll
            for (int b = 0; b < 2; ++b)
#pragma unroll
                for (int m = 0; m < 4; ++m)
#pragma unroll
                    for (int n = 0; n < 2; ++n) acc[a][b][m][n] = (f32x4){0.f, 0.f, 0.f, 0.f};
        cur = nxt; cA = nA; cB = nB; ++ui;
        if constexpr (AG::ON) { gcur0[0] = gnxt0[0]; gcur0[1] = gnxt0[1]; gcur1[0] = gnxt1[0]; gcur1[1] = gnxt1[1]; }
        if constexpr (ALIGN_EPI) { if (wr == 1) PG8_BAR; }
    }
    PG8_WAIT_V(0);
    if constexpr (!ALIGN_EPI) { if (wr == 0) PG8_BAR; }
    PG8_BAR;
    if constexpr (Epi::AFTER_DRAIN) { E.fused(acc, cur, wr, wc, fr, fq, lds, wid, lane); S.done(cur); }
#undef PG8_SA
#undef PG8_SB
#undef PG8_STAGE
#undef PG8_STAGE_A
#undef PG8_GOFF
#undef PG8_LDA
#undef PG8_LDB
#undef PG8_MMA
#undef PG8_WAIT_V
#undef PG8_WAIT_L
#undef PG8_BAR
#undef PG8_SCHED
}
}

#include <hip/hip_bf16.h>
#include <cmath>
namespace attn_body {
using bf16=__hip_bfloat16;
using bf16x8=__attribute__((ext_vector_type(8)))short;
using s16x4=__attribute__((ext_vector_type(4)))short;
using f32x16=__attribute__((ext_vector_type(16)))float;
using u32x4=__attribute__((ext_vector_type(4)))unsigned;
constexpr int BATCH=4,NVH=32,SEQ=8192,D=64,PQ=1024,PO=1024;
constexpr int NW=8,QBLK=32,QB=QBLK*NW,KVBLK=64,NQB=SEQ/QB;
constexpr int ATTN_UNIT_ROWS=QB;
__device__ __forceinline__ int crow(int r,int hi){return (r&3)+8*(r>>2)+4*hi;}
#define SBAR() __builtin_amdgcn_sched_barrier(0)
__device__ __forceinline__ void cmask(f32x16&p0,f32x16&p1,int jb,int qrel,int hi){
  const float NEG=-INFINITY; int kb=64*jb+4*hi;
  #pragma unroll
  for(int r=0;r<16;++r){int kv=kb+(r&3)+8*(r>>2); if(kv>qrel)p0[r]=NEG; if(kv+32>qrel)p1[r]=NEG;}
}

constexpr int NSLOT=3, SLOTB=8192;
constexpr int LDS_K=0, LDS_V=NSLOT*SLOTB, LDS_WS=3*NSLOT*SLOTB, LDS_OST=LDS_WS+NW*64*4, LDS_BYTES=LDS_OST+NW*4096;
constexpr float C2=0.125f*1.4426950408889634f;
__device__ __forceinline__ void glds16(const void*gsrc,unsigned lds_dst){unsigned keep;
  asm volatile("s_mov_b32 %0, m0\n\ts_mov_b32 m0, %2\n\ts_nop 0\n\tglobal_load_lds_dwordx4 %1, off\n\ts_mov_b32 m0, %0":"=&s"(keep):"v"(gsrc),"s"(lds_dst):"memory");}
__device__ __forceinline__ float max3f(float a,float b,float c){float r;asm("v_max3_f32 %0, %1, %2, %3":"=v"(r):"v"(a),"v"(b),"v"(c));return r;}
__device__ __forceinline__ float max2f(float a,float b){float r;asm("v_max_f32_e32 %0, %1, %2":"=v"(r):"v"(a),"v"(b));return r;}
__device__ __forceinline__ float fadd_s(float a,float b){float r;asm("v_add_f32_e32 %0, %1, %2":"=v"(r):"v"(a),"v"(b));return r;}
__device__ __forceinline__ float fsub_s(float a,float b){float r;asm("v_sub_f32_e32 %0, %1, %2":"=v"(r):"v"(a),"v"(b));return r;}
typedef float f32x2_t __attribute__((ext_vector_type(2))); typedef __bf16 bf16x2_t __attribute__((ext_vector_type(2)));
__device__ __forceinline__ unsigned cvtpk_s(float lo,float hi){f32x2_t v={lo,hi};bf16x2_t b=__builtin_convertvector(v,bf16x2_t);return __builtin_bit_cast(unsigned,b);}
#define WAIT_BAR(N) asm volatile("s_waitcnt vmcnt(" #N ") lgkmcnt(0)\n\ts_barrier":::"memory")

__device__ __forceinline__ void qkt(f32x16&p0,f32x16&p1,const char*Kslot,const bf16x8*qr,const f32x16&negm,int r32,int hi){
  const char*kb=Kslot+hi*1024+r32*16;
  #pragma unroll
  for(int d0=0;d0<4;++d0){
    const bf16x8 b0=*reinterpret_cast<const bf16x8*>(kb+d0*2048);
    const bf16x8 b1=*reinterpret_cast<const bf16x8*>(kb+d0*2048+512);
    if(d0==0){p0=__builtin_amdgcn_mfma_f32_32x32x16_bf16(b0,qr[0],negm,0,0,0);p1=__builtin_amdgcn_mfma_f32_32x32x16_bf16(b1,qr[0],negm,0,0,0);}
    else{p0=__builtin_amdgcn_mfma_f32_32x32x16_bf16(b0,qr[d0],p0,0,0,0);p1=__builtin_amdgcn_mfma_f32_32x32x16_bf16(b1,qr[d0],p1,0,0,0);}}
}
typedef __attribute__((address_space(3))) const char* lds_cptr;
typedef short v4i16_t __attribute__((ext_vector_type(4)));
__device__ __forceinline__ void kload8(bf16x8*kf,lds_cptr kp){
  kf[0]=*(const __attribute__((address_space(3))) bf16x8*)(kp);      kf[1]=*(const __attribute__((address_space(3))) bf16x8*)(kp+512);
  kf[2]=*(const __attribute__((address_space(3))) bf16x8*)(kp+2048); kf[3]=*(const __attribute__((address_space(3))) bf16x8*)(kp+2560);
  kf[4]=*(const __attribute__((address_space(3))) bf16x8*)(kp+4096); kf[5]=*(const __attribute__((address_space(3))) bf16x8*)(kp+4608);
  kf[6]=*(const __attribute__((address_space(3))) bf16x8*)(kp+6144); kf[7]=*(const __attribute__((address_space(3))) bf16x8*)(kp+6656);
}
__device__ __forceinline__ void kload2(bf16x8*kf,lds_cptr kp,int j){ kf[2*j]=*(const __attribute__((address_space(3))) bf16x8*)(kp+j*2048); kf[2*j+1]=*(const __attribute__((address_space(3))) bf16x8*)(kp+j*2048+512); }
__device__ __forceinline__ s16x4 vtr(lds_cptr p){ return __builtin_bit_cast(s16x4,__builtin_amdgcn_ds_read_tr16_b64_v4i16((__attribute__((address_space(3))) v4i16_t*)p)); }
__device__ __forceinline__ float rowmax(const f32x16&p0,const f32x16&p1){
  float a=max3f(p0[0],p0[1],p1[0]),b=max3f(p0[2],p0[3],p1[1]);a=max3f(a,p1[2],p1[3]);
  #pragma unroll
  for(int r=4;r<16;r+=4){a=max3f(a,p0[r],p0[r+1]);b=max3f(b,p0[r+2],p0[r+3]);a=max3f(a,p1[r],p1[r+1]);b=max3f(b,p1[r+2],p1[r+3]);}
  const float m=max2f(a,b);
  auto rr=__builtin_amdgcn_permlane32_swap(__float_as_uint(m),__float_as_uint(m),false,false);
  return max2f(__uint_as_float(rr[0]),__uint_as_float(rr[1]));
}
__device__ __forceinline__ void pv(f32x16*o,int vb,bf16x8 pa0,bf16x8 pa1,bf16x8 pa2,bf16x8 pa3){
  #pragma unroll
  for(int d0=0;d0<4;++d0){s16x4 lo[4],hi[4];
    #pragma unroll
    for(int ks=0;ks<4;++ks){
      asm volatile("ds_read_b64_tr_b16 %0,%1 offset:%c2":"=&v"(lo[ks]):"v"(vb),"i"(d0*4096+ks*1024):"memory");
      asm volatile("ds_read_b64_tr_b16 %0,%1 offset:%c2":"=&v"(hi[ks]):"v"(vb),"i"(d0*4096+ks*1024+512):"memory");}
    asm volatile("s_waitcnt lgkmcnt(0)":::"memory");SBAR();
    #define PK(k) (bf16x8){lo[k][0],lo[k][1],lo[k][2],lo[k][3],hi[k][0],hi[k][1],hi[k][2],hi[k][3]}
    o[d0]=__builtin_amdgcn_mfma_f32_32x32x16_bf16(pa0,PK(0),o[d0],0,0,0);
    o[d0]=__builtin_amdgcn_mfma_f32_32x32x16_bf16(pa1,PK(1),o[d0],0,0,0);
    o[d0]=__builtin_amdgcn_mfma_f32_32x32x16_bf16(pa2,PK(2),o[d0],0,0,0);
    o[d0]=__builtin_amdgcn_mfma_f32_32x32x16_bf16(pa3,PK(3),o[d0],0,0,0);
    #undef PK
  }
}

#ifndef ATTN_STORE16
#define ATTN_STORE16(p,v) (*(u32x4*)(p)=(v))
#endif
template<int THRL> __device__ __forceinline__ void attn_unit(int b,int qcol,int kcol,int vcol,int ocol,int qb,const bf16*Q,const bf16*__restrict__ K,const bf16*__restrict__ V,bf16*O,bf16*O2,int mode,float lam,const __attribute__((address_space(3))) float*gn,char*shm,bool pre,bool has_next,int nb,int nkcol,int nvcol){
  int tid_=threadIdx.x; asm volatile("":"+v"(tid_)); const int tid=tid_,lane=tid&63,r32=lane&31,hi=lane>>5; const int wid=__builtin_amdgcn_readfirstlane(tid>>6);
  const long rowbase=(long)b*SEQ; const int q0=qb*QB;
  const bf16*Qw=Q+(rowbase+q0+wid*QBLK)*PQ+qcol;
  const bf16*Kh=K+rowbase*PQ+kcol,*Vh=V+rowbase*PQ+vcol;
  const unsigned lds0=(unsigned)(uintptr_t)shm;
  float*wsf=(float*)(shm+LDS_WS)+wid*64;
  const bf16*ksrc=Kh+(long)lane*PQ+wid*8;
  const bf16*vsrc=Vh+(long)(16*(wid&3)+(lane>>2))*PQ+(wid>>2)*32+(lane&3)*8;
  const unsigned kdst=lds0+LDS_K+wid*1024, vdst=lds0+LDS_V+wid*1024;
  #define DMA_K(t,slot) glds16(ksrc+(long)(t)*KVBLK*PQ,(unsigned)__builtin_amdgcn_readfirstlane(kdst+(slot)))
  #define DMA_V(t,slot) do{ glds16(vsrc+(long)(t)*KVBLK*PQ,(unsigned)__builtin_amdgcn_readfirstlane(vdst+2*(slot))); glds16(vsrc+(long)(t)*KVBLK*PQ+64,(unsigned)__builtin_amdgcn_readfirstlane(vdst+2*(slot)+8192)); }while(0)
  const int vb0=(int)(lds0+LDS_V)+((lane>>4)&1)*32+(lane&3)*8+(4*hi+((lane&15)>>2))*64;
  const char*Kbase=shm+LDS_K; bf16x8 kf[8];
  const lds_cptr shm3=(lds_cptr)shm; const lds_cptr kp0=shm3+LDS_K+hi*1024+r32*16; const lds_cptr vp0=shm3+LDS_V+((lane>>4)&1)*32+(lane&3)*8+(4*hi+((lane&15)>>2))*64;
  const int NT=(q0+QB)/KVBLK;
  if(!pre){DMA_K(0,0);DMA_V(0,0);DMA_K(1,SLOTB);}
  typedef __attribute__((address_space(3))) bf16x8 lds_bf16x8;
  lds_bf16x8*const qst=(lds_bf16x8*)(shm3+LDS_OST+wid*4096)+lane;
  { bf16x8 qr[4];
    #pragma unroll
    for(int d0=0;d0<4;++d0)qr[d0]=*reinterpret_cast<const bf16x8*>(&Qw[(long)r32*PQ+d0*16+hi*8]);
    #pragma unroll
    for(int d0=0;d0<4;++d0)qst[64*d0]=qr[d0]; }
  float mhat=0.f,l_reg=0.f;f32x16 o[4];o[0]=f32x16{};o[1]=f32x16{};o[2]=f32x16{};o[3]=f32x16{};f32x16 negm=f32x16{};asm volatile("":"+v"(negm));
  const int qrel=wid*QBLK+r32;
  #define CMASK(P0,P1,t) do{int jb_=(t)-(NT-4); if(jb_>=0)cmask(P0,P1,jb_,qrel,hi);}while(0)
  bool resc=false;
  #define START(P0,P1) do{ const float rm=rowmax(P0,P1); resc=false; \
    { const float dl=rm; mhat=fadd_s(mhat,dl); \
      _Pragma("unroll") for(int r=0;r<16;++r){P0[r]=fsub_s(P0[r],dl);P1[r]=fsub_s(P1[r],dl);} \
      _Pragma("unroll") for(int r=0;r<16;++r)negm[r]=-mhat; asm volatile("":"+v"(negm)); } \
    _Pragma("unroll") for(int r=0;r<16;++r)P0[r]=__builtin_amdgcn_exp2f(P0[r]); }while(0)
  #define RESC() do{ if(resc){ asm volatile("s_waitcnt lgkmcnt(0)":::"memory"); \
      _Pragma("unroll") for(int d_=0;d_<4;++d_) _Pragma("unroll") for(int r=0;r<16;++r)o[d_][r]*=wsf[crow(r,hi)]; } }while(0)
  f32x16 pA0,pA1,pB0,pB1;
  int sl_prev=0,sl_cur=0,sl_next=SLOTB;
  #define ROT() do{sl_prev=sl_cur;sl_cur=sl_next;sl_next=(sl_next==(NSLOT-1)*SLOTB)?0:sl_next+SLOTB;}while(0)
  if(!pre)DMA_K(2,2*SLOTB);
  WAIT_BAR(4);
  { bf16x8 qr[4];
    #pragma unroll
    for(int d0=0;d0<4;++d0)qr[d0]=qst[64*d0];
    qkt(pA0,pA1,Kbase,qr,negm,r32,hi); }
  asm volatile("s_nop 15\n\ts_nop 7":"+v"(pA0),"+v"(pA1));CMASK(pA0,pA1,0);
  START(pA0,pA1);
  _Pragma("unroll") for(int r=0;r<16;++r)pA1[r]=__builtin_amdgcn_exp2f(pA1[r]);
  WAIT_BAR(0);
  DMA_K(3,0);DMA_V(1,SLOTB);
  ROT();
  kload8(kf,kp0+sl_cur);
  WAIT_BAR(3);
  bf16x8 vf[4]; u32x4 pw0,pw1,pw2,pw3;
  #define PKW(P,B) cvtpk_s(P[B],P[B+1])
  #define PAF(k) __builtin_bit_cast(bf16x8,pw##k)
  #define VFR(i) vf[i]
  #define PIN(x) asm volatile("":"+v"(x))
  #define MX3(a,b,c) __builtin_fmaxf(__builtin_fmaxf((a),(b)),(c))
  #define GAPA(MF,A0,A1,A2,A3,W0,W1,PW) do{ MF; sacc+=A0; sacc+=A1; sacc+=A2; sacc+=A3; PIN(sacc); W0; W1; PIN(PW); SBAR(); }while(0)
  #define EX(v) __builtin_amdgcn_exp2f(v)
  #define GAPB(MF,X,B) do{ MF; X[B]=EX(X[B]); X[B+1]=EX(X[B+1]); PIN(X); SBAR(); }while(0)
  #define VRD(n) do{ const s16x4 lo_=vtr(vp_+(((n)&3)*4096+((n)>>2)*1024)), hi_=vtr(vp_+(((n)&3)*4096+((n)>>2)*1024+512)); vf[(n)&3]=__builtin_shufflevector(lo_,hi_,0,1,2,3,4,5,6,7); }while(0)
  #define KRD(G,j) do{ if(G){ kload2(kf,kp0+sl_next,j); SBAR(); } }while(0)
  #define PVM(n,X,B) GAPB(o[(n)&3]=__builtin_amdgcn_mfma_f32_32x32x16_bf16(PAFN((n)>>2),VFR((n)&3),o[(n)&3],0,0,0), X,B)
  #define PAFN(k) ((k)==0?PAF(0):(k)==1?PAF(1):(k)==2?PAF(2):PAF(3))
  #define STEP(C0,C1,P0,P1,t,GK,GV,GL) do{ SBAR(); \
    const lds_cptr vp_=vp0+2*sl_prev; \
    bf16x8 q0_=qst[0],q1_=qst[64]; SBAR(); float sacc=(P0[0]+P0[1]); \
    GAPA(C0=__builtin_amdgcn_mfma_f32_32x32x16_bf16(kf[0],q0_,negm,0,0,0), P0[2],P0[3],P0[4],P0[5],     pw0[0]=PKW(P0,0), pw0[1]=PKW(P0,2), pw0); \
    GAPA(C1=__builtin_amdgcn_mfma_f32_32x32x16_bf16(kf[1],q0_,negm,0,0,0), P0[6],P0[7],P0[8],P0[9],     pw0[2]=PKW(P0,4), pw0[3]=PKW(P0,6), pw0); \
    bf16x8 q2_=qst[128]; SBAR(); \
    GAPA(C0=__builtin_amdgcn_mfma_f32_32x32x16_bf16(kf[2],q1_,C0,0,0,0),   P0[10],P0[11],P0[12],P0[13], pw1[0]=PKW(P0,8), pw1[1]=PKW(P0,10), pw1); \
    GAPA(C1=__builtin_amdgcn_mfma_f32_32x32x16_bf16(kf[3],q1_,C1,0,0,0),   P0[14],P0[15],P1[0],P1[1],   pw1[2]=PKW(P0,12),pw1[3]=PKW(P0,14), pw1); \
    bf16x8 q3_=qst[192]; SBAR(); \
    GAPA(C0=__builtin_amdgcn_mfma_f32_32x32x16_bf16(kf[4],q2_,C0,0,0,0),   P1[2],P1[3],P1[4],P1[5],     pw2[0]=PKW(P1,0), pw2[1]=PKW(P1,2), pw2); \
    GAPA(C1=__builtin_amdgcn_mfma_f32_32x32x16_bf16(kf[5],q2_,C1,0,0,0),   P1[6],P1[7],P1[8],P1[9],     pw2[2]=PKW(P1,4), pw2[3]=PKW(P1,6), pw2); \
    VRD(0); SBAR(); \
    GAPA(C0=__builtin_amdgcn_mfma_f32_32x32x16_bf16(kf[6],q3_,C0,0,0,0),   P1[10],P1[11],P1[12],P1[13], pw3[0]=PKW(P1,8), pw3[1]=PKW(P1,10), pw3); \
    VRD(1); VRD(2); SBAR(); \
    GAPA(C1=__builtin_amdgcn_mfma_f32_32x32x16_bf16(kf[7],q3_,C1,0,0,0),   P1[14],P1[15],0.f,0.f,       pw3[2]=PKW(P1,12),pw3[3]=PKW(P1,14), pw3); \
    l_reg+=sacc; \
    if(GK){DMA_K((t)+3,sl_cur);} if(GV){DMA_V((t)+1,sl_next);} \
    CMASK(C0,C1,t); \
    { float a=MX3(C0[0],C0[1],C1[0]),b=MX3(C0[2],C0[3],C1[1]); a=MX3(a,C1[2],C1[3]); \
      _Pragma("unroll") for(int r=4;r<16;r+=4){a=MX3(a,C0[r],C0[r+1]);b=MX3(b,C0[r+2],C0[r+3]);a=MX3(a,C1[r],C1[r+1]);b=MX3(b,C1[r+2],C1[r+3]);} \
      float rm=__builtin_fmaxf(a,b); { auto rr=__builtin_amdgcn_permlane32_swap(__float_as_uint(rm),__float_as_uint(rm),false,false); rm=__builtin_fmaxf(__uint_as_float(rr[0]),__uint_as_float(rr[1])); } \
      resc=false; \
      if(__builtin_expect(__any(rm>(float)THRL),0)){ const float dl=__builtin_fmaxf(rm,0.f); mhat+=dl; \
        _Pragma("unroll") for(int r=0;r<16;++r){C0[r]-=dl;C1[r]-=dl;} \
        _Pragma("unroll") for(int r=0;r<16;++r)negm[r]=-mhat; asm volatile("":"+v"(negm)); \
        const float f=__builtin_amdgcn_exp2f(-dl); l_reg*=f; if(hi==0)wsf[r32]=f; resc=true; } } \
    SBAR(); \
    VRD(3); SBAR(); PVM(0,C0,0); \
    VRD(4); SBAR(); PVM(1,C0,2); \
    VRD(5); SBAR(); PVM(2,C0,4); \
    VRD(6); SBAR(); KRD(GL,0); PVM(3,C0,6); \
    VRD(7); SBAR(); PVM(4,C0,8); \
    VRD(8); SBAR(); KRD(GL,1); PVM(5,C0,10); \
    VRD(9); SBAR(); PVM(6,C0,12); \
    VRD(10); SBAR(); KRD(GL,2); PVM(7,C0,14); \
    VRD(11); SBAR(); PVM(8,C1,0); \
    VRD(12); SBAR(); KRD(GL,3); PVM(9,C1,2); \
    VRD(13); SBAR(); PVM(10,C1,4); \
    VRD(14); SBAR(); PVM(11,C1,6); \
    VRD(15); SBAR(); PVM(12,C1,8); \
    PVM(13,C1,10); \
    PVM(14,C1,12); \
    PVM(15,C1,14); \
    }while(0)
  int t=1;
  #undef CMASK
  #define CMASK(P0,P1,t) do{}while(0)
  for(;t+5<NT;t+=2){
    STEP(pB0,pB1,pA0,pA1,t,true,true,true);     WAIT_BAR(3); RESC(); ROT();
    STEP(pA0,pA1,pB0,pB1,t+1,true,true,true);   WAIT_BAR(3); RESC(); ROT();
  }
  #undef CMASK
  #define CMASK(P0,P1,t) do{int jb_=(t)-(NT-4); if(jb_>=0)cmask(P0,P1,jb_,qrel,hi);}while(0)
  #define ENDW(tt) do{ if((tt)+3<NT){WAIT_BAR(3);} else if((tt)+2<NT){WAIT_BAR(2);} else {WAIT_BAR(0);} }while(0)
  for(;t+1<NT;t+=2){
    STEP(pB0,pB1,pA0,pA1,t,(t+3<NT),(t+1<NT),(t+1<NT));       ENDW(t);   RESC(); ROT();
    STEP(pA0,pA1,pB0,pB1,t+1,(t+4<NT),(t+2<NT),(t+2<NT));     ENDW(t+1); RESC(); ROT();
  }
  STEP(pB0,pB1,pA0,pA1,NT-1,false,false,false); RESC();
  { float sacc=pB0[0]+pB0[1]; _Pragma("unroll") for(int r=2;r<16;++r)sacc+=pB0[r]; _Pragma("unroll") for(int r=0;r<16;++r)sacc+=pB1[r]; l_reg+=sacc;
    pw0=(u32x4){PKW(pB0,0),PKW(pB0,2),PKW(pB0,4),PKW(pB0,6)};pw1=(u32x4){PKW(pB0,8),PKW(pB0,10),PKW(pB0,12),PKW(pB0,14)};pw2=(u32x4){PKW(pB1,0),PKW(pB1,2),PKW(pB1,4),PKW(pB1,6)};pw3=(u32x4){PKW(pB1,8),PKW(pB1,10),PKW(pB1,12),PKW(pB1,14)};
    SBAR(); pv(o,vb0+2*sl_cur,PAF(0),PAF(1),PAF(2),PAF(3)); }
  asm volatile("s_waitcnt lgkmcnt(0)\n\ts_barrier":::"memory");
  if(has_next){ const bf16*Kn=K+(long)nb*SEQ*PQ+nkcol,*Vn=V+(long)nb*SEQ*PQ+nvcol;
    const bf16*ksn=Kn+(long)lane*PQ+wid*8; const bf16*vsn=Vn+(long)(16*(wid&3)+(lane>>2))*PQ+(wid>>2)*32+(lane&3)*8;
    glds16(ksn,(unsigned)__builtin_amdgcn_readfirstlane(kdst));
    glds16(vsn,(unsigned)__builtin_amdgcn_readfirstlane(vdst)); glds16(vsn+64,(unsigned)__builtin_amdgcn_readfirstlane(vdst+8192));
    glds16(ksn+(long)KVBLK*PQ,(unsigned)__builtin_amdgcn_readfirstlane(kdst+SLOTB));
    glds16(ksn+(long)2*KVBLK*PQ,(unsigned)__builtin_amdgcn_readfirstlane(kdst+2*SLOTB)); }
  #undef PKW
  #undef PAF
  #undef VFR
  #undef PIN
  #undef MX3
  #undef GAPA
  #undef GAPB
  #undef PVM
  #undef PAFN
  #undef EX
  #undef VRD
  #undef KRD
  #undef STEP
  #undef ENDW
  {auto rr=__builtin_amdgcn_permlane32_swap(__float_as_uint(l_reg),__float_as_uint(l_reg),false,false);l_reg=__uint_as_float(rr[0])+__uint_as_float(rr[1]);}
  if(hi==0)wsf[32+r32]=l_reg;asm volatile("s_waitcnt lgkmcnt(0)":::"memory");
  float rli[16];
  #pragma unroll
  for(int r=0;r<16;++r)rli[r]=__builtin_amdgcn_rcpf(wsf[32+crow(r,hi)]);
  bf16*Ow=O+(rowbase+q0+wid*QBLK)*PO+ocol;
  { bf16*stg=(bf16*)(shm+LDS_OST)+wid*2048;
    if(mode==0){
      #pragma unroll
      for(int ps=0;ps<2;++ps){
        #pragma unroll
        for(int r=0;r<16;++r){const int orow=crow(r,hi);
          #pragma unroll
          for(int d0=0;d0<2;++d0)stg[orow*64+d0*32+r32]=__float2bfloat16(o[2*ps+d0][r]*rli[r]);}
        asm volatile("s_waitcnt lgkmcnt(0)":::"memory");
        #pragma unroll
        for(int i=0;i<4;++i){const int row=i*8+(lane>>3),ch=lane&7; const u32x4 v=*(const u32x4*)(stg+row*64+ch*8); ATTN_STORE16(Ow+(long)row*PO+ps*64+ch*8,v);}
        asm volatile("s_waitcnt lgkmcnt(0)":::"memory"); }
    } else {
      bf16*O2w=O2+(rowbase+q0+wid*QBLK)*PO+ocol;
      float df[2][4][8]; float ssq[4]={0.f,0.f,0.f,0.f};
      #pragma unroll
      for(int ps=0;ps<2;++ps){
        #pragma unroll
        for(int r=0;r<16;++r){const int orow=crow(r,hi);
          #pragma unroll
          for(int d0=0;d0<2;++d0)stg[orow*64+d0*32+r32]=__float2bfloat16(o[2*ps+d0][r]*rli[r]);}
        asm volatile("s_waitcnt lgkmcnt(0)":::"memory");
        #pragma unroll
        for(int i=0;i<4;++i){const int row=i*8+(lane>>3),ch=lane&7; const u32x4 v1=*(const u32x4*)(stg+row*64+ch*8);
          const unsigned long long*p0=(const unsigned long long*)(Ow+(long)row*PO+ps*64+ch*8);
          const unsigned long long a0=__hip_atomic_load(p0,__ATOMIC_RELAXED,__HIP_MEMORY_SCOPE_AGENT),a1=__hip_atomic_load(p0+1,__ATOMIC_RELAXED,__HIP_MEMORY_SCOPE_AGENT);
          const unsigned w0[4]={(unsigned)a0,(unsigned)(a0>>32),(unsigned)a1,(unsigned)(a1>>32)};
          #pragma unroll
          for(int e=0;e<4;++e){ const float x0=__uint_as_float(w0[e]<<16)-lam*__uint_as_float(v1[e]<<16), x1=__uint_as_float(w0[e]&0xffff0000u)-lam*__uint_as_float(v1[e]&0xffff0000u);
            df[ps][i][2*e]=x0; df[ps][i][2*e+1]=x1; ssq[i]+=x0*x0+x1*x1; } }
        asm volatile("s_waitcnt lgkmcnt(0)":::"memory"); }
      #pragma unroll
      for(int i=0;i<4;++i){ float q=ssq[i]; q+=__shfl_xor(q,1); q+=__shfl_xor(q,2); q+=__shfl_xor(q,4); ssq[i]=__builtin_amdgcn_rsqf(q*(1.f/128.f)+1e-5f); }
      #pragma unroll
      for(int ps=0;ps<2;++ps){ const int ch=lane&7; const __attribute__((address_space(3))) float*gp=gn+ps*64+ch*8; float g8[8];
        #pragma unroll
        for(int e=0;e<8;++e)g8[e]=gp[e];
        #pragma unroll
        for(int i=0;i<4;++i){const int row=i*8+(lane>>3); u32x4 w;
          w[0]=cvtpk_s(df[ps][i][0]*ssq[i]*g8[0],df[ps][i][1]*ssq[i]*g8[1]); w[1]=cvtpk_s(df[ps][i][2]*ssq[i]*g8[2],df[ps][i][3]*ssq[i]*g8[3]);
          w[2]=cvtpk_s(df[ps][i][4]*ssq[i]*g8[4],df[ps][i][5]*ssq[i]*g8[5]); w[3]=cvtpk_s(df[ps][i][6]*ssq[i]*g8[6],df[ps][i][7]*ssq[i]*g8[7]);
          ATTN_STORE16(O2w+(long)row*PO+ps*64+ch*8,w);} }
    } }
  asm volatile("s_waitcnt lgkmcnt(0)\n\ts_barrier":::"memory");
  #undef DMA_K
  #undef DMA_V
  #undef CMASK
  #undef START
  #undef RESC
  #undef ROT
}
constexpr int ATTN_LDS_BYTES=LDS_BYTES;
struct AttnTensors { const bf16* Q; const bf16* K; const bf16* V; bf16* O0; bf16* O2; float lam; const __attribute__((address_space(3))) float* gn; };
struct AttnUnit { int bh; int qb; };
struct StaticOrder {
  int vcu,G;
  __device__ __forceinline__ explicit StaticOrder(int grid,int block):vcu((grid%8==0)?(block%8)*(grid/8)+block/8:block),G(grid){}
  __device__ __forceinline__ bool next(int i,AttnUnit&u)const{ const int pi=vcu+(i>>1)*G; if(pi>=BATCH*8*16)return false; const int s=pi&15; u.bh=pi>>4; u.qb=(i&1)?31-s:s; return true; }
  __device__ __forceinline__ void a_ready(const AttnUnit&)const{}
  __device__ __forceinline__ void done(const AttnUnit&)const{}
};
template<class Sched,int THRL=8> __device__ __forceinline__ void attn_phase(char*lds,const AttnTensors&T,const Sched&S){
  AttnUnit u,un; bool pre=false;
  if(!S.next(0,u))return;
  for(int i=0;;++i){ S.a_ready(u); const int b=u.bh>>3,h=u.bh&7; const bool more=S.next(i+1,un); const int nb=un.bh>>3,nh=un.bh&7;
    for(int c=0;c<2;++c) attn_unit<THRL>(b,h*128+c*64,h*128+c*64,h*128,h*128,u.qb,T.Q,T.K,T.V,T.O0,T.O2,c,T.lam,T.gn,lds,pre||c==1,c==0||more,c==0?b:nb,c==0?h*128+64:nh*128,c==0?h*128:nh*128);
    S.done(u); if(!more)break; u=un; pre=true; }
}
#undef SBAR
#undef WAIT_BAR
}


#ifndef MK_P2_NOKWT
#define MK_P2_NOKWT 0
#endif

#ifndef MK_P4_HALFLDS
#define MK_P4_HALFLDS 0
#endif

constexpr int NWAVES = 8;
constexpr int T = 32768, D = 1024, SEQ = 8192, NB = 4;
constexpr int ML_H = 4, ML_DV = 512, ML_DQK = 256, ML_QK = 1024, ML_V = 2048, ML_LD = 6152, NCH = 128;
constexpr int VT_ROWS = 544;
constexpr int NEXP = 32, DEXP = 256, MAXPANEL = 288, MAXSLOT = MAXPANEL * 256;
constexpr float LAMBDA_INIT1 = 0.35550906759f;

constexpr size_t MiB = 1u << 20;
constexpr size_t WS_CTL = 0, CTL_ZERO_BYTES = 1 * MiB;
constexpr size_t WS_GATES = 1 * MiB;
constexpr size_t WS_SA = 2 * MiB, WS_SB = WS_SA + 512 * 1024, WS_SIS = 3 * MiB, WS_SFL = WS_SIS + 512 * 1024, WS_RS = 4 * MiB, WS_QN = WS_RS + 512 * 1024;
constexpr size_t WS_CHB = 5 * MiB, WS_CHM = WS_CHB + 8192, WS_DEC = WS_CHM + 8192;
constexpr size_t WS_WR = 5 * MiB + 512 * 1024;
constexpr size_t WS_TE = 6 * MiB, WS_TW = WS_TE + 256 * 1024, WS_TPOS = WS_TW + 256 * 1024, WS_TSLOT = WS_TPOS + 256 * 1024;
constexpr size_t WS_ERS = 1 * MiB, WS_RSTD = 5 * MiB;
constexpr size_t WS_E2T = 8 * MiB, WS_EW = 12 * MiB;
constexpr size_t WS_WML_IN = 16 * MiB, WS_WML_OUT = 28 * MiB;
constexpr size_t WS_KWT = 32 * MiB;
constexpr size_t WS_WDA_IN = 504 * MiB, WS_WDA_OUT = 510 * MiB, WS_WGU = 40 * MiB, WS_WDN = 72 * MiB;
constexpr size_t WS_WGU1 = 196 * MiB, WS_WDN1 = 228 * MiB;
constexpr size_t WS_R0 = 96 * MiB;
constexpr size_t WS_QKRAW = WS_R0, WS_OG = WS_R0 + 128 * MiB, WS_VT = WS_R0 + 256 * MiB;
constexpr size_t WS_WGU0 = WS_R0 + 192 * MiB, WS_WDN0 = WS_WGU0 + 32 * MiB;
constexpr size_t WS_PG = 488 * MiB;
constexpr size_t WS_HN = WS_R0;
constexpr size_t WS_ACT = WS_R0 + 64 * MiB, WS_YS = 352 * MiB;
constexpr size_t WS_AQ = 244 * MiB, WS_AK = WS_AQ + 64 * MiB, WS_AV = WS_AK + 64 * MiB, WS_AO = WS_AV + 64 * MiB;
constexpr size_t WS_END = WS_YS + 144 * MiB;
static_assert(WS_VT + (size_t)4 * VT_ROWS * T * 2 <= 488 * MiB && WS_END <= 496 * MiB && WS_AO + (size_t)T * 1024 * 2 <= 504 * MiB && WS_WDN0 + 16 * MiB <= WS_VT && WS_WDN1 + 16 * MiB <= WS_AQ && WS_ACT + 36 * MiB <= WS_WGU1, "d_ws map");
constexpr int CW_BAR = 4096;
constexpr int CW_CNT = 16384;

constexpr int RING_OFF = 0, RING_BYTES = 131072;
constexpr int LDSCTL_OFF = RING_BYTES, MISC_OFF = LDSCTL_OFF + 320;
constexpr int TAB_OFF = LDSCTL_OFF + 1024;
constexpr int TAB_PEXP = TAB_OFF, TAB_ECNT = TAB_OFF + 1280, TAB_EOFF = TAB_ECNT + 128, TAB_NP = TAB_EOFF + 136;
constexpr int LDS_BYTES = 147456;

#define GAS __attribute__((address_space(1)))
#define LAS __attribute__((address_space(3)))
typedef unsigned short bf16;
typedef unsigned v4u __attribute__((ext_vector_type(4)));
typedef unsigned v2u __attribute__((ext_vector_type(2)));
typedef float f32x4 __attribute__((ext_vector_type(4)));
typedef float f32x2 __attribute__((ext_vector_type(2)));
typedef short bf16x8 __attribute__((ext_vector_type(8)));
typedef GAS unsigned gu32;
#define RLX_AGENT __ATOMIC_RELAXED, __HIP_MEMORY_SCOPE_AGENT
#define LDS_WAIT() asm volatile("s_waitcnt lgkmcnt(0)" ::: "memory")
__device__ __forceinline__ unsigned f2bf(float f) { unsigned u = __builtin_bit_cast(unsigned, f); return (u + 0x7fffu + ((u >> 16) & 1u)) >> 16; }
__device__ __forceinline__ unsigned pk2(float lo, float hi) { typedef float f2v_t __attribute__((ext_vector_type(2))); typedef __bf16 b2v_t __attribute__((ext_vector_type(2)));
    f2v_t v = {lo, hi}; b2v_t b = __builtin_convertvector(v, b2v_t); return __builtin_bit_cast(unsigned, b); }
__device__ __forceinline__ float bf_lo(unsigned w) { return __builtin_bit_cast(float, w << 16); }
__device__ __forceinline__ float bf_hi(unsigned w) { return __builtin_bit_cast(float, w & 0xffff0000u); }
__device__ __forceinline__ float bf1(bf16 h) { return __builtin_bit_cast(float, (unsigned)h << 16); }
__device__ __forceinline__ float wave_sum(float v) {
#pragma unroll
    for (int o = 1; o < 64; o <<= 1) v += __shfl_xor(v, o);
    return v;
}
__device__ __forceinline__ float wave_max(float v) {
#pragma unroll
    for (int o = 1; o < 64; o <<= 1) v = fmaxf(v, __shfl_xor(v, o));
    return v;
}
__device__ __forceinline__ float prefix_sum_incl(float v, int lane) {
#pragma unroll
    for (int o = 1; o < 64; o <<= 1) { const float u = __shfl_up(v, o); if (lane >= o) v += u; }
    return v;
}
__device__ __forceinline__ float prefix_max_incl(float v, int lane) {
#pragma unroll
    for (int o = 1; o < 64; o <<= 1) { const float u = __shfl_up(v, o); if (lane >= o) v = fmaxf(v, u); }
    return v;
}
__device__ __forceinline__ float log_sigmoid(float z) { return fminf(z, 0.f) - log1pf(__expf(-fabsf(z))); }
__device__ __forceinline__ float sigmoidf_(float z) { return 1.f / (1.f + __expf(-z)); }
#define XB_TMO      128
#define XB_XCNT(j)  (256  + 64 * (j))
#define XB_XSUB(j)  (1280 + 64 * (j))
#define XB_XGEN(j)  (2304 + 64 * (j))
#define XB_TOP      3328
#define XB_TOPGEN   3392
#define XCD_BAR_WORDS 3456
#define XB_SPIN_CAP (1u << 18)

__device__ __forceinline__ unsigned xb_ld(unsigned* p)              { return __hip_atomic_load(p, __ATOMIC_RELAXED, __HIP_MEMORY_SCOPE_AGENT); }
__device__ __forceinline__ unsigned xb_add(unsigned* p, unsigned v) { return __hip_atomic_fetch_add(p, v, __ATOMIC_RELAXED, __HIP_MEMORY_SCOPE_AGENT); }
__device__ __forceinline__ unsigned xb_xcc_id() { return (unsigned)__builtin_amdgcn_s_getreg((3 << 11) | 20) & 0xFu; }
#define XB_SPIN(cond, bar) do { unsigned _sp = 0; while (cond) { __builtin_amdgcn_s_sleep(1); \
    if ((++_sp & 255u) == 0u) { if (xb_ld(&(bar)[XB_TMO])) break; if (_sp > XB_SPIN_CAP) { atomicAdd(&(bar)[XB_TMO], 1u); break; } } } } while (0)

struct XcdBarrier {
    unsigned* bar; unsigned x;
    volatile LAS unsigned* st;
};

__device__ __forceinline__ XcdBarrier xcd_barrier_post(unsigned* bar, volatile LAS unsigned* st) {
    XcdBarrier b; b.bar = bar; b.x = xb_xcc_id(); b.st = st;
    if (threadIdx.x == 0) (void)xb_add(&bar[XB_XCNT(b.x)], 1u);
    return b;
}
__device__ __forceinline__ void xcd_barrier_complete(unsigned* bar, unsigned x, unsigned& nloc, unsigned& nx) {
    const unsigned G = gridDim.x * gridDim.y * gridDim.z;
    unsigned sum, cnt, mine, sp = 0u;
    for (;;) {
        sum = 0u; cnt = 0u; mine = 0u;
#pragma unroll
        for (unsigned j = 0; j < 16; ++j) { const unsigned c = xb_ld(&bar[XB_XCNT(j)]); sum += c; cnt += (c > 0u) ? 1u : 0u; mine = (j == x) ? c : mine; }
        if (sum == G) break;
        __builtin_amdgcn_s_sleep(1);
        if ((++sp & 255u) == 0u) { if (xb_ld(&bar[XB_TMO])) break; if (sp > XB_SPIN_CAP) { atomicAdd(&bar[XB_TMO], 1u); break; } }
    }
    nloc = mine > 0u ? mine : 1u; nx = cnt > 0u ? cnt : 1u;
}

__device__ __forceinline__ void xcd_barrier(const XcdBarrier& b) {
    asm volatile("s_waitcnt vmcnt(0)" ::: "memory");
    __syncthreads();
    if (threadIdx.x == 0) {
        unsigned* bar = b.bar;
        __builtin_amdgcn_s_waitcnt(0);
        unsigned nloc = b.st[0], nx = b.st[1];
        if (nloc == 0u) { xcd_barrier_complete(bar, b.x, nloc, nx); b.st[0] = nloc; b.st[1] = nx; }
        const unsigned old = xb_add(&bar[XB_XSUB(b.x)], 1u);
        const unsigned gen = old / nloc;
        if (old + 1u == (gen + 1u) * nloc) {
            __builtin_amdgcn_fence(__ATOMIC_RELEASE, "agent");
            asm volatile("s_waitcnt vmcnt(0)" ::: "memory");
            const unsigned og = xb_add(&bar[XB_TOP], 1u);
            const unsigned tg = og / nx;
            if (og + 1u == (tg + 1u) * nx) xb_add(&bar[XB_TOPGEN], 1u);
            else XB_SPIN(xb_ld(&bar[XB_TOPGEN]) == tg, bar);
            __builtin_amdgcn_fence(__ATOMIC_ACQUIRE, "agent");
            xb_add(&bar[XB_XGEN(b.x)], 1u);
            asm volatile("s_waitcnt vmcnt(0)" ::: "memory");
        } else {
            XB_SPIN(xb_ld(&bar[XB_XGEN(b.x)]) == gen, bar);
            __builtin_amdgcn_fence(__ATOMIC_ACQUIRE, "agent");
            asm volatile("s_waitcnt vmcnt(0)" ::: "memory");
        }
    }
    __syncthreads();
}


struct Ctx { LAS unsigned char* lds; int tid, lane, wave, vcu, G, gw, NGW; };

__device__ __forceinline__ void tr_item(const float* W, int ld, int K, int k0, int c0, bf16* WT, int drow0, LAS float* scr, int lane, const float* kscale = nullptr) {
    f32x4 wv[8];
#pragma unroll
    for (int i = 0; i < 8; ++i) { wv[i] = *(const GAS f32x4*)(W + (size_t)(k0 + 8 * i + (lane >> 3)) * ld + c0 + 4 * (lane & 7)); if (kscale) wv[i] = wv[i] * kscale[k0 + 8 * i + (lane >> 3)]; }
#pragma unroll
    for (int i = 0; i < 8; ++i) { LAS float* d = scr + (8 * i + (lane >> 3)) * 33 + 4 * (lane & 7); d[0] = wv[i].x; d[1] = wv[i].y; d[2] = wv[i].z; d[3] = wv[i].w; }
    LDS_WAIT(); asm volatile("" ::: "memory");
    const int c = lane & 7;
#pragma unroll
    for (int j = 0; j < 4; ++j) { const int n = (lane >> 3) + 8 * j; const LAS float* s = scr + (8 * c) * 33 + n;
        v4u o; o.x = pk2(s[0 * 33], s[1 * 33]); o.y = pk2(s[2 * 33], s[3 * 33]); o.z = pk2(s[4 * 33], s[5 * 33]); o.w = pk2(s[6 * 33], s[7 * 33]);
        *(GAS v4u*)(WT + (size_t)(drow0 + n) * K + k0 + 8 * c) = o; }
    LDS_WAIT(); asm volatile("" ::: "memory");
}
__device__ __forceinline__ void tr_load(f32x4 (&wv)[8], float (&ks)[8], const float* W, int ld, int k0, int c0, int lane, const float* kscale) {
#pragma unroll
    for (int i = 0; i < 8; ++i) { wv[i] = *(const GAS f32x4*)(W + (size_t)(k0 + 8 * i + (lane >> 3)) * ld + c0 + 4 * (lane & 7)); ks[i] = kscale ? kscale[k0 + 8 * i + (lane >> 3)] : 1.f; }
}
__device__ __forceinline__ void tr_finish(const f32x4 (&wv)[8], const float (&ks)[8], int K, int k0, bf16* WT, int drow0, LAS float* scr, int lane) {
#pragma unroll
    for (int i = 0; i < 8; ++i) { LAS float* d = scr + (8 * i + (lane >> 3)) * 33 + 4 * (lane & 7); const f32x4 w = wv[i] * ks[i]; d[0] = w.x; d[1] = w.y; d[2] = w.z; d[3] = w.w; }
    LDS_WAIT(); asm volatile("" ::: "memory");
    const int c = lane & 7;
#pragma unroll
    for (int j = 0; j < 4; ++j) { const int n = (lane >> 3) + 8 * j; const LAS float* s = scr + (8 * c) * 33 + n;
        v4u o; o.x = pk2(s[0 * 33], s[1 * 33]); o.y = pk2(s[2 * 33], s[3 * 33]); o.z = pk2(s[4 * 33], s[5 * 33]); o.w = pk2(s[6 * 33], s[7 * 33]);
        *(GAS v4u*)(WT + (size_t)(drow0 + n) * K + k0 + 8 * c) = o; }
    LDS_WAIT(); asm volatile("" ::: "memory");
}
__device__ __forceinline__ void tr_matrix_items(const Ctx& C, const float* W, int K, int N, bf16* WT, int& it0) {
    (void)C; (void)W; (void)K; (void)N; (void)WT; (void)it0;
}

__device__ __forceinline__ void conv_ml_out(const Ctx& C, const float* ml_w_out, unsigned char* ws) {
    LAS float* scr = (LAS float*)(C.lds + RING_OFF + C.wave * 16384); bf16* wml_out = (bf16*)(ws + WS_WML_OUT);
    for (int it = C.gw; it < 32 * 32; it += C.NGW) { const int kb = it / 32, nb = it % 32; tr_item(ml_w_out, D, ML_V, kb * 64, nb * 32, wml_out, nb * 32, scr, C.lane); }
}
__device__ __forceinline__ void p0_prologue(const Ctx& C, const float* x, const float* norm_mix0, const float* ml_w_in, const float* ml_w_out,
                                            const float* norm_ffn, const float* w_group, const float* w_expert, unsigned char* ws, bf16* hn0) {
    LAS float* scr = (LAS float*)(C.lds + RING_OFF + C.wave * 16384);
    bf16* wml_in = (bf16*)(ws + WS_WML_IN); bf16* wml_out = (bf16*)(ws + WS_WML_OUT);
    constexpr int I_IN = 16 * 192;
    for (int it = C.gw; it < I_IN; it += C.NGW) {
        const int kb = it / 192, nb = it % 192, c0 = nb * 32;
        const int drow = c0 < 2048 ? c0 : (c0 < 4096 ? c0 + 2048 : c0 - 2048);
        tr_item(ml_w_in, ML_LD, D, kb * 64, c0, wml_in, drow, scr, C.lane);
    }
    (void)wml_out; (void)ml_w_out;
    { bf16* WRH = (bf16*)(ws + WS_WR); bf16* WRL = WRH + 2 * 32 * 3 * 4 * 16 * 8; const int n = 2 * 32 * 3 * 4 * 16 * 8;
      for (int idx = C.gw * 64 + C.lane; idx < n; idx += C.NGW * 64) {
          int r = idx; const int j = r & 7; r >>= 3; const int c15 = r & 15; r >>= 4; const int g4 = r & 3; r >>= 2; const int ct = r % 3; r /= 3; const int ks = r & 31; const int l = r >> 5;
          const int k = 32 * ks + 8 * g4 + j, col = 16 * ct + c15;
          float w = 0.f; if (col < 4) w = w_group[((size_t)l * D + k) * 4 + col]; else if (col < 36) w = w_expert[((size_t)l * D + k) * 32 + (col - 4)];
          w *= norm_ffn[l * D + k];
          const unsigned hb = f2bf(w); const float hf = __builtin_bit_cast(float, hb << 16);
          WRH[idx] = (bf16)hb; WRL[idx] = (bf16)f2bf(w - hf); } }
    { bf16* vt = (bf16*)(ws + WS_VT); const int per_head = 32 * (T / 8);
      for (int idx = C.gw * 64 + C.lane; idx < 4 * per_head; idx += C.NGW * 64) { const int h = idx / per_head, r = idx % per_head, row = r / (T / 8), ch = r % (T / 8);
          const unsigned v = row == 0 ? 0x3f803f80u : 0u; *(GAS v4u*)(vt + ((size_t)(h * VT_ROWS + 512 + row)) * T + ch * 8) = (v4u){v, v, v, v}; } }
    { float* gates = (float*)(ws + WS_GATES);
      f32x4 gn[4]; float wg[4][4][8];
#pragma unroll
      for (int j = 0; j < 4; ++j) { gn[j] = *(const f32x4*)(norm_mix0 + 4 * C.lane + 256 * j);
#pragma unroll
          for (int e = 0; e < 4; ++e) { const float* p = ml_w_in + (size_t)(4 * C.lane + 256 * j + e) * ML_LD + 6144; const f32x4 a = *(const f32x4*)p, b = *(const f32x4*)(p + 4);
              wg[j][e][0] = a.x; wg[j][e][1] = a.y; wg[j][e][2] = a.z; wg[j][e][3] = a.w; wg[j][e][4] = b.x; wg[j][e][5] = b.y; wg[j][e][6] = b.z; wg[j][e][7] = b.w; } }
      f32x4 v[4], vn[4];
      if (C.gw < T) {
#pragma unroll
          for (int j = 0; j < 4; ++j) vn[j] = ((const GAS f32x4*)(x + (size_t)C.gw * D) + C.lane)[64 * j]; }
      for (int m = C.gw; m < T; m += C.NGW) {
#pragma unroll
          for (int j = 0; j < 4; ++j) v[j] = vn[j];
          if (m + C.NGW < T) {
#pragma unroll
              for (int j = 0; j < 4; ++j) vn[j] = ((const GAS f32x4*)(x + (size_t)(m + C.NGW) * D) + C.lane)[64 * j]; }
          float ss = 0.f;
#pragma unroll
          for (int j = 0; j < 4; ++j) ss += (v[j].x * v[j].x + v[j].y * v[j].y) + (v[j].z * v[j].z + v[j].w * v[j].w);
          const float rstd = rsqrtf(wave_sum(ss) * (1.f / D) + 1e-6f);
          GAS unsigned long long* o8 = (GAS unsigned long long*)(hn0 + (size_t)m * D) + C.lane;
          float ga[8];
#pragma unroll
          for (int c = 0; c < 8; ++c) ga[c] = 0.f;
#pragma unroll
          for (int j = 0; j < 4; ++j) { v[j] = v[j] * rstd * gn[j];
              o8[64 * j] = (unsigned long long)pk2(v[j].x, v[j].y) | ((unsigned long long)pk2(v[j].z, v[j].w) << 32);
#pragma unroll
              for (int c = 0; c < 8; ++c) ga[c] += (v[j].x * wg[j][0][c] + v[j].y * wg[j][1][c]) + (v[j].z * wg[j][2][c] + v[j].w * wg[j][3][c]); }
          float h4[4], h2[2], h1;
          { const bool up = (C.lane & 32) != 0;
#pragma unroll
            for (int c = 0; c < 4; ++c) { const float keep = up ? ga[c + 4] : ga[c], give = up ? ga[c] : ga[c + 4]; h4[c] = keep + __shfl_xor(give, 32); } }
          { const bool up = (C.lane & 16) != 0;
#pragma unroll
            for (int c = 0; c < 2; ++c) { const float keep = up ? h4[c + 2] : h4[c], give = up ? h4[c] : h4[c + 2]; h2[c] = keep + __shfl_xor(give, 16); } }
          { const bool up = (C.lane & 8) != 0; const float keep = up ? h2[1] : h2[0], give = up ? h2[0] : h2[1]; h1 = keep + __shfl_xor(give, 8); }
          h1 += __shfl_xor(h1, 4); h1 += __shfl_xor(h1, 2); h1 += __shfl_xor(h1, 1);
          if ((C.lane & 7) == 0) gates[(size_t)m * 8 + (((C.lane >> 5) & 1) << 2 | ((C.lane >> 4) & 1) << 1 | ((C.lane >> 3) & 1))] = h1;
      } }
}

__device__ __forceinline__ void p1_gate_chunks(const Ctx& C, const float* b_i, const float* b_f, unsigned char* ws) {
    const float* gates = (const float*)(ws + WS_GATES); float* chb = (float*)(ws + WS_CHB); float* chm = (float*)(ws + WS_CHM);
    for (int it = C.gw; it < 16 * NCH; it += C.NGW) {
        const int bh = it >> 7, c = it & 127, b = bh >> 2, h = bh & 3; const size_t t = (size_t)b * SEQ + c * 64 + C.lane;
        const float gi = gates[t * 8 + h] + b_i[h]; const float lf = log_sigmoid(gates[t * 8 + 4 + h] + b_f[h]);
        const float bc = prefix_sum_incl(lf, C.lane); const float bL = __shfl(bc, 63);
        const float mx = wave_max(bL - bc + gi);
        if (C.lane == 0) { chb[it] = bL; chm[it] = mx; }
    }
}

__device__ __forceinline__ void p2_conv(const Ctx& C, const float* b_i, const float* b_f, const float* conv_w, unsigned char* ws, bf16* Qo, bf16* Ko, int probe = 0) {
    const float* gates = (const float*)(ws + WS_GATES); const float* chb = (const float*)(ws + WS_CHB); const float* chm = (const float*)(ws + WS_CHM);
    float* SA = (float*)(ws + WS_SA); float* SB = (float*)(ws + WS_SB); float* SIS = (float*)(ws + WS_SIS); float* SFL = (float*)(ws + WS_SFL); float* DEC = (float*)(ws + WS_DEC);
    const bf16* raw = (const bf16*)(ws + WS_QKRAW); bf16* kwt = (bf16*)(ws + WS_KWT);
    LAS float* wsl = (LAS float*)(C.lds + TAB_OFF + 4096);
    LAS unsigned char* kst = C.lds + RING_OFF;
    const int rg = C.tid >> 8, ct = C.tid & 255; const bool isk = (C.wave & 2) != 0;
    float w[4][8];
#pragma unroll
    for (int j = 0; j < 4; ++j) { const f32x4 a = *(const f32x4*)(conv_w + j * 2048 + 8 * ct), b = *(const f32x4*)(conv_w + j * 2048 + 8 * ct + 4);
        w[j][0] = a.x; w[j][1] = a.y; w[j][2] = a.z; w[j][3] = a.w; w[j][4] = b.x; w[j][5] = b.y; w[j][6] = b.z; w[j][7] = b.w; }
    for (int item = C.vcu; item < NB * NCH; item += C.G) {
        const int b = item >> 7, c = item & 127; const size_t t0 = (size_t)b * SEQ + c * 64;
        if (C.wave < 4) {
            const int h = C.wave, bh = b * 4 + h;
            float a0 = chb[bh * 128 + C.lane], m0 = chm[bh * 128 + C.lane], a1 = chb[bh * 128 + 64 + C.lane], m1 = chm[bh * 128 + 64 + C.lane];
#pragma unroll
            for (int o = 1; o < 64; o <<= 1) { const float pa0 = __shfl_up(a0, o), pm0 = __shfl_up(m0, o), pa1 = __shfl_up(a1, o), pm1 = __shfl_up(m1, o);
                if (C.lane >= o) { m0 = fmaxf(pm0 + a0, m0); a0 += pa0; m1 = fmaxf(pm1 + a1, m1); a1 += pa1; } }
            const float mA = fmaxf(a0, m0);
            const float m64 = __shfl(mA, 63);
            const float mB = fmaxf(m64 + a1, m1);
            const float mc_a = __shfl(mA, (c + 63) & 63), mc_b = __shfl(mB, (c + 63) & 63);
            const float mc = c == 0 ? 0.f : (c <= 64 ? mc_a : mc_b);
            const float mn_a = __shfl(mA, c & 63), mn_b = __shfl(mB, c & 63);
            const float mn = c < 64 ? mn_a : mn_b;
            const size_t t = t0 + C.lane;
            const float gi = gates[t * 8 + h] + b_i[h]; const float lf = log_sigmoid(gates[t * 8 + 4 + h] + b_f[h]);
            const float bc = prefix_sum_incl(lf, C.lane); const float bL = __shfl(bc, 63);
            const float Bv = gi - bc; const float cmx = prefix_max_incl(Bv, C.lane);
            const float Aa = -fmaxf(mc, cmx);
            SA[t * 4 + h] = Aa; SB[t * 4 + h] = Bv; SIS[t * 4 + h] = __expf(mc + Aa); SFL[t * 4 + h] = __expf(Aa - bc);
            wsl[h * 64 + C.lane] = __expf(bL + Bv - mn);
            if (C.lane == 0) DEC[bh * 128 + c] = __expf(bL + mc - mn);
        }
        __syncthreads();
        float x3[8], x2[8], x1[8];
        {   const int sb = c * 64 + 32 * rg - 3;
            const bf16* rp = raw + (t0 + 32 * rg - 3) * 2048 + 8 * ct;
            v4u r3 = (v4u){0u, 0u, 0u, 0u}, r2 = r3, r1 = r3;
            if (sb >= 0) r3 = *(const GAS v4u*)(rp); if (sb + 1 >= 0) r2 = *(const GAS v4u*)(rp + 2048); if (sb + 2 >= 0) r1 = *(const GAS v4u*)(rp + 4096);
#pragma unroll
            for (int e = 0; e < 4; ++e) { x3[2 * e] = bf_lo(r3[e]); x3[2 * e + 1] = bf_hi(r3[e]); x2[2 * e] = bf_lo(r2[e]); x2[2 * e + 1] = bf_hi(r2[e]); x1[2 * e] = bf_lo(r1[e]); x1[2 * e + 1] = bf_hi(r1[e]); } }
        const int kh = (ct - 128) >> 5;
        const bf16* rbase = raw + (t0 + 32 * rg) * 2048 + 8 * ct;
        v4u rr[8];
#pragma unroll
        for (int r = 0; r < 8; ++r) rr[r] = *(const GAS v4u*)(rbase + (size_t)r * 2048);
        for (int blk = 0; blk < 4; ++blk) {
            v4u rc[8];
#pragma unroll
            for (int r = 0; r < 8; ++r) rc[r] = rr[r];
            if (blk < 3) {
#pragma unroll
                for (int r = 0; r < 8; ++r) rr[r] = *(const GAS v4u*)(rbase + (size_t)((blk + 1) * 8 + r) * 2048);
            }
            float yy[8][8];
#pragma unroll
            for (int r = 0; r < 8; ++r) {
                float cur[8];
#pragma unroll
                for (int e = 0; e < 4; ++e) { cur[2 * e] = bf_lo(rc[r][e]); cur[2 * e + 1] = bf_hi(rc[r][e]); }
#pragma unroll
                for (int e = 0; e < 8; ++e) { const float sv = (w[0][e] * x3[e] + w[1][e] * x2[e]) + (w[2][e] * x1[e] + w[3][e] * cur[e]);
                    yy[r][e] = sv * __builtin_amdgcn_rcpf(1.f + __builtin_amdgcn_exp2f(-1.4426950408889634f * sv));     x3[e] = x2[e]; x2[e] = x1[e]; x1[e] = cur[e]; }
            }
            if (!isk) {
#pragma unroll
                for (int r = 0; r < 8; ++r) { const int row = 32 * rg + blk * 8 + r; const float* y = yy[r]; if (!(probe & 2))
                    *(GAS v4u*)(Qo + (t0 + row) * 1024 + 8 * ct) = (v4u){pk2(y[0] * 0.0625f, y[1] * 0.0625f), pk2(y[2] * 0.0625f, y[3] * 0.0625f), pk2(y[4] * 0.0625f, y[5] * 0.0625f), pk2(y[6] * 0.0625f, y[7] * 0.0625f)}; }
            } else {
#pragma unroll
                for (int r = 0; r < 8; ++r) { const int row = 32 * rg + blk * 8 + r; const float* y = yy[r]; if (!(probe & 2))
                    *(GAS v4u*)(Ko + (t0 + row) * 1024 + 8 * (ct - 128)) = (v4u){pk2(y[0], y[1]), pk2(y[2], y[3]), pk2(y[4], y[5]), pk2(y[6], y[7])}; }
                float wv[8];
#pragma unroll
                for (int r = 0; r < 8; ++r) wv[r] = wsl[kh * 64 + 32 * rg + blk * 8 + r];
#pragma unroll
                for (int e = 0; e < 8; ++e)
                    *(LAS v4u*)(kst + (8 * (ct - 128) + e) * 128 + (((4 * rg + blk) ^ ((ct - 128) & 7)) * 16)) =
                        (v4u){pk2(yy[0][e] * wv[0], yy[1][e] * wv[1]), pk2(yy[2][e] * wv[2], yy[3][e] * wv[3]), pk2(yy[4][e] * wv[4], yy[5][e] * wv[5]), pk2(yy[6][e] * wv[6], yy[7][e] * wv[7])};
            }
        }
        __syncthreads();
        if (!(probe & 1)) {
#pragma unroll 4
            for (int j = 0; j < 16; ++j) { const int q = j * 512 + C.tid, dg = q >> 3, pc = q & 7;
                const v4u v = *(const LAS v4u*)(kst + dg * 128 + ((pc ^ ((dg >> 3) & 7)) * 16));
                *(GAS v4u*)(kwt + ((size_t)((b * 4 + (dg >> 8)) * NCH + c) * 256 + (dg & 255)) * 64 + pc * 8) = v; } }
        __syncthreads();
    }
}

__device__ __forceinline__ unsigned cvtpk(float lo, float hi);
#define MFMA16(a, b, c) __builtin_amdgcn_mfma_f32_16x16x32_bf16((a), (b), (c), 0, 0, 0)
__device__ __forceinline__ void p3a_scores(const Ctx& C, unsigned char* ws, const bf16* Q, const bf16* K, int first, int stride) {
    const float* SA = (const float*)(ws + WS_SA); const float* SB = (const float*)(ws + WS_SB); float* RS = (float*)(ws + WS_RS); bf16* Pg = (bf16*)(ws + WS_PG);
    LAS float* rsum = (LAS float*)(C.lds + RING_OFF + 92160);
    const int l15 = C.lane & 15, g = C.lane >> 4, tb = C.wave & 3, sh = C.wave >> 2;
    for (int item = first; item < 16 * NCH; item += stride) {
        const int bh = item >> 7, c = item & 127, b = bh >> 2, h = bh & 3; const size_t t0 = (size_t)b * SEQ + c * 64;
        bf16* Pi = Pg + (size_t)item * 4096;
        const int t = tb * 16 + l15;
        bf16x8 qa[8], ka[2][8]; float At = 0.f, Bs[2][4];
        const bool need0 = 2 * sh <= tb, need1 = 2 * sh + 1 <= tb;
        if (need0) {
            const bf16* qp = Q + (t0 + tb * 16 + l15) * 1024 + h * 256 + 8 * g;
#pragma unroll
            for (int ks = 0; ks < 8; ++ks) qa[ks] = *(const GAS bf16x8*)(qp + 32 * ks);
            At = SA[(t0 + t) * 4 + h];
#pragma unroll
            for (int sbi = 0; sbi < 2; ++sbi) { if (sbi == 0 || need1) { const int sb = 2 * sh + sbi; const bf16* kp = K + (t0 + sb * 16 + l15) * 1024 + h * 256 + 8 * g;
#pragma unroll
                for (int ks = 0; ks < 8; ++ks) ka[sbi][ks] = *(const GAS bf16x8*)(kp + 32 * ks);
#pragma unroll
                for (int r = 0; r < 4; ++r) Bs[sbi][r] = SB[(t0 + sb * 16 + 4 * g + r) * 4 + h]; } }
        }
#pragma unroll
        for (int sbi = 0; sbi < 2; ++sbi) {
            const int sb = 2 * sh + sbi;
            if (sb > tb) { *(GAS v2u*)(Pi + t * 64 + sb * 16 + 4 * g) = (v2u){0u, 0u}; if (g == 0) rsum[sb * 64 + t] = 0.f; }
            else {
                f32x4 acc = (f32x4){0.f, 0.f, 0.f, 0.f};
#pragma unroll
                for (int ks = 0; ks < 8; ++ks) acc = MFMA16(ka[sbi][ks], qa[ks], acc);
                float p[4], q = 0.f;
#pragma unroll
                for (int r = 0; r < 4; ++r) { const int s_ = sb * 16 + 4 * g + r; p[r] = (s_ <= t) ? acc[r] * __expf(At + Bs[sbi][r]) : 0.f; q += p[r]; }
                *(GAS v2u*)(Pi + t * 64 + sb * 16 + 4 * g) = (v2u){cvtpk(p[0], p[1]), cvtpk(p[2], p[3])};
                q += __shfl_xor(q, 16); q += __shfl_xor(q, 32);
                if (g == 0) rsum[sb * 64 + t] = q;
            }
        }
        asm volatile("s_waitcnt lgkmcnt(0)\n\ts_barrier" ::: "memory");
        if (C.tid < 64) RS[(t0 + C.tid) * 4 + h] = (rsum[C.tid] + rsum[64 + C.tid]) + (rsum[128 + C.tid] + rsum[192 + C.tid]);
        asm volatile("s_waitcnt lgkmcnt(0)\n\ts_barrier" ::: "memory");
    }
}

template <bool DRY>
__device__ __forceinline__ void p3_intra(const Ctx& C, unsigned char* ws, const float* ml_norm) {
    const float* SA = (const float*)(ws + WS_SA); const float* RS = (const float*)(ws + WS_RS); const bf16* Pg = (const bf16*)(ws + WS_PG);
    const bf16* vt = (const bf16*)(ws + WS_VT); bf16* H = (bf16*)(ws + WS_QKRAW); const unsigned char* OG = (const unsigned char*)(ws + WS_OG);
    const float* SIS = (const float*)(ws + WS_SIS); const float* QN = (const float*)(ws + WS_QN); const float* SFL = (const float*)(ws + WS_SFL);
    LAS float* ssum = (LAS float*)(C.lds + RING_OFF + 9216 + 256);
    const int l15 = C.lane & 15, g = C.lane >> 4;
    for (int item = C.vcu; item < 16 * NCH; item += C.G) {
        const int bh = item >> 7, c = item & 127, b = bh >> 2, h = bh & 3; const size_t t0 = (size_t)b * SEQ + c * 64;
        bf16x8 vfr[2][4], pfr[2][4]; v4u holdr[8]; v2u ogr[8]; float sis8[8], qn8[8], sfl8[8], rs8[8];
#pragma unroll
        for (int ks = 0; ks < 2; ++ks)
#pragma unroll
            for (int vtile = 0; vtile < 4; ++vtile) vfr[ks][vtile] = *(const GAS bf16x8*)(vt + (size_t)(h * VT_ROWS + 64 * C.wave + vtile * 16 + l15) * T + t0 + 32 * ks + 8 * g);
#pragma unroll
        for (int i = 0; i < 8; ++i) { const size_t tr = t0 + 8 * i + (C.lane >> 3); const size_t ho = tr * 2048 + h * 512 + 64 * C.wave + 8 * (C.lane & 7);
            holdr[i] = *(const GAS v4u*)(H + ho); ogr[i] = *(const GAS v2u*)(OG + ho); sis8[i] = SIS[tr * 4 + h]; qn8[i] = QN[tr * 4 + h]; sfl8[i] = SFL[tr * 4 + h]; rs8[i] = RS[tr * 4 + h]; }
#pragma unroll
        for (int ks = 0; ks < 2; ++ks)
#pragma unroll
            for (int t4 = 0; t4 < 4; ++t4) pfr[ks][t4] = *(const GAS bf16x8*)(Pg + (size_t)item * 4096 + (t4 * 16 + l15) * 64 + 32 * ks + 8 * g);
        __builtin_amdgcn_sched_barrier(0);
        const bool skip = DRY && SA[0] < 1e30f;
        f32x4 acc2[4][4];
#pragma unroll
        for (int vtile = 0; vtile < 4; ++vtile)
#pragma unroll
            for (int t4 = 0; t4 < 4; ++t4) acc2[vtile][t4] = (f32x4){0.f, 0.f, 0.f, 0.f};
#pragma unroll
        for (int ks = 0; ks < 2; ++ks) {
#pragma unroll
            for (int vtile = 0; vtile < 4; ++vtile)
#pragma unroll
                for (int t4 = 0; t4 < 4; ++t4) acc2[vtile][t4] = MFMA16(vfr[ks][vtile], pfr[ks][t4], acc2[vtile][t4]);
        }
        LAS unsigned char* stg = C.lds + RING_OFF + 16384 + C.wave * 9216;
#pragma unroll
        for (int vtile = 0; vtile < 4; ++vtile)
#pragma unroll
            for (int t4 = 0; t4 < 4; ++t4) { const f32x4 a = acc2[vtile][t4]; *(LAS v2u*)(stg + (t4 * 16 + l15) * 144 + (vtile * 16 + 4 * g) * 2) = (v2u){cvtpk(a[0], a[1]), cvtpk(a[2], a[3])}; }
        float hh[8][8], ssq8[8];
#pragma unroll
        for (int i = 0; i < 8; ++i) { const int row = 8 * i + (C.lane >> 3); const v4u sv = *(const LAS v4u*)(stg + row * 144 + (C.lane & 7) * 16);
            const float den = rs8[i] + sis8[i] * qn8[i]; const float inv = 1.f / fmaxf(fabsf(den), sfl8[i]); float q = 0.f;
#pragma unroll
            for (int e = 0; e < 4; ++e) { const float a = (bf_lo(sv[e]) + bf_lo(holdr[i][e])) * inv, b = (bf_hi(sv[e]) + bf_hi(holdr[i][e])) * inv; hh[i][2 * e] = a; hh[i][2 * e + 1] = b; q += a * a + b * b; }
            q += __shfl_xor(q, 1); q += __shfl_xor(q, 2); q += __shfl_xor(q, 4); ssq8[i] = q;
            if ((C.lane & 7) == 0) ssum[C.wave * 64 + row] = q; }
        asm volatile("s_waitcnt lgkmcnt(0)\n\ts_barrier" ::: "memory");
        const f32x4 gn0 = *(const f32x4*)(ml_norm + h * 512 + 64 * C.wave + 8 * (C.lane & 7)), gn1 = *(const f32x4*)(ml_norm + h * 512 + 64 * C.wave + 8 * (C.lane & 7) + 4);
        const float gn8[8] = {gn0[0], gn0[1], gn0[2], gn0[3], gn1[0], gn1[1], gn1[2], gn1[3]};
#pragma unroll
        for (int i = 0; i < 8; ++i) { const int row = 8 * i + (C.lane >> 3); float q = 0.f;
#pragma unroll
            for (int w = 0; w < 8; ++w) q += ssum[w * 64 + row];
            const float r = rsqrtf(q * (1.f / 512.f) + 1e-6f); float y[8];
#pragma unroll
            for (int e = 0; e < 8; ++e) y[e] = hh[i][e] * r * gn8[e] * ((float)((ogr[i][e >> 2] >> (8 * (e & 3))) & 255u) * (1.f / 255.f));
            if (!skip) *(GAS v4u*)(H + (t0 + row) * 2048 + h * 512 + 64 * C.wave + 8 * (C.lane & 7)) = (v4u){cvtpk(y[0], y[1]), cvtpk(y[2], y[3]), cvtpk(y[4], y[5]), cvtpk(y[6], y[7])}; }
        asm volatile("s_waitcnt lgkmcnt(0)\n\ts_barrier" ::: "memory");
    }
}

__device__ __forceinline__ unsigned p4_qslot(int t, int c) { return (unsigned)(t * 32 + ((c & 16) | ((c ^ t) & 15))); }
__device__ __forceinline__ unsigned p4_kslot(int row, int c) { return (unsigned)(row * 8 + (c ^ ((((row >> 4) & 1) << 2) | (((row >> 1) & 1) << 1)))); }
__device__ __forceinline__ unsigned cvtpk(float lo, float hi) { typedef float f2_t __attribute__((ext_vector_type(2))); typedef __bf16 b2_t __attribute__((ext_vector_type(2)));
    f2_t v = {lo, hi}; b2_t b = __builtin_convertvector(v, b2_t); return __builtin_bit_cast(unsigned, b); }
template <bool DRY>
__device__ __forceinline__ void p4_scan(const Ctx& C, unsigned char* ws, const bf16* Q) {
    const float* SIS = (const float*)(ws + WS_SIS); const float* DEC = (const float*)(ws + WS_DEC); float* QN = (float*)(ws + WS_QN);
    const bf16* vt = (const bf16*)(ws + WS_VT); const bf16* kwt = (const bf16*)(ws + WS_KWT); bf16* H = (bf16*)(ws + WS_QKRAW);
    const int l15 = C.lane & 15, g = C.lane >> 4;
    const unsigned lds0 = (unsigned)(uintptr_t)(C.lds + RING_OFF);
    for (int id = (int)blockIdx.x; id < 144; id += C.G) {
        const int bh = (id & 7) * 2 + (id < 128 ? (id >> 6) : ((id - 128) >> 3)); const int vblk = id < 128 ? (((id >> 3) & 7) * 4 + C.wave) : 32;
        const bool active = id < 128 ? (C.wave < 4) : (C.wave == 0);
        const bool loader = C.wave >= 4;
        const int b = bh >> 2, h = bh & 3;
        unsigned qoff[8], koff[8];
#pragma unroll
        for (int i = 0; i < 8; ++i) { const int sg = 64 * (8 * (C.wave & 3) + i) + C.lane;
            { const int t = sg >> 5, cp = sg & 31, c = (cp & 16) | ((cp ^ t) & 15); qoff[i] = (unsigned)((t * 1024 + c * 8) * 2); }
            { const int row = sg >> 3, cp = sg & 7, c = cp ^ ((((row >> 4) & 1) << 2) | (((row >> 1) & 1) << 1)); koff[i] = (unsigned)((row * 64 + c * 8) * 2); } }
        const char* qsrc = (const char*)(Q + (size_t)b * SEQ * 1024 + h * 256); const char* ksrc = (const char*)(kwt + (size_t)bh * NCH * 16384);
#define P4_DMA(cc, buf) do { if (loader) { _Pragma("unroll") for (int i_ = 0; i_ < 8; ++i_) \
            attn_body::glds16(qsrc + (size_t)(cc) * (64 * 1024 * 2) + qoff[i_], (unsigned)__builtin_amdgcn_readfirstlane(lds0 + (buf) * 65536 + (8 * (C.wave & 3) + i_) * 1024)); \
            _Pragma("unroll") for (int i_ = 0; i_ < 8; ++i_) \
            attn_body::glds16(ksrc + (size_t)(cc) * (16384 * 2) + koff[i_], (unsigned)__builtin_amdgcn_readfirstlane(lds0 + (buf) * 65536 + 32768 + (8 * (C.wave & 3) + i_) * 1024)); } } while (0)
        P4_DMA(0, 0);
        const bf16* vbase = vt + (size_t)(h * VT_ROWS + vblk * 16 + l15) * T + (size_t)b * SEQ + 8 * g;
        f32x4 X[16];
#pragma unroll
        for (int db = 0; db < 16; ++db) X[db] = (f32x4){0.f, 0.f, 0.f, 0.f};
        bf16x8 vcur[2]; vcur[0] = vcur[1] = (bf16x8){0, 0, 0, 0, 0, 0, 0, 0};
        float isc[4] = {0.f, 0.f, 0.f, 0.f}, dec = 0.f;
        if (active) { vcur[0] = *(const GAS bf16x8*)(vbase); vcur[1] = *(const GAS bf16x8*)(vbase + 32);
#pragma unroll
            for (int t4 = 0; t4 < 4; ++t4) isc[t4] = SIS[((size_t)b * SEQ + 16 * t4 + l15) * 4 + h];
            dec = DEC[bh * 128]; }
        asm volatile("s_waitcnt vmcnt(0)\n\ts_barrier" ::: "memory");
        bf16x8 vodd[2]; vodd[0] = vcur[0]; vodd[1] = vcur[1]; float decodd = 0.f;
        auto chunk = [&](const int c, bf16x8 (&vc)[2], bf16x8 (&vn)[2], float& dc, float& dn) __attribute__((always_inline)) {
            const int buf = c & 1;
            if (c + 1 < NCH && !(DRY && MK_P4_HALFLDS > 1)) P4_DMA(c + 1, buf ^ 1);
            if (active) {
                const size_t t0 = (size_t)b * SEQ + c * 64;
                const LAS unsigned char* qb = C.lds + RING_OFF + buf * 65536 + l15 * 512; const LAS unsigned char* kb = C.lds + RING_OFF + buf * 65536 + 32768 + (8 * (l15 >> 2) + (l15 & 3)) * 128;
                int qx[4];
#pragma unroll
                for (int k3 = 0; k3 < 4; ++k3) qx[k3] = (((4 * k3 + g) ^ l15) & 15) * 16;
                const int hl = (((l15 >> 3) & 1) << 2) | (((l15 >> 1) & 1) << 1); const int kx0 = (g ^ hl) * 16, kx1 = kx0 ^ 64;
                f32x4 hi[4];
#pragma unroll
                for (int t4 = 0; t4 < 4; ++t4) hi[t4] = (f32x4){0.f, 0.f, 0.f, 0.f};
                bf16x8 qf[2][4];
#pragma unroll
                for (int t4 = 0; t4 < 4; ++t4) qf[0][t4] = *(const LAS bf16x8*)(qb + qx[0] + t4 * 8192);
#pragma unroll
                for (int ks = 0; ks < 8; ++ks) {
                    if (ks + 1 < 8 && !(DRY && MK_P4_HALFLDS)) {
#pragma unroll
                        for (int t4 = 0; t4 < 4; ++t4) qf[(ks + 1) & 1][t4] = *(const LAS bf16x8*)(qb + qx[(ks + 1) & 3] + t4 * 8192 + ((ks + 1) >> 2) * 256);
                    }
                    const f32x4 lo = X[2 * ks], up = X[2 * ks + 1];
                    const bf16x8 xfr = __builtin_bit_cast(bf16x8, (v4u){cvtpk(lo[0], lo[1]), cvtpk(lo[2], lo[3]), cvtpk(up[0], up[1]), cvtpk(up[2], up[3])});
                    __builtin_amdgcn_sched_barrier(0);
#pragma unroll
                    for (int t4 = 0; t4 < 4; ++t4) hi[t4] = MFMA16(xfr, qf[ks & 1][t4], hi[t4]);
                    __builtin_amdgcn_sched_barrier(0);
                }
                asm volatile("" :: "v"(dc), "v"(vc[0]), "v"(vc[1]));
                if (DRY && DEC[0] < 1e30f) { }
                else if (vblk < 32) {
#pragma unroll
                    for (int t4 = 0; t4 < 4; ++t4) { const f32x4 o = hi[t4] * isc[t4];
                        *(GAS v2u*)(H + (t0 + 16 * t4 + l15) * 2048 + h * 512 + vblk * 16 + 4 * g) = (v2u){cvtpk(o[0], o[1]), cvtpk(o[2], o[3])}; }
                } else if (g == 0) {
#pragma unroll
                    for (int t4 = 0; t4 < 4; ++t4) QN[(t0 + 16 * t4 + l15) * 4 + h] = hi[t4][0];
                }
                if (c + 1 < NCH) { vn[0] = *(const GAS bf16x8*)(vbase + (c + 1) * 64); vn[1] = *(const GAS bf16x8*)(vbase + (c + 1) * 64 + 32);
#pragma unroll
                    for (int t4 = 0; t4 < 4; ++t4) isc[t4] = SIS[(t0 + 64 + 16 * t4 + l15) * 4 + h];
                    dn = DEC[bh * 128 + c + 1]; }
                bf16x8 kf[2][4];
#define P4_KOFF(db) ((32 * ((db) >> 1) + 4 * ((db) & 1)) * 128)
                kf[0][0] = *(const LAS bf16x8*)(kb + kx0 + P4_KOFF(0)); kf[0][1] = *(const LAS bf16x8*)(kb + kx1 + P4_KOFF(0));
                kf[0][2] = *(const LAS bf16x8*)(kb + kx0 + P4_KOFF(1)); kf[0][3] = *(const LAS bf16x8*)(kb + kx1 + P4_KOFF(1));
#pragma unroll
                for (int dp = 0; dp < 8; ++dp) {
                    if (dp + 1 < 8 && !(DRY && MK_P4_HALFLDS)) {
                        kf[(dp + 1) & 1][0] = *(const LAS bf16x8*)(kb + kx0 + P4_KOFF(2 * dp + 2)); kf[(dp + 1) & 1][1] = *(const LAS bf16x8*)(kb + kx1 + P4_KOFF(2 * dp + 2));
                        kf[(dp + 1) & 1][2] = *(const LAS bf16x8*)(kb + kx0 + P4_KOFF(2 * dp + 3)); kf[(dp + 1) & 1][3] = *(const LAS bf16x8*)(kb + kx1 + P4_KOFF(2 * dp + 3));
                    }
                    f32x4 xa = X[2 * dp] * dc, xb = X[2 * dp + 1] * dc;
                    __builtin_amdgcn_sched_barrier(0);
                    xa = MFMA16(kf[dp & 1][0], vc[0], xa); xb = MFMA16(kf[dp & 1][2], vc[0], xb);
                    xa = MFMA16(kf[dp & 1][1], vc[1], xa); xb = MFMA16(kf[dp & 1][3], vc[1], xb);
                    __builtin_amdgcn_sched_barrier(0);
                    X[2 * dp] = xa; X[2 * dp + 1] = xb;
                }
#undef P4_KOFF
            }
            if (loader) asm volatile("s_waitcnt vmcnt(0)\n\ts_barrier" ::: "memory");
            else asm volatile("s_waitcnt lgkmcnt(0)\n\ts_barrier" ::: "memory");
        };
        for (int c = 0; c < NCH; c += 2) { chunk(c, vcur, vodd, dec, decodd); chunk(c + 1, vodd, vcur, decodd, dec); }
#undef P4_DMA
    }
}

template <bool DRY>
__device__ __forceinline__ void p5_headnorm(const Ctx& C, unsigned char* ws, const float* ml_norm) {
    const float* RS = (const float*)(ws + WS_RS); const float* SIS = (const float*)(ws + WS_SIS); const float* QN = (const float*)(ws + WS_QN); const float* SFL = (const float*)(ws + WS_SFL);
    bf16* H = (bf16*)(ws + WS_QKRAW); const bf16* OG = (const bf16*)(ws + WS_OG);
    for (int idx = C.gw; idx < T * 4; idx += C.NGW) {
        const int h = idx & 3; const size_t t = idx >> 2;
        const float den = RS[idx] + SIS[idx] * QN[idx]; const float inv = 1.f / fmaxf(fabsf(den), SFL[idx]);
        bf16* hp = H + t * 2048 + h * 512 + 8 * C.lane;
        const v4u hv = *(const GAS v4u*)hp; const v4u ov = *(const GAS v4u*)(OG + t * 2048 + h * 512 + 8 * C.lane);
        float x[8], o[8]; float ss = 0.f;
#pragma unroll
        for (int e = 0; e < 4; ++e) { x[2 * e] = bf_lo(hv[e]) * inv; x[2 * e + 1] = bf_hi(hv[e]) * inv; o[2 * e] = bf_lo(ov[e]); o[2 * e + 1] = bf_hi(ov[e]); }
#pragma unroll
        for (int e = 0; e < 8; ++e) ss += x[e] * x[e];
        const float rstd = rsqrtf(wave_sum(ss) * (1.f / 512.f) + 1e-6f);
        const f32x4 g0 = *(const f32x4*)(ml_norm + h * 512 + 8 * C.lane), g1 = *(const f32x4*)(ml_norm + h * 512 + 8 * C.lane + 4);
        const float gn[8] = {g0.x, g0.y, g0.z, g0.w, g1.x, g1.y, g1.z, g1.w};
        float y[8];
#pragma unroll
        for (int e = 0; e < 8; ++e) y[e] = x[e] * rstd * gn[e] * sigmoidf_(o[e]);
        if (!(DRY && RS[0] < 1e30f)) *(GAS v4u*)hp = (v4u){pk2(y[0], y[1]), pk2(y[2], y[3]), pk2(y[4], y[5]), pk2(y[6], y[7])};
    }
}

__device__ __forceinline__ void conv_moe_weights(const Ctx& C, const float* w_gu_l, const float* w_down_l, bf16* wgu, bf16* wdn, const float* gffn) {
    LAS float* scr = (LAS float*)(C.lds + RING_OFF + C.wave * 16384);
    constexpr int I_GU = 32 * 16 * 16, I_DN = 32 * 4 * 32;
#define MOE_SRC(it, W_, ld_, k0_, c0_, ksc_) do { if ((it) < I_GU) { const int e_ = (it) >> 8, r_ = (it) & 255; W_ = w_gu_l + (size_t)e_ * 1024 * 512; ld_ = 512; k0_ = (r_ >> 4) * 64; c0_ = (r_ & 15) * 32; ksc_ = gffn; } \
        else { const int r0_ = (it) - I_GU, e_ = r0_ >> 7, r_ = r0_ & 127; W_ = w_down_l + (size_t)e_ * 256 * 1024; ld_ = 1024; k0_ = (r_ >> 5) * 64; c0_ = (r_ & 31) * 32; ksc_ = nullptr; } } while (0)
    int it = C.gw; if (it >= I_GU + I_DN) return;
    f32x4 wv[8]; float ks[8];
    { const float* W_; int ld_, k0_, c0_; const float* ksc_; MOE_SRC(it, W_, ld_, k0_, c0_, ksc_); tr_load(wv, ks, W_, ld_, k0_, c0_, C.lane, ksc_); }
    for (;;) {
        const int nx = it + C.NGW; const bool more = nx < I_GU + I_DN;
        f32x4 wn[8]; float kn[8];
#pragma unroll
        for (int i = 0; i < 8; ++i) { wn[i] = wv[i]; kn[i] = ks[i]; }
        if (more) { const float* W_; int ld_, k0_, c0_; const float* ksc_; MOE_SRC(nx, W_, ld_, k0_, c0_, ksc_); tr_load(wn, kn, W_, ld_, k0_, c0_, C.lane, ksc_); }
        if (it < I_GU) { const int e = it >> 8, r = it & 255, kb = r >> 4, nb = r & 15, n0 = nb * 32;
            const int half = n0 >> 8, jj = (n0 & 255) >> 7, i0 = n0 & 127;
            tr_finish(wv, ks, 1024, kb * 64, wgu, e * 512 + jj * 256 + half * 128 + i0, scr, C.lane); }
        else { const int r0 = it - I_GU, e = r0 >> 7, r = r0 & 127, kb = r >> 5, nb = r & 31;
            tr_finish(wv, ks, 256, kb * 64, wdn, e * 1024 + nb * 32, scr, C.lane); }
        if (!more) break;
#pragma unroll
        for (int i = 0; i < 8; ++i) { wv[i] = wn[i]; ks[i] = kn[i]; }
        it = nx;
    }
#undef MOE_SRC
}
__device__ __forceinline__ void conv_da_weights(const Ctx& C, const float* da_w_in, const float* da_w_out, unsigned char* ws, const float* gmix) {
    LAS float* scr = (LAS float*)(C.lds + RING_OFF + C.wave * 16384);
    bf16* win = (bf16*)(ws + WS_WDA_IN); bf16* wout = (bf16*)(ws + WS_WDA_OUT);
    constexpr int I_IN = 16 * 96, I_OUT = 16 * 32;
    for (int it = C.gw; it < I_IN + I_OUT; it += C.NGW) {
        if (it < I_IN) { const int kb = it / 96, nb = it % 96; tr_item(da_w_in, 3072, 1024, kb * 64, nb * 32, win, nb * 32, scr, C.lane, gmix); }
        else { const int r = it - I_IN, kb = r >> 5, nb = r & 31; tr_item(da_w_out, 1024, 1024, kb * 64, nb * 32, wout, nb * 32, scr, C.lane); }
    }
}

__device__ __forceinline__ void p7_route(const Ctx& C, const bf16* xres, const float* norm_g, const float* b_group, const float* b_expert, int layer, unsigned char* ws, int cbank) {
    const bf16* WRH = (const bf16*)(ws + WS_WR) + (size_t)layer * (32 * 3 * 4 * 16 * 8); const bf16* WRL = WRH + 2 * 32 * 3 * 4 * 16 * 8;
    int* TE = (int*)(ws + WS_TE); int* TPOS = (int*)(ws + WS_TPOS); int* E2T = (int*)(ws + WS_E2T); float* EW = (float*)(ws + WS_EW); float* ERS = (float*)(ws + WS_ERS);
    unsigned* CNT = (unsigned*)(ws + WS_CTL) + CW_CNT + 64 * cbank;
    LAS float* lg = (LAS float*)(C.lds + RING_OFF + C.wave * 3072);
    LAS int* lcnt = (LAS int*)(C.lds + RING_OFF + 32768); LAS int* lbase = lcnt + 32;
    const int l15 = C.lane & 15, g = C.lane >> 4;
    for (int base = 0; base < T / 16; base += C.NGW) {
        const int grp = base + C.gw; const bool valid = grp < T / 16;
        if (C.tid < 32) lcnt[C.tid] = 0;
        __syncthreads();
        int E1 = 0, E2 = 0, lp1 = 0, lp2 = 0; float w1 = 0.f, w2 = 0.f, rstd = 0.f;
        const size_t row = (size_t)(valid ? grp : 0) * 16 + l15;
        if (valid) {
            f32x4 acc[3]; acc[0] = acc[1] = acc[2] = (f32x4){0.f, 0.f, 0.f, 0.f}; float ss = 0.f;
            const bf16* xq = xres + row * D + 8 * g;
            const bf16* wh = WRH + (size_t)(g * 16 + l15) * 8; const bf16* wl = WRL + (size_t)(g * 16 + l15) * 8;
#pragma unroll 4
            for (int ks = 0; ks < 32; ++ks) {
                const v4u xv = *(const GAS v4u*)(xq + 32 * ks);
                bf16x8 bh[3], bl[3];
#pragma unroll
                for (int ctile = 0; ctile < 3; ++ctile) { bh[ctile] = *(const GAS bf16x8*)(wh + (size_t)(ks * 3 + ctile) * 512); bl[ctile] = *(const GAS bf16x8*)(wl + (size_t)(ks * 3 + ctile) * 512); }
#pragma unroll
                for (int e = 0; e < 4; ++e) { const float a = bf_lo(xv[e]), b = bf_hi(xv[e]); ss += a * a + b * b; }
                const bf16x8 ah = __builtin_bit_cast(bf16x8, xv);
#pragma unroll
                for (int ctile = 0; ctile < 3; ++ctile) { acc[ctile] = MFMA16(ah, bh[ctile], acc[ctile]); acc[ctile] = MFMA16(ah, bl[ctile], acc[ctile]); }
            }
            ss += __shfl_xor(ss, 16); ss += __shfl_xor(ss, 32);
            rstd = rsqrtf(ss * (1.f / D) + 1e-6f);
#pragma unroll
            for (int ctile = 0; ctile < 3; ++ctile)
#pragma unroll
                for (int r = 0; r < 4; ++r) lg[(4 * g + r) * 48 + ctile * 16 + l15] = acc[ctile][r];
            LDS_WAIT(); asm volatile("" ::: "memory");
            if (C.lane < 16) {
                const LAS float* my = lg + C.lane * 48;
                float gl[4]; int gi = 0; float gmax;
#pragma unroll
                for (int j = 0; j < 4; ++j) gl[j] = rstd * my[j] + b_group[layer * 4 + j];
                gmax = gl[0];
#pragma unroll
                for (int j = 1; j < 4; ++j) if (gl[j] > gmax) { gmax = gl[j]; gi = j; }
                float gsum = 0.f;
#pragma unroll
                for (int j = 0; j < 4; ++j) gsum += __expf(gl[j] - gmax);
                const float g_w = 1.f / gsum;
                float el[8];
#pragma unroll
                for (int j = 0; j < 8; ++j) el[j] = rstd * my[4 + gi * 8 + j] + b_expert[layer * 32 + gi * 8 + j];
                int i1 = 0; float e1 = el[0];
#pragma unroll
                for (int j = 1; j < 8; ++j) if (el[j] > e1) { e1 = el[j]; i1 = j; }
                int i2 = -1; float e2 = -INFINITY;
#pragma unroll
                for (int j = 0; j < 8; ++j) if (j != i1 && el[j] > e2) { e2 = el[j]; i2 = j; }
                const float r2 = __expf(e2 - e1); const float p1 = 1.f / (1.f + r2), p2 = r2 * p1;
                w1 = g_w * p1; w2 = g_w * p2; E1 = gi * 8 + i1; E2 = gi * 8 + i2;
                lp1 = __hip_atomic_fetch_add(lcnt + E1, 1, __ATOMIC_RELAXED, __HIP_MEMORY_SCOPE_WORKGROUP);
                lp2 = __hip_atomic_fetch_add(lcnt + E2, 1, __ATOMIC_RELAXED, __HIP_MEMORY_SCOPE_WORKGROUP);
            }
        }
        __syncthreads();
        if (C.tid < 32) { const int n = lcnt[C.tid]; lbase[C.tid] = n ? (int)__hip_atomic_fetch_add(CNT + C.tid, (unsigned)n, RLX_AGENT) : 0; }
        __syncthreads();
        if (valid) {
            if (C.lane < 16) { const int p1 = lbase[E1] + lp1, p2 = lbase[E2] + lp2; TE[row * 2] = E1; TE[row * 2 + 1] = E2; TPOS[row * 2] = p1; TPOS[row * 2 + 1] = p2;
                E2T[(size_t)E1 * T + p1] = (int)row; E2T[(size_t)E2 * T + p2] = (int)row; EW[(size_t)E1 * T + p1] = w1; EW[(size_t)E2 * T + p2] = w2; ERS[(size_t)E1 * T + p1] = rstd; ERS[(size_t)E2 * T + p2] = rstd; }
        }
        __syncthreads();
    }
}

__device__ __forceinline__ void moe_tables(const Ctx& C, int layer, unsigned char* ws) {
    const unsigned* CNT = (const unsigned*)(ws + WS_CTL) + CW_CNT + 64 * layer;
    LAS int* pexp = (LAS int*)(C.lds + TAB_PEXP); LAS int* eoff = (LAS int*)(C.lds + TAB_EOFF); LAS int* npp = (LAS int*)(C.lds + TAB_NP);
    if (C.tid == 0) { int off = 0, p = 0;
        for (int e = 0; e < NEXP; ++e) { const int n = (int)__hip_atomic_load(CNT + e, RLX_AGENT); eoff[e] = off; const int np_e = (n + 255) >> 8;
            for (int q = 0; q < np_e && p < MAXPANEL; ++q) pexp[p++] = e; off += np_e << 8; }
        eoff[NEXP] = off; npp[0] = p; }
    __syncthreads();
}

template <bool FINAL, bool DRY>
__device__ __forceinline__ void p11_combine(const Ctx& C, bf16* xio, float* fout, const float* gnorm, unsigned char* ws) {
    float* rstd_out = (float*)(ws + WS_RSTD);
    const int* TE = (const int*)(ws + WS_TE); const int* TPOS = (const int*)(ws + WS_TPOS); const LAS int* eoff = (const LAS int*)(C.lds + TAB_EOFF); const bf16* YS = (const bf16*)(ws + WS_YS);
    f32x4 gn[4];
#pragma unroll
    for (int j = 0; j < 4; ++j) gn[j] = *(const f32x4*)(gnorm + 4 * C.lane + 256 * j);
    v2u xn[4], an[4], bn[4];
#define P11_LOAD(tt) do { const int s0_ = eoff[TE[(tt) * 2]] + TPOS[(tt) * 2], s1_ = eoff[TE[(tt) * 2 + 1]] + TPOS[(tt) * 2 + 1]; \
        const GAS v2u* xr_ = (const GAS v2u*)(xio + (size_t)(tt) * D) + C.lane; const GAS v2u* y0_ = (const GAS v2u*)(YS + (size_t)s0_ * D) + C.lane; const GAS v2u* y1_ = (const GAS v2u*)(YS + (size_t)s1_ * D) + C.lane; \
        _Pragma("unroll") for (int j = 0; j < 4; ++j) { xn[j] = xr_[64 * j]; an[j] = y0_[64 * j]; bn[j] = y1_[64 * j]; } } while (0)
    if (C.gw < T) P11_LOAD(C.gw);
    for (int t = C.gw; t < T; t += C.NGW) {
        GAS v2u* xr = (GAS v2u*)(xio + (size_t)t * D) + C.lane; GAS f32x4* fr_ = (GAS f32x4*)(fout + (size_t)t * D) + C.lane;
        f32x4 v[4]; v2u ya[4], yb[4]; float ss = 0.f;
#pragma unroll
        for (int j = 0; j < 4; ++j) { v[j] = (f32x4){bf_lo(xn[j].x), bf_hi(xn[j].x), bf_lo(xn[j].y), bf_hi(xn[j].y)}; ya[j] = an[j]; yb[j] = bn[j]; }
        if (t + C.NGW < T) P11_LOAD(t + C.NGW);
#pragma unroll
        for (int j = 0; j < 4; ++j) { const v2u a = ya[j], b = yb[j];
            v[j].x += bf_lo(a.x) + bf_lo(b.x); v[j].y += bf_hi(a.x) + bf_hi(b.x); v[j].z += bf_lo(a.y) + bf_lo(b.y); v[j].w += bf_hi(a.y) + bf_hi(b.y);
            ss += (v[j].x * v[j].x + v[j].y * v[j].y) + (v[j].z * v[j].z + v[j].w * v[j].w); }
        const float rstd = rsqrtf(wave_sum(ss) * (1.f / D) + 1e-6f);
        if (DRY && gnorm[0] < 1e30f) { }
        else if (FINAL) {
#pragma unroll
            for (int j = 0; j < 4; ++j) fr_[64 * j] = v[j] * rstd * gn[j];
        } else {
#pragma unroll
            for (int j = 0; j < 4; ++j) xr[64 * j] = (v2u){pk2(v[j].x, v[j].y), pk2(v[j].z, v[j].w)};
            if (C.lane == 0) rstd_out[t] = rstd;
        }
    }
}

#undef P11_LOAD
__device__ __forceinline__ void p14_diffnorm(const Ctx& C, const float* lq1, const float* lk1, const float* lq2, const float* lk2, const float* da_norm, unsigned char* ws) {
    const bf16* O = (const bf16*)(ws + WS_AO); bf16* A2 = (bf16*)(ws + WS_HN);
    const float lam = __expf(wave_sum(lq1[C.lane] * lk1[C.lane])) - __expf(wave_sum(lq2[C.lane] * lk2[C.lane])) + LAMBDA_INIT1;
    const float g0 = da_norm[2 * C.lane] * (1.f - LAMBDA_INIT1), g1 = da_norm[2 * C.lane + 1] * (1.f - LAMBDA_INIT1);
    for (int t = C.gw; t < T; t += C.NGW) {
#pragma unroll
        for (int h = 0; h < 8; ++h) {
            const unsigned a = *(const GAS unsigned*)(O + (size_t)t * 2048 + h * 256 + 2 * C.lane), b = *(const GAS unsigned*)(O + (size_t)t * 2048 + h * 256 + 128 + 2 * C.lane);
            const float d0 = bf_lo(a) - lam * bf_lo(b), d1 = bf_hi(a) - lam * bf_hi(b);
            const float rstd = rsqrtf(wave_sum(d0 * d0 + d1 * d1) * (1.f / 128.f) + 1e-5f);
            *(GAS unsigned*)(A2 + (size_t)t * D + h * 128 + 2 * C.lane) = pk2(d0 * rstd * g0, d1 * rstd * g1);
        }
    }
}

__device__ __forceinline__ Ctx make_ctx(unsigned char* lds) {
    Ctx C; int t = threadIdx.x; asm volatile("" : "+v"(t));
    C.lds = (LAS unsigned char*)lds;
    C.tid = t; C.lane = t & 63; C.wave = __builtin_amdgcn_readfirstlane(t >> 6);
    C.G = gridDim.x; { const int bx = blockIdx.x; C.vcu = (C.G % 8 == 0) ? (bx % 8) * (C.G / 8) + bx / 8 : bx; }
    C.gw = C.vcu * NWAVES + C.wave; C.NGW = C.G * NWAVES;
    return C;
}
struct Args { const float* in[23]; float* out; unsigned char* ws; };
#ifndef MK_DUP
#define MK_DUP 0
#endif
#define DUP(k) ((MK_DUP >> (k)) & 1)
#ifndef MK_PHASE_LO
#define MK_PHASE_LO 0
#endif
#ifndef MK_PHASE_HI
#define MK_PHASE_HI 99
#endif
__global__ void __launch_bounds__(NWAVES * 64, 2) mk_fwd(Args args) {
    extern __shared__ __attribute__((aligned(16))) unsigned char lds[];
    Ctx C = make_ctx(lds);
#define FRESH() C = make_ctx(lds); LOADARGS()
    typedef const __attribute__((address_space(4))) Args* ArgP;
#define LOADARGS() ArgP A_ = (ArgP)__builtin_amdgcn_kernarg_segment_ptr(); asm volatile("" : "+s"(A_)); unsigned char* const ws = A_->ws; float* const out = A_->out; (void)out
#define xin (A_->in[0])
#define norm_mix (A_->in[1])
#define norm_ffn (A_->in[2])
#define ml_w_in (A_->in[3])
#define ml_conv (A_->in[4])
#define ml_b_i (A_->in[5])
#define ml_b_f (A_->in[6])
#define ml_norm (A_->in[7])
#define ml_w_out (A_->in[8])
#define da_w_in (A_->in[9])
#define da_lq1 (A_->in[10])
#define da_lk1 (A_->in[11])
#define da_lq2 (A_->in[12])
#define da_lk2 (A_->in[13])
#define da_norm (A_->in[14])
#define da_w_out (A_->in[15])
#define moe_w_group (A_->in[16])
#define moe_b_group (A_->in[17])
#define moe_w_expert (A_->in[18])
#define moe_b_expert (A_->in[19])
#define moe_w_gu (A_->in[20])
#define moe_w_down (A_->in[21])
#define final_norm (A_->in[22])
    for (int u = C.tid; u < (LDS_BYTES - LDSCTL_OFF) / 4; u += NWAVES * 64) ((LAS unsigned*)(C.lds + LDSCTL_OFF))[u] = 0u;
    __syncthreads();
    volatile LAS unsigned* MISC = (volatile LAS unsigned*)(C.lds + MISC_OFF);
    XcdBarrier bar; { LOADARGS(); bar = xcd_barrier_post((unsigned*)(ws + WS_CTL) + CW_BAR, MISC + 8); }
#define GRID_BAR() xcd_barrier(bar)
#define PH(k) ((k) <= MK_PHASE_HI && (k) >= MK_PHASE_LO)
#define MFMA_SPIN(k) if (DUP(k)) { typedef short b8_ __attribute__((ext_vector_type(8))); f32x4 s0_ = {0.f, 0.f, 0.f, 0.f}, s1_ = s0_, s2_ = s0_, s3_ = s0_; b8_ xx_ = {0, 0, 0, 0, 0, 0, 0, 0}; asm volatile("" : "+v"(xx_)); \
        for (int i_ = 0; i_ < 5000; ++i_) { s0_ = __builtin_amdgcn_mfma_f32_16x16x32_bf16(xx_, xx_, s0_, 0, 0, 0); s1_ = __builtin_amdgcn_mfma_f32_16x16x32_bf16(xx_, xx_, s1_, 0, 0, 0); \
            s2_ = __builtin_amdgcn_mfma_f32_16x16x32_bf16(xx_, xx_, s2_, 0, 0, 0); s3_ = __builtin_amdgcn_mfma_f32_16x16x32_bf16(xx_, xx_, s3_, 0, 0, 0); } \
        asm volatile("" :: "v"(s0_), "v"(s1_), "v"(s2_), "v"(s3_)); GRID_BAR(); }
#define hn0 ((bf16*)out)
#define Qm ((bf16*)out)
#define Km ((bf16*)out + (size_t)T * 1024)
#define HN ((bf16*)(ws + WS_HN))
#define XB ((bf16*)out)
#define XB2 ((bf16*)(ws + WS_AQ))
    const int bx = (int)blockIdx.x;

#ifndef MK_NO_P0
    { FRESH();
    p0_prologue(C, xin, norm_mix, ml_w_in, ml_w_out, norm_ffn, moe_w_group, moe_w_expert, ws, hn0); }
#define P0ONCE { GRID_BAR(); FRESH(); p0_prologue(C, xin, norm_mix, ml_w_in, ml_w_out, norm_ffn, moe_w_group, moe_w_expert, ws, hn0); }
    if (DUP(0)) { P0ONCE P0ONCE P0ONCE P0ONCE }
#endif
    GRID_BAR();
    MFMA_SPIN(22)
    if (PH(1)) { FRESH();
        p1_gate_chunks(C, ml_b_i, ml_b_f, ws);
        { pg8::Gemm g{hn0, (const bf16*)(ws + WS_WML_IN), T, 4096, D}; pg8::StaticOrder S; S.init(T, 4096, C.G, bx);
          pg8::EpiQKO E{(bf16*)(ws + WS_QKRAW), (unsigned char*)(ws + WS_OG)};
          pg8::gemm_phase<pg8::EpiQKO, pg8::StaticOrder, true, true>(C.lds + RING_OFF, g, S, E); }
        { pg8::Gemm g{(const bf16*)(ws + WS_WML_IN) + (size_t)4096 * D, hn0, 2048, T, D}; pg8::StaticOrder S; S.init(2048, T, C.G, bx);
          pg8::EpiBf16S E{(bf16*)(ws + WS_VT), T, 0, 0, 1.f, 0x7fffffff, VT_ROWS - 512, nullptr};
          pg8::gemm_phase<pg8::EpiBf16S, pg8::StaticOrder, true, true>(C.lds + RING_OFF, g, S, E); }
        if (DUP(1)) {
        { pg8::Gemm g{hn0, (const bf16*)(ws + WS_WML_IN), T, 4096, D}; pg8::StaticOrder S; S.init(T, 4096, C.G, bx);
          pg8::EpiQKO E{(bf16*)(ws + WS_QKRAW), (unsigned char*)(ws + WS_OG)};
          pg8::gemm_phase<pg8::EpiQKO, pg8::StaticOrder, true, true>(C.lds + RING_OFF, g, S, E); }
        { pg8::Gemm g{(const bf16*)(ws + WS_WML_IN) + (size_t)4096 * D, hn0, 2048, T, D}; pg8::StaticOrder S; S.init(2048, T, C.G, bx);
          pg8::EpiBf16S E{(bf16*)(ws + WS_VT), T, 0, 0, 1.f, 0x7fffffff, VT_ROWS - 512, nullptr};
          pg8::gemm_phase<pg8::EpiBf16S, pg8::StaticOrder, true, true>(C.lds + RING_OFF, g, S, E); }
        }
        GRID_BAR();
    }
    if (PH(2)) { FRESH(); p2_conv(C, ml_b_i, ml_b_f, ml_conv, ws, Qm, Km); GRID_BAR(); }
#ifndef MK_P2_PROBE
#define MK_P2_PROBE 0
#endif
#define P2ONCE { FRESH(); int pr_ = MK_P2_PROBE; asm volatile("" : "+s"(pr_)); p2_conv(C, ml_b_i, ml_b_f, ml_conv, ws, Qm, Km, pr_); GRID_BAR(); }
    if (DUP(2)) { P2ONCE P2ONCE P2ONCE P2ONCE }
    if (DUP(4)) { { FRESH(); p4_scan<true>(C, ws, Qm); GRID_BAR(); } { FRESH(); p4_scan<true>(C, ws, Qm); GRID_BAR(); } }
    if (DUP(28)) { FRESH(); p4_scan<false>(C, ws, Qm); GRID_BAR(); }
    if (DUP(27)) { FRESH();
        if (C.G > 144) { if ((int)blockIdx.x >= 144) { p3a_scores(C, ws, Qm, Km, (int)blockIdx.x - 144, C.G - 144);
                Ctx Cf = C; Cf.gw = ((int)blockIdx.x - 144) * NWAVES + C.wave; Cf.NGW = (C.G - 144) * NWAVES; conv_da_weights(Cf, da_w_in, da_w_out, ws, norm_mix + D); conv_ml_out(Cf, ml_w_out, ws); conv_moe_weights(Cf, moe_w_gu, moe_w_down, (bf16*)(ws + WS_WGU0), (bf16*)(ws + WS_WDN0), norm_ffn); }
            else p4_scan<false>(C, ws, Qm); }
        else { p4_scan<false>(C, ws, Qm); p3a_scores(C, ws, Qm, Km, (int)blockIdx.x, C.G); conv_da_weights(C, da_w_in, da_w_out, ws, norm_mix + D); conv_ml_out(C, ml_w_out, ws); conv_moe_weights(C, moe_w_gu, moe_w_down, (bf16*)(ws + WS_WGU0), (bf16*)(ws + WS_WDN0), norm_ffn); }
        GRID_BAR(); }
    if (PH(4)) { FRESH();
        if (C.G > 144) { if ((int)blockIdx.x >= 144) { p3a_scores(C, ws, Qm, Km, (int)blockIdx.x - 144, C.G - 144);
                Ctx Cf = C; Cf.gw = ((int)blockIdx.x - 144) * NWAVES + C.wave; Cf.NGW = (C.G - 144) * NWAVES; conv_da_weights(Cf, da_w_in, da_w_out, ws, norm_mix + D); conv_ml_out(Cf, ml_w_out, ws); conv_moe_weights(Cf, moe_w_gu, moe_w_down, (bf16*)(ws + WS_WGU0), (bf16*)(ws + WS_WDN0), norm_ffn); }
            else p4_scan<false>(C, ws, Qm); }
        else { p4_scan<false>(C, ws, Qm); p3a_scores(C, ws, Qm, Km, (int)blockIdx.x, C.G); conv_da_weights(C, da_w_in, da_w_out, ws, norm_mix + D); conv_ml_out(C, ml_w_out, ws); conv_moe_weights(C, moe_w_gu, moe_w_down, (bf16*)(ws + WS_WGU0), (bf16*)(ws + WS_WDN0), norm_ffn); }
        GRID_BAR(); }
    if (DUP(23)) { FRESH();
        if ((int)blockIdx.x >= 144) { if (DUP(24)) p3a_scores(C, ws, Qm, Km, (int)blockIdx.x - 144, C.G - 144);
            Ctx Cf = C; Cf.gw = ((int)blockIdx.x - 144) * NWAVES + C.wave; Cf.NGW = (C.G - 144) * NWAVES; if (DUP(25)) { conv_da_weights(Cf, da_w_in, da_w_out, ws, norm_mix + D); conv_ml_out(Cf, ml_w_out, ws); } if (DUP(26)) conv_moe_weights(Cf, moe_w_gu, moe_w_down, (bf16*)(ws + WS_WGU0), (bf16*)(ws + WS_WDN0), norm_ffn); }
        GRID_BAR(); }
#define P3ONCE { FRESH(); p3_intra<true>(C, ws, ml_norm); GRID_BAR(); }
    if (DUP(3)) { P3ONCE P3ONCE P3ONCE P3ONCE }
    if (PH(3)) { FRESH(); p3_intra<false>(C, ws, ml_norm); }
    if (PH(5)) { GRID_BAR(); }
    if (PH(6)) { FRESH();
        pg8::Gemm g{(const bf16*)(ws + WS_QKRAW), (const bf16*)(ws + WS_WML_OUT), T, D, ML_V}; pg8::StaticOrder S; S.init(T, D, C.G, bx);
        pg8::EpiResBf16<true> E{xin, XB, D};
        pg8::gemm_phase<pg8::EpiResBf16<true>, pg8::StaticOrder, true, true>(C.lds + RING_OFF, g, S, E);
        if (DUP(6)) pg8::gemm_phase<pg8::EpiResBf16<true>, pg8::StaticOrder, true, true>(C.lds + RING_OFF, g, S, E);
        GRID_BAR();
    }
#define MOE_LAYER(L, PBASE, FINAL_, GNEXT, WGU_, WDN_, XR_)                                                                                                              \
    if (PH(PBASE)) { FRESH(); p7_route(C, (XR_), norm_ffn + (L) * D, moe_b_group, moe_b_expert, (L), ws, (L)); if (DUP(7)) p7_route(C, (XR_), norm_ffn + (L) * D, moe_b_group, moe_b_expert, (L), ws, (L) + 2); GRID_BAR(); }                                                \
    if ((L) == 1 && PH(PBASE + 2)) {     \
      { FRESH(); moe_tables(C, (L), ws);                                                                                                                \
        const int np = __builtin_amdgcn_readfirstlane(*(LAS int*)(C.lds + TAB_NP));                                                                      \
        pg8::Gemm g{(const bf16*)(XR_), (const bf16*)(ws + (WGU_)), np * 256, NEXP * 512, D};                                                   \
        pg8::MoeOrder S{(const LAS int*)(C.lds + TAB_PEXP), np, 1, C.G, bx, 0, 2 * C.G};                                                                 \
        pg8::EpiSwiGLU E{(bf16*)(ws + WS_ACT), (const float*)(ws + WS_EW), (const float*)(ws + WS_ERS), (const LAS int*)(C.lds + TAB_EOFF), T};                                       \
        pg8::MoeGather GA{(const int*)(ws + WS_E2T), (const LAS int*)(C.lds + TAB_EOFF), 1, T};                                                          \
        pg8::gemm_phase<pg8::EpiSwiGLU, pg8::MoeOrder, true, true, pg8::MoeGather>(C.lds + RING_OFF, g, S, E, GA);                                      \
        GRID_BAR(); }                                                                                                                                    \
      { FRESH();                                                                                                                                         \
        const int np = __builtin_amdgcn_readfirstlane(*(LAS int*)(C.lds + TAB_NP));                                                                      \
        const int ntail = 2 * np > 2 * C.G ? 2 * np - 2 * C.G : 0; const int npa = np < C.G ? np : C.G;     \
        { pg8::Gemm g{(const bf16*)(XR_), (const bf16*)(ws + (WGU_)), np * 256, NEXP * 512, D};                                                 \
          pg8::MoeOrder S{(const LAS int*)(C.lds + TAB_PEXP), np, 1, C.G, bx, 2 * C.G, 0x7fffffff};                                                      \
          pg8::EpiSwiGLU E{(bf16*)(ws + WS_ACT), (const float*)(ws + WS_EW), (const float*)(ws + WS_ERS), (const LAS int*)(C.lds + TAB_EOFF), T};                                     \
          pg8::MoeGather GA{(const int*)(ws + WS_E2T), (const LAS int*)(C.lds + TAB_EOFF), 1, T};                                                        \
          pg8::gemm_phase<pg8::EpiSwiGLU, pg8::MoeOrder, true, true, pg8::MoeGather>(C.lds + RING_OFF, g, S, E, GA); }                                  \
        int kdn = DEXP; asm volatile("" : "+s"(kdn));                                                                                                    \
        pg8::Gemm gd{(const bf16*)(ws + WS_ACT), (const bf16*)(ws + (WDN_)), np * 256, NEXP * 1024, kdn};                                              \
        pg8::EpiBf16S Ed{(bf16*)(ws + WS_YS), D, 0, 0, 1.f, 3, 0, nullptr};                                                                               \
        { pg8::MoeOrder S{(const LAS int*)(C.lds + TAB_PEXP), npa, 2, C.G - ntail, bx - ntail, 0, 0x7fffffff};                                           \
          pg8::gemm_phase<pg8::EpiBf16S, pg8::MoeOrder, true, true>(C.lds + RING_OFF, gd, S, Ed); }                                                     \
        GRID_BAR();                                                                                                                                      \
        { pg8::MoeOrder S{(const LAS int*)(C.lds + TAB_PEXP), np, 2, C.G, bx, 4 * C.G, 0x7fffffff};                                                      \
          pg8::gemm_phase<pg8::EpiBf16S, pg8::MoeOrder, true, true>(C.lds + RING_OFF, gd, S, Ed); }                                                     \
        GRID_BAR(); } }                                                                                                                                  \
    if ((L) != 1 && PH(PBASE + 2)) { FRESH(); moe_tables(C, (L), ws);                                                                                               \
        const int np = __builtin_amdgcn_readfirstlane(*(LAS int*)(C.lds + TAB_NP));                                                                      \
        pg8::Gemm g{(const bf16*)(XR_), (const bf16*)(ws + (WGU_)), np * 256, NEXP * 512, D};                                                   \
        pg8::MoeOrder S{(const LAS int*)(C.lds + TAB_PEXP), np, 1, C.G, bx};                                                                             \
        pg8::EpiSwiGLU E{(bf16*)(ws + WS_ACT), (const float*)(ws + WS_EW), (const float*)(ws + WS_ERS), (const LAS int*)(C.lds + TAB_EOFF), T};                                       \
        pg8::MoeGather GA{(const int*)(ws + WS_E2T), (const LAS int*)(C.lds + TAB_EOFF), 1, T};                                                          \
        pg8::gemm_phase<pg8::EpiSwiGLU, pg8::MoeOrder, true, true, pg8::MoeGather>(C.lds + RING_OFF, g, S, E, GA);                                      \
        if (DUP(9)) pg8::gemm_phase<pg8::EpiSwiGLU, pg8::MoeOrder, true, true, pg8::MoeGather>(C.lds + RING_OFF, g, S, E, GA);                          \
        if ((L) == 0) {     \
            const int r9 = (2 * np) % C.G; const bool few = (C.G - r9) * 2 < C.G; const int k9 = (r9 == 0 || few) ? bx : bx - r9, n9 = (r9 == 0 || few) ? C.G : C.G - r9;  \
            if (k9 >= 0) { Ctx Cf = C; Cf.gw = k9 * NWAVES + C.wave; Cf.NGW = n9 * NWAVES;                                                                 \
                conv_moe_weights(Cf, moe_w_gu + (size_t)NEXP * D * 512, moe_w_down + (size_t)NEXP * DEXP * D, (bf16*)(ws + WS_WGU1), (bf16*)(ws + WS_WDN1), norm_ffn + D); } }  \
        GRID_BAR(); }                                                                                                                                    \
    if ((L) != 1 && PH(PBASE + 3)) { FRESH();                                                                                                            \
        const int np = __builtin_amdgcn_readfirstlane(*(LAS int*)(C.lds + TAB_NP));                                                                      \
        int kdn = DEXP; asm volatile("" : "+s"(kdn));                                                                                                    \
        pg8::Gemm g{(const bf16*)(ws + WS_ACT), (const bf16*)(ws + (WDN_)), np * 256, NEXP * 1024, kdn};                                               \
        pg8::MoeOrder S{(const LAS int*)(C.lds + TAB_PEXP), np, 2, C.G, bx};                                                                             \
        pg8::EpiBf16S E{(bf16*)(ws + WS_YS), D, 0, 0, 1.f, 3, 0, nullptr};                                                                                        \
        pg8::gemm_phase<pg8::EpiBf16S, pg8::MoeOrder, true, true>(C.lds + RING_OFF, g, S, E);                                                           \
        if (DUP(10)) pg8::gemm_phase<pg8::EpiBf16S, pg8::MoeOrder, true, true>(C.lds + RING_OFF, g, S, E);                                              \
        GRID_BAR(); }                                                                                                                                    \
    if (PH(PBASE + 4)) { FRESH(); if (DUP(11)) p11_combine<FINAL_, true>(C, (XR_), out, (GNEXT), ws); p11_combine<FINAL_, false>(C, (XR_), out, (GNEXT), ws); }

    MOE_LAYER(0, 7, false, norm_mix + D, WS_WGU0, WS_WDN0, XB)
    if (PH(11)) { GRID_BAR(); }
    if (PH(12)) { FRESH();
        pg8::Gemm g{XB, (const bf16*)(ws + WS_WDA_IN), T, 3072, D}; pg8::StaticOrder S; S.init(T, 3072, C.G, bx);
        pg8::EpiBf16S E{(bf16*)(ws + WS_AQ), 1024, 1024, (size_t)(WS_AK - WS_AQ) / 2, attn_body::C2, 0x7fffffff, 0, (const float*)(ws + WS_RSTD)};
        pg8::gemm_phase<pg8::EpiBf16S, pg8::StaticOrder, true, true>(C.lds + RING_OFF, g, S, E);
        if (DUP(12)) pg8::gemm_phase<pg8::EpiBf16S, pg8::StaticOrder, true, true>(C.lds + RING_OFF, g, S, E);
        GRID_BAR();
    }
    MFMA_SPIN(21)
    if (PH(13)) { FRESH();
        static_assert(attn_body::ATTN_LDS_BYTES <= RING_BYTES, "attention LDS");
        LAS float* gnl = (LAS float*)(C.lds + TAB_OFF + 2048);
        float s1 = 0.f, s2 = 0.f;
        for (int i = 0; i < 64; ++i) { s1 += da_lq1[i] * da_lk1[i]; s2 += da_lq2[i] * da_lk2[i]; }
        const float lam = __int_as_float(__builtin_amdgcn_readfirstlane(__float_as_int(__expf(s1) - __expf(s2) + LAMBDA_INIT1)));
        if (C.tid < 128) gnl[C.tid] = da_norm[C.tid] * (1.f - LAMBDA_INIT1);
        __syncthreads();
        const attn_body::AttnTensors AT{(const attn_body::bf16*)(ws + WS_AQ), (const attn_body::bf16*)(ws + WS_AK), (const attn_body::bf16*)(ws + WS_AV), (attn_body::bf16*)(ws + WS_AO), (attn_body::bf16*)(ws + WS_HN), lam, (const LAS float*)(C.lds + TAB_OFF + 2048)};
        const attn_body::StaticOrder S((int)C.G, bx);
        attn_body::attn_phase<attn_body::StaticOrder>((char*)lds + RING_OFF, AT, S);
        GRID_BAR();
        if (DUP(13)) { attn_body::attn_phase<attn_body::StaticOrder>((char*)lds + RING_OFF, AT, S); GRID_BAR(); }
    }
    if (PH(15)) { FRESH();
        pg8::Gemm g{HN, (const bf16*)(ws + WS_WDA_OUT), T, D, D}; pg8::StaticOrder S; S.init(T, D, C.G, bx);
        pg8::EpiResBf16<false> E{XB, XB2, D};
        pg8::gemm_phase<pg8::EpiResBf16<false>, pg8::StaticOrder, true, true>(C.lds + RING_OFF, g, S, E);
        GRID_BAR();
    }
    if (DUP(20)) { for (int rep_ = 0; rep_ < 20; ++rep_) GRID_BAR(); }
    MOE_LAYER(1, 16, true, final_norm, WS_WGU1, WS_WDN1, XB2)
#if MK_PHASE_HI < 20
    { if (MK_PHASE_HI == 11 || MK_PHASE_HI < 1) { } GRID_BAR(); FRESH();
      const float* src = MK_PHASE_HI >= 6 ? out : xin;
      f32x4 gn[4];
#pragma unroll
      for (int j = 0; j < 4; ++j) gn[j] = *(const f32x4*)(final_norm + 4 * C.lane + 256 * j);
      for (int t = C.gw; t < T; t += C.NGW) { const GAS f32x4* xr = (const GAS f32x4*)(src + (size_t)t * D) + C.lane; GAS f32x4* orow = (GAS f32x4*)(out + (size_t)t * D) + C.lane;
          f32x4 v[4]; float ss = 0.f;
#pragma unroll
          for (int j = 0; j < 4; ++j) { v[j] = xr[64 * j]; ss += (v[j].x * v[j].x + v[j].y * v[j].y) + (v[j].z * v[j].z + v[j].w * v[j].w); }
          const float rstd = rsqrtf(wave_sum(ss) * (1.f / D) + 1e-6f);
#pragma unroll
          for (int j = 0; j < 4; ++j) orow[64 * j] = v[j] * rstd * gn[j]; } }
#endif
}

#undef xin
#undef norm_mix
#undef norm_ffn
#undef ml_w_in
#undef ml_conv
#undef ml_b_i
#undef ml_b_f
#undef ml_norm
#undef ml_w_out
#undef da_w_in
#undef da_lq1
#undef da_lk1
#undef da_lq2
#undef da_lk2
#undef da_norm
#undef da_w_out
#undef moe_w_group
#undef moe_b_group
#undef moe_w_expert
#undef moe_b_expert
#undef moe_w_gu
#undef moe_w_down
#undef final_norm
#undef hn0
#undef Qm
#undef Km
#undef HN
#undef XB
#undef XB2
extern "C" void kernel_launch(void* const* d_in, const int* in_sizes, int n_in, void* d_out, int out_size, void* d_ws, size_t ws_size, hipStream_t stream) {
    static int grid = 0;
    if (grid == 0) {
        if (n_in != 23 || out_size != T * D || ws_size < (size_t)512 * MiB) { fprintf(stderr, "kernel_launch: unexpected shapes (n_in %d out %d ws %zu)\n", n_in, out_size, ws_size); grid = -1; return; }
        int dev = 0, cus = 0, per_cu = 0;
        if (hipGetDevice(&dev) != hipSuccess || hipDeviceGetAttribute(&cus, hipDeviceAttributeMultiprocessorCount, dev) != hipSuccess) { grid = -1; return; }
        if (hipFuncSetAttribute((const void*)mk_fwd, hipFuncAttributeMaxDynamicSharedMemorySize, LDS_BYTES) != hipSuccess) { fprintf(stderr, "kernel_launch: hipFuncSetAttribute failed\n"); grid = -1; return; }
        if (hipOccupancyMaxActiveBlocksPerMultiprocessor(&per_cu, (const void*)mk_fwd, NWAVES * 64, LDS_BYTES) != hipSuccess || per_cu < 1) { fprintf(stderr, "kernel_launch: occupancy query says %d\n", per_cu); }
        (void)hipGetLastError();
        grid = cus;
    }
    if (grid < 0) return;
    if (hipMemsetAsync((char*)d_ws + WS_CTL, 0, CTL_ZERO_BYTES, stream) != hipSuccess) return;
    Args a{};
    for (int i = 0; i < 23; ++i) a.in[i] = (const float*)d_in[i];
    a.out = (float*)d_out; a.ws = (unsigned char*)d_ws;
    hipLaunchKernelGGL(mk_fwd, dim3(grid), dim3(NWAVES * 64), LDS_BYTES, stream, a);
}
```

```cpp
#include <hip/hip_runtime.h>
#include <hip/hip_bf16.h>
#include <cstdio>
#include <cstdint>
#include <cmath>
#define MK_P2_PROBE 0
namespace pg8 {
#define PG8_LAS __attribute__((address_space(3)))
typedef unsigned short bf16_t;
typedef short bf16x8 __attribute__((ext_vector_type(8)));
typedef float f32x4 __attribute__((ext_vector_type(4)));
typedef unsigned u32x4 __attribute__((ext_vector_type(4)));
constexpr int BM = 256, BK = 64, HALF = 128, HTB = HALF * BK * 2  , STAGE_BYTES = 8 * HTB, NXCD = 8, WGM = 8;

__host__ __device__ __forceinline__ int lds_byte(int r, int c) { const int st = (r >> 4) * 2 + (c >> 5), rr = r & 15, cc = c & 31, ob = rr * 64 + cc * 2; return st * 1024 + (ob ^ (((ob >> 9) & 1) << 5)); }
__host__ __device__ __forceinline__ void stage_rc(int b, int& R, int& C) { const int st = b / 1024, sb = b % 1024, swz = sb ^ (((sb >> 9) & 1) << 5); R = (st >> 1) * 16 + swz / 64; C = (st & 1) * 32 + (swz % 64) / 2; }
__host__ __device__ __forceinline__ int perm32(int rho) { const int n = rho >> 4, i = rho & 15; return 8 * (i >> 2) + 4 * n + (i & 3); }

struct Unit { int pm, pn; };
struct Gemm { const bf16_t* A; const bf16_t* Bt; int M, N, K; };

struct StaticOrder {
    int nM, nN, nwg, G, c;
    __host__ __device__ void init(int M, int N, int G_, int c_) { nM = M / BM; nN = N / BM; nwg = nM * nN; G = G_; c = c_; }
    __host__ __device__ bool next(int i, Unit& u) const {
        const long L = (long)i * G + c; if (L >= nwg) return false;
        int wgid = (int)L; { const int q = nwg / NXCD, r = nwg % NXCD, xcd = wgid % NXCD, off = wgid / NXCD; wgid = (xcd < r ? xcd * (q + 1) : r * (q + 1) + (xcd - r) * q) + off; }
        const int nig = WGM * nN, gid = wgid / nig, fm = gid * WGM, gsz = (nM - fm) < WGM ? (nM - fm) : WGM;
        u.pm = fm + ((wgid % nig) % gsz); u.pn = (wgid % nig) / gsz; return true;
    }
    __device__ __forceinline__ void a_ready(const Unit&) const {}
    __device__ __forceinline__ void done(const Unit&) const {}
};

__device__ __forceinline__ unsigned cvt_pk_bf16(float lo, float hi) { unsigned r; asm volatile("v_cvt_pk_bf16_f32 %0, %1, %2" : "=v"(r) : "v"(lo), "v"(hi)); return r; }

struct EpiBf16S {
    static constexpr bool PERM = true, AFTER_DRAIN = false;
    bf16_t* O; int ldc; int split_cols; size_t split_stride; float scale0; int pn_mask; int row_skew; const float* rowscale; int dry = 0;
    __device__ __forceinline__ void operator()(const f32x4 (&acc)[2][2][4][2], const Unit& u, int wr, int wc, int fr, int fq) const {
        const int row0 = u.pm * BM + wr * 64 + fr + (u.pm >> 1) * row_skew; int colt = (u.pn & pn_mask) * BM; bf16_t* base = O;
        float sc = 1.f; if (split_cols) { const int t = colt / split_cols; base += (size_t)t * split_stride; colt -= t * split_cols; if (t == 0) sc = scale0; }
        const int col0 = colt + wc * 32 + 8 * fq;
#pragma unroll
        for (int ai = 0; ai < 2; ++ai)
#pragma unroll
            for (int m = 0; m < 4; ++m) { bf16_t* rowp = base + (size_t)(row0 + ai * HALF + m * 16) * ldc + col0; const float sr = rowscale ? sc * rowscale[u.pm * BM + wr * 64 + fr + ai * HALF + m * 16] : sc;
#pragma unroll
                for (int bj = 0; bj < 2; ++bj) { f32x4 v0 = acc[ai][bj][m][0] * sr, v1 = acc[ai][bj][m][1] * sr;
                    u32x4 w; w.x = cvt_pk_bf16(v0[0], v0[1]); w.y = cvt_pk_bf16(v0[2], v0[3]); w.z = cvt_pk_bf16(v1[0], v1[1]); w.w = cvt_pk_bf16(v1[2], v1[3]);
                    if (!dry) *(u32x4*)(rowp + bj * HALF) = w; } }
    }
};
struct EpiQKO {
    static constexpr bool PERM = true, AFTER_DRAIN = false;
    bf16_t* QK; unsigned char* OG8;
    __device__ __forceinline__ void operator()(const f32x4 (&acc)[2][2][4][2], const Unit& u, int wr, int wc, int fr, int fq) const {
        const int row0 = u.pm * BM + wr * 64 + fr; const bool gate = u.pn >= 8; const int col0 = (u.pn & 7) * BM + wc * 32 + 8 * fq;
#pragma unroll
        for (int ai = 0; ai < 2; ++ai)
#pragma unroll
            for (int m = 0; m < 4; ++m) { const size_t ro = (size_t)(row0 + ai * HALF + m * 16) * 2048 + col0;
#pragma unroll
                for (int bj = 0; bj < 2; ++bj) { const f32x4 v0 = acc[ai][bj][m][0], v1 = acc[ai][bj][m][1];
                    if (!gate) { u32x4 w; w.x = cvt_pk_bf16(v0[0], v0[1]); w.y = cvt_pk_bf16(v0[2], v0[3]); w.z = cvt_pk_bf16(v1[0], v1[1]); w.w = cvt_pk_bf16(v1[2], v1[3]);
                        *(u32x4*)(QK + ro + bj * HALF) = w; }
                    else { unsigned b[8];
#pragma unroll
                        for (int e = 0; e < 4; ++e) { b[e] = (unsigned)(255.f * __builtin_amdgcn_rcpf(1.f + __builtin_amdgcn_exp2f(-1.4426950408889634f * v0[e])) + 0.5f);
                                                      b[4 + e] = (unsigned)(255.f * __builtin_amdgcn_rcpf(1.f + __builtin_amdgcn_exp2f(-1.4426950408889634f * v1[e])) + 0.5f); }
                        typedef unsigned u32x2_t __attribute__((ext_vector_type(2)));
                        *(u32x2_t*)(OG8 + ro + bj * HALF) = (u32x2_t){b[0] | (b[1] << 8) | (b[2] << 16) | (b[3] << 24), b[4] | (b[5] << 8) | (b[6] << 16) | (b[7] << 24)}; } } }
    }
};
struct EpiResF32 {
    static constexpr bool PERM = false, AFTER_DRAIN = false;
    const float* res; float* out; int ldc;
    __device__ __forceinline__ void operator()(const f32x4 (&acc)[2][2][4][2], const Unit& u, int wr, int wc, int fr, int fq) const {
        const int row0 = u.pm * BM + wr * 64 + fr, col0 = u.pn * BM + wc * 32 + 4 * fq;
        f32x4 rb[2][2][2][2];
#define PG8_RLOAD(buf, ai, mp) do { _Pragma("unroll") for (int mm = 0; mm < 2; ++mm) { const size_t off_ = (size_t)(row0 + (ai) * HALF + (2 * (mp) + mm) * 16) * ldc + col0; \
            _Pragma("unroll") for (int bj = 0; bj < 2; ++bj) _Pragma("unroll") for (int n = 0; n < 2; ++n) rb[buf][mm][bj][n] = *(const f32x4*)(res + off_ + bj * HALF + n * 16); } } while (0)
        PG8_RLOAD(0, 0, 0);
#pragma unroll
        for (int grp = 0; grp < 4; ++grp) {
            const int ai = grp >> 1, mp = grp & 1;
            if (grp + 1 < 4) { if (((grp + 1) & 1) == 0) PG8_RLOAD(0, (grp + 1) >> 1, (grp + 1) & 1); else PG8_RLOAD(1, (grp + 1) >> 1, (grp + 1) & 1); }
            __builtin_amdgcn_sched_barrier(0);
#pragma unroll
            for (int mm = 0; mm < 2; ++mm) { const int m = 2 * mp + mm; const size_t off = (size_t)(row0 + ai * HALF + m * 16) * ldc + col0;
#pragma unroll
                for (int bj = 0; bj < 2; ++bj)
#pragma unroll
                    for (int n = 0; n < 2; ++n) *(f32x4*)(out + off + bj * HALF + n * 16) = rb[grp & 1][mm][bj][n] + acc[ai][bj][m][n]; }
            __builtin_amdgcn_sched_barrier(0);
        }
#undef PG8_RLOAD
    }
};
template <bool RES_F32> struct EpiResBf16 {
    static constexpr bool PERM = true, AFTER_DRAIN = false;
    const void* res; bf16_t* out; int ldc;
    __device__ __forceinline__ void operator()(const f32x4 (&acc)[2][2][4][2], const Unit& u, int wr, int wc, int fr, int fq) const {
        const int row0 = u.pm * BM + wr * 64 + fr, col0 = u.pn * BM + wc * 32 + 8 * fq;
        f32x4 rb[2][2][2][2];
#define PG8_RLOAD(buf, ai, mp) do { _Pragma("unroll") for (int mm = 0; mm < 2; ++mm) { const size_t off_ = (size_t)(row0 + (ai) * HALF + (2 * (mp) + mm) * 16) * ldc + col0; \
            _Pragma("unroll") for (int bj = 0; bj < 2; ++bj) { if (RES_F32) { rb[buf][mm][bj][0] = *(const f32x4*)((const float*)res + off_ + bj * HALF); rb[buf][mm][bj][1] = *(const f32x4*)((const float*)res + off_ + bj * HALF + 4); } \
                else { const u32x4 w_ = *(const u32x4*)((const bf16_t*)res + off_ + bj * HALF); \
                    rb[buf][mm][bj][0] = (f32x4){__builtin_bit_cast(float, w_.x << 16), __builtin_bit_cast(float, w_.x & 0xffff0000u), __builtin_bit_cast(float, w_.y << 16), __builtin_bit_cast(float, w_.y & 0xffff0000u)}; \
                    rb[buf][mm][bj][1] = (f32x4){__builtin_bit_cast(float, w_.z << 16), __builtin_bit_cast(float, w_.z & 0xffff0000u), __builtin_bit_cast(float, w_.w << 16), __builtin_bit_cast(float, w_.w & 0xffff0000u)}; } } } } while (0)
        PG8_RLOAD(0, 0, 0);
#pragma unroll
        for (int grp = 0; grp < 4; ++grp) {
            const int ai = grp >> 1, mp = grp & 1;
            if (grp + 1 < 4) { if (((grp + 1) & 1) == 0) PG8_RLOAD(0, (grp + 1) >> 1, (grp + 1) & 1); else PG8_RLOAD(1, (grp + 1) >> 1, (grp + 1) & 1); }
            __builtin_amdgcn_sched_barrier(0);
#pragma unroll
            for (int mm = 0; mm < 2; ++mm) { const int m = 2 * mp + mm; const size_t off = (size_t)(row0 + ai * HALF + m * 16) * ldc + col0;
#pragma unroll
                for (int bj = 0; bj < 2; ++bj) { const f32x4 v0 = rb[grp & 1][mm][bj][0] + acc[ai][bj][m][0], v1 = rb[grp & 1][mm][bj][1] + acc[ai][bj][m][1];
                    u32x4 w; w.x = cvt_pk_bf16(v0[0], v0[1]); w.y = cvt_pk_bf16(v0[2], v0[3]); w.z = cvt_pk_bf16(v1[0], v1[1]); w.w = cvt_pk_bf16(v1[2], v1[3]);
                    *(u32x4*)(out + off + bj * HALF) = w; } }
            __builtin_amdgcn_sched_barrier(0);
        }
#undef PG8_RLOAD
    }
};
struct EpiSwiGLU {
    static constexpr bool PERM = true, AFTER_DRAIN = false;
    bf16_t* O; const float* ew; const float* ers; const PG8_LAS int* eoff; int ldw;
    __device__ __forceinline__ void operator()(const f32x4 (&acc)[2][2][4][2], const Unit& u, int wr, int wc, int fr, int fq) const {
        const int row0 = u.pm * BM + wr * 64 + fr, col0 = (u.pn & 1) * 128 + wc * 32 + 8 * fq; const int e = u.pn >> 1;
        const float* roww = ew + (size_t)e * ldw - eoff[e]; const float* rowr = ers + (size_t)e * ldw - eoff[e];
        float gws[2][4], grs[2][4];
#pragma unroll
        for (int ai = 0; ai < 2; ++ai)
#pragma unroll
            for (int m = 0; m < 4; ++m) { gws[ai][m] = roww[row0 + ai * HALF + m * 16]; grs[ai][m] = rowr[row0 + ai * HALF + m * 16]; }
#pragma unroll
        for (int ai = 0; ai < 2; ++ai)
#pragma unroll
            for (int m = 0; m < 4; ++m) { const int row = row0 + ai * HALF + m * 16; const float gw = gws[ai][m], gr = grs[ai][m]; float a[8];
#pragma unroll
                for (int n = 0; n < 2; ++n)
#pragma unroll
                    for (int e4 = 0; e4 < 4; ++e4) { const float g = acc[ai][0][m][n][e4] * gr, up = acc[ai][1][m][n][e4] * gr;
                        const float sg = g * __builtin_amdgcn_rcpf(1.f + __builtin_amdgcn_exp2f(-1.4426950408889634f * g)); a[n * 4 + e4] = sg * up * gw; }
                u32x4 w; w.x = cvt_pk_bf16(a[0], a[1]); w.y = cvt_pk_bf16(a[2], a[3]); w.z = cvt_pk_bf16(a[4], a[5]); w.w = cvt_pk_bf16(a[6], a[7]);
                *(u32x4*)(O + (size_t)row * 256 + col0) = w; }
    }
};
struct MoeGather {
    static constexpr bool ON = true;
    const int* e2t; const PG8_LAS int* eoff; int shift, ld;
    __device__ __forceinline__ unsigned row(const Unit& u, int r) const { const int e = u.pn >> shift; const unsigned t = (unsigned)e2t[(size_t)e * ld + (u.pm * BM + r - eoff[e])]; return t < (unsigned)ld ? t : (unsigned)(ld - 1); }
};
struct MoeOrder {
    const PG8_LAS int* pexp; int np, shift, G, c; int lo = 0, hi = 0x7fffffff;
    __device__ __forceinline__ bool next(int i, Unit& u) const {
        const int L = lo + i * G + c; if (c < 0 || L >= hi || L >= (np << shift)) return false;
        const int p = L >> shift; const int e = __builtin_amdgcn_readfirstlane(pexp[p]);
        u.pm = p; u.pn = (e << shift) + (L & ((1 << shift) - 1)); return true;
    }
    __device__ __forceinline__ void a_ready(const Unit&) const {}
    __device__ __forceinline__ void done(const Unit&) const {}
};
struct NoGather { static constexpr bool ON = false; __device__ __forceinline__ unsigned row(const Unit&, int) const { return 0u; } };
template <class Epi, class Sched, bool ALIGN_EPI = false, bool SP2 = false, class AG = NoGather, bool NOLOAD = false, int NOLDS = 0>
__device__ __forceinline__ void gemm_phase(PG8_LAS unsigned char* lds, const Gemm g, const Sched& S, const Epi& E, const AG& GA = AG()) {
    static_assert(!AG::ON || SP2, "row gather is wired into the SP2 loop only");
    int tid_ = threadIdx.x; asm volatile("" : "+v"(tid_)); const int tid = tid_, wid = __builtin_amdgcn_readfirstlane(tid >> 6), lane = tid & 63, wr = wid >> 2, wc = wid & 3, fr = lane & 15, fq = lane >> 4;
    const int K = g.K, nt = K / BK;
    unsigned voffA[2], voffB[2]; int aR[2], aC[2];
#pragma unroll
    for (int i = 0; i < 2; ++i) { int R, C; stage_rc(tid * 16 + i * 8192, R, C); const int Rb = Epi::PERM ? ((R & ~31) + perm32(R & 31)) : R; aR[i] = R; aC[i] = C;
        voffA[i] = (unsigned)(R * K + C) * 2u; voffB[i] = (unsigned)(Rb * K + C) * 2u; }
    unsigned gcur0[2], gcur1[2], gnxt0[2], gnxt1[2];
#define PG8_GOFF(u, d0, d1) do { _Pragma("unroll") for (int _i = 0; _i < 2; ++_i) { d0[_i] = (GA.row(u, aR[_i]) * (unsigned)K + (unsigned)aC[_i]) * 2u; d1[_i] = (GA.row(u, HALF + aR[_i]) * (unsigned)K + (unsigned)aC[_i]) * 2u; } } while (0)
    const size_t kstep = (size_t)(BK * 2);
    const size_t hstep = (size_t)HALF * K * 2;
    const size_t tstep = 2 * hstep;
    const unsigned ldsw = (unsigned)wid * 1024u;
    const int aoff = lds_byte(wr * 64 + fr, fq * 8), boff = lds_byte(wc * 32 + fr, fq * 8);
#define PG8_SA(b, h) (((b) * 2 + (h)) * HTB)
#define PG8_SB(b, h) ((4 + (b) * 2 + (h)) * HTB)
#define PG8_STAGE(bufoff, gbase, voff) do { if (!NOLOAD) _Pragma("unroll") for (int _i = 0; _i < 2; ++_i) \
        __builtin_amdgcn_global_load_lds((const unsigned*)((const char*)(gbase) + (voff)[_i]), (PG8_LAS unsigned*)(lds + (bufoff) + ldsw + _i * 8192), 16, 0, 0); } while (0)
#define PG8_LDA(dst, b, h) do { if (!(NOLDS & 1)) _Pragma("unroll") for (int m = 0; m < 4; ++m) _Pragma("unroll") for (int k = 0; k < 2; ++k) dst[m][k] = *(const PG8_LAS bf16x8*)(lds + PG8_SA(b, h) + aoff + m * 2048 + k * 1024); } while (0)
#define PG8_LDB(dst, b, h) do { if (!(NOLDS & 2)) _Pragma("unroll") for (int n = 0; n < 2; ++n) _Pragma("unroll") for (int k = 0; k < 2; ++k) dst[n][k] = *(const PG8_LAS bf16x8*)(lds + PG8_SB(b, h) + boff + n * 2048 + k * 1024); } while (0)
#define PG8_MMA(ai, bj, At, Bt) do { __builtin_amdgcn_s_setprio(1); _Pragma("unroll") for (int m = 0; m < 4; ++m) _Pragma("unroll") for (int n = 0; n < 2; ++n) _Pragma("unroll") for (int k = 0; k < 2; ++k) \
        acc[ai][bj][m][n] = __builtin_amdgcn_mfma_f32_16x16x32_bf16(Bt[n][k], At[m][k], acc[ai][bj][m][n], 0, 0, 0); __builtin_amdgcn_s_setprio(0); } while (0)
#define PG8_WAIT_V(n) asm volatile("s_waitcnt vmcnt(" #n ")" ::: "memory")
#define PG8_WAIT_L(n) asm volatile("s_waitcnt lgkmcnt(" #n ")" ::: "memory")
#define PG8_BAR do { if (!(NOLDS & 4)) __builtin_amdgcn_s_barrier(); } while (0)
#define PG8_SCHED __builtin_amdgcn_sched_barrier(0)
    Unit cur, nxt; int ui = 0;
    if (!S.next(0, cur)) return;
    f32x4 acc[2][2][4][2];
#pragma unroll
    for (int a = 0; a < 2; ++a)
#pragma unroll
        for (int b = 0; b < 2; ++b)
#pragma unroll
            for (int m = 0; m < 4; ++m)
#pragma unroll
                for (int n = 0; n < 2; ++n) acc[a][b][m][n] = (f32x4){0.f, 0.f, 0.f, 0.f};
    bf16x8 At[4][2], B0[2][2], B1[2][2];
    if (NOLDS) { _Pragma("unroll") for (int m = 0; m < 4; ++m) _Pragma("unroll") for (int k = 0; k < 2; ++k) { At[m][k] = (bf16x8){0, 0, 0, 0, 0, 0, 0, 0}; asm volatile("" : "+v"(At[m][k])); }
        _Pragma("unroll") for (int n = 0; n < 2; ++n) _Pragma("unroll") for (int k = 0; k < 2; ++k) { B0[n][k] = (bf16x8){0, 0, 0, 0, 0, 0, 0, 0}; asm volatile("" : "+v"(B0[n][k])); B1[n][k] = B0[n][k]; asm volatile("" : "+v"(B1[n][k])); } }
    const char* cA = (const char*)g.A + (AG::ON ? (size_t)0 : (size_t)cur.pm * tstep); const char* cB = (const char*)g.Bt + (size_t)cur.pn * tstep;
    if constexpr (AG::ON) { PG8_GOFF(cur, gcur0, gcur1); gnxt0[0] = gcur0[0]; gnxt0[1] = gcur0[1]; gnxt1[0] = gcur1[0]; gnxt1[1] = gcur1[1]; }
#define PG8_STAGE_A(bufoff, base, half, G0, G1) do { if constexpr (AG::ON) { if ((half) == 0) PG8_STAGE(bufoff, base, G0); else PG8_STAGE(bufoff, base, G1); } else { PG8_STAGE(bufoff, (base) + (half) * hstep, voffA); } } while (0)
    S.a_ready(cur);
    if constexpr (SP2) {
        PG8_STAGE(PG8_SB(0, 0), cB, voffB); PG8_STAGE(PG8_SB(0, 1), cB + hstep, voffB); PG8_STAGE_A(PG8_SA(0, 0), cA, 0, gcur0, gcur1); PG8_STAGE_A(PG8_SA(0, 1), cA, 1, gcur0, gcur1);
        if (wr == 1) PG8_BAR;
        PG8_WAIT_V(2); PG8_BAR;
        PG8_STAGE(PG8_SB(1, 0), cB + kstep, voffB); PG8_STAGE_A(PG8_SA(1, 0), cA + kstep, 0, gcur0, gcur1); PG8_STAGE(PG8_SB(1, 1), cB + hstep + kstep, voffB);
        PG8_WAIT_V(6); PG8_BAR;
    } else {
        PG8_STAGE(PG8_SB(0, 0), cB, voffB); PG8_STAGE(PG8_SA(0, 0), cA, voffA); PG8_STAGE(PG8_SB(0, 1), cB + hstep, voffB); PG8_STAGE(PG8_SA(0, 1), cA + hstep, voffA);
        if (wr == 1) PG8_BAR;
        PG8_WAIT_V(4); PG8_BAR;
        PG8_STAGE(PG8_SB(1, 0), cB + kstep, voffB); PG8_STAGE(PG8_SA(1, 0), cA + kstep, voffA); PG8_STAGE(PG8_SB(1, 1), cB + hstep + kstep, voffB);
        PG8_WAIT_V(6); PG8_BAR;
    }
    for (;;) {
        const bool has_next = S.next(ui + 1, nxt);
        if constexpr (AG::ON) { if (has_next) PG8_GOFF(nxt, gnxt0, gnxt1); }
        const char* nA = (has_next && !AG::ON) ? (const char*)g.A + (size_t)nxt.pm * tstep : cA; const char* nB = has_next ? (const char*)g.Bt + (size_t)nxt.pn * tstep : cB;
        for (int t = 0; t < nt; t += 2) {
            const bool last = (t == nt - 2);
            const char* a1 = cA + (size_t)(t + 1) * kstep;
            const char* a2 = last ? nA : cA + (size_t)(t + 2) * kstep; const char* b2 = last ? nB : cB + (size_t)(t + 2) * kstep;
            const char* a3 = a2 + kstep; const char* b3 = b2 + kstep;
            if (last && has_next) S.a_ready(nxt);
            if constexpr (SP2) {
            unsigned g20[2], g21[2];
            if constexpr (AG::ON) { g20[0] = last ? gnxt0[0] : gcur0[0]; g20[1] = last ? gnxt0[1] : gcur0[1]; g21[0] = last ? gnxt1[0] : gcur1[0]; g21[1] = last ? gnxt1[1] : gcur1[1]; }
            PG8_LDB(B0, 0, 0); PG8_LDB(B1, 0, 1); PG8_SCHED; PG8_LDA(At, 0, 0); PG8_STAGE_A(PG8_SA(1, 1), a1, 1, gcur0, gcur1);
            PG8_WAIT_V(8); PG8_WAIT_L(0); PG8_BAR; PG8_MMA(0, 0, At, B0); PG8_MMA(0, 1, At, B1); PG8_BAR; PG8_SCHED;
            PG8_LDA(At, 0, 1); PG8_STAGE(PG8_SB(0, 0), b2, voffB); PG8_STAGE(PG8_SB(0, 1), b2 + hstep, voffB); PG8_STAGE_A(PG8_SA(0, 0), a2, 0, g20, g21);
            PG8_WAIT_V(8); PG8_WAIT_L(0); PG8_BAR; PG8_MMA(1, 0, At, B0); PG8_MMA(1, 1, At, B1); PG8_BAR; PG8_SCHED;
            PG8_LDB(B0, 1, 0); PG8_LDB(B1, 1, 1); PG8_SCHED; PG8_LDA(At, 1, 0); PG8_STAGE_A(PG8_SA(0, 1), a2, 1, g20, g21);
            PG8_WAIT_V(8); PG8_WAIT_L(0); PG8_BAR; PG8_MMA(0, 0, At, B0); PG8_MMA(0, 1, At, B1); PG8_BAR; PG8_SCHED;
            PG8_LDA(At, 1, 1); PG8_STAGE(PG8_SB(1, 0), b3, voffB); PG8_STAGE(PG8_SB(1, 1), b3 + hstep, voffB); PG8_STAGE_A(PG8_SA(1, 0), a3, 0, g20, g21);
            PG8_WAIT_V(8); PG8_WAIT_L(0); PG8_BAR; PG8_MMA(1, 0, At, B0); PG8_MMA(1, 1, At, B1); PG8_BAR; PG8_SCHED;
            } else {
            PG8_LDB(B0, 0, 0); PG8_SCHED; PG8_LDA(At, 0, 0); PG8_STAGE(PG8_SA(1, 1), a1 + hstep, voffA);
            PG8_WAIT_L(8); PG8_BAR; PG8_WAIT_L(0); PG8_MMA(0, 0, At, B0); PG8_BAR; PG8_SCHED;
            PG8_LDB(B1, 0, 1); PG8_STAGE(PG8_SB(0, 0), b2, voffB);
            PG8_BAR; PG8_WAIT_L(0); PG8_MMA(0, 1, At, B1); PG8_BAR;
            PG8_LDA(At, 0, 1); PG8_STAGE(PG8_SA(0, 0), a2, voffA);
            PG8_BAR; PG8_WAIT_L(0); PG8_MMA(1, 0, At, B0); PG8_BAR; PG8_SCHED;
            PG8_STAGE(PG8_SB(0, 1), b2 + hstep, voffB);
            PG8_WAIT_V(6); PG8_BAR; PG8_MMA(1, 1, At, B1); PG8_BAR;
            PG8_LDB(B0, 1, 0); PG8_SCHED; PG8_LDA(At, 1, 0); PG8_STAGE(PG8_SA(0, 1), a2 + hstep, voffA);
            PG8_WAIT_L(8); PG8_BAR; PG8_WAIT_L(0); PG8_MMA(0, 0, At, B0); PG8_BAR; PG8_SCHED;
            PG8_LDB(B1, 1, 1); PG8_STAGE(PG8_SB(1, 0), b3, voffB);
            PG8_BAR; PG8_WAIT_L(0); PG8_MMA(0, 1, At, B1); PG8_BAR;
            PG8_LDA(At, 1, 1); PG8_STAGE(PG8_SA(1, 0), a3, voffA);
            PG8_BAR; PG8_WAIT_L(0); PG8_MMA(1, 0, At, B0); PG8_BAR; PG8_SCHED;
            PG8_STAGE(PG8_SB(1, 1), b3 + hstep, voffB);
            PG8_WAIT_V(6); PG8_BAR; PG8_MMA(1, 1, At, B1); PG8_BAR;
            }
        }
        if constexpr (ALIGN_EPI) { if (wr == 0) PG8_BAR; }
        if constexpr (!Epi::AFTER_DRAIN) { E(acc, cur, wr, wc, fr, fq); S.done(cur); }
        if (!has_next) break;
#pragma unroll
        for (int a = 0; a < 2; ++a)
#pragma unroll
            for (int b = 0; b < 2; ++b)
#pragma unroll
                for (int m = 0; m < 4; ++m)
#pragma unroll
                    for (int n = 0; n < 2; ++n) acc[a][b][m][n] = (f32x4){0.f, 0.f, 0.f, 0.f};
        cur = nxt; cA = nA; cB = nB; ++ui;
        if constexpr (AG::ON) { gcur0[0] = gnxt0[0]; gcur0[1] = gnxt0[1]; gcur1[0] = gnxt1[0]; gcur1[1] = gnxt1[1]; }
        if constexpr (ALIGN_EPI) { if (wr == 1) PG8_BAR; }
    }
    PG8_WAIT_V(0);
    if constexpr (!ALIGN_EPI) { if (wr == 0) PG8_BAR; }
    PG8_BAR;
    if constexpr (Epi::AFTER_DRAIN) { E.fused(acc, cur, wr, wc, fr, fq, lds, wid, lane); S.done(cur); }
#undef PG8_SA
#undef PG8_SB
#undef PG8_STAGE
#undef PG8_STAGE_A
#undef PG8_GOFF
#undef PG8_LDA
#undef PG8_LDB
#undef PG8_MMA
#undef PG8_WAIT_V
#undef PG8_WAIT_L
#undef PG8_BAR
#undef PG8_SCHED
}
}

#include <hip/hip_bf16.h>
#include <cmath>
namespace attn_body {
using bf16=__hip_bfloat16;
using bf16x8=__attribute__((ext_vector_type(8)))short;
using s16x4=__attribute__((ext_vector_type(4)))short;
using f32x16=__attribute__((ext_vector_type(16)))float;
using u32x4=__attribute__((ext_vector_type(4)))unsigned;
constexpr int BATCH=4,NVH=32,SEQ=8192,D=64,PQ=1024,PO=1024;
constexpr int NW=8,QBLK=32,QB=QBLK*NW,KVBLK=64,NQB=SEQ/QB;
constexpr int ATTN_UNIT_ROWS=QB;
__device__ __forceinline__ int crow(int r,int hi){return (r&3)+8*(r>>2)+4*hi;}
#define SBAR() __builtin_amdgcn_sched_barrier(0)
__device__ __forceinline__ void cmask(f32x16&p0,f32x16&p1,int jb,int qrel,int hi){
  const float NEG=-INFINITY; int kb=64*jb+4*hi;
  #pragma unroll
  for(int r=0;r<16;++r){int kv=kb+(r&3)+8*(r>>2); if(kv>qrel)p0[r]=NEG; if(kv+32>qrel)p1[r]=NEG;}
}

constexpr int NSLOT=3, SLOTB=8192;
constexpr int LDS_K=0, LDS_V=NSLOT*SLOTB, LDS_WS=3*NSLOT*SLOTB, LDS_OST=LDS_WS+NW*64*4, LDS_BYTES=LDS_OST+NW*4096;
constexpr float C2=0.125f*1.4426950408889634f;
__device__ __forceinline__ void glds16(const void*gsrc,unsigned lds_dst){unsigned keep;
  asm volatile("s_mov_b32 %0, m0\n\ts_mov_b32 m0, %2\n\ts_nop 0\n\tglobal_load_lds_dwordx4 %1, off\n\ts_mov_b32 m0, %0":"=&s"(keep):"v"(gsrc),"s"(lds_dst):"memory");}
__device__ __forceinline__ float max3f(float a,float b,float c){float r;asm("v_max3_f32 %0, %1, %2, %3":"=v"(r):"v"(a),"v"(b),"v"(c));return r;}
__device__ __forceinline__ float max2f(float a,float b){float r;asm("v_max_f32_e32 %0, %1, %2":"=v"(r):"v"(a),"v"(b));return r;}
__device__ __forceinline__ float fadd_s(float a,float b){float r;asm("v_add_f32_e32 %0, %1, %2":"=v"(r):"v"(a),"v"(b));return r;}
__device__ __forceinline__ float fsub_s(float a,float b){float r;asm("v_sub_f32_e32 %0, %1, %2":"=v"(r):"v"(a),"v"(b));return r;}
typedef float f32x2_t __attribute__((ext_vector_type(2))); typedef __bf16 bf16x2_t __attribute__((ext_vector_type(2)));
__device__ __forceinline__ unsigned cvtpk_s(float lo,float hi){f32x2_t v={lo,hi};bf16x2_t b=__builtin_convertvector(v,bf16x2_t);return __builtin_bit_cast(unsigned,b);}
#define WAIT_BAR(N) asm volatile("s_waitcnt vmcnt(" #N ") lgkmcnt(0)\n\ts_barrier":::"memory")

__device__ __forceinline__ void qkt(f32x16&p0,f32x16&p1,const char*Kslot,const bf16x8*qr,const f32x16&negm,int r32,int hi){
  const char*kb=Kslot+hi*1024+r32*16;
  #pragma unroll
  for(int d0=0;d0<4;++d0){
    const bf16x8 b0=*reinterpret_cast<const bf16x8*>(kb+d0*2048);
    const bf16x8 b1=*reinterpret_cast<const bf16x8*>(kb+d0*2048+512);
    if(d0==0){p0=__builtin_amdgcn_mfma_f32_32x32x16_bf16(b0,qr[0],negm,0,0,0);p1=__builtin_amdgcn_mfma_f32_32x32x16_bf16(b1,qr[0],negm,0,0,0);}
    else{p0=__builtin_amdgcn_mfma_f32_32x32x16_bf16(b0,qr[d0],p0,0,0,0);p1=__builtin_amdgcn_mfma_f32_32x32x16_bf16(b1,qr[d0],p1,0,0,0);}}
}
typedef __attribute__((address_space(3))) const char* lds_cptr;
typedef short v4i16_t __attribute__((ext_vector_type(4)));
__device__ __forceinline__ void kload8(bf16x8*kf,lds_cptr kp){
  kf[0]=*(const __attribute__((address_space(3))) bf16x8*)(kp);      kf[1]=*(const __attribute__((address_space(3))) bf16x8*)(kp+512);
  kf[2]=*(const __attribute__((address_space(3))) bf16x8*)(kp+2048); kf[3]=*(const __attribute__((address_space(3))) bf16x8*)(kp+2560);
  kf[4]=*(const __attribute__((address_space(3))) bf16x8*)(kp+4096); kf[5]=*(const __attribute__((address_space(3))) bf16x8*)(kp+4608);
  kf[6]=*(const __attribute__((address_space(3))) bf16x8*)(kp+6144); kf[7]=*(const __attribute__((address_space(3))) bf16x8*)(kp+6656);
}
__device__ __forceinline__ void kload2(bf16x8*kf,lds_cptr kp,int j){ kf[2*j]=*(const __attribute__((address_space(3))) bf16x8*)(kp+j*2048); kf[2*j+1]=*(const __attribute__((address_space(3))) bf16x8*)(kp+j*2048+512); }
__device__ __forceinline__ s16x4 vtr(lds_cptr p){ return __builtin_bit_cast(s16x4,__builtin_amdgcn_ds_read_tr16_b64_v4i16((__attribute__((address_space(3))) v4i16_t*)p)); }
__device__ __forceinline__ float rowmax(const f32x16&p0,const f32x16&p1){
  float a=max3f(p0[0],p0[1],p1[0]),b=max3f(p0[2],p0[3],p1[1]);a=max3f(a,p1[2],p1[3]);
  #pragma unroll
  for(int r=4;r<16;r+=4){a=max3f(a,p0[r],p0[r+1]);b=max3f(b,p0[r+2],p0[r+3]);a=max3f(a,p1[r],p1[r+1]);b=max3f(b,p1[r+2],p1[r+3]);}
  const float m=max2f(a,b);
  auto rr=__builtin_amdgcn_permlane32_swap(__float_as_uint(m),__float_as_uint(m),false,false);
  return max2f(__uint_as_float(rr[0]),__uint_as_float(rr[1]));
}
__device__ __forceinline__ void pv(f32x16*o,int vb,bf16x8 pa0,bf16x8 pa1,bf16x8 pa2,bf16x8 pa3){
  #pragma unroll
  for(int d0=0;d0<4;++d0){s16x4 lo[4],hi[4];
    #pragma unroll
    for(int ks=0;ks<4;++ks){
      asm volatile("ds_read_b64_tr_b16 %0,%1 offset:%c2":"=&v"(lo[ks]):"v"(vb),"i"(d0*4096+ks*1024):"memory");
      asm volatile("ds_read_b64_tr_b16 %0,%1 offset:%c2":"=&v"(hi[ks]):"v"(vb),"i"(d0*4096+ks*1024+512):"memory");}
    asm volatile("s_waitcnt lgkmcnt(0)":::"memory");SBAR();
    #define PK(k) (bf16x8){lo[k][0],lo[k][1],lo[k][2],lo[k][3],hi[k][0],hi[k][1],hi[k][2],hi[k][3]}
    o[d0]=__builtin_amdgcn_mfma_f32_32x32x16_bf16(pa0,PK(0),o[d0],0,0,0);
    o[d0]=__builtin_amdgcn_mfma_f32_32x32x16_bf16(pa1,PK(1),o[d0],0,0,0);
    o[d0]=__builtin_amdgcn_mfma_f32_32x32x16_bf16(pa2,PK(2),o[d0],0,0,0);
    o[d0]=__builtin_amdgcn_mfma_f32_32x32x16_bf16(pa3,PK(3),o[d0],0,0,0);
    #undef PK
  }
}

#ifndef ATTN_STORE16
#define ATTN_STORE16(p,v) (*(u32x4*)(p)=(v))
#endif
template<int THRL> __device__ __forceinline__ void attn_unit(int b,int qcol,int kcol,int vcol,int ocol,int qb,const bf16*Q,const bf16*__restrict__ K,const bf16*__restrict__ V,bf16*O,bf16*O2,int mode,float lam,const __attribute__((address_space(3))) float*gn,char*shm,bool pre,bool has_next,int nb,int nkcol,int nvcol){
  int tid_=threadIdx.x; asm volatile("":"+v"(tid_)); const int tid=tid_,lane=tid&63,r32=lane&31,hi=lane>>5; const int wid=__builtin_amdgcn_readfirstlane(tid>>6);
  const long rowbase=(long)b*SEQ; const int q0=qb*QB;
  const bf16*Qw=Q+(rowbase+q0+wid*QBLK)*PQ+qcol;
  const bf16*Kh=K+rowbase*PQ+kcol,*Vh=V+rowbase*PQ+vcol;
  const unsigned lds0=(unsigned)(uintptr_t)shm;
  float*wsf=(float*)(shm+LDS_WS)+wid*64;
  const bf16*ksrc=Kh+(long)lane*PQ+wid*8;
  const bf16*vsrc=Vh+(long)(16*(wid&3)+(lane>>2))*PQ+(wid>>2)*32+(lane&3)*8;
  const unsigned kdst=lds0+LDS_K+wid*1024, vdst=lds0+LDS_V+wid*1024;
  #define DMA_K(t,slot) glds16(ksrc+(long)(t)*KVBLK*PQ,(unsigned)__builtin_amdgcn_readfirstlane(kdst+(slot)))
  #define DMA_V(t,slot) do{ glds16(vsrc+(long)(t)*KVBLK*PQ,(unsigned)__builtin_amdgcn_readfirstlane(vdst+2*(slot))); glds16(vsrc+(long)(t)*KVBLK*PQ+64,(unsigned)__builtin_amdgcn_readfirstlane(vdst+2*(slot)+8192)); }while(0)
  const int vb0=(int)(lds0+LDS_V)+((lane>>4)&1)*32+(lane&3)*8+(4*hi+((lane&15)>>2))*64;
  const char*Kbase=shm+LDS_K; bf16x8 kf[8];
  const lds_cptr shm3=(lds_cptr)shm; const lds_cptr kp0=shm3+LDS_K+hi*1024+r32*16; const lds_cptr vp0=shm3+LDS_V+((lane>>4)&1)*32+(lane&3)*8+(4*hi+((lane&15)>>2))*64;
  const int NT=(q0+QB)/KVBLK;
  if(!pre){DMA_K(0,0);DMA_V(0,0);DMA_K(1,SLOTB);}
  typedef __attribute__((address_space(3))) bf16x8 lds_bf16x8;
  lds_bf16x8*const qst=(lds_bf16x8*)(shm3+LDS_OST+wid*4096)+lane;
  { bf16x8 qr[4];
    #pragma unroll
    for(int d0=0;d0<4;++d0)qr[d0]=*reinterpret_cast<const bf16x8*>(&Qw[(long)r32*PQ+d0*16+hi*8]);
    #pragma unroll
    for(int d0=0;d0<4;++d0)qst[64*d0]=qr[d0]; }
  float mhat=0.f,l_reg=0.f;f32x16 o[4];o[0]=f32x16{};o[1]=f32x16{};o[2]=f32x16{};o[3]=f32x16{};f32x16 negm=f32x16{};asm volatile("":"+v"(negm));
  const int qrel=wid*QBLK+r32;
  #define CMASK(P0,P1,t) do{int jb_=(t)-(NT-4); if(jb_>=0)cmask(P0,P1,jb_,qrel,hi);}while(0)
  bool resc=false;
  #define START(P0,P1) do{ const float rm=rowmax(P0,P1); resc=false; \
    { const float dl=rm; mhat=fadd_s(mhat,dl); \
      _Pragma("unroll") for(int r=0;r<16;++r){P0[r]=fsub_s(P0[r],dl);P1[r]=fsub_s(P1[r],dl);} \
      _Pragma("unroll") for(int r=0;r<16;++r)negm[r]=-mhat; asm volatile("":"+v"(negm)); } \
    _Pragma("unroll") for(int r=0;r<16;++r)P0[r]=__builtin_amdgcn_exp2f(P0[r]); }while(0)
  #define RESC() do{ if(resc){ asm volatile("s_waitcnt lgkmcnt(0)":::"memory"); \
      _Pragma("unroll") for(int d_=0;d_<4;++d_) _Pragma("unroll") for(int r=0;r<16;++r)o[d_][r]*=wsf[crow(r,hi)]; } }while(0)
  f32x16 pA0,pA1,pB0,pB1;
  int sl_prev=0,sl_cur=0,sl_next=SLOTB;
  #define ROT() do{sl_prev=sl_cur;sl_cur=sl_next;sl_next=(sl_next==(NSLOT-1)*SLOTB)?0:sl_next+SLOTB;}while(0)
  if(!pre)DMA_K(2,2*SLOTB);
  WAIT_BAR(4);
  { bf16x8 qr[4];
    #pragma unroll
    for(int d0=0;d0<4;++d0)qr[d0]=qst[64*d0];
    qkt(pA0,pA1,Kbase,qr,negm,r32,hi); }
  asm volatile("s_nop 15\n\ts_nop 7":"+v"(pA0),"+v"(pA1));CMASK(pA0,pA1,0);
  START(pA0,pA1);
  _Pragma("unroll") for(int r=0;r<16;++r)pA1[r]=__builtin_amdgcn_exp2f(pA1[r]);
  WAIT_BAR(0);
  DMA_K(3,0);DMA_V(1,SLOTB);
  ROT();
  kload8(kf,kp0+sl_cur);
  WAIT_BAR(3);
  bf16x8 vf[4]; u32x4 pw0,pw1,pw2,pw3;
  #define PKW(P,B) cvtpk_s(P[B],P[B+1])
  #define PAF(k) __builtin_bit_cast(bf16x8,pw##k)
  #define VFR(i) vf[i]
  #define PIN(x) asm volatile("":"+v"(x))
  #define MX3(a,b,c) __builtin_fmaxf(__builtin_fmaxf((a),(b)),(c))
  #define GAPA(MF,A0,A1,A2,A3,W0,W1,PW) do{ MF; sacc+=A0; sacc+=A1; sacc+=A2; sacc+=A3; PIN(sacc); W0; W1; PIN(PW); SBAR(); }while(0)
  #define EX(v) __builtin_amdgcn_exp2f(v)
  #define GAPB(MF,X,B) do{ MF; X[B]=EX(X[B]); X[B+1]=EX(X[B+1]); PIN(X); SBAR(); }while(0)
  #define VRD(n) do{ const s16x4 lo_=vtr(vp_+(((n)&3)*4096+((n)>>2)*1024)), hi_=vtr(vp_+(((n)&3)*4096+((n)>>2)*1024+512)); vf[(n)&3]=__builtin_shufflevector(lo_,hi_,0,1,2,3,4,5,6,7); }while(0)
  #define KRD(G,j) do{ if(G){ kload2(kf,kp0+sl_next,j); SBAR(); } }while(0)
  #define PVM(n,X,B) GAPB(o[(n)&3]=__builtin_amdgcn_mfma_f32_32x32x16_bf16(PAFN((n)>>2),VFR((n)&3),o[(n)&3],0,0,0), X,B)
  #define PAFN(k) ((k)==0?PAF(0):(k)==1?PAF(1):(k)==2?PAF(2):PAF(3))
  #define STEP(C0,C1,P0,P1,t,GK,GV,GL) do{ SBAR(); \
    const lds_cptr vp_=vp0+2*sl_prev; \
    bf16x8 q0_=qst[0],q1_=qst[64]; SBAR(); float sacc=(P0[0]+P0[1]); \
    GAPA(C0=__builtin_amdgcn_mfma_f32_32x32x16_bf16(kf[0],q0_,negm,0,0,0), P0[2],P0[3],P0[4],P0[5],     pw0[0]=PKW(P0,0), pw0[1]=PKW(P0,2), pw0); \
    GAPA(C1=__builtin_amdgcn_mfma_f32_32x32x16_bf16(kf[1],q0_,negm,0,0,0), P0[6],P0[7],P0[8],P0[9],     pw0[2]=PKW(P0,4), pw0[3]=PKW(P0,6), pw0); \
    bf16x8 q2_=qst[128]; SBAR(); \
    GAPA(C0=__builtin_amdgcn_mfma_f32_32x32x16_bf16(kf[2],q1_,C0,0,0,0),   P0[10],P0[11],P0[12],P0[13], pw1[0]=PKW(P0,8), pw1[1]=PKW(P0,10), pw1); \
    GAPA(C1=__builtin_amdgcn_mfma_f32_32x32x16_bf16(kf[3],q1_,C1,0,0,0),   P0[14],P0[15],P1[0],P1[1],   pw1[2]=PKW(P0,12),pw1[3]=PKW(P0,14), pw1); \
    bf16x8 q3_=qst[192]; SBAR(); \
    GAPA(C0=__builtin_amdgcn_mfma_f32_32x32x16_bf16(kf[4],q2_,C0,0,0,0),   P1[2],P1[3],P1[4],P1[5],     pw2[0]=PKW(P1,0), pw2[1]=PKW(P1,2), pw2); \
    GAPA(C1=__builtin_amdgcn_mfma_f32_32x32x16_bf16(kf[5],q2_,C1,0,0,0),   P1[6],P1[7],P1[8],P1[9],     pw2[2]=PKW(P1,4), pw2[3]=PKW(P1,6), pw2); \
    VRD(0); SBAR(); \
    GAPA(C0=__builtin_amdgcn_mfma_f32_32x32x16_bf16(kf[6],q3_,C0,0,0,0),   P1[10],P1[11],P1[12],P1[13], pw3[0]=PKW(P1,8), pw3[1]=PKW(P1,10), pw3); \
    VRD(1); VRD(2); SBAR(); \
    GAPA(C1=__builtin_amdgcn_mfma_f32_32x32x16_bf16(kf[7],q3_,C1,0,0,0),   P1[14],P1[15],0.f,0.f,       pw3[2]=PKW(P1,12),pw3[3]=PKW(P1,14), pw3); \
    l_reg+=sacc; \
    if(GK){DMA_K((t)+3,sl_cur);} if(GV){DMA_V((t)+1,sl_next);} \
    CMASK(C0,C1,t); \
    { float a=MX3(C0[0],C0[1],C1[0]),b=MX3(C0[2],C0[3],C1[1]); a=MX3(a,C1[2],C1[3]); \
      _Pragma("unroll") for(int r=4;r<16;r+=4){a=MX3(a,C0[r],C0[r+1]);b=MX3(b,C0[r+2],C0[r+3]);a=MX3(a,C1[r],C1[r+1]);b=MX3(b,C1[r+2],C1[r+3]);} \
      float rm=__builtin_fmaxf(a,b); { auto rr=__builtin_amdgcn_permlane32_swap(__float_as_uint(rm),__float_as_uint(rm),false,false); rm=__builtin_fmaxf(__uint_as_float(rr[0]),__uint_as_float(rr[1])); } \
      resc=false; \
      if(__builtin_expect(__any(rm>(float)THRL),0)){ const float dl=__builtin_fmaxf(rm,0.f); mhat+=dl; \
        _Pragma("unroll") for(int r=0;r<16;++r){C0[r]-=dl;C1[r]-=dl;} \
        _Pragma("unroll") for(int r=0;r<16;++r)negm[r]=-mhat; asm volatile("":"+v"(negm)); \
        const float f=__builtin_amdgcn_exp2f(-dl); l_reg*=f; if(hi==0)wsf[r32]=f; resc=true; } } \
    SBAR(); \
    VRD(3); SBAR(); PVM(0,C0,0); \
    VRD(4); SBAR(); PVM(1,C0,2); \
    VRD(5); SBAR(); PVM(2,C0,4); \
    VRD(6); SBAR(); KRD(GL,0); PVM(3,C0,6); \
    VRD(7); SBAR(); PVM(4,C0,8); \
    VRD(8); SBAR(); KRD(GL,1); PVM(5,C0,10); \
    VRD(9); SBAR(); PVM(6,C0,12); \
    VRD(10); SBAR(); KRD(GL,2); PVM(7,C0,14); \
    VRD(11); SBAR(); PVM(8,C1,0); \
    VRD(12); SBAR(); KRD(GL,3); PVM(9,C1,2); \
    VRD(13); SBAR(); PVM(10,C1,4); \
    VRD(14); SBAR(); PVM(11,C1,6); \
    VRD(15); SBAR(); PVM(12,C1,8); \
    PVM(13,C1,10); \
    PVM(14,C1,12); \
    PVM(15,C1,14); \
    }while(0)
  int t=1;
  #undef CMASK
  #define CMASK(P0,P1,t) do{}while(0)
  for(;t+5<NT;t+=2){
    STEP(pB0,pB1,pA0,pA1,t,true,true,true);     WAIT_BAR(3); RESC(); ROT();
    STEP(pA0,pA1,pB0,pB1,t+1,true,true,true);   WAIT_BAR(3); RESC(); ROT();
  }
  #undef CMASK
  #define CMASK(P0,P1,t) do{int jb_=(t)-(NT-4); if(jb_>=0)cmask(P0,P1,jb_,qrel,hi);}while(0)
  #define ENDW(tt) do{ if((tt)+3<NT){WAIT_BAR(3);} else if((tt)+2<NT){WAIT_BAR(2);} else {WAIT_BAR(0);} }while(0)
  for(;t+1<NT;t+=2){
    STEP(pB0,pB1,pA0,pA1,t,(t+3<NT),(t+1<NT),(t+1<NT));       ENDW(t);   RESC(); ROT();
    STEP(pA0,pA1,pB0,pB1,t+1,(t+4<NT),(t+2<NT),(t+2<NT));     ENDW(t+1); RESC(); ROT();
  }
  STEP(pB0,pB1,pA0,pA1,NT-1,false,false,false); RESC();
  { float sacc=pB0[0]+pB0[1]; _Pragma("unroll") for(int r=2;r<16;++r)sacc+=pB0[r]; _Pragma("unroll") for(int r=0;r<16;++r)sacc+=pB1[r]; l_reg+=sacc;
    pw0=(u32x4){PKW(pB0,0),PKW(pB0,2),PKW(pB0,4),PKW(pB0,6)};pw1=(u32x4){PKW(pB0,8),PKW(pB0,10),PKW(pB0,12),PKW(pB0,14)};pw2=(u32x4){PKW(pB1,0),PKW(pB1,2),PKW(pB1,4),PKW(pB1,6)};pw3=(u32x4){PKW(pB1,8),PKW(pB1,10),PKW(pB1,12),PKW(pB1,14)};
    SBAR(); pv(o,vb0+2*sl_cur,PAF(0),PAF(1),PAF(2),PAF(3)); }
  asm volatile("s_waitcnt lgkmcnt(0)\n\ts_barrier":::"memory");
  if(has_next){ const bf16*Kn=K+(long)nb*SEQ*PQ+nkcol,*Vn=V+(long)nb*SEQ*PQ+nvcol;
    const bf16*ksn=Kn+(long)lane*PQ+wid*8; const bf16*vsn=Vn+(long)(16*(wid&3)+(lane>>2))*PQ+(wid>>2)*32+(lane&3)*8;
    glds16(ksn,(unsigned)__builtin_amdgcn_readfirstlane(kdst));
    glds16(vsn,(unsigned)__builtin_amdgcn_readfirstlane(vdst)); glds16(vsn+64,(unsigned)__builtin_amdgcn_readfirstlane(vdst+8192));
    glds16(ksn+(long)KVBLK*PQ,(unsigned)__builtin_amdgcn_readfirstlane(kdst+SLOTB));
    glds16(ksn+(long)2*KVBLK*PQ,(unsigned)__builtin_amdgcn_readfirstlane(kdst+2*SLOTB)); }
  #undef PKW
  #undef PAF
  #undef VFR
  #undef PIN
  #undef MX3
  #undef GAPA
  #undef GAPB
  #undef PVM
  #undef PAFN
  #undef EX
  #undef VRD
  #undef KRD
  #undef STEP
  #undef ENDW
  {auto rr=__builtin_amdgcn_permlane32_swap(__float_as_uint(l_reg),__float_as_uint(l_reg),false,false);l_reg=__uint_as_float(rr[0])+__uint_as_float(rr[1]);}
  if(hi==0)wsf[32+r32]=l_reg;asm volatile("s_waitcnt lgkmcnt(0)":::"memory");
  float rli[16];
  #pragma unroll
  for(int r=0;r<16;++r)rli[r]=__builtin_amdgcn_rcpf(wsf[32+crow(r,hi)]);
  bf16*Ow=O+(rowbase+q0+wid*QBLK)*PO+ocol;
  { bf16*stg=(bf16*)(shm+LDS_OST)+wid*2048;
    if(mode==0){
      #pragma unroll
      for(int ps=0;ps<2;++ps){
        #pragma unroll
        for(int r=0;r<16;++r){const int orow=crow(r,hi);
          #pragma unroll
          for(int d0=0;d0<2;++d0)stg[orow*64+d0*32+r32]=__float2bfloat16(o[2*ps+d0][r]*rli[r]);}
        asm volatile("s_waitcnt lgkmcnt(0)":::"memory");
        #pragma unroll
        for(int i=0;i<4;++i){const int row=i*8+(lane>>3),ch=lane&7; const u32x4 v=*(const u32x4*)(stg+row*64+ch*8); ATTN_STORE16(Ow+(long)row*PO+ps*64+ch*8,v);}
        asm volatile("s_waitcnt lgkmcnt(0)":::"memory"); }
    } else {
      bf16*O2w=O2+(rowbase+q0+wid*QBLK)*PO+ocol;
      float df[2][4][8]; float ssq[4]={0.f,0.f,0.f,0.f};
      #pragma unroll
      for(int ps=0;ps<2;++ps){
        #pragma unroll
        for(int r=0;r<16;++r){const int orow=crow(r,hi);
          #pragma unroll
          for(int d0=0;d0<2;++d0)stg[orow*64+d0*32+r32]=__float2bfloat16(o[2*ps+d0][r]*rli[r]);}
        asm volatile("s_waitcnt lgkmcnt(0)":::"memory");
        #pragma unroll
        for(int i=0;i<4;++i){const int row=i*8+(lane>>3),ch=lane&7; const u32x4 v1=*(const u32x4*)(stg+row*64+ch*8);
          const unsigned long long*p0=(const unsigned long long*)(Ow+(long)row*PO+ps*64+ch*8);
          const unsigned long long a0=__hip_atomic_load(p0,__ATOMIC_RELAXED,__HIP_MEMORY_SCOPE_AGENT),a1=__hip_atomic_load(p0+1,__ATOMIC_RELAXED,__HIP_MEMORY_SCOPE_AGENT);
          const unsigned w0[4]={(unsigned)a0,(unsigned)(a0>>32),(unsigned)a1,(unsigned)(a1>>32)};
          #pragma unroll
          for(int e=0;e<4;++e){ const float x0=__uint_as_float(w0[e]<<16)-lam*__uint_as_float(v1[e]<<16), x1=__uint_as_float(w0[e]&0xffff0000u)-lam*__uint_as_float(v1[e]&0xffff0000u);
            df[ps][i][2*e]=x0; df[ps][i][2*e+1]=x1; ssq[i]+=x0*x0+x1*x1; } }
        asm volatile("s_waitcnt lgkmcnt(0)":::"memory"); }
      #pragma unroll
      for(int i=0;i<4;++i){ float q=ssq[i]; q+=__shfl_xor(q,1); q+=__shfl_xor(q,2); q+=__shfl_xor(q,4); ssq[i]=__builtin_amdgcn_rsqf(q*(1.f/128.f)+1e-5f); }
      #pragma unroll
      for(int ps=0;ps<2;++ps){ const int ch=lane&7; const __attribute__((address_space(3))) float*gp=gn+ps*64+ch*8; float g8[8];
        #pragma unroll
        for(int e=0;e<8;++e)g8[e]=gp[e];
        #pragma unroll
        for(int i=0;i<4;++i){const int row=i*8+(lane>>3); u32x4 w;
          w[0]=cvtpk_s(df[ps][i][0]*ssq[i]*g8[0],df[ps][i][1]*ssq[i]*g8[1]); w[1]=cvtpk_s(df[ps][i][2]*ssq[i]*g8[2],df[ps][i][3]*ssq[i]*g8[3]);
          w[2]=cvtpk_s(df[ps][i][4]*ssq[i]*g8[4],df[ps][i][5]*ssq[i]*g8[5]); w[3]=cvtpk_s(df[ps][i][6]*ssq[i]*g8[6],df[ps][i][7]*ssq[i]*g8[7]);
          ATTN_STORE16(O2w+(long)row*PO+ps*64+ch*8,w);} }
    } }
  asm volatile("s_waitcnt lgkmcnt(0)\n\ts_barrier":::"memory");
  #undef DMA_K
  #undef DMA_V
  #undef CMASK
  #undef START
  #undef RESC
  #undef ROT
}
constexpr int ATTN_LDS_BYTES=LDS_BYTES;
struct AttnTensors { const bf16* Q; const bf16* K; const bf16* V; bf16* O0; bf16* O2; float lam; const __attribute__((address_space(3))) float* gn; };
struct AttnUnit { int bh; int qb; };
struct StaticOrder {
  int vcu,G;
  __device__ __forceinline__ explicit StaticOrder(int grid,int block):vcu((grid%8==0)?(block%8)*(grid/8)+block/8:block),G(grid){}
  __device__ __forceinline__ bool next(int i,AttnUnit&u)const{ const int pi=vcu+(i>>1)*G; if(pi>=BATCH*8*16)return false; const int s=pi&15; u.bh=pi>>4; u.qb=(i&1)?31-s:s; return true; }
  __device__ __forceinline__ void a_ready(const AttnUnit&)const{}
  __device__ __forceinline__ void done(const AttnUnit&)const{}
};
template<class Sched,int THRL=8> __device__ __forceinline__ void attn_phase(char*lds,const AttnTensors&T,const Sched&S){
  AttnUnit u,un; bool pre=false;
  if(!S.next(0,u))return;
  for(int i=0;;++i){ S.a_ready(u); const int b=u.bh>>3,h=u.bh&7; const bool more=S.next(i+1,un); const int nb=un.bh>>3,nh=un.bh&7;
    for(int c=0;c<2;++c) attn_unit<THRL>(b,h*128+c*64,h*128+c*64,h*128,h*128,u.qb,T.Q,T.K,T.V,T.O0,T.O2,c,T.lam,T.gn,lds,pre||c==1,c==0||more,c==0?b:nb,c==0?h*128+64:nh*128,c==0?h*128:nh*128);
    S.done(u); if(!more)break; u=un; pre=true; }
}
#undef SBAR
#undef WAIT_BAR
}


#ifndef MK_P2_NOKWT
#define MK_P2_NOKWT 0
#endif

#ifndef MK_P4_HALFLDS
#define MK_P4_HALFLDS 0
#endif

constexpr int NWAVES = 8;
constexpr int T = 32768, D = 1024, SEQ = 8192, NB = 4;
constexpr int ML_H = 4, ML_DV = 512, ML_DQK = 256, ML_QK = 1024, ML_V = 2048, ML_LD = 6152, NCH = 128;
constexpr int VT_ROWS = 544;
constexpr int NEXP = 32, DEXP = 256, MAXPANEL = 288, MAXSLOT = MAXPANEL * 256;
constexpr float LAMBDA_INIT1 = 0.35550906759f;

constexpr size_t MiB = 1u << 20;
constexpr size_t WS_CTL = 0, CTL_ZERO_BYTES = 1 * MiB;
constexpr size_t WS_GATES = 1 * MiB;
constexpr size_t WS_SA = 2 * MiB, WS_SB = WS_SA + 512 * 1024, WS_SIS = 3 * MiB, WS_SFL = WS_SIS + 512 * 1024, WS_RS = 4 * MiB, WS_QN = WS_RS + 512 * 1024;
constexpr size_t WS_CHB = 5 * MiB, WS_CHM = WS_CHB + 8192, WS_DEC = WS_CHM + 8192;
constexpr size_t WS_WR = 5 * MiB + 512 * 1024;
constexpr size_t WS_TE = 6 * MiB, WS_TW = WS_TE + 256 * 1024, WS_TPOS = WS_TW + 256 * 1024, WS_TSLOT = WS_TPOS + 256 * 1024;
constexpr size_t WS_ERS = 1 * MiB, WS_RSTD = 5 * MiB;
constexpr size_t WS_E2T = 8 * MiB, WS_EW = 12 * MiB;
constexpr size_t WS_WML_IN = 16 * MiB, WS_WML_OUT = 28 * MiB;
constexpr size_t WS_KWT = 32 * MiB;
constexpr size_t WS_WDA_IN = 504 * MiB, WS_WDA_OUT = 510 * MiB, WS_WGU = 40 * MiB, WS_WDN = 72 * MiB;
constexpr size_t WS_WGU1 = 196 * MiB, WS_WDN1 = 228 * MiB;
constexpr size_t WS_R0 = 96 * MiB;
constexpr size_t WS_QKRAW = WS_R0, WS_OG = WS_R0 + 128 * MiB, WS_VT = WS_R0 + 256 * MiB;
constexpr size_t WS_WGU0 = WS_R0 + 192 * MiB, WS_WDN0 = WS_WGU0 + 32 * MiB;
constexpr size_t WS_PG = 488 * MiB;
constexpr size_t WS_HN = WS_R0;
constexpr size_t WS_ACT = WS_R0 + 64 * MiB, WS_YS = 352 * MiB;
constexpr size_t WS_AQ = 244 * MiB, WS_AK = WS_AQ + 64 * MiB, WS_AV = WS_AK + 64 * MiB, WS_AO = WS_AV + 64 * MiB;
constexpr size_t WS_END = WS_YS + 144 * MiB;
static_assert(WS_VT + (size_t)4 * VT_ROWS * T * 2 <= 488 * MiB && WS_END <= 496 * MiB && WS_AO + (size_t)T * 1024 * 2 <= 504 * MiB && WS_WDN0 + 16 * MiB <= WS_VT && WS_WDN1 + 16 * MiB <= WS_AQ && WS_ACT + 36 * MiB <= WS_WGU1, "d_ws map");
constexpr int CW_BAR = 4096;
constexpr int CW_CNT = 16384;

constexpr int RING_OFF = 0, RING_BYTES = 131072;
constexpr int LDSCTL_OFF = RING_BYTES, MISC_OFF = LDSCTL_OFF + 320;
constexpr int TAB_OFF = LDSCTL_OFF + 1024;
constexpr int TAB_PEXP = TAB_OFF, TAB_ECNT = TAB_OFF + 1280, TAB_EOFF = TAB_ECNT + 128, TAB_NP = TAB_EOFF + 136;
constexpr int HST_OFF = TAB_OFF;
constexpr int LDS_BYTES = 148480;

#define GAS __attribute__((address_space(1)))
#define LAS __attribute__((address_space(3)))
typedef unsigned short bf16;
typedef unsigned v4u __attribute__((ext_vector_type(4)));
typedef unsigned v2u __attribute__((ext_vector_type(2)));
typedef float f32x4 __attribute__((ext_vector_type(4)));
typedef float f32x2 __attribute__((ext_vector_type(2)));
typedef short bf16x8 __attribute__((ext_vector_type(8)));
typedef GAS unsigned gu32;
#define RLX_AGENT __ATOMIC_RELAXED, __HIP_MEMORY_SCOPE_AGENT
#define LDS_WAIT() asm volatile("s_waitcnt lgkmcnt(0)" ::: "memory")
__device__ __forceinline__ unsigned f2bf(float f) { unsigned u = __builtin_bit_cast(unsigned, f); return (u + 0x7fffu + ((u >> 16) & 1u)) >> 16; }
__device__ __forceinline__ unsigned pk2(float lo, float hi) { typedef float f2v_t __attribute__((ext_vector_type(2))); typedef __bf16 b2v_t __attribute__((ext_vector_type(2)));
    f2v_t v = {lo, hi}; b2v_t b = __builtin_convertvector(v, b2v_t); return __builtin_bit_cast(unsigned, b); }
__device__ __forceinline__ float bf_lo(unsigned w) { return __builtin_bit_cast(float, w << 16); }
__device__ __forceinline__ float bf_hi(unsigned w) { return __builtin_bit_cast(float, w & 0xffff0000u); }
__device__ __forceinline__ float bf1(bf16 h) { return __builtin_bit_cast(float, (unsigned)h << 16); }
__device__ __forceinline__ float wave_sum(float v) {
#pragma unroll
    for (int o = 1; o < 64; o <<= 1) v += __shfl_xor(v, o);
    return v;
}
__device__ __forceinline__ float wave_max(float v) {
#pragma unroll
    for (int o = 1; o < 64; o <<= 1) v = fmaxf(v, __shfl_xor(v, o));
    return v;
}
__device__ __forceinline__ float prefix_sum_incl(float v, int lane) {
#pragma unroll
    for (int o = 1; o < 64; o <<= 1) { const float u = __shfl_up(v, o); if (lane >= o) v += u; }
    return v;
}
__device__ __forceinline__ float prefix_max_incl(float v, int lane) {
#pragma unroll
    for (int o = 1; o < 64; o <<= 1) { const float u = __shfl_up(v, o); if (lane >= o) v = fmaxf(v, u); }
    return v;
}
__device__ __forceinline__ float log_sigmoid(float z) { return fminf(z, 0.f) - log1pf(__expf(-fabsf(z))); }
__device__ __forceinline__ float sigmoidf_(float z) { return 1.f / (1.f + __expf(-z)); }
#define XB_TMO      128
#define XB_XCNT(j)  (256  + 64 * (j))
#define XB_XSUB(j)  (1280 + 64 * (j))
#define XB_XGEN(j)  (2304 + 64 * (j))
#define XB_TOP      3328
#define XB_TOPGEN   3392
#define XCD_BAR_WORDS 3456
#define XB_SPIN_CAP (1u << 18)

__device__ __forceinline__ unsigned xb_ld(unsigned* p)              { return __hip_atomic_load(p, __ATOMIC_RELAXED, __HIP_MEMORY_SCOPE_AGENT); }
__device__ __forceinline__ unsigned xb_add(unsigned* p, unsigned v) { return __hip_atomic_fetch_add(p, v, __ATOMIC_RELAXED, __HIP_MEMORY_SCOPE_AGENT); }
__device__ __forceinline__ unsigned xb_xcc_id() { return (unsigned)__builtin_amdgcn_s_getreg((3 << 11) | 20) & 0xFu; }
#define XB_SPIN(cond, bar) do { unsigned _sp = 0; while (cond) { __builtin_amdgcn_s_sleep(1); \
    if ((++_sp & 255u) == 0u) { if (xb_ld(&(bar)[XB_TMO])) break; if (_sp > XB_SPIN_CAP) { atomicAdd(&(bar)[XB_TMO], 1u); break; } } } } while (0)

struct XcdBarrier {
    unsigned* bar; unsigned x;
    volatile LAS unsigned* st;
};

__device__ __forceinline__ XcdBarrier xcd_barrier_post(unsigned* bar, volatile LAS unsigned* st) {
    XcdBarrier b; b.bar = bar; b.x = xb_xcc_id(); b.st = st;
    if (threadIdx.x == 0) (void)xb_add(&bar[XB_XCNT(b.x)], 1u);
    return b;
}
__device__ __forceinline__ void xcd_barrier_complete(unsigned* bar, unsigned x, unsigned& nloc, unsigned& nx) {
    const unsigned G = gridDim.x * gridDim.y * gridDim.z;
    unsigned sum, cnt, mine, sp = 0u;
    for (;;) {
        sum = 0u; cnt = 0u; mine = 0u;
#pragma unroll
        for (unsigned j = 0; j < 16; ++j) { const unsigned c = xb_ld(&bar[XB_XCNT(j)]); sum += c; cnt += (c > 0u) ? 1u : 0u; mine = (j == x) ? c : mine; }
        if (sum == G) break;
        __builtin_amdgcn_s_sleep(1);
        if ((++sp & 255u) == 0u) { if (xb_ld(&bar[XB_TMO])) break; if (sp > XB_SPIN_CAP) { atomicAdd(&bar[XB_TMO], 1u); break; } }
    }
    nloc = mine > 0u ? mine : 1u; nx = cnt > 0u ? cnt : 1u;
}

__device__ __forceinline__ void xcd_barrier(const XcdBarrier& b) {
    asm volatile("s_waitcnt vmcnt(0)" ::: "memory");
    __syncthreads();
    if (threadIdx.x == 0) {
        unsigned* bar = b.bar;
        __builtin_amdgcn_s_waitcnt(0);
        unsigned nloc = b.st[0], nx = b.st[1];
        if (nloc == 0u) { xcd_barrier_complete(bar, b.x, nloc, nx); b.st[0] = nloc; b.st[1] = nx; }
        const unsigned old = xb_add(&bar[XB_XSUB(b.x)], 1u);
        const unsigned gen = old / nloc;
        if (old + 1u == (gen + 1u) * nloc) {
            __builtin_amdgcn_fence(__ATOMIC_RELEASE, "agent");
            asm volatile("s_waitcnt vmcnt(0)" ::: "memory");
            const unsigned og = xb_add(&bar[XB_TOP], 1u);
            const unsigned tg = og / nx;
            if (og + 1u == (tg + 1u) * nx) xb_add(&bar[XB_TOPGEN], 1u);
            else XB_SPIN(xb_ld(&bar[XB_TOPGEN]) == tg, bar);
            __builtin_amdgcn_fence(__ATOMIC_ACQUIRE, "agent");
            xb_add(&bar[XB_XGEN(b.x)], 1u);
            asm volatile("s_waitcnt vmcnt(0)" ::: "memory");
        } else {
            XB_SPIN(xb_ld(&bar[XB_XGEN(b.x)]) == gen, bar);
            __builtin_amdgcn_fence(__ATOMIC_ACQUIRE, "agent");
            asm volatile("s_waitcnt vmcnt(0)" ::: "memory");
        }
    }
    __syncthreads();
}


struct Ctx { LAS unsigned char* lds; int tid, lane, wave, vcu, G, gw, NGW; };

__device__ __forceinline__ void tr_item(const float* W, int ld, int K, int k0, int c0, bf16* WT, int drow0, LAS float* scr, int lane, const float* kscale = nullptr) {
    f32x4 wv[8];
#pragma unroll
    for (int i = 0; i < 8; ++i) { wv[i] = *(const GAS f32x4*)(W + (size_t)(k0 + 8 * i + (lane >> 3)) * ld + c0 + 4 * (lane & 7)); if (kscale) wv[i] = wv[i] * kscale[k0 + 8 * i + (lane >> 3)]; }
#pragma unroll
    for (int i = 0; i < 8; ++i) { LAS float* d = scr + (8 * i + (lane >> 3)) * 33 + 4 * (lane & 7); d[0] = wv[i].x; d[1] = wv[i].y; d[2] = wv[i].z; d[3] = wv[i].w; }
    LDS_WAIT(); asm volatile("" ::: "memory");
    const int c = lane & 7;
#pragma unroll
    for (int j = 0; j < 4; ++j) { const int n = (lane >> 3) + 8 * j; const LAS float* s = scr + (8 * c) * 33 + n;
        v4u o; o.x = pk2(s[0 * 33], s[1 * 33]); o.y = pk2(s[2 * 33], s[3 * 33]); o.z = pk2(s[4 * 33], s[5 * 33]); o.w = pk2(s[6 * 33], s[7 * 33]);
        *(GAS v4u*)(WT + (size_t)(drow0 + n) * K + k0 + 8 * c) = o; }
    LDS_WAIT(); asm volatile("" ::: "memory");
}
__device__ __forceinline__ void tr_load(f32x4 (&wv)[8], float (&ks)[8], const float* W, int ld, int k0, int c0, int lane, const float* kscale) {
#pragma unroll
    for (int i = 0; i < 8; ++i) { wv[i] = *(const GAS f32x4*)(W + (size_t)(k0 + 8 * i + (lane >> 3)) * ld + c0 + 4 * (lane & 7)); ks[i] = kscale ? kscale[k0 + 8 * i + (lane >> 3)] : 1.f; }
}
__device__ __forceinline__ void tr_finish(const f32x4 (&wv)[8], const float (&ks)[8], int K, int k0, bf16* WT, int drow0, LAS float* scr, int lane) {
#pragma unroll
    for (int i = 0; i < 8; ++i) { LAS float* d = scr + (8 * i + (lane >> 3)) * 33 + 4 * (lane & 7); const f32x4 w = wv[i] * ks[i]; d[0] = w.x; d[1] = w.y; d[2] = w.z; d[3] = w.w; }
    LDS_WAIT(); asm volatile("" ::: "memory");
    const int c = lane & 7;
#pragma unroll
    for (int j = 0; j < 4; ++j) { const int n = (lane >> 3) + 8 * j; const LAS float* s = scr + (8 * c) * 33 + n;
        v4u o; o.x = pk2(s[0 * 33], s[1 * 33]); o.y = pk2(s[2 * 33], s[3 * 33]); o.z = pk2(s[4 * 33], s[5 * 33]); o.w = pk2(s[6 * 33], s[7 * 33]);
        *(GAS v4u*)(WT + (size_t)(drow0 + n) * K + k0 + 8 * c) = o; }
    LDS_WAIT(); asm volatile("" ::: "memory");
}
__device__ __forceinline__ void tr_matrix_items(const Ctx& C, const float* W, int K, int N, bf16* WT, int& it0) {
    (void)C; (void)W; (void)K; (void)N; (void)WT; (void)it0;
}

__device__ __forceinline__ void conv_ml_out(const Ctx& C, const float* ml_w_out, unsigned char* ws) {
    LAS float* scr = (LAS float*)(C.lds + RING_OFF + C.wave * 16384); bf16* wml_out = (bf16*)(ws + WS_WML_OUT);
    for (int it = C.gw; it < 32 * 32; it += C.NGW) { const int kb = it / 32, nb = it % 32; tr_item(ml_w_out, D, ML_V, kb * 64, nb * 32, wml_out, nb * 32, scr, C.lane); }
}
__device__ __forceinline__ void p0_prologue(const Ctx& C, const float* x, const float* norm_mix0, const float* ml_w_in, const float* ml_w_out,
                                            const float* norm_ffn, const float* w_group, const float* w_expert, unsigned char* ws, bf16* hn0) {
    LAS float* scr = (LAS float*)(C.lds + RING_OFF + C.wave * 16384);
    bf16* wml_in = (bf16*)(ws + WS_WML_IN); bf16* wml_out = (bf16*)(ws + WS_WML_OUT);
    constexpr int I_IN = 16 * 192;
    for (int it = C.gw; it < I_IN; it += C.NGW) {
        const int kb = it / 192, nb = it % 192, c0 = nb * 32;
        const int drow = c0 < 2048 ? c0 : (c0 < 4096 ? c0 + 2048 : c0 - 2048);
        tr_item(ml_w_in, ML_LD, D, kb * 64, c0, wml_in, drow, scr, C.lane);
    }
    (void)wml_out; (void)ml_w_out;
    { bf16* WRH = (bf16*)(ws + WS_WR); bf16* WRL = WRH + 2 * 32 * 3 * 4 * 16 * 8; const int n = 2 * 32 * 3 * 4 * 16 * 8;
      for (int idx = C.gw * 64 + C.lane; idx < n; idx += C.NGW * 64) {
          int r = idx; const int j = r & 7; r >>= 3; const int c15 = r & 15; r >>= 4; const int g4 = r & 3; r >>= 2; const int ct = r % 3; r /= 3; const int ks = r & 31; const int l = r >> 5;
          const int k = 32 * ks + 8 * g4 + j, col = 16 * ct + c15;
          float w = 0.f; if (col < 4) w = w_group[((size_t)l * D + k) * 4 + col]; else if (col < 36) w = w_expert[((size_t)l * D + k) * 32 + (col - 4)];
          w *= norm_ffn[l * D + k];
          const unsigned hb = f2bf(w); const float hf = __builtin_bit_cast(float, hb << 16);
          WRH[idx] = (bf16)hb; WRL[idx] = (bf16)f2bf(w - hf); } }
    { bf16* vt = (bf16*)(ws + WS_VT); const int per_head = 32 * (T / 8);
      for (int idx = C.gw * 64 + C.lane; idx < 4 * per_head; idx += C.NGW * 64) { const int h = idx / per_head, r = idx % per_head, row = r / (T / 8), ch = r % (T / 8);
          const unsigned v = row == 0 ? 0x3f803f80u : 0u; *(GAS v4u*)(vt + ((size_t)(h * VT_ROWS + 512 + row)) * T + ch * 8) = (v4u){v, v, v, v}; } }
    { float* gates = (float*)(ws + WS_GATES);
      f32x4 gn[4]; float wg[4][4][8];
#pragma unroll
      for (int j = 0; j < 4; ++j) { gn[j] = *(const f32x4*)(norm_mix0 + 4 * C.lane + 256 * j);
#pragma unroll
          for (int e = 0; e < 4; ++e) { const float* p = ml_w_in + (size_t)(4 * C.lane + 256 * j + e) * ML_LD + 6144; const f32x4 a = *(const f32x4*)p, b = *(const f32x4*)(p + 4);
              wg[j][e][0] = a.x; wg[j][e][1] = a.y; wg[j][e][2] = a.z; wg[j][e][3] = a.w; wg[j][e][4] = b.x; wg[j][e][5] = b.y; wg[j][e][6] = b.z; wg[j][e][7] = b.w; } }
      f32x4 v[4], vn[4];
      if (C.gw < T) {
#pragma unroll
          for (int j = 0; j < 4; ++j) vn[j] = ((const GAS f32x4*)(x + (size_t)C.gw * D) + C.lane)[64 * j]; }
      for (int m = C.gw; m < T; m += C.NGW) {
#pragma unroll
          for (int j = 0; j < 4; ++j) v[j] = vn[j];
          if (m + C.NGW < T) {
#pragma unroll
              for (int j = 0; j < 4; ++j) vn[j] = ((const GAS f32x4*)(x + (size_t)(m + C.NGW) * D) + C.lane)[64 * j]; }
          float ss = 0.f;
#pragma unroll
          for (int j = 0; j < 4; ++j) ss += (v[j].x * v[j].x + v[j].y * v[j].y) + (v[j].z * v[j].z + v[j].w * v[j].w);
          const float rstd = rsqrtf(wave_sum(ss) * (1.f / D) + 1e-6f);
          GAS unsigned long long* o8 = (GAS unsigned long long*)(hn0 + (size_t)m * D) + C.lane;
          float ga[8];
#pragma unroll
          for (int c = 0; c < 8; ++c) ga[c] = 0.f;
#pragma unroll
          for (int j = 0; j < 4; ++j) { v[j] = v[j] * rstd * gn[j];
              o8[64 * j] = (unsigned long long)pk2(v[j].x, v[j].y) | ((unsigned long long)pk2(v[j].z, v[j].w) << 32);
#pragma unroll
              for (int c = 0; c < 8; ++c) ga[c] += (v[j].x * wg[j][0][c] + v[j].y * wg[j][1][c]) + (v[j].z * wg[j][2][c] + v[j].w * wg[j][3][c]); }
          float h4[4], h2[2], h1;
          { const bool up = (C.lane & 32) != 0;
#pragma unroll
            for (int c = 0; c < 4; ++c) { const float keep = up ? ga[c + 4] : ga[c], give = up ? ga[c] : ga[c + 4]; h4[c] = keep + __shfl_xor(give, 32); } }
          { const bool up = (C.lane & 16) != 0;
#pragma unroll
            for (int c = 0; c < 2; ++c) { const float keep = up ? h4[c + 2] : h4[c], give = up ? h4[c] : h4[c + 2]; h2[c] = keep + __shfl_xor(give, 16); } }
          { const bool up = (C.lane & 8) != 0; const float keep = up ? h2[1] : h2[0], give = up ? h2[0] : h2[1]; h1 = keep + __shfl_xor(give, 8); }
          h1 += __shfl_xor(h1, 4); h1 += __shfl_xor(h1, 2); h1 += __shfl_xor(h1, 1);
          if ((C.lane & 7) == 0) gates[(size_t)m * 8 + (((C.lane >> 5) & 1) << 2 | ((C.lane >> 4) & 1) << 1 | ((C.lane >> 3) & 1))] = h1;
      } }
}

__device__ __forceinline__ void p1_gate_chunks(const Ctx& C, const float* b_i, const float* b_f, unsigned char* ws) {
    const float* gates = (const float*)(ws + WS_GATES); float* chb = (float*)(ws + WS_CHB); float* chm = (float*)(ws + WS_CHM);
    for (int it = C.gw; it < 16 * NCH; it += C.NGW) {
        const int bh = it >> 7, c = it & 127, b = bh >> 2, h = bh & 3; const size_t t = (size_t)b * SEQ + c * 64 + C.lane;
        const float gi = gates[t * 8 + h] + b_i[h]; const float lf = log_sigmoid(gates[t * 8 + 4 + h] + b_f[h]);
        const float bc = prefix_sum_incl(lf, C.lane); const float bL = __shfl(bc, 63);
        const float mx = wave_max(bL - bc + gi);
        if (C.lane == 0) { chb[it] = bL; chm[it] = mx; }
    }
}

__device__ __forceinline__ void p2_conv(const Ctx& C, const float* b_i, const float* b_f, const float* conv_w, unsigned char* ws, bf16* Qo, bf16* Ko, int probe = 0) {
    const float* gates = (const float*)(ws + WS_GATES); const float* chb = (const float*)(ws + WS_CHB); const float* chm = (const float*)(ws + WS_CHM);
    float* SA = (float*)(ws + WS_SA); float* SB = (float*)(ws + WS_SB); float* SIS = (float*)(ws + WS_SIS); float* SFL = (float*)(ws + WS_SFL); float* DEC = (float*)(ws + WS_DEC);
    const bf16* raw = (const bf16*)(ws + WS_QKRAW); bf16* kwt = (bf16*)(ws + WS_KWT);
    LAS float* wsl = (LAS float*)(C.lds + TAB_OFF + 4096);
    LAS unsigned char* kst = C.lds + RING_OFF;
    const int rg = C.tid >> 8, ct = C.tid & 255; const bool isk = (C.wave & 2) != 0;
    float w[4][8];
#pragma unroll
    for (int j = 0; j < 4; ++j) { const f32x4 a = *(const f32x4*)(conv_w + j * 2048 + 8 * ct), b = *(const f32x4*)(conv_w + j * 2048 + 8 * ct + 4);
        w[j][0] = a.x; w[j][1] = a.y; w[j][2] = a.z; w[j][3] = a.w; w[j][4] = b.x; w[j][5] = b.y; w[j][6] = b.z; w[j][7] = b.w; }
    for (int item = C.vcu; item < NB * NCH; item += C.G) {
        const int b = item >> 7, c = item & 127; const size_t t0 = (size_t)b * SEQ + c * 64;
        if (C.wave < 4) {
            const int h = C.wave, bh = b * 4 + h;
            float a0 = chb[bh * 128 + C.lane], m0 = chm[bh * 128 + C.lane], a1 = chb[bh * 128 + 64 + C.lane], m1 = chm[bh * 128 + 64 + C.lane];
#pragma unroll
            for (int o = 1; o < 64; o <<= 1) { const float pa0 = __shfl_up(a0, o), pm0 = __shfl_up(m0, o), pa1 = __shfl_up(a1, o), pm1 = __shfl_up(m1, o);
                if (C.lane >= o) { m0 = fmaxf(pm0 + a0, m0); a0 += pa0; m1 = fmaxf(pm1 + a1, m1); a1 += pa1; } }
            const float mA = fmaxf(a0, m0);
            const float m64 = __shfl(mA, 63);
            const float mB = fmaxf(m64 + a1, m1);
            const float mc_a = __shfl(mA, (c + 63) & 63), mc_b = __shfl(mB, (c + 63) & 63);
            const float mc = c == 0 ? 0.f : (c <= 64 ? mc_a : mc_b);
            const float mn_a = __shfl(mA, c & 63), mn_b = __shfl(mB, c & 63);
            const float mn = c < 64 ? mn_a : mn_b;
            const size_t t = t0 + C.lane;
            const float gi = gates[t * 8 + h] + b_i[h]; const float lf = log_sigmoid(gates[t * 8 + 4 + h] + b_f[h]);
            const float bc = prefix_sum_incl(lf, C.lane); const float bL = __shfl(bc, 63);
            const float Bv = gi - bc; const float cmx = prefix_max_incl(Bv, C.lane);
            const float Aa = -fmaxf(mc, cmx);
            SA[t * 4 + h] = Aa; SB[t * 4 + h] = Bv; SIS[t * 4 + h] = __expf(mc + Aa); SFL[t * 4 + h] = __expf(Aa - bc);
            wsl[h * 64 + C.lane] = __expf(bL + Bv - mn);
            if (C.lane == 0) DEC[bh * 128 + c] = __expf(bL + mc - mn);
        }
        __syncthreads();
        float x3[8], x2[8], x1[8];
        {   const int sb = c * 64 + 32 * rg - 3;
            const bf16* rp = raw + (t0 + 32 * rg - 3) * 2048 + 8 * ct;
            v4u r3 = (v4u){0u, 0u, 0u, 0u}, r2 = r3, r1 = r3;
            if (sb >= 0) r3 = *(const GAS v4u*)(rp); if (sb + 1 >= 0) r2 = *(const GAS v4u*)(rp + 2048); if (sb + 2 >= 0) r1 = *(const GAS v4u*)(rp + 4096);
#pragma unroll
            for (int e = 0; e < 4; ++e) { x3[2 * e] = bf_lo(r3[e]); x3[2 * e + 1] = bf_hi(r3[e]); x2[2 * e] = bf_lo(r2[e]); x2[2 * e + 1] = bf_hi(r2[e]); x1[2 * e] = bf_lo(r1[e]); x1[2 * e + 1] = bf_hi(r1[e]); } }
        const int kh = (ct - 128) >> 5;
        const bf16* rbase = raw + (t0 + 32 * rg) * 2048 + 8 * ct;
        v4u rr[8];
#pragma unroll
        for (int r = 0; r < 8; ++r) rr[r] = *(const GAS v4u*)(rbase + (size_t)r * 2048);
        for (int blk = 0; blk < 4; ++blk) {
            v4u rc[8];
#pragma unroll
            for (int r = 0; r < 8; ++r) rc[r] = rr[r];
            if (blk < 3) {
#pragma unroll
                for (int r = 0; r < 8; ++r) rr[r] = *(const GAS v4u*)(rbase + (size_t)((blk + 1) * 8 + r) * 2048);
            }
            float yy[8][8];
#pragma unroll
            for (int r = 0; r < 8; ++r) {
                float cur[8];
#pragma unroll
                for (int e = 0; e < 4; ++e) { cur[2 * e] = bf_lo(rc[r][e]); cur[2 * e + 1] = bf_hi(rc[r][e]); }
#pragma unroll
                for (int e = 0; e < 8; ++e) { const float sv = (w[0][e] * x3[e] + w[1][e] * x2[e]) + (w[2][e] * x1[e] + w[3][e] * cur[e]);
                    yy[r][e] = sv * __builtin_amdgcn_rcpf(1.f + __builtin_amdgcn_exp2f(-1.4426950408889634f * sv));     x3[e] = x2[e]; x2[e] = x1[e]; x1[e] = cur[e]; }
            }
            if (!isk) {
#pragma unroll
                for (int r = 0; r < 8; ++r) { const int row = 32 * rg + blk * 8 + r; const float* y = yy[r]; if (!(probe & 2))
                    *(GAS v4u*)(Qo + (t0 + row) * 1024 + 8 * ct) = (v4u){pk2(y[0] * 0.0625f, y[1] * 0.0625f), pk2(y[2] * 0.0625f, y[3] * 0.0625f), pk2(y[4] * 0.0625f, y[5] * 0.0625f), pk2(y[6] * 0.0625f, y[7] * 0.0625f)}; }
            } else {
#pragma unroll
                for (int r = 0; r < 8; ++r) { const int row = 32 * rg + blk * 8 + r; const float* y = yy[r]; if (!(probe & 2))
                    *(GAS v4u*)(Ko + (t0 + row) * 1024 + 8 * (ct - 128)) = (v4u){pk2(y[0], y[1]), pk2(y[2], y[3]), pk2(y[4], y[5]), pk2(y[6], y[7])}; }
                float wv[8];
#pragma unroll
                for (int r = 0; r < 8; ++r) wv[r] = wsl[kh * 64 + 32 * rg + blk * 8 + r];
#pragma unroll
                for (int e = 0; e < 8; ++e)
                    *(LAS v4u*)(kst + (8 * (ct - 128) + e) * 128 + (((4 * rg + blk) ^ ((ct - 128) & 7)) * 16)) =
                        (v4u){pk2(yy[0][e] * wv[0], yy[1][e] * wv[1]), pk2(yy[2][e] * wv[2], yy[3][e] * wv[3]), pk2(yy[4][e] * wv[4], yy[5][e] * wv[5]), pk2(yy[6][e] * wv[6], yy[7][e] * wv[7])};
            }
        }
        __syncthreads();
        if (!(probe & 1)) {
#pragma unroll 4
            for (int j = 0; j < 16; ++j) { const int q = j * 512 + C.tid, dg = q >> 3, pc = q & 7;
                const v4u v = *(const LAS v4u*)(kst + dg * 128 + ((pc ^ ((dg >> 3) & 7)) * 16));
                *(GAS v4u*)(kwt + ((size_t)((b * 4 + (dg >> 8)) * NCH + c) * 256 + (dg & 255)) * 64 + pc * 8) = v; } }
        __syncthreads();
    }
}

__device__ __forceinline__ unsigned cvtpk(float lo, float hi);
#define MFMA16(a, b, c) __builtin_amdgcn_mfma_f32_16x16x32_bf16((a), (b), (c), 0, 0, 0)
__device__ __forceinline__ void p3a_scores(const Ctx& C, unsigned char* ws, const bf16* Q, const bf16* K, int first, int stride) {
    const float* SA = (const float*)(ws + WS_SA); const float* SB = (const float*)(ws + WS_SB); float* RS = (float*)(ws + WS_RS); bf16* Pg = (bf16*)(ws + WS_PG);
    LAS float* rsum = (LAS float*)(C.lds + RING_OFF + 92160);
    const int l15 = C.lane & 15, g = C.lane >> 4, tb = C.wave & 3, sh = C.wave >> 2;
    for (int item = first; item < 16 * NCH; item += stride) {
        const int bh = item >> 7, c = item & 127, b = bh >> 2, h = bh & 3; const size_t t0 = (size_t)b * SEQ + c * 64;
        bf16* Pi = Pg + (size_t)item * 4096;
        const int t = tb * 16 + l15;
        bf16x8 qa[8], ka[2][8]; float At = 0.f, Bs[2][4];
        const bool need0 = 2 * sh <= tb, need1 = 2 * sh + 1 <= tb;
        if (need0) {
            const bf16* qp = Q + (t0 + tb * 16 + l15) * 1024 + h * 256 + 8 * g;
#pragma unroll
            for (int ks = 0; ks < 8; ++ks) qa[ks] = *(const GAS bf16x8*)(qp + 32 * ks);
            At = SA[(t0 + t) * 4 + h];
#pragma unroll
            for (int sbi = 0; sbi < 2; ++sbi) { if (sbi == 0 || need1) { const int sb = 2 * sh + sbi; const bf16* kp = K + (t0 + sb * 16 + l15) * 1024 + h * 256 + 8 * g;
#pragma unroll
                for (int ks = 0; ks < 8; ++ks) ka[sbi][ks] = *(const GAS bf16x8*)(kp + 32 * ks);
#pragma unroll
                for (int r = 0; r < 4; ++r) Bs[sbi][r] = SB[(t0 + sb * 16 + 4 * g + r) * 4 + h]; } }
        }
#pragma unroll
        for (int sbi = 0; sbi < 2; ++sbi) {
            const int sb = 2 * sh + sbi;
            if (sb > tb) { *(GAS v2u*)(Pi + t * 64 + sb * 16 + 4 * g) = (v2u){0u, 0u}; if (g == 0) rsum[sb * 64 + t] = 0.f; }
            else {
                f32x4 acc = (f32x4){0.f, 0.f, 0.f, 0.f};
#pragma unroll
                for (int ks = 0; ks < 8; ++ks) acc = MFMA16(ka[sbi][ks], qa[ks], acc);
                float p[4], q = 0.f;
#pragma unroll
                for (int r = 0; r < 4; ++r) { const int s_ = sb * 16 + 4 * g + r; p[r] = (s_ <= t) ? acc[r] * __expf(At + Bs[sbi][r]) : 0.f; q += p[r]; }
                *(GAS v2u*)(Pi + t * 64 + sb * 16 + 4 * g) = (v2u){cvtpk(p[0], p[1]), cvtpk(p[2], p[3])};
                q += __shfl_xor(q, 16); q += __shfl_xor(q, 32);
                if (g == 0) rsum[sb * 64 + t] = q;
            }
        }
        asm volatile("s_waitcnt lgkmcnt(0)\n\ts_barrier" ::: "memory");
        if (C.tid < 64) RS[(t0 + C.tid) * 4 + h] = (rsum[C.tid] + rsum[64 + C.tid]) + (rsum[128 + C.tid] + rsum[192 + C.tid]);
        asm volatile("s_waitcnt lgkmcnt(0)\n\ts_barrier" ::: "memory");
    }
}

template <bool DRY>
__device__ __forceinline__ void p3_intra(const Ctx& C, unsigned char* ws, const float* ml_norm) {
    const float* SA = (const float*)(ws + WS_SA); const float* RS = (const float*)(ws + WS_RS); const bf16* Pg = (const bf16*)(ws + WS_PG);
    const bf16* vt = (const bf16*)(ws + WS_VT); bf16* H = (bf16*)(ws + WS_QKRAW); const unsigned char* OG = (const unsigned char*)(ws + WS_OG);
    const float* SIS = (const float*)(ws + WS_SIS); const float* QN = (const float*)(ws + WS_QN); const float* SFL = (const float*)(ws + WS_SFL);
    LAS float* ssum = (LAS float*)(C.lds + RING_OFF + 9216 + 256);
    const int l15 = C.lane & 15, g = C.lane >> 4;
    for (int item = C.vcu; item < 16 * NCH; item += C.G) {
        const int bh = item >> 7, c = item & 127, b = bh >> 2, h = bh & 3; const size_t t0 = (size_t)b * SEQ + c * 64;
        bf16x8 vfr[2][4], pfr[2][4]; v4u holdr[8]; v2u ogr[8]; float sis8[8], qn8[8], sfl8[8], rs8[8];
#pragma unroll
        for (int ks = 0; ks < 2; ++ks)
#pragma unroll
            for (int vtile = 0; vtile < 4; ++vtile) vfr[ks][vtile] = *(const GAS bf16x8*)(vt + (size_t)(h * VT_ROWS + 64 * C.wave + vtile * 16 + l15) * T + t0 + 32 * ks + 8 * g);
#pragma unroll
        for (int i = 0; i < 8; ++i) { const size_t tr = t0 + 8 * i + (C.lane >> 3); const size_t ho = tr * 2048 + h * 512 + 64 * C.wave + 8 * (C.lane & 7);
            holdr[i] = *(const GAS v4u*)(H + ho); ogr[i] = *(const GAS v2u*)(OG + ho); sis8[i] = SIS[tr * 4 + h]; qn8[i] = QN[tr * 4 + h]; sfl8[i] = SFL[tr * 4 + h]; rs8[i] = RS[tr * 4 + h]; }
#pragma unroll
        for (int ks = 0; ks < 2; ++ks)
#pragma unroll
            for (int t4 = 0; t4 < 4; ++t4) pfr[ks][t4] = *(const GAS bf16x8*)(Pg + (size_t)item * 4096 + (t4 * 16 + l15) * 64 + 32 * ks + 8 * g);
        __builtin_amdgcn_sched_barrier(0);
        const bool skip = DRY && SA[0] < 1e30f;
        f32x4 acc2[4][4];
#pragma unroll
        for (int vtile = 0; vtile < 4; ++vtile)
#pragma unroll
            for (int t4 = 0; t4 < 4; ++t4) acc2[vtile][t4] = (f32x4){0.f, 0.f, 0.f, 0.f};
#pragma unroll
        for (int ks = 0; ks < 2; ++ks) {
#pragma unroll
            for (int vtile = 0; vtile < 4; ++vtile)
#pragma unroll
                for (int t4 = 0; t4 < 4; ++t4) acc2[vtile][t4] = MFMA16(vfr[ks][vtile], pfr[ks][t4], acc2[vtile][t4]);
        }
        LAS unsigned char* stg = C.lds + RING_OFF + 16384 + C.wave * 9216;
#pragma unroll
        for (int vtile = 0; vtile < 4; ++vtile)
#pragma unroll
            for (int t4 = 0; t4 < 4; ++t4) { const f32x4 a = acc2[vtile][t4]; *(LAS v2u*)(stg + (t4 * 16 + l15) * 144 + (vtile * 16 + 4 * g) * 2) = (v2u){cvtpk(a[0], a[1]), cvtpk(a[2], a[3])}; }
        float hh[8][8], ssq8[8];
#pragma unroll
        for (int i = 0; i < 8; ++i) { const int row = 8 * i + (C.lane >> 3); const v4u sv = *(const LAS v4u*)(stg + row * 144 + (C.lane & 7) * 16);
            const float den = rs8[i] + sis8[i] * qn8[i]; const float inv = 1.f / fmaxf(fabsf(den), sfl8[i]); float q = 0.f;
#pragma unroll
            for (int e = 0; e < 4; ++e) { const float a = (bf_lo(sv[e]) + bf_lo(holdr[i][e])) * inv, b = (bf_hi(sv[e]) + bf_hi(holdr[i][e])) * inv; hh[i][2 * e] = a; hh[i][2 * e + 1] = b; q += a * a + b * b; }
            q += __shfl_xor(q, 1); q += __shfl_xor(q, 2); q += __shfl_xor(q, 4); ssq8[i] = q;
            if ((C.lane & 7) == 0) ssum[C.wave * 64 + row] = q; }
        asm volatile("s_waitcnt lgkmcnt(0)\n\ts_barrier" ::: "memory");
        const f32x4 gn0 = *(const f32x4*)(ml_norm + h * 512 + 64 * C.wave + 8 * (C.lane & 7)), gn1 = *(const f32x4*)(ml_norm + h * 512 + 64 * C.wave + 8 * (C.lane & 7) + 4);
        const float gn8[8] = {gn0[0], gn0[1], gn0[2], gn0[3], gn1[0], gn1[1], gn1[2], gn1[3]};
#pragma unroll
        for (int i = 0; i < 8; ++i) { const int row = 8 * i + (C.lane >> 3); float q = 0.f;
#pragma unroll
            for (int w = 0; w < 8; ++w) q += ssum[w * 64 + row];
            const float r = rsqrtf(q * (1.f / 512.f) + 1e-6f); float y[8];
#pragma unroll
            for (int e = 0; e < 8; ++e) y[e] = hh[i][e] * r * gn8[e] * ((float)((ogr[i][e >> 2] >> (8 * (e & 3))) & 255u) * (1.f / 255.f));
            if (!skip) *(GAS v4u*)(H + (t0 + row) * 2048 + h * 512 + 64 * C.wave + 8 * (C.lane & 7)) = (v4u){cvtpk(y[0], y[1]), cvtpk(y[2], y[3]), cvtpk(y[4], y[5]), cvtpk(y[6], y[7])}; }
        asm volatile("s_waitcnt lgkmcnt(0)\n\ts_barrier" ::: "memory");
    }
}

__device__ __forceinline__ unsigned p4_qslot(int t, int c) { return (unsigned)(t * 32 + ((c & 16) | ((c ^ t) & 15))); }
__device__ __forceinline__ unsigned p4_kslot(int row, int c) { return (unsigned)(row * 8 + (c ^ ((((row >> 4) & 1) << 2) | (((row >> 1) & 1) << 1)))); }
__device__ __forceinline__ unsigned cvtpk(float lo, float hi) { typedef float f2_t __attribute__((ext_vector_type(2))); typedef __bf16 b2_t __attribute__((ext_vector_type(2)));
    f2_t v = {lo, hi}; b2_t b = __builtin_convertvector(v, b2_t); return __builtin_bit_cast(unsigned, b); }
template <bool DRY>
__device__ __forceinline__ void p4_scan(const Ctx& C, unsigned char* ws, const bf16* Q) {
    const float* SIS = (const float*)(ws + WS_SIS); const float* DEC = (const float*)(ws + WS_DEC); float* QN = (float*)(ws + WS_QN);
    const bf16* vt = (const bf16*)(ws + WS_VT); const bf16* kwt = (const bf16*)(ws + WS_KWT); bf16* H = (bf16*)(ws + WS_QKRAW);
    const int l15 = C.lane & 15, g = C.lane >> 4;
    const unsigned lds0 = (unsigned)(uintptr_t)(C.lds + RING_OFF);
    for (int id = (int)blockIdx.x; id < 144; id += C.G) {
        const int bh = (id & 7) * 2 + (id < 128 ? (id >> 6) : ((id - 128) >> 3)); const int vblk = id < 128 ? (((id >> 3) & 7) * 4 + C.wave) : 32;
        const bool active = id < 128 ? (C.wave < 4) : (C.wave == 0);
        const bool loader = C.wave >= 4;
        const int b = bh >> 2, h = bh & 3;
        unsigned qoff[8], koff[8];
#pragma unroll
        for (int i = 0; i < 8; ++i) { const int sg = 64 * (8 * (C.wave & 3) + i) + C.lane;
            { const int t = sg >> 5, cp = sg & 31, c = (cp & 16) | ((cp ^ t) & 15); qoff[i] = (unsigned)((t * 1024 + c * 8) * 2); }
            { const int row = sg >> 3, cp = sg & 7, c = cp ^ ((((row >> 4) & 1) << 2) | (((row >> 1) & 1) << 1)); koff[i] = (unsigned)((row * 64 + c * 8) * 2); } }
        const char* qsrc = (const char*)(Q + (size_t)b * SEQ * 1024 + h * 256); const char* ksrc = (const char*)(kwt + (size_t)bh * NCH * 16384);
#define P4_DMA(cc, buf) do { if (loader) { _Pragma("unroll") for (int i_ = 0; i_ < 8; ++i_) \
            attn_body::glds16(qsrc + (size_t)(cc) * (64 * 1024 * 2) + qoff[i_], (unsigned)__builtin_amdgcn_readfirstlane(lds0 + (buf) * 65536 + (8 * (C.wave & 3) + i_) * 1024)); \
            _Pragma("unroll") for (int i_ = 0; i_ < 8; ++i_) \
            attn_body::glds16(ksrc + (size_t)(cc) * (16384 * 2) + koff[i_], (unsigned)__builtin_amdgcn_readfirstlane(lds0 + (buf) * 65536 + 32768 + (8 * (C.wave & 3) + i_) * 1024)); } } while (0)
#define P4_HOUT(cc) do { if (loader && id < 128 && !(DRY && DEC[0] < 1e30f)) { _Pragma("unroll") for (int i_ = 0; i_ < 2; ++i_) { const int q_ = i_ * 256 + (C.wave - 4) * 64 + C.lane, t_ = q_ >> 3, p_ = q_ & 7; \
            v4u v_ = *(const LAS v4u*)(C.lds + HST_OFF + ((cc) & 1) * 8192 + t_ * 128 + ((p_ ^ ((t_ & 15) >> 1)) * 16)); if (t_ & 1) v_ = (v4u){v_.z, v_.w, v_.x, v_.y}; \
            *(GAS v4u*)(H + ((size_t)b * SEQ + (size_t)(cc) * 64 + t_) * 2048 + h * 512 + ((id >> 3) & 7) * 64 + p_ * 8) = v_; } } } while (0)
        P4_DMA(0, 0);
        const bf16* vbase = vt + (size_t)(h * VT_ROWS + vblk * 16 + l15) * T + (size_t)b * SEQ + 8 * g;
        f32x4 X[16];
#pragma unroll
        for (int db = 0; db < 16; ++db) X[db] = (f32x4){0.f, 0.f, 0.f, 0.f};
        bf16x8 vcur[2]; vcur[0] = vcur[1] = (bf16x8){0, 0, 0, 0, 0, 0, 0, 0};
        float isc[4] = {0.f, 0.f, 0.f, 0.f}, dec = 0.f;
        if (active) { vcur[0] = *(const GAS bf16x8*)(vbase); vcur[1] = *(const GAS bf16x8*)(vbase + 32);
#pragma unroll
            for (int t4 = 0; t4 < 4; ++t4) isc[t4] = SIS[((size_t)b * SEQ + 16 * t4 + l15) * 4 + h];
            dec = DEC[bh * 128]; }
        asm volatile("s_waitcnt vmcnt(0)\n\ts_barrier" ::: "memory");
        bf16x8 vodd[2]; vodd[0] = vcur[0]; vodd[1] = vcur[1]; float decodd = 0.f;
        auto chunk = [&](const int c, bf16x8 (&vc)[2], bf16x8 (&vn)[2], float& dc, float& dn) __attribute__((always_inline)) {
            const int buf = c & 1;
            if (c + 1 < NCH && !(DRY && MK_P4_HALFLDS > 1)) P4_DMA(c + 1, buf ^ 1);
            if (c > 0) P4_HOUT(c - 1);
            if (active) {
                const size_t t0 = (size_t)b * SEQ + c * 64;
                const LAS unsigned char* qb = C.lds + RING_OFF + buf * 65536 + l15 * 512; const LAS unsigned char* kb = C.lds + RING_OFF + buf * 65536 + 32768 + (8 * (l15 >> 2) + (l15 & 3)) * 128;
                int qx[4];
#pragma unroll
                for (int k3 = 0; k3 < 4; ++k3) qx[k3] = (((4 * k3 + g) ^ l15) & 15) * 16;
                const int hl = (((l15 >> 3) & 1) << 2) | (((l15 >> 1) & 1) << 1); const int kx0 = (g ^ hl) * 16, kx1 = kx0 ^ 64;
                f32x4 hi[4];
#pragma unroll
                for (int t4 = 0; t4 < 4; ++t4) hi[t4] = (f32x4){0.f, 0.f, 0.f, 0.f};
                bf16x8 qf[2][4];
#pragma unroll
                for (int t4 = 0; t4 < 4; ++t4) qf[0][t4] = *(const LAS bf16x8*)(qb + qx[0] + t4 * 8192);
#pragma unroll
                for (int ks = 0; ks < 8; ++ks) {
                    if (ks + 1 < 8 && !(DRY && MK_P4_HALFLDS)) {
#pragma unroll
                        for (int t4 = 0; t4 < 4; ++t4) qf[(ks + 1) & 1][t4] = *(const LAS bf16x8*)(qb + qx[(ks + 1) & 3] + t4 * 8192 + ((ks + 1) >> 2) * 256);
                    }
                    const f32x4 lo = X[2 * ks], up = X[2 * ks + 1];
                    const bf16x8 xfr = __builtin_bit_cast(bf16x8, (v4u){cvtpk(lo[0], lo[1]), cvtpk(lo[2], lo[3]), cvtpk(up[0], up[1]), cvtpk(up[2], up[3])});
                    __builtin_amdgcn_sched_barrier(0);
#pragma unroll
                    for (int t4 = 0; t4 < 4; ++t4) hi[t4] = MFMA16(xfr, qf[ks & 1][t4], hi[t4]);
                    __builtin_amdgcn_sched_barrier(0);
                }
                asm volatile("" :: "v"(dc), "v"(vc[0]), "v"(vc[1]));
                if (vblk < 32) {
#pragma unroll
                    for (int t4 = 0; t4 < 4; ++t4) { const f32x4 o = hi[t4] * isc[t4];
                        *(LAS v2u*)(C.lds + HST_OFF + buf * 8192 + (16 * t4 + l15) * 128 + (((C.wave * 4 + g) ^ l15) * 8)) = (v2u){cvtpk(o[0], o[1]), cvtpk(o[2], o[3])}; }
                } else if (DRY && DEC[0] < 1e30f) { }
                else if (g == 0) {
#pragma unroll
                    for (int t4 = 0; t4 < 4; ++t4) QN[(t0 + 16 * t4 + l15) * 4 + h] = hi[t4][0];
                }
                if (c + 1 < NCH) { vn[0] = *(const GAS bf16x8*)(vbase + (c + 1) * 64); vn[1] = *(const GAS bf16x8*)(vbase + (c + 1) * 64 + 32);
#pragma unroll
                    for (int t4 = 0; t4 < 4; ++t4) isc[t4] = SIS[(t0 + 64 + 16 * t4 + l15) * 4 + h];
                    dn = DEC[bh * 128 + c + 1]; }
                bf16x8 kf[2][4];
#define P4_KOFF(db) ((32 * ((db) >> 1) + 4 * ((db) & 1)) * 128)
                kf[0][0] = *(const LAS bf16x8*)(kb + kx0 + P4_KOFF(0)); kf[0][1] = *(const LAS bf16x8*)(kb + kx1 + P4_KOFF(0));
                kf[0][2] = *(const LAS bf16x8*)(kb + kx0 + P4_KOFF(1)); kf[0][3] = *(const LAS bf16x8*)(kb + kx1 + P4_KOFF(1));
#pragma unroll
                for (int dp = 0; dp < 8; ++dp) {
                    if (dp + 1 < 8 && !(DRY && MK_P4_HALFLDS)) {
                        kf[(dp + 1) & 1][0] = *(const LAS bf16x8*)(kb + kx0 + P4_KOFF(2 * dp + 2)); kf[(dp + 1) & 1][1] = *(const LAS bf16x8*)(kb + kx1 + P4_KOFF(2 * dp + 2));
                        kf[(dp + 1) & 1][2] = *(const LAS bf16x8*)(kb + kx0 + P4_KOFF(2 * dp + 3)); kf[(dp + 1) & 1][3] = *(const LAS bf16x8*)(kb + kx1 + P4_KOFF(2 * dp + 3));
                    }
                    f32x4 xa = X[2 * dp] * dc, xb = X[2 * dp + 1] * dc;
                    __builtin_amdgcn_sched_barrier(0);
                    xa = MFMA16(kf[dp & 1][0], vc[0], xa); xb = MFMA16(kf[dp & 1][2], vc[0], xb);
                    xa = MFMA16(kf[dp & 1][1], vc[1], xa); xb = MFMA16(kf[dp & 1][3], vc[1], xb);
                    __builtin_amdgcn_sched_barrier(0);
                    X[2 * dp] = xa; X[2 * dp + 1] = xb;
                }
#undef P4_KOFF
            }
            if (loader) asm volatile("s_waitcnt vmcnt(0) lgkmcnt(0)\n\ts_barrier" ::: "memory");
            else asm volatile("s_waitcnt lgkmcnt(0)\n\ts_barrier" ::: "memory");
        };
        for (int c = 0; c < NCH; c += 2) { chunk(c, vcur, vodd, dec, decodd); chunk(c + 1, vodd, vcur, decodd, dec); }
        P4_HOUT(NCH - 1);
#undef P4_DMA
#undef P4_HOUT
    }
}

template <bool DRY>
__device__ __forceinline__ void p5_headnorm(const Ctx& C, unsigned char* ws, const float* ml_norm) {
    const float* RS = (const float*)(ws + WS_RS); const float* SIS = (const float*)(ws + WS_SIS); const float* QN = (const float*)(ws + WS_QN); const float* SFL = (const float*)(ws + WS_SFL);
    bf16* H = (bf16*)(ws + WS_QKRAW); const bf16* OG = (const bf16*)(ws + WS_OG);
    for (int idx = C.gw; idx < T * 4; idx += C.NGW) {
        const int h = idx & 3; const size_t t = idx >> 2;
        const float den = RS[idx] + SIS[idx] * QN[idx]; const float inv = 1.f / fmaxf(fabsf(den), SFL[idx]);
        bf16* hp = H + t * 2048 + h * 512 + 8 * C.lane;
        const v4u hv = *(const GAS v4u*)hp; const v4u ov = *(const GAS v4u*)(OG + t * 2048 + h * 512 + 8 * C.lane);
        float x[8], o[8]; float ss = 0.f;
#pragma unroll
        for (int e = 0; e < 4; ++e) { x[2 * e] = bf_lo(hv[e]) * inv; x[2 * e + 1] = bf_hi(hv[e]) * inv; o[2 * e] = bf_lo(ov[e]); o[2 * e + 1] = bf_hi(ov[e]); }
#pragma unroll
        for (int e = 0; e < 8; ++e) ss += x[e] * x[e];
        const float rstd = rsqrtf(wave_sum(ss) * (1.f / 512.f) + 1e-6f);
        const f32x4 g0 = *(const f32x4*)(ml_norm + h * 512 + 8 * C.lane), g1 = *(const f32x4*)(ml_norm + h * 512 + 8 * C.lane + 4);
        const float gn[8] = {g0.x, g0.y, g0.z, g0.w, g1.x, g1.y, g1.z, g1.w};
        float y[8];
#pragma unroll
        for (int e = 0; e < 8; ++e) y[e] = x[e] * rstd * gn[e] * sigmoidf_(o[e]);
        if (!(DRY && RS[0] < 1e30f)) *(GAS v4u*)hp = (v4u){pk2(y[0], y[1]), pk2(y[2], y[3]), pk2(y[4], y[5]), pk2(y[6], y[7])};
    }
}

__device__ __forceinline__ void conv_moe_weights(const Ctx& C, const float* w_gu_l, const float* w_down_l, bf16* wgu, bf16* wdn, const float* gffn) {
    LAS float* scr = (LAS float*)(C.lds + RING_OFF + C.wave * 16384);
    constexpr int I_GU = 32 * 16 * 16, I_DN = 32 * 4 * 32;
#define MOE_SRC(it, W_, ld_, k0_, c0_, ksc_) do { if ((it) < I_GU) { const int e_ = (it) >> 8, r_ = (it) & 255; W_ = w_gu_l + (size_t)e_ * 1024 * 512; ld_ = 512; k0_ = (r_ >> 4) * 64; c0_ = (r_ & 15) * 32; ksc_ = gffn; } \
        else { const int r0_ = (it) - I_GU, e_ = r0_ >> 7, r_ = r0_ & 127; W_ = w_down_l + (size_t)e_ * 256 * 1024; ld_ = 1024; k0_ = (r_ >> 5) * 64; c0_ = (r_ & 31) * 32; ksc_ = nullptr; } } while (0)
    int it = C.gw; if (it >= I_GU + I_DN) return;
    f32x4 wv[8]; float ks[8];
    { const float* W_; int ld_, k0_, c0_; const float* ksc_; MOE_SRC(it, W_, ld_, k0_, c0_, ksc_); tr_load(wv, ks, W_, ld_, k0_, c0_, C.lane, ksc_); }
    for (;;) {
        const int nx = it + C.NGW; const bool more = nx < I_GU + I_DN;
        f32x4 wn[8]; float kn[8];
#pragma unroll
        for (int i = 0; i < 8; ++i) { wn[i] = wv[i]; kn[i] = ks[i]; }
        if (more) { const float* W_; int ld_, k0_, c0_; const float* ksc_; MOE_SRC(nx, W_, ld_, k0_, c0_, ksc_); tr_load(wn, kn, W_, ld_, k0_, c0_, C.lane, ksc_); }
        if (it < I_GU) { const int e = it >> 8, r = it & 255, kb = r >> 4, nb = r & 15, n0 = nb * 32;
            const int half = n0 >> 8, jj = (n0 & 255) >> 7, i0 = n0 & 127;
            tr_finish(wv, ks, 1024, kb * 64, wgu, e * 512 + jj * 256 + half * 128 + i0, scr, C.lane); }
        else { const int r0 = it - I_GU, e = r0 >> 7, r = r0 & 127, kb = r >> 5, nb = r & 31;
            tr_finish(wv, ks, 256, kb * 64, wdn, e * 1024 + nb * 32, scr, C.lane); }
        if (!more) break;
#pragma unroll
        for (int i = 0; i < 8; ++i) { wv[i] = wn[i]; ks[i] = kn[i]; }
        it = nx;
    }
#undef MOE_SRC
}
__device__ __forceinline__ void conv_da_weights(const Ctx& C, const float* da_w_in, const float* da_w_out, unsigned char* ws, const float* gmix) {
    LAS float* scr = (LAS float*)(C.lds + RING_OFF + C.wave * 16384);
    bf16* win = (bf16*)(ws + WS_WDA_IN); bf16* wout = (bf16*)(ws + WS_WDA_OUT);
    constexpr int I_IN = 16 * 96, I_OUT = 16 * 32;
    for (int it = C.gw; it < I_IN + I_OUT; it += C.NGW) {
        if (it < I_IN) { const int kb = it / 96, nb = it % 96; tr_item(da_w_in, 3072, 1024, kb * 64, nb * 32, win, nb * 32, scr, C.lane, gmix); }
        else { const int r = it - I_IN, kb = r >> 5, nb = r & 31; tr_item(da_w_out, 1024, 1024, kb * 64, nb * 32, wout, nb * 32, scr, C.lane); }
    }
}

__device__ __forceinline__ void p7_route(const Ctx& C, const bf16* xres, const float* norm_g, const float* b_group, const float* b_expert, int layer, unsigned char* ws, int cbank) {
    const bf16* WRH = (const bf16*)(ws + WS_WR) + (size_t)layer * (32 * 3 * 4 * 16 * 8); const bf16* WRL = WRH + 2 * 32 * 3 * 4 * 16 * 8;
    int* TE = (int*)(ws + WS_TE); int* TPOS = (int*)(ws + WS_TPOS); int* E2T = (int*)(ws + WS_E2T); float* EW = (float*)(ws + WS_EW); float* ERS = (float*)(ws + WS_ERS);
    unsigned* CNT = (unsigned*)(ws + WS_CTL) + CW_CNT + 64 * cbank;
    LAS float* lg = (LAS float*)(C.lds + RING_OFF + C.wave * 3072);
    LAS int* lcnt = (LAS int*)(C.lds + RING_OFF + 32768); LAS int* lbase = lcnt + 32;
    const int l15 = C.lane & 15, g = C.lane >> 4;
    for (int base = 0; base < T / 16; base += C.NGW) {
        const int grp = base + C.gw; const bool valid = grp < T / 16;
        if (C.tid < 32) lcnt[C.tid] = 0;
        __syncthreads();
        int E1 = 0, E2 = 0, lp1 = 0, lp2 = 0; float w1 = 0.f, w2 = 0.f, rstd = 0.f;
        const size_t row = (size_t)(valid ? grp : 0) * 16 + l15;
        if (valid) {
            f32x4 acc[3]; acc[0] = acc[1] = acc[2] = (f32x4){0.f, 0.f, 0.f, 0.f}; float ss = 0.f;
            const bf16* xq = xres + row * D + 8 * g;
            const bf16* wh = WRH + (size_t)(g * 16 + l15) * 8; const bf16* wl = WRL + (size_t)(g * 16 + l15) * 8;
#pragma unroll 4
            for (int ks = 0; ks < 32; ++ks) {
                const v4u xv = *(const GAS v4u*)(xq + 32 * ks);
                bf16x8 bh[3], bl[3];
#pragma unroll
                for (int ctile = 0; ctile < 3; ++ctile) { bh[ctile] = *(const GAS bf16x8*)(wh + (size_t)(ks * 3 + ctile) * 512); bl[ctile] = *(const GAS bf16x8*)(wl + (size_t)(ks * 3 + ctile) * 512); }
#pragma unroll
                for (int e = 0; e < 4; ++e) { const float a = bf_lo(xv[e]), b = bf_hi(xv[e]); ss += a * a + b * b; }
                const bf16x8 ah = __builtin_bit_cast(bf16x8, xv);
#pragma unroll
                for (int ctile = 0; ctile < 3; ++ctile) { acc[ctile] = MFMA16(ah, bh[ctile], acc[ctile]); acc[ctile] = MFMA16(ah, bl[ctile], acc[ctile]); }
            }
            ss += __shfl_xor(ss, 16); ss += __shfl_xor(ss, 32);
            rstd = rsqrtf(ss * (1.f / D) + 1e-6f);
#pragma unroll
            for (int ctile = 0; ctile < 3; ++ctile)
#pragma unroll
                for (int r = 0; r < 4; ++r) lg[(4 * g + r) * 48 + ctile * 16 + l15] = acc[ctile][r];
            LDS_WAIT(); asm volatile("" ::: "memory");
            if (C.lane < 16) {
                const LAS float* my = lg + C.lane * 48;
                float gl[4]; int gi = 0; float gmax;
#pragma unroll
                for (int j = 0; j < 4; ++j) gl[j] = rstd * my[j] + b_group[layer * 4 + j];
                gmax = gl[0];
#pragma unroll
                for (int j = 1; j < 4; ++j) if (gl[j] > gmax) { gmax = gl[j]; gi = j; }
                float gsum = 0.f;
#pragma unroll
                for (int j = 0; j < 4; ++j) gsum += __expf(gl[j] - gmax);
                const float g_w = 1.f / gsum;
                float el[8];
#pragma unroll
                for (int j = 0; j < 8; ++j) el[j] = rstd * my[4 + gi * 8 + j] + b_expert[layer * 32 + gi * 8 + j];
                int i1 = 0; float e1 = el[0];
#pragma unroll
                for (int j = 1; j < 8; ++j) if (el[j] > e1) { e1 = el[j]; i1 = j; }
                int i2 = -1; float e2 = -INFINITY;
#pragma unroll
                for (int j = 0; j < 8; ++j) if (j != i1 && el[j] > e2) { e2 = el[j]; i2 = j; }
                const float r2 = __expf(e2 - e1); const float p1 = 1.f / (1.f + r2), p2 = r2 * p1;
                w1 = g_w * p1; w2 = g_w * p2; E1 = gi * 8 + i1; E2 = gi * 8 + i2;
                lp1 = __hip_atomic_fetch_add(lcnt + E1, 1, __ATOMIC_RELAXED, __HIP_MEMORY_SCOPE_WORKGROUP);
                lp2 = __hip_atomic_fetch_add(lcnt + E2, 1, __ATOMIC_RELAXED, __HIP_MEMORY_SCOPE_WORKGROUP);
            }
        }
        __syncthreads();
        if (C.tid < 32) { const int n = lcnt[C.tid]; lbase[C.tid] = n ? (int)__hip_atomic_fetch_add(CNT + C.tid, (unsigned)n, RLX_AGENT) : 0; }
        __syncthreads();
        if (valid) {
            if (C.lane < 16) { const int p1 = lbase[E1] + lp1, p2 = lbase[E2] + lp2; TE[row * 2] = E1; TE[row * 2 + 1] = E2; TPOS[row * 2] = p1; TPOS[row * 2 + 1] = p2;
                E2T[(size_t)E1 * T + p1] = (int)row; E2T[(size_t)E2 * T + p2] = (int)row; EW[(size_t)E1 * T + p1] = w1; EW[(size_t)E2 * T + p2] = w2; ERS[(size_t)E1 * T + p1] = rstd; ERS[(size_t)E2 * T + p2] = rstd; }
        }
        __syncthreads();
    }
}

__device__ __forceinline__ void moe_tables(const Ctx& C, int layer, unsigned char* ws) {
    const unsigned* CNT = (const unsigned*)(ws + WS_CTL) + CW_CNT + 64 * layer;
    LAS int* pexp = (LAS int*)(C.lds + TAB_PEXP); LAS int* eoff = (LAS int*)(C.lds + TAB_EOFF); LAS int* npp = (LAS int*)(C.lds + TAB_NP);
    if (C.tid == 0) { int off = 0, p = 0;
        for (int e = 0; e < NEXP; ++e) { const int n = (int)__hip_atomic_load(CNT + e, RLX_AGENT); eoff[e] = off; const int np_e = (n + 255) >> 8;
            for (int q = 0; q < np_e && p < MAXPANEL; ++q) pexp[p++] = e; off += np_e << 8; }
        eoff[NEXP] = off; npp[0] = p; }
    __syncthreads();
}

template <bool FINAL, bool DRY>
__device__ __forceinline__ void p11_combine(const Ctx& C, bf16* xio, float* fout, const float* gnorm, unsigned char* ws) {
    float* rstd_out = (float*)(ws + WS_RSTD);
    const int* TE = (const int*)(ws + WS_TE); const int* TPOS = (const int*)(ws + WS_TPOS); const LAS int* eoff = (const LAS int*)(C.lds + TAB_EOFF); const bf16* YS = (const bf16*)(ws + WS_YS);
    f32x4 gn[4];
#pragma unroll
    for (int j = 0; j < 4; ++j) gn[j] = *(const f32x4*)(gnorm + 4 * C.lane + 256 * j);
    v2u xn[4], an[4], bn[4];
#define P11_LOAD(tt) do { const int s0_ = eoff[TE[(tt) * 2]] + TPOS[(tt) * 2], s1_ = eoff[TE[(tt) * 2 + 1]] + TPOS[(tt) * 2 + 1]; \
        const GAS v2u* xr_ = (const GAS v2u*)(xio + (size_t)(tt) * D) + C.lane; const GAS v2u* y0_ = (const GAS v2u*)(YS + (size_t)s0_ * D) + C.lane; const GAS v2u* y1_ = (const GAS v2u*)(YS + (size_t)s1_ * D) + C.lane; \
        _Pragma("unroll") for (int j = 0; j < 4; ++j) { xn[j] = xr_[64 * j]; an[j] = y0_[64 * j]; bn[j] = y1_[64 * j]; } } while (0)
    if (C.gw < T) P11_LOAD(C.gw);
    for (int t = C.gw; t < T; t += C.NGW) {
        GAS v2u* xr = (GAS v2u*)(xio + (size_t)t * D) + C.lane; GAS f32x4* fr_ = (GAS f32x4*)(fout + (size_t)t * D) + C.lane;
        f32x4 v[4]; v2u ya[4], yb[4]; float ss = 0.f;
#pragma unroll
        for (int j = 0; j < 4; ++j) { v[j] = (f32x4){bf_lo(xn[j].x), bf_hi(xn[j].x), bf_lo(xn[j].y), bf_hi(xn[j].y)}; ya[j] = an[j]; yb[j] = bn[j]; }
        if (t + C.NGW < T) P11_LOAD(t + C.NGW);
#pragma unroll
        for (int j = 0; j < 4; ++j) { const v2u a = ya[j], b = yb[j];
            v[j].x += bf_lo(a.x) + bf_lo(b.x); v[j].y += bf_hi(a.x) + bf_hi(b.x); v[j].z += bf_lo(a.y) + bf_lo(b.y); v[j].w += bf_hi(a.y) + bf_hi(b.y);
            ss += (v[j].x * v[j].x + v[j].y * v[j].y) + (v[j].z * v[j].z + v[j].w * v[j].w); }
        const float rstd = rsqrtf(wave_sum(ss) * (1.f / D) + 1e-6f);
        if (DRY && gnorm[0] < 1e30f) { }
        else if (FINAL) {
#pragma unroll
            for (int j = 0; j < 4; ++j) fr_[64 * j] = v[j] * rstd * gn[j];
        } else {
#pragma unroll
            for (int j = 0; j < 4; ++j) xr[64 * j] = (v2u){pk2(v[j].x, v[j].y), pk2(v[j].z, v[j].w)};
            if (C.lane == 0) rstd_out[t] = rstd;
        }
    }
}

#undef P11_LOAD
__device__ __forceinline__ void p14_diffnorm(const Ctx& C, const float* lq1, const float* lk1, const float* lq2, const float* lk2, const float* da_norm, unsigned char* ws) {
    const bf16* O = (const bf16*)(ws + WS_AO); bf16* A2 = (bf16*)(ws + WS_HN);
    const float lam = __expf(wave_sum(lq1[C.lane] * lk1[C.lane])) - __expf(wave_sum(lq2[C.lane] * lk2[C.lane])) + LAMBDA_INIT1;
    const float g0 = da_norm[2 * C.lane] * (1.f - LAMBDA_INIT1), g1 = da_norm[2 * C.lane + 1] * (1.f - LAMBDA_INIT1);
    for (int t = C.gw; t < T; t += C.NGW) {
#pragma unroll
        for (int h = 0; h < 8; ++h) {
            const unsigned a = *(const GAS unsigned*)(O + (size_t)t * 2048 + h * 256 + 2 * C.lane), b = *(const GAS unsigned*)(O + (size_t)t * 2048 + h * 256 + 128 + 2 * C.lane);
            const float d0 = bf_lo(a) - lam * bf_lo(b), d1 = bf_hi(a) - lam * bf_hi(b);
            const float rstd = rsqrtf(wave_sum(d0 * d0 + d1 * d1) * (1.f / 128.f) + 1e-5f);
            *(GAS unsigned*)(A2 + (size_t)t * D + h * 128 + 2 * C.lane) = pk2(d0 * rstd * g0, d1 * rstd * g1);
        }
    }
}

__device__ __forceinline__ Ctx make_ctx(unsigned char* lds) {
    Ctx C; int t = threadIdx.x; asm volatile("" : "+v"(t));
    C.lds = (LAS unsigned char*)lds;
    C.tid = t; C.lane = t & 63; C.wave = __builtin_amdgcn_readfirstlane(t >> 6);
    C.G = gridDim.x; { const int bx = blockIdx.x; C.vcu = (C.G % 8 == 0) ? (bx % 8) * (C.G / 8) + bx / 8 : bx; }
    C.gw = C.vcu * NWAVES + C.wave; C.NGW = C.G * NWAVES;
    return C;
}
struct Args { const float* in[23]; float* out; unsigned char* ws; };
#ifndef MK_DUP
#define MK_DUP 0
#endif
#define DUP(k) ((MK_DUP >> (k)) & 1)
#ifndef MK_PHASE_LO
#define MK_PHASE_LO 0
#endif
#ifndef MK_PHASE_HI
#define MK_PHASE_HI 99
#endif
__global__ void __launch_bounds__(NWAVES * 64, 2) mk_fwd(Args args) {
    extern __shared__ __attribute__((aligned(16))) unsigned char lds[];
    Ctx C = make_ctx(lds);
#define FRESH() C = make_ctx(lds); LOADARGS()
    typedef const __attribute__((address_space(4))) Args* ArgP;
#define LOADARGS() ArgP A_ = (ArgP)__builtin_amdgcn_kernarg_segment_ptr(); asm volatile("" : "+s"(A_)); unsigned char* const ws = A_->ws; float* const out = A_->out; (void)out
#define xin (A_->in[0])
#define norm_mix (A_->in[1])
#define norm_ffn (A_->in[2])
#define ml_w_in (A_->in[3])
#define ml_conv (A_->in[4])
#define ml_b_i (A_->in[5])
#define ml_b_f (A_->in[6])
#define ml_norm (A_->in[7])
#define ml_w_out (A_->in[8])
#define da_w_in (A_->in[9])
#define da_lq1 (A_->in[10])
#define da_lk1 (A_->in[11])
#define da_lq2 (A_->in[12])
#define da_lk2 (A_->in[13])
#define da_norm (A_->in[14])
#define da_w_out (A_->in[15])
#define moe_w_group (A_->in[16])
#define moe_b_group (A_->in[17])
#define moe_w_expert (A_->in[18])
#define moe_b_expert (A_->in[19])
#define moe_w_gu (A_->in[20])
#define moe_w_down (A_->in[21])
#define final_norm (A_->in[22])
    for (int u = C.tid; u < (LDS_BYTES - LDSCTL_OFF) / 4; u += NWAVES * 64) ((LAS unsigned*)(C.lds + LDSCTL_OFF))[u] = 0u;
    __syncthreads();
    volatile LAS unsigned* MISC = (volatile LAS unsigned*)(C.lds + MISC_OFF);
    XcdBarrier bar; { LOADARGS(); bar = xcd_barrier_post((unsigned*)(ws + WS_CTL) + CW_BAR, MISC + 8); }
#define GRID_BAR() xcd_barrier(bar)
#define PH(k) ((k) <= MK_PHASE_HI && (k) >= MK_PHASE_LO)
#define MFMA_SPIN(k) if (DUP(k)) { typedef short b8_ __attribute__((ext_vector_type(8))); f32x4 s0_ = {0.f, 0.f, 0.f, 0.f}, s1_ = s0_, s2_ = s0_, s3_ = s0_; b8_ xx_ = {0, 0, 0, 0, 0, 0, 0, 0}; asm volatile("" : "+v"(xx_)); \
        for (int i_ = 0; i_ < 5000; ++i_) { s0_ = __builtin_amdgcn_mfma_f32_16x16x32_bf16(xx_, xx_, s0_, 0, 0, 0); s1_ = __builtin_amdgcn_mfma_f32_16x16x32_bf16(xx_, xx_, s1_, 0, 0, 0); \
            s2_ = __builtin_amdgcn_mfma_f32_16x16x32_bf16(xx_, xx_, s2_, 0, 0, 0); s3_ = __builtin_amdgcn_mfma_f32_16x16x32_bf16(xx_, xx_, s3_, 0, 0, 0); } \
        asm volatile("" :: "v"(s0_), "v"(s1_), "v"(s2_), "v"(s3_)); GRID_BAR(); }
#define hn0 ((bf16*)out)
#define Qm ((bf16*)out)
#define Km ((bf16*)out + (size_t)T * 1024)
#define HN ((bf16*)(ws + WS_HN))
#define XB ((bf16*)out)
#define XB2 ((bf16*)(ws + WS_AQ))
    const int bx = (int)blockIdx.x;

#ifndef MK_NO_P0
    { FRESH();
    p0_prologue(C, xin, norm_mix, ml_w_in, ml_w_out, norm_ffn, moe_w_group, moe_w_expert, ws, hn0); }
#define P0ONCE { GRID_BAR(); FRESH(); p0_prologue(C, xin, norm_mix, ml_w_in, ml_w_out, norm_ffn, moe_w_group, moe_w_expert, ws, hn0); }
    if (DUP(0)) { P0ONCE P0ONCE P0ONCE P0ONCE }
#endif
    GRID_BAR();
    MFMA_SPIN(22)
    if (PH(1)) { FRESH();
        p1_gate_chunks(C, ml_b_i, ml_b_f, ws);
        { pg8::Gemm g{hn0, (const bf16*)(ws + WS_WML_IN), T, 4096, D}; pg8::StaticOrder S; S.init(T, 4096, C.G, bx);
          pg8::EpiQKO E{(bf16*)(ws + WS_QKRAW), (unsigned char*)(ws + WS_OG)};
          pg8::gemm_phase<pg8::EpiQKO, pg8::StaticOrder, true, true>(C.lds + RING_OFF, g, S, E); }
        { pg8::Gemm g{(const bf16*)(ws + WS_WML_IN) + (size_t)4096 * D, hn0, 2048, T, D}; pg8::StaticOrder S; S.init(2048, T, C.G, bx);
          pg8::EpiBf16S E{(bf16*)(ws + WS_VT), T, 0, 0, 1.f, 0x7fffffff, VT_ROWS - 512, nullptr};
          pg8::gemm_phase<pg8::EpiBf16S, pg8::StaticOrder, true, true>(C.lds + RING_OFF, g, S, E); }
        if (DUP(1)) {
        { pg8::Gemm g{hn0, (const bf16*)(ws + WS_WML_IN), T, 4096, D}; pg8::StaticOrder S; S.init(T, 4096, C.G, bx);
          pg8::EpiQKO E{(bf16*)(ws + WS_QKRAW), (unsigned char*)(ws + WS_OG)};
          pg8::gemm_phase<pg8::EpiQKO, pg8::StaticOrder, true, true>(C.lds + RING_OFF, g, S, E); }
        { pg8::Gemm g{(const bf16*)(ws + WS_WML_IN) + (size_t)4096 * D, hn0, 2048, T, D}; pg8::StaticOrder S; S.init(2048, T, C.G, bx);
          pg8::EpiBf16S E{(bf16*)(ws + WS_VT), T, 0, 0, 1.f, 0x7fffffff, VT_ROWS - 512, nullptr};
          pg8::gemm_phase<pg8::EpiBf16S, pg8::StaticOrder, true, true>(C.lds + RING_OFF, g, S, E); }
        }
        GRID_BAR();
    }
    if (PH(2)) { FRESH(); p2_conv(C, ml_b_i, ml_b_f, ml_conv, ws, Qm, Km); GRID_BAR(); }
#ifndef MK_P2_PROBE
#define MK_P2_PROBE 0
#endif
#define P2ONCE { FRESH(); int pr_ = MK_P2_PROBE; asm volatile("" : "+s"(pr_)); p2_conv(C, ml_b_i, ml_b_f, ml_conv, ws, Qm, Km, pr_); GRID_BAR(); }
    if (DUP(2)) { P2ONCE P2ONCE P2ONCE P2ONCE }
    if (DUP(4)) { { FRESH(); p4_scan<true>(C, ws, Qm); GRID_BAR(); } { FRESH(); p4_scan<true>(C, ws, Qm); GRID_BAR(); } }
    if (DUP(28)) { FRESH(); p4_scan<false>(C, ws, Qm); GRID_BAR(); }
    if (DUP(27)) { FRESH();
        if (C.G > 144) { if ((int)blockIdx.x >= 144) { p3a_scores(C, ws, Qm, Km, (int)blockIdx.x - 144, C.G - 144);
                Ctx Cf = C; Cf.gw = ((int)blockIdx.x - 144) * NWAVES + C.wave; Cf.NGW = (C.G - 144) * NWAVES; conv_da_weights(Cf, da_w_in, da_w_out, ws, norm_mix + D); conv_ml_out(Cf, ml_w_out, ws); conv_moe_weights(Cf, moe_w_gu, moe_w_down, (bf16*)(ws + WS_WGU0), (bf16*)(ws + WS_WDN0), norm_ffn); }
            else p4_scan<false>(C, ws, Qm); }
        else { p4_scan<false>(C, ws, Qm); p3a_scores(C, ws, Qm, Km, (int)blockIdx.x, C.G); conv_da_weights(C, da_w_in, da_w_out, ws, norm_mix + D); conv_ml_out(C, ml_w_out, ws); conv_moe_weights(C, moe_w_gu, moe_w_down, (bf16*)(ws + WS_WGU0), (bf16*)(ws + WS_WDN0), norm_ffn); }
        GRID_BAR(); }
    if (PH(4)) { FRESH();
        if (C.G > 144) { if ((int)blockIdx.x >= 144) { p3a_scores(C, ws, Qm, Km, (int)blockIdx.x - 144, C.G - 144);
                Ctx Cf = C; Cf.gw = ((int)blockIdx.x - 144) * NWAVES + C.wave; Cf.NGW = (C.G - 144) * NWAVES; conv_da_weights(Cf, da_w_in, da_w_out, ws, norm_mix + D); conv_ml_out(Cf, ml_w_out, ws); conv_moe_weights(Cf, moe_w_gu, moe_w_down, (bf16*)(ws + WS_WGU0), (bf16*)(ws + WS_WDN0), norm_ffn); }
            else p4_scan<false>(C, ws, Qm); }
        else { p4_scan<false>(C, ws, Qm); p3a_scores(C, ws, Qm, Km, (int)blockIdx.x, C.G); conv_da_weights(C, da_w_in, da_w_out, ws, norm_mix + D); conv_ml_out(C, ml_w_out, ws); conv_moe_weights(C, moe_w_gu, moe_w_down, (bf16*)(ws + WS_WGU0), (bf16*)(ws + WS_WDN0), norm_ffn); }
        GRID_BAR(); }
    if (DUP(23)) { FRESH();
        if ((int)blockIdx.x >= 144) { if (DUP(24)) p3a_scores(C, ws, Qm, Km, (int)blockIdx.x - 144, C.G - 144);
            Ctx Cf = C; Cf.gw = ((int)blockIdx.x - 144) * NWAVES + C.wave; Cf.NGW = (C.G - 144) * NWAVES; if (DUP(25)) { conv_da_weights(Cf, da_w_in, da_w_out, ws, norm_mix + D); conv_ml_out(Cf, ml_w_out, ws); } if (DUP(26)) conv_moe_weights(Cf, moe_w_gu, moe_w_down, (bf16*)(ws + WS_WGU0), (bf16*)(ws + WS_WDN0), norm_ffn); }
        GRID_BAR(); }
#define P3ONCE { FRESH(); p3_intra<true>(C, ws, ml_norm); GRID_BAR(); }
    if (DUP(3)) { P3ONCE P3ONCE P3ONCE P3ONCE }
    if (PH(3)) { FRESH(); p3_intra<false>(C, ws, ml_norm); }
    if (PH(5)) { GRID_BAR(); }
    if (PH(6)) { FRESH();
        pg8::Gemm g{(const bf16*)(ws + WS_QKRAW), (const bf16*)(ws + WS_WML_OUT), T, D, ML_V}; pg8::StaticOrder S; S.init(T, D, C.G, bx);
        pg8::EpiResBf16<true> E{xin, XB, D};
        pg8::gemm_phase<pg8::EpiResBf16<true>, pg8::StaticOrder, true, true>(C.lds + RING_OFF, g, S, E);
        if (DUP(6)) pg8::gemm_phase<pg8::EpiResBf16<true>, pg8::StaticOrder, true, true>(C.lds + RING_OFF, g, S, E);
        GRID_BAR();
    }
#define MOE_LAYER(L, PBASE, FINAL_, GNEXT, WGU_, WDN_, XR_)                                                                                                              \
    if (PH(PBASE)) { FRESH(); p7_route(C, (XR_), norm_ffn + (L) * D, moe_b_group, moe_b_expert, (L), ws, (L)); if (DUP(7)) p7_route(C, (XR_), norm_ffn + (L) * D, moe_b_group, moe_b_expert, (L), ws, (L) + 2); GRID_BAR(); }                                                \
    if ((L) == 1 && PH(PBASE + 2)) {     \
      { FRESH(); moe_tables(C, (L), ws);                                                                                                                \
        const int np = __builtin_amdgcn_readfirstlane(*(LAS int*)(C.lds + TAB_NP));                                                                      \
        pg8::Gemm g{(const bf16*)(XR_), (const bf16*)(ws + (WGU_)), np * 256, NEXP * 512, D};                                                   \
        pg8::MoeOrder S{(const LAS int*)(C.lds + TAB_PEXP), np, 1, C.G, bx, 0, 2 * C.G};                                                                 \
        pg8::EpiSwiGLU E{(bf16*)(ws + WS_ACT), (const float*)(ws + WS_EW), (const float*)(ws + WS_ERS), (const LAS int*)(C.lds + TAB_EOFF), T};                                       \
        pg8::MoeGather GA{(const int*)(ws + WS_E2T), (const LAS int*)(C.lds + TAB_EOFF), 1, T};                                                          \
        pg8::gemm_phase<pg8::EpiSwiGLU, pg8::MoeOrder, true, true, pg8::MoeGather>(C.lds + RING_OFF, g, S, E, GA);                                      \
        GRID_BAR(); }                                                                                                                                    \
      { FRESH();                                                                                                                                         \
        const int np = __builtin_amdgcn_readfirstlane(*(LAS int*)(C.lds + TAB_NP));                                                                      \
        const int ntail = 2 * np > 2 * C.G ? 2 * np - 2 * C.G : 0; const int npa = np < C.G ? np : C.G;     \
        { pg8::Gemm g{(const bf16*)(XR_), (const bf16*)(ws + (WGU_)), np * 256, NEXP * 512, D};                                                 \
          pg8::MoeOrder S{(const LAS int*)(C.lds + TAB_PEXP), np, 1, C.G, bx, 2 * C.G, 0x7fffffff};                                                      \
          pg8::EpiSwiGLU E{(bf16*)(ws + WS_ACT), (const float*)(ws + WS_EW), (const float*)(ws + WS_ERS), (const LAS int*)(C.lds + TAB_EOFF), T};                                     \
          pg8::MoeGather GA{(const int*)(ws + WS_E2T), (const LAS int*)(C.lds + TAB_EOFF), 1, T};                                                        \
          pg8::gemm_phase<pg8::EpiSwiGLU, pg8::MoeOrder, true, true, pg8::MoeGather>(C.lds + RING_OFF, g, S, E, GA); }                                  \
        int kdn = DEXP; asm volatile("" : "+s"(kdn));                                                                                                    \
        pg8::Gemm gd{(const bf16*)(ws + WS_ACT), (const bf16*)(ws + (WDN_)), np * 256, NEXP * 1024, kdn};                                              \
        pg8::EpiBf16S Ed{(bf16*)(ws + WS_YS), D, 0, 0, 1.f, 3, 0, nullptr};                                                                               \
        { pg8::MoeOrder S{(const LAS int*)(C.lds + TAB_PEXP), npa, 2, C.G - ntail, bx - ntail, 0, 0x7fffffff};                                           \
          pg8::gemm_phase<pg8::EpiBf16S, pg8::MoeOrder, true, true>(C.lds + RING_OFF, gd, S, Ed); }                                                     \
        GRID_BAR();                                                                                                                                      \
        { pg8::MoeOrder S{(const LAS int*)(C.lds + TAB_PEXP), np, 2, C.G, bx, 4 * C.G, 0x7fffffff};                                                      \
          pg8::gemm_phase<pg8::EpiBf16S, pg8::MoeOrder, true, true>(C.lds + RING_OFF, gd, S, Ed); }                                                     \
        GRID_BAR(); } }                                                                                                                                  \
    if ((L) != 1 && PH(PBASE + 2)) { FRESH(); moe_tables(C, (L), ws);                                                                                               \
        const int np = __builtin_amdgcn_readfirstlane(*(LAS int*)(C.lds + TAB_NP));                                                                      \
        pg8::Gemm g{(const bf16*)(XR_), (const bf16*)(ws + (WGU_)), np * 256, NEXP * 512, D};                                                   \
        pg8::MoeOrder S{(const LAS int*)(C.lds + TAB_PEXP), np, 1, C.G, bx};                                                                             \
        pg8::EpiSwiGLU E{(bf16*)(ws + WS_ACT), (const float*)(ws + WS_EW), (const float*)(ws + WS_ERS), (const LAS int*)(C.lds + TAB_EOFF), T};                                       \
        pg8::MoeGather GA{(const int*)(ws + WS_E2T), (const LAS int*)(C.lds + TAB_EOFF), 1, T};                                                          \
        pg8::gemm_phase<pg8::EpiSwiGLU, pg8::MoeOrder, true, true, pg8::MoeGather>(C.lds + RING_OFF, g, S, E, GA);                                      \
        if (DUP(9)) pg8::gemm_phase<pg8::EpiSwiGLU, pg8::MoeOrder, true, true, pg8::MoeGather>(C.lds + RING_OFF, g, S, E, GA);                          \
        if ((L) == 0) {     \
            const int r9 = (2 * np) % C.G; const bool few = (C.G - r9) * 2 < C.G; const int k9 = (r9 == 0 || few) ? bx : bx - r9, n9 = (r9 == 0 || few) ? C.G : C.G - r9;  \
            if (k9 >= 0) { Ctx Cf = C; Cf.gw = k9 * NWAVES + C.wave; Cf.NGW = n9 * NWAVES;                                                                 \
                conv_moe_weights(Cf, moe_w_gu + (size_t)NEXP * D * 512, moe_w_down + (size_t)NEXP * DEXP * D, (bf16*)(ws + WS_WGU1), (bf16*)(ws + WS_WDN1), norm_ffn + D); } }  \
        GRID_BAR(); }                                                                                                                                    \
    if ((L) != 1 && PH(PBASE + 3)) { FRESH();                                                                                                            \
        const int np = __builtin_amdgcn_readfirstlane(*(LAS int*)(C.lds + TAB_NP));                                                                      \
        int kdn = DEXP; asm volatile("" : "+s"(kdn));                                                                                                    \
        pg8::Gemm g{(const bf16*)(ws + WS_ACT), (const bf16*)(ws + (WDN_)), np * 256, NEXP * 1024, kdn};                                               \
        pg8::MoeOrder S{(const LAS int*)(C.lds + TAB_PEXP), np, 2, C.G, bx};                                                                             \
        pg8::EpiBf16S E{(bf16*)(ws + WS_YS), D, 0, 0, 1.f, 3, 0, nullptr};                                                                                        \
        pg8::gemm_phase<pg8::EpiBf16S, pg8::MoeOrder, true, true>(C.lds + RING_OFF, g, S, E);                                                           \
        if (DUP(10)) pg8::gemm_phase<pg8::EpiBf16S, pg8::MoeOrder, true, true>(C.lds + RING_OFF, g, S, E);                                              \
        GRID_BAR(); }                                                                                                                                    \
    if (PH(PBASE + 4)) { FRESH(); if (DUP(11)) p11_combine<FINAL_, true>(C, (XR_), out, (GNEXT), ws); p11_combine<FINAL_, false>(C, (XR_), out, (GNEXT), ws); }

    MOE_LAYER(0, 7, false, norm_mix + D, WS_WGU0, WS_WDN0, XB)
    if (PH(11)) { GRID_BAR(); }
    if (PH(12)) { FRESH();
        pg8::Gemm g{XB, (const bf16*)(ws + WS_WDA_IN), T, 3072, D}; pg8::StaticOrder S; S.init(T, 3072, C.G, bx);
        pg8::EpiBf16S E{(bf16*)(ws + WS_AQ), 1024, 1024, (size_t)(WS_AK - WS_AQ) / 2, attn_body::C2, 0x7fffffff, 0, (const float*)(ws + WS_RSTD)};
        pg8::gemm_phase<pg8::EpiBf16S, pg8::StaticOrder, true, true>(C.lds + RING_OFF, g, S, E);
        if (DUP(12)) pg8::gemm_phase<pg8::EpiBf16S, pg8::StaticOrder, true, true>(C.lds + RING_OFF, g, S, E);
        GRID_BAR();
    }
    MFMA_SPIN(21)
    if (PH(13)) { FRESH();
        static_assert(attn_body::ATTN_LDS_BYTES <= RING_BYTES, "attention LDS");
        LAS float* gnl = (LAS float*)(C.lds + TAB_OFF + 2048);
        float s1 = 0.f, s2 = 0.f;
        for (int i = 0; i < 64; ++i) { s1 += da_lq1[i] * da_lk1[i]; s2 += da_lq2[i] * da_lk2[i]; }
        const float lam = __int_as_float(__builtin_amdgcn_readfirstlane(__float_as_int(__expf(s1) - __expf(s2) + LAMBDA_INIT1)));
        if (C.tid < 128) gnl[C.tid] = da_norm[C.tid] * (1.f - LAMBDA_INIT1);
        __syncthreads();
        const attn_body::AttnTensors AT{(const attn_body::bf16*)(ws + WS_AQ), (const attn_body::bf16*)(ws + WS_AK), (const attn_body::bf16*)(ws + WS_AV), (attn_body::bf16*)(ws + WS_AO), (attn_body::bf16*)(ws + WS_HN), lam, (const LAS float*)(C.lds + TAB_OFF + 2048)};
        const attn_body::StaticOrder S((int)C.G, bx);
        attn_body::attn_phase<attn_body::StaticOrder>((char*)lds + RING_OFF, AT, S);
        GRID_BAR();
        if (DUP(13)) { attn_body::attn_phase<attn_body::StaticOrder>((char*)lds + RING_OFF, AT, S); GRID_BAR(); }
    }
    if (PH(15)) { FRESH();
        pg8::Gemm g{HN, (const bf16*)(ws + WS_WDA_OUT), T, D, D}; pg8::StaticOrder S; S.init(T, D, C.G, bx);
        pg8::EpiResBf16<false> E{XB, XB2, D};
        pg8::gemm_phase<pg8::EpiResBf16<false>, pg8::StaticOrder, true, true>(C.lds + RING_OFF, g, S, E);
        GRID_BAR();
    }
    if (DUP(20)) { for (int rep_ = 0; rep_ < 20; ++rep_) GRID_BAR(); }
    MOE_LAYER(1, 16, true, final_norm, WS_WGU1, WS_WDN1, XB2)
#if MK_PHASE_HI < 20
    { if (MK_PHASE_HI == 11 || MK_PHASE_HI < 1) { } GRID_BAR(); FRESH();
      const float* src = MK_PHASE_HI >= 6 ? out : xin;
      f32x4 gn[4];
#pragma unroll
      for (int j = 0; j < 4; ++j) gn[j] = *(const f32x4*)(final_norm + 4 * C.lane + 256 * j);
      for (int t = C.gw; t < T; t += C.NGW) { const GAS f32x4* xr = (const GAS f32x4*)(src + (size_t)t * D) + C.lane; GAS f32x4* orow = (GAS f32x4*)(out + (size_t)t * D) + C.lane;
          f32x4 v[4]; float ss = 0.f;
#pragma unroll
          for (int j = 0; j < 4; ++j) { v[j] = xr[64 * j]; ss += (v[j].x * v[j].x + v[j].y * v[j].y) + (v[j].z * v[j].z + v[j].w * v[j].w); }
          const float rstd = rsqrtf(wave_sum(ss) * (1.f / D) + 1e-6f);
#pragma unroll
          for (int j = 0; j < 4; ++j) orow[64 * j] = v[j] * rstd * gn[j]; } }
#endif
}

#undef xin
#undef norm_mix
#undef norm_ffn
#undef ml_w_in
#undef ml_conv
#undef ml_b_i
#undef ml_b_f
#undef ml_norm
#undef ml_w_out
#undef da_w_in
#undef da_lq1
#undef da_lk1
#undef da_lq2
#undef da_lk2
#undef da_norm
#undef da_w_out
#undef moe_w_group
#undef moe_b_group
#undef moe_w_expert
#undef moe_b_expert
#undef moe_w_gu
#undef moe_w_down
#undef final_norm
#undef hn0
#undef Qm
#undef Km
#undef HN
#undef XB
#undef XB2
extern "C" void kernel_launch(void* const* d_in, const int* in_sizes, int n_in, void* d_out, int out_size, void* d_ws, size_t ws_size, hipStream_t stream) {
    static int grid = 0;
    if (grid == 0) {
        if (n_in != 23 || out_size != T * D || ws_size < (size_t)512 * MiB) { fprintf(stderr, "kernel_launch: unexpected shapes (n_in %d out %d ws %zu)\n", n_in, out_size, ws_size); grid = -1; return; }
        int dev = 0, cus = 0, per_cu = 0;
        if (hipGetDevice(&dev) != hipSuccess || hipDeviceGetAttribute(&cus, hipDeviceAttributeMultiprocessorCount, dev) != hipSuccess) { grid = -1; return; }
        if (hipFuncSetAttribute((const void*)mk_fwd, hipFuncAttributeMaxDynamicSharedMemorySize, LDS_BYTES) != hipSuccess) { fprintf(stderr, "kernel_launch: hipFuncSetAttribute failed\n"); grid = -1; return; }
        if (hipOccupancyMaxActiveBlocksPerMultiprocessor(&per_cu, (const void*)mk_fwd, NWAVES * 64, LDS_BYTES) != hipSuccess || per_cu < 1) { fprintf(stderr, "kernel_launch: occupancy query says %d\n", per_cu); }
        (void)hipGetLastError();
        grid = cus;
    }
    if (grid < 0) return;
    if (hipMemsetAsync((char*)d_ws + WS_CTL, 0, CTL_ZERO_BYTES, stream) != hipSuccess) return;
    Args a{};
    for (int i = 0; i < 23; ++i) a.in[i] = (const float*)d_in[i];
    a.out = (float*)d_out; a.ws = (unsigned char*)d_ws;
    hipLaunchKernelGGL(mk_fwd, dim3(grid), dim3(NWAVES * 64), LDS_BYTES, stream, a);
}
```

```cpp
#include <hip/hip_runtime.h>
#include <hip/hip_bf16.h>
#include <cstdio>
#include <cstdint>
#include <cmath>
#define MK_P2_PROBE 0
#define MK_P1_PROBE 0
namespace pg8 {
#define PG8_LAS __attribute__((address_space(3)))
typedef unsigned short bf16_t;
typedef short bf16x8 __attribute__((ext_vector_type(8)));
typedef float f32x4 __attribute__((ext_vector_type(4)));
typedef unsigned u32x4 __attribute__((ext_vector_type(4)));
constexpr int BM = 256, BK = 64, HALF = 128, HTB = HALF * BK * 2  , STAGE_BYTES = 8 * HTB, NXCD = 8, WGM = 8;

__host__ __device__ __forceinline__ int lds_byte(int r, int c) { const int st = (r >> 4) * 2 + (c >> 5), rr = r & 15, cc = c & 31, ob = rr * 64 + cc * 2; return st * 1024 + (ob ^ (((ob >> 9) & 1) << 5)); }
__host__ __device__ __forceinline__ void stage_rc(int b, int& R, int& C) { const int st = b / 1024, sb = b % 1024, swz = sb ^ (((sb >> 9) & 1) << 5); R = (st >> 1) * 16 + swz / 64; C = (st & 1) * 32 + (swz % 64) / 2; }
__host__ __device__ __forceinline__ int perm32(int rho) { const int n = rho >> 4, i = rho & 15; return 8 * (i >> 2) + 4 * n + (i & 3); }

struct Unit { int pm, pn; };
struct Gemm { const bf16_t* A; const bf16_t* Bt; int M, N, K; };

struct StaticOrder {
    int nM, nN, nwg, G, c;
    __host__ __device__ void init(int M, int N, int G_, int c_) { nM = M / BM; nN = N / BM; nwg = nM * nN; G = G_; c = c_; }
    __host__ __device__ bool next(int i, Unit& u) const {
        const long L = (long)i * G + c; if (L >= nwg) return false;
        int wgid = (int)L; { const int q = nwg / NXCD, r = nwg % NXCD, xcd = wgid % NXCD, off = wgid / NXCD; wgid = (xcd < r ? xcd * (q + 1) : r * (q + 1) + (xcd - r) * q) + off; }
        const int nig = WGM * nN, gid = wgid / nig, fm = gid * WGM, gsz = (nM - fm) < WGM ? (nM - fm) : WGM;
        u.pm = fm + ((wgid % nig) % gsz); u.pn = (wgid % nig) / gsz; return true;
    }
    __device__ __forceinline__ void a_ready(const Unit&) const {}
    __device__ __forceinline__ void done(const Unit&) const {}
};

__device__ __forceinline__ unsigned cvt_pk_bf16(float lo, float hi) { unsigned r; asm volatile("v_cvt_pk_bf16_f32 %0, %1, %2" : "=v"(r) : "v"(lo), "v"(hi)); return r; }

struct EpiBf16S {
    static constexpr bool PERM = true, AFTER_DRAIN = false;
    bf16_t* O; int ldc; int split_cols; size_t split_stride; float scale0; int pn_mask; int row_skew; const float* rowscale; int dry = 0;
    __device__ __forceinline__ void operator()(const f32x4 (&acc)[2][2][4][2], const Unit& u, int wr, int wc, int fr, int fq) const {
        const int row0 = u.pm * BM + wr * 64 + fr + (u.pm >> 1) * row_skew; int colt = (u.pn & pn_mask) * BM; bf16_t* base = O;
        float sc = 1.f; if (split_cols) { const int t = colt / split_cols; base += (size_t)t * split_stride; colt -= t * split_cols; if (t == 0) sc = scale0; }
        const int col0 = colt + wc * 32 + 8 * fq;
#pragma unroll
        for (int ai = 0; ai < 2; ++ai)
#pragma unroll
            for (int m = 0; m < 4; ++m) { bf16_t* rowp = base + (size_t)(row0 + ai * HALF + m * 16) * ldc + col0; const float sr = rowscale ? sc * rowscale[u.pm * BM + wr * 64 + fr + ai * HALF + m * 16] : sc;
#pragma unroll
                for (int bj = 0; bj < 2; ++bj) { f32x4 v0 = acc[ai][bj][m][0] * sr, v1 = acc[ai][bj][m][1] * sr;
                    u32x4 w; w.x = cvt_pk_bf16(v0[0], v0[1]); w.y = cvt_pk_bf16(v0[2], v0[3]); w.z = cvt_pk_bf16(v1[0], v1[1]); w.w = cvt_pk_bf16(v1[2], v1[3]);
                    if (!dry) *(u32x4*)(rowp + bj * HALF) = w; } }
    }
};
struct EpiQKO {
    static constexpr bool PERM = true, AFTER_DRAIN = false;
    bf16_t* QK; unsigned char* OG8; int probe = 0;
    __device__ __forceinline__ void operator()(const f32x4 (&acc)[2][2][4][2], const Unit& u, int wr, int wc, int fr, int fq) const {
        const int row0 = u.pm * BM + wr * 64 + fr; const bool gate = u.pn >= 8; const int col0 = (u.pn & 7) * BM + wc * 32 + 8 * fq;
        if (gate && probe) return;
#pragma unroll
        for (int ai = 0; ai < 2; ++ai)
#pragma unroll
            for (int m = 0; m < 4; ++m) { const size_t ro = (size_t)(row0 + ai * HALF + m * 16) * 2048 + col0;
#pragma unroll
                for (int bj = 0; bj < 2; ++bj) { const f32x4 v0 = acc[ai][bj][m][0], v1 = acc[ai][bj][m][1];
                    if (!gate) { u32x4 w; w.x = cvt_pk_bf16(v0[0], v0[1]); w.y = cvt_pk_bf16(v0[2], v0[3]); w.z = cvt_pk_bf16(v1[0], v1[1]); w.w = cvt_pk_bf16(v1[2], v1[3]);
                        *(u32x4*)(QK + ro + bj * HALF) = w; }
                    else { unsigned w0 = 0u, w1 = 0u;
#pragma unroll
                        for (int e = 0; e < 4; ++e) { w0 = __builtin_amdgcn_cvt_pk_u8_f32(255.f * __builtin_amdgcn_rcpf(1.f + __builtin_amdgcn_exp2f(-1.4426950408889634f * v0[e])), e, w0);
                                                      w1 = __builtin_amdgcn_cvt_pk_u8_f32(255.f * __builtin_amdgcn_rcpf(1.f + __builtin_amdgcn_exp2f(-1.4426950408889634f * v1[e])), e, w1); }
                        typedef unsigned u32x2_t __attribute__((ext_vector_type(2)));
                        *(u32x2_t*)(OG8 + ro + bj * HALF) = (u32x2_t){w0, w1}; } } }
    }
};
struct EpiResF32 {
    static constexpr bool PERM = false, AFTER_DRAIN = false;
    const float* res; float* out; int ldc;
    __device__ __forceinline__ void operator()(const f32x4 (&acc)[2][2][4][2], const Unit& u, int wr, int wc, int fr, int fq) const {
        const int row0 = u.pm * BM + wr * 64 + fr, col0 = u.pn * BM + wc * 32 + 4 * fq;
        f32x4 rb[2][2][2][2];
#define PG8_RLOAD(buf, ai, mp) do { _Pragma("unroll") for (int mm = 0; mm < 2; ++mm) { const size_t off_ = (size_t)(row0 + (ai) * HALF + (2 * (mp) + mm) * 16) * ldc + col0; \
            _Pragma("unroll") for (int bj = 0; bj < 2; ++bj) _Pragma("unroll") for (int n = 0; n < 2; ++n) rb[buf][mm][bj][n] = *(const f32x4*)(res + off_ + bj * HALF + n * 16); } } while (0)
        PG8_RLOAD(0, 0, 0);
#pragma unroll
        for (int grp = 0; grp < 4; ++grp) {
            const int ai = grp >> 1, mp = grp & 1;
            if (grp + 1 < 4) { if (((grp + 1) & 1) == 0) PG8_RLOAD(0, (grp + 1) >> 1, (grp + 1) & 1); else PG8_RLOAD(1, (grp + 1) >> 1, (grp + 1) & 1); }
            __builtin_amdgcn_sched_barrier(0);
#pragma unroll
            for (int mm = 0; mm < 2; ++mm) { const int m = 2 * mp + mm; const size_t off = (size_t)(row0 + ai * HALF + m * 16) * ldc + col0;
#pragma unroll
                for (int bj = 0; bj < 2; ++bj)
#pragma unroll
                    for (int n = 0; n < 2; ++n) *(f32x4*)(out + off + bj * HALF + n * 16) = rb[grp & 1][mm][bj][n] + acc[ai][bj][m][n]; }
            __builtin_amdgcn_sched_barrier(0);
        }
#undef PG8_RLOAD
    }
};
template <bool RES_F32> struct EpiResBf16 {
    static constexpr bool PERM = true, AFTER_DRAIN = false;
    const void* res; bf16_t* out; int ldc;
    __device__ __forceinline__ void operator()(const f32x4 (&acc)[2][2][4][2], const Unit& u, int wr, int wc, int fr, int fq) const {
        const int row0 = u.pm * BM + wr * 64 + fr, col0 = u.pn * BM + wc * 32 + 8 * fq;
        f32x4 rb[2][2][2][2];
#define PG8_RLOAD(buf, ai, mp) do { _Pragma("unroll") for (int mm = 0; mm < 2; ++mm) { const size_t off_ = (size_t)(row0 + (ai) * HALF + (2 * (mp) + mm) * 16) * ldc + col0; \
            _Pragma("unroll") for (int bj = 0; bj < 2; ++bj) { if (RES_F32) { rb[buf][mm][bj][0] = *(const f32x4*)((const float*)res + off_ + bj * HALF); rb[buf][mm][bj][1] = *(const f32x4*)((const float*)res + off_ + bj * HALF + 4); } \
                else { const u32x4 w_ = *(const u32x4*)((const bf16_t*)res + off_ + bj * HALF); \
                    rb[buf][mm][bj][0] = (f32x4){__builtin_bit_cast(float, w_.x << 16), __builtin_bit_cast(float, w_.x & 0xffff0000u), __builtin_bit_cast(float, w_.y << 16), __builtin_bit_cast(float, w_.y & 0xffff0000u)}; \
                    rb[buf][mm][bj][1] = (f32x4){__builtin_bit_cast(float, w_.z << 16), __builtin_bit_cast(float, w_.z & 0xffff0000u), __builtin_bit_cast(float, w_.w << 16), __builtin_bit_cast(float, w_.w & 0xffff0000u)}; } } } } while (0)
        PG8_RLOAD(0, 0, 0);
#pragma unroll
        for (int grp = 0; grp < 4; ++grp) {
            const int ai = grp >> 1, mp = grp & 1;
            if (grp + 1 < 4) { if (((grp + 1) & 1) == 0) PG8_RLOAD(0, (grp + 1) >> 1, (grp + 1) & 1); else PG8_RLOAD(1, (grp + 1) >> 1, (grp + 1) & 1); }
            __builtin_amdgcn_sched_barrier(0);
#pragma unroll
            for (int mm = 0; mm < 2; ++mm) { const int m = 2 * mp + mm; const size_t off = (size_t)(row0 + ai * HALF + m * 16) * ldc + col0;
#pragma unroll
                for (int bj = 0; bj < 2; ++bj) { const f32x4 v0 = rb[grp & 1][mm][bj][0] + acc[ai][bj][m][0], v1 = rb[grp & 1][mm][bj][1] + acc[ai][bj][m][1];
                    u32x4 w; w.x = cvt_pk_bf16(v0[0], v0[1]); w.y = cvt_pk_bf16(v0[2], v0[3]); w.z = cvt_pk_bf16(v1[0], v1[1]); w.w = cvt_pk_bf16(v1[2], v1[3]);
                    *(u32x4*)(out + off + bj * HALF) = w; } }
            __builtin_amdgcn_sched_barrier(0);
        }
#undef PG8_RLOAD
    }
};
struct EpiSwiGLU {
    static constexpr bool PERM = true, AFTER_DRAIN = false;
    bf16_t* O; const float* ew; const float* ers; const PG8_LAS int* eoff; int ldw;
    __device__ __forceinline__ void operator()(const f32x4 (&acc)[2][2][4][2], const Unit& u, int wr, int wc, int fr, int fq) const {
        const int row0 = u.pm * BM + wr * 64 + fr, col0 = (u.pn & 1) * 128 + wc * 32 + 8 * fq; const int e = u.pn >> 1;
        const float* roww = ew + (size_t)e * ldw - eoff[e]; const float* rowr = ers + (size_t)e * ldw - eoff[e];
        float gws[2][4], grs[2][4];
#pragma unroll
        for (int ai = 0; ai < 2; ++ai)
#pragma unroll
            for (int m = 0; m < 4; ++m) { gws[ai][m] = roww[row0 + ai * HALF + m * 16]; grs[ai][m] = rowr[row0 + ai * HALF + m * 16]; }
#pragma unroll
        for (int ai = 0; ai < 2; ++ai)
#pragma unroll
            for (int m = 0; m < 4; ++m) { const int row = row0 + ai * HALF + m * 16; const float gw = gws[ai][m], gr = grs[ai][m]; float a[8];
#pragma unroll
                for (int n = 0; n < 2; ++n)
#pragma unroll
                    for (int e4 = 0; e4 < 4; ++e4) { const float g = acc[ai][0][m][n][e4] * gr, up = acc[ai][1][m][n][e4] * gr;
                        const float sg = g * __builtin_amdgcn_rcpf(1.f + __builtin_amdgcn_exp2f(-1.4426950408889634f * g)); a[n * 4 + e4] = sg * up * gw; }
                u32x4 w; w.x = cvt_pk_bf16(a[0], a[1]); w.y = cvt_pk_bf16(a[2], a[3]); w.z = cvt_pk_bf16(a[4], a[5]); w.w = cvt_pk_bf16(a[6], a[7]);
                *(u32x4*)(O + (size_t)row * 256 + col0) = w; }
    }
};
struct MoeGather {
    static constexpr bool ON = true;
    const int* e2t; const PG8_LAS int* eoff; int shift, ld;
    __device__ __forceinline__ unsigned row(const Unit& u, int r) const { const int e = u.pn >> shift; const unsigned t = (unsigned)e2t[(size_t)e * ld + (u.pm * BM + r - eoff[e])]; return t < (unsigned)ld ? t : (unsigned)(ld - 1); }
};
struct MoeOrder {
    const PG8_LAS int* pexp; int np, shift, G, c; int lo = 0, hi = 0x7fffffff;
    __device__ __forceinline__ bool next(int i, Unit& u) const {
        const int L = lo + i * G + c; if (c < 0 || L >= hi || L >= (np << shift)) return false;
        const int p = L >> shift; const int e = __builtin_amdgcn_readfirstlane(pexp[p]);
        u.pm = p; u.pn = (e << shift) + (L & ((1 << shift) - 1)); return true;
    }
    __device__ __forceinline__ void a_ready(const Unit&) const {}
    __device__ __forceinline__ void done(const Unit&) const {}
};
struct NoGather { static constexpr bool ON = false; __device__ __forceinline__ unsigned row(const Unit&, int) const { return 0u; } };
template <class Epi, class Sched, bool ALIGN_EPI = false, bool SP2 = false, class AG = NoGather, bool NOLOAD = false, int NOLDS = 0>
__device__ __forceinline__ void gemm_phase(PG8_LAS unsigned char* lds, const Gemm g, const Sched& S, const Epi& E, const AG& GA = AG()) {
    static_assert(!AG::ON || SP2, "row gather is wired into the SP2 loop only");
    int tid_ = threadIdx.x; asm volatile("" : "+v"(tid_)); const int tid = tid_, wid = __builtin_amdgcn_readfirstlane(tid >> 6), lane = tid & 63, wr = wid >> 2, wc = wid & 3, fr = lane & 15, fq = lane >> 4;
    const int K = g.K, nt = K / BK;
    unsigned voffA[2], voffB[2]; int aR[2], aC[2];
#pragma unroll
    for (int i = 0; i < 2; ++i) { int R, C; stage_rc(tid * 16 + i * 8192, R, C); const int Rb = Epi::PERM ? ((R & ~31) + perm32(R & 31)) : R; aR[i] = R; aC[i] = C;
        voffA[i] = (unsigned)(R * K + C) * 2u; voffB[i] = (unsigned)(Rb * K + C) * 2u; }
    unsigned gcur0[2], gcur1[2], gnxt0[2], gnxt1[2];
#define PG8_GOFF(u, d0, d1) do { _Pragma("unroll") for (int _i = 0; _i < 2; ++_i) { d0[_i] = (GA.row(u, aR[_i]) * (unsigned)K + (unsigned)aC[_i]) * 2u; d1[_i] = (GA.row(u, HALF + aR[_i]) * (unsigned)K + (unsigned)aC[_i]) * 2u; } } while (0)
    const size_t kstep = (size_t)(BK * 2);
    const size_t hstep = (size_t)HALF * K * 2;
    const size_t tstep = 2 * hstep;
    const unsigned ldsw = (unsigned)wid * 1024u;
    const int aoff = lds_byte(wr * 64 + fr, fq * 8), boff = lds_byte(wc * 32 + fr, fq * 8);
#define PG8_SA(b, h) (((b) * 2 + (h)) * HTB)
#define PG8_SB(b, h) ((4 + (b) * 2 + (h)) * HTB)
#define PG8_STAGE(bufoff, gbase, voff) do { if (!NOLOAD) _Pragma("unroll") for (int _i = 0; _i < 2; ++_i) \
        __builtin_amdgcn_global_load_lds((const unsigned*)((const char*)(gbase) + (voff)[_i]), (PG8_LAS unsigned*)(lds + (bufoff) + ldsw + _i * 8192), 16, 0, 0); } while (0)
#define PG8_LDA(dst, b, h) do { if (!(NOLDS & 1)) _Pragma("unroll") for (int m = 0; m < 4; ++m) _Pragma("unroll") for (int k = 0; k < 2; ++k) dst[m][k] = *(const PG8_LAS bf16x8*)(lds + PG8_SA(b, h) + aoff + m * 2048 + k * 1024); } while (0)
#define PG8_LDB(dst, b, h) do { if (!(NOLDS & 2)) _Pragma("unroll") for (int n = 0; n < 2; ++n) _Pragma("unroll") for (int k = 0; k < 2; ++k) dst[n][k] = *(const PG8_LAS bf16x8*)(lds + PG8_SB(b, h) + boff + n * 2048 + k * 1024); } while (0)
#define PG8_MMA(ai, bj, At, Bt) do { __builtin_amdgcn_s_setprio(1); _Pragma("unroll") for (int m = 0; m < 4; ++m) _Pragma("unroll") for (int n = 0; n < 2; ++n) _Pragma("unroll") for (int k = 0; k < 2; ++k) \
        acc[ai][bj][m][n] = __builtin_amdgcn_mfma_f32_16x16x32_bf16(Bt[n][k], At[m][k], acc[ai][bj][m][n], 0, 0, 0); __builtin_amdgcn_s_setprio(0); } while (0)
#define PG8_WAIT_V(n) asm volatile("s_waitcnt vmcnt(" #n ")" ::: "memory")
#define PG8_WAIT_L(n) asm volatile("s_waitcnt lgkmcnt(" #n ")" ::: "memory")
#define PG8_BAR do { if (!(NOLDS & 4)) __builtin_amdgcn_s_barrier(); } while (0)
#define PG8_SCHED __builtin_amdgcn_sched_barrier(0)
    Unit cur, nxt; int ui = 0;
    if (!S.next(0, cur)) return;
    f32x4 acc[2][2][4][2];
#pragma unroll
    for (int a = 0; a < 2; ++a)
#pragma unroll
        for (int b = 0; b < 2; ++b)
#pragma unroll
            for (int m = 0; m < 4; ++m)
#pragma unroll
                for (int n = 0; n < 2; ++n) acc[a][b][m][n] = (f32x4){0.f, 0.f, 0.f, 0.f};
    bf16x8 At[4][2], B0[2][2], B1[2][2];
    if (NOLDS) { _Pragma("unroll") for (int m = 0; m < 4; ++m) _Pragma("unroll") for (int k = 0; k < 2; ++k) { At[m][k] = (bf16x8){0, 0, 0, 0, 0, 0, 0, 0}; asm volatile("" : "+v"(At[m][k])); }
        _Pragma("unroll") for (int n = 0; n < 2; ++n) _Pragma("unroll") for (int k = 0; k < 2; ++k) { B0[n][k] = (bf16x8){0, 0, 0, 0, 0, 0, 0, 0}; asm volatile("" : "+v"(B0[n][k])); B1[n][k] = B0[n][k]; asm volatile("" : "+v"(B1[n][k])); } }
    const char* cA = (const char*)g.A + (AG::ON ? (size_t)0 : (size_t)cur.pm * tstep); const char* cB = (const char*)g.Bt + (size_t)cur.pn * tstep;
    if constexpr (AG::ON) { PG8_GOFF(cur, gcur0, gcur1); gnxt0[0] = gcur0[0]; gnxt0[1] = gcur0[1]; gnxt1[0] = gcur1[0]; gnxt1[1] = gcur1[1]; }
#define PG8_STAGE_A(bufoff, base, half, G0, G1) do { if constexpr (AG::ON) { if ((half) == 0) PG8_STAGE(bufoff, base, G0); else PG8_STAGE(bufoff, base, G1); } else { PG8_STAGE(bufoff, (base) + (half) * hstep, voffA); } } while (0)
    S.a_ready(cur);
    if constexpr (SP2) {
        PG8_STAGE(PG8_SB(0, 0), cB, voffB); PG8_STAGE(PG8_SB(0, 1), cB + hstep, voffB); PG8_STAGE_A(PG8_SA(0, 0), cA, 0, gcur0, gcur1); PG8_STAGE_A(PG8_SA(0, 1), cA, 1, gcur0, gcur1);
        if (wr == 1) PG8_BAR;
        PG8_WAIT_V(2); PG8_BAR;
        PG8_STAGE(PG8_SB(1, 0), cB + kstep, voffB); PG8_STAGE_A(PG8_SA(1, 0), cA + kstep, 0, gcur0, gcur1); PG8_STAGE(PG8_SB(1, 1), cB + hstep + kstep, voffB);
        PG8_WAIT_V(6); PG8_BAR;
    } else {
        PG8_STAGE(PG8_SB(0, 0), cB, voffB); PG8_STAGE(PG8_SA(0, 0), cA, voffA); PG8_STAGE(PG8_SB(0, 1), cB + hstep, voffB); PG8_STAGE(PG8_SA(0, 1), cA + hstep, voffA);
        if (wr == 1) PG8_BAR;
        PG8_WAIT_V(4); PG8_BAR;
        PG8_STAGE(PG8_SB(1, 0), cB + kstep, voffB); PG8_STAGE(PG8_SA(1, 0), cA + kstep, voffA); PG8_STAGE(PG8_SB(1, 1), cB + hstep + kstep, voffB);
        PG8_WAIT_V(6); PG8_BAR;
    }
    for (;;) {
        const bool has_next = S.next(ui + 1, nxt);
        if constexpr (AG::ON) { if (has_next) PG8_GOFF(nxt, gnxt0, gnxt1); }
        const char* nA = (has_next && !AG::ON) ? (const char*)g.A + (size_t)nxt.pm * tstep : cA; const char* nB = has_next ? (const char*)g.Bt + (size_t)nxt.pn * tstep : cB;
        for (int t = 0; t < nt; t += 2) {
            const bool last = (t == nt - 2);
            const char* a1 = cA + (size_t)(t + 1) * kstep;
            const char* a2 = last ? nA : cA + (size_t)(t + 2) * kstep; const char* b2 = last ? nB : cB + (size_t)(t + 2) * kstep;
            const char* a3 = a2 + kstep; const char* b3 = b2 + kstep;
            if (last && has_next) S.a_ready(nxt);
            if constexpr (SP2) {
            unsigned g20[2], g21[2];
            if constexpr (AG::ON) { g20[0] = last ? gnxt0[0] : gcur0[0]; g20[1] = last ? gnxt0[1] : gcur0[1]; g21[0] = last ? gnxt1[0] : gcur1[0]; g21[1] = last ? gnxt1[1] : gcur1[1]; }
            PG8_LDB(B0, 0, 0); PG8_LDB(B1, 0, 1); PG8_SCHED; PG8_LDA(At, 0, 0); PG8_STAGE_A(PG8_SA(1, 1), a1, 1, gcur0, gcur1);
            PG8_WAIT_V(8); PG8_WAIT_L(0); PG8_BAR; PG8_MMA(0, 0, At, B0); PG8_MMA(0, 1, At, B1); PG8_BAR; PG8_SCHED;
            PG8_LDA(At, 0, 1); PG8_STAGE(PG8_SB(0, 0), b2, voffB); PG8_STAGE(PG8_SB(0, 1), b2 + hstep, voffB); PG8_STAGE_A(PG8_SA(0, 0), a2, 0, g20, g21);
            PG8_WAIT_V(8); PG8_WAIT_L(0); PG8_BAR; PG8_MMA(1, 0, At, B0); PG8_MMA(1, 1, At, B1); PG8_BAR; PG8_SCHED;
            PG8_LDB(B0, 1, 0); PG8_LDB(B1, 1, 1); PG8_SCHED; PG8_LDA(At, 1, 0); PG8_STAGE_A(PG8_SA(0, 1), a2, 1, g20, g21);
            PG8_WAIT_V(8); PG8_WAIT_L(0); PG8_BAR; PG8_MMA(0, 0, At, B0); PG8_MMA(0, 1, At, B1); PG8_BAR; PG8_SCHED;
            PG8_LDA(At, 1, 1); PG8_STAGE(PG8_SB(1, 0), b3, voffB); PG8_STAGE(PG8_SB(1, 1), b3 + hstep, voffB); PG8_STAGE_A(PG8_SA(1, 0), a3, 0, g20, g21);
            PG8_WAIT_V(8); PG8_WAIT_L(0); PG8_BAR; PG8_MMA(1, 0, At, B0); PG8_MMA(1, 1, At, B1); PG8_BAR; PG8_SCHED;
            } else {
            PG8_LDB(B0, 0, 0); PG8_SCHED; PG8_LDA(At, 0, 0); PG8_STAGE(PG8_SA(1, 1), a1 + hstep, voffA);
            PG8_WAIT_L(8); PG8_BAR; PG8_WAIT_L(0); PG8_MMA(0, 0, At, B0); PG8_BAR; PG8_SCHED;
            PG8_LDB(B1, 0, 1); PG8_STAGE(PG8_SB(0, 0), b2, voffB);
            PG8_BAR; PG8_WAIT_L(0); PG8_MMA(0, 1, At, B1); PG8_BAR;
            PG8_LDA(At, 0, 1); PG8_STAGE(PG8_SA(0, 0), a2, voffA);
            PG8_BAR; PG8_WAIT_L(0); PG8_MMA(1, 0, At, B0); PG8_BAR; PG8_SCHED;
            PG8_STAGE(PG8_SB(0, 1), b2 + hstep, voffB);
            PG8_WAIT_V(6); PG8_BAR; PG8_MMA(1, 1, At, B1); PG8_BAR;
            PG8_LDB(B0, 1, 0); PG8_SCHED; PG8_LDA(At, 1, 0); PG8_STAGE(PG8_SA(0, 1), a2 + hstep, voffA);
            PG8_WAIT_L(8); PG8_BAR; PG8_WAIT_L(0); PG8_MMA(0, 0, At, B0); PG8_BAR; PG8_SCHED;
            PG8_LDB(B1, 1, 1); PG8_STAGE(PG8_SB(1, 0), b3, voffB);
            PG8_BAR; PG8_WAIT_L(0); PG8_MMA(0, 1, At, B1); PG8_BAR;
            PG8_LDA(At, 1, 1); PG8_STAGE(PG8_SA(1, 0), a3, voffA);
            PG8_BAR; PG8_WAIT_L(0); PG8_MMA(1, 0, At, B0); PG8_BAR; PG8_SCHED;
            PG8_STAGE(PG8_SB(1, 1), b3 + hstep, voffB);
            PG8_WAIT_V(6); PG8_BAR; PG8_MMA(1, 1, At, B1); PG8_BAR;
            }
        }
        if constexpr (ALIGN_EPI) { if (wr == 0) PG8_BAR; }
        if constexpr (!Epi::AFTER_DRAIN) { E(acc, cur, wr, wc, fr, fq); S.done(cur); }
        if (!has_next) break;
#pragma unroll
        for (int a = 0; a < 2; ++a)
#pragma unroll
            for (int b = 0; b < 2; ++b)
#pragma unroll
                for (int m = 0; m < 4; ++m)
#pragma unroll
                    for (int n = 0; n < 2; ++n) acc[a][b][m][n] = (f32x4){0.f, 0.f, 0.f, 0.f};
        cur = nxt; cA = nA; cB = nB; ++ui;
        if constexpr (AG::ON) { gcur0[0] = gnxt0[0]; gcur0[1] = gnxt0[1]; gcur1[0] = gnxt1[0]; gcur1[1] = gnxt1[1]; }
        if constexpr (ALIGN_EPI) { if (wr == 1) PG8_BAR; }
    }
    PG8_WAIT_V(0);
    if constexpr (!ALIGN_EPI) { if (wr == 0) PG8_BAR; }
    PG8_BAR;
    if constexpr (Epi::AFTER_DRAIN) { E.fused(acc, cur, wr, wc, fr, fq, lds, wid, lane); S.done(cur); }
#undef PG8_SA
#undef PG8_SB
#undef PG8_STAGE
#undef PG8_STAGE_A
#undef PG8_GOFF
#undef PG8_LDA
#undef PG8_LDB
#undef PG8_MMA
#undef PG8_WAIT_V
#undef PG8_WAIT_L
#undef PG8_BAR
#undef PG8_SCHED
}
}

#include <hip/hip_bf16.h>
#include <cmath>
namespace attn_body {
using bf16=__hip_bfloat16;
using bf16x8=__attribute__((ext_vector_type(8)))short;
using s16x4=__attribute__((ext_vector_type(4)))short;
using f32x16=__attribute__((ext_vector_type(16)))float;
using u32x4=__attribute__((ext_vector_type(4)))unsigned;
constexpr int BATCH=4,NVH=32,SEQ=8192,D=64,PQ=1024,PO=1024;
constexpr int NW=8,QBLK=32,QB=QBLK*NW,KVBLK=64,NQB=SEQ/QB;
constexpr int ATTN_UNIT_ROWS=QB;
__device__ __forceinline__ int crow(int r,int hi){return (r&3)+8*(r>>2)+4*hi;}
#define SBAR() __builtin_amdgcn_sched_barrier(0)
__device__ __forceinline__ void cmask(f32x16&p0,f32x16&p1,int jb,int qrel,int hi){
  const float NEG=-INFINITY; int kb=64*jb+4*hi;
  #pragma unroll
  for(int r=0;r<16;++r){int kv=kb+(r&3)+8*(r>>2); if(kv>qrel)p0[r]=NEG; if(kv+32>qrel)p1[r]=NEG;}
}

constexpr int NSLOT=3, SLOTB=8192;
constexpr int LDS_K=0, LDS_V=NSLOT*SLOTB, LDS_WS=3*NSLOT*SLOTB, LDS_OST=LDS_WS+NW*64*4, LDS_BYTES=LDS_OST+NW*4096;
constexpr float C2=0.125f*1.4426950408889634f;
__device__ __forceinline__ void glds16(const void*gsrc,unsigned lds_dst){unsigned keep;
  asm volatile("s_mov_b32 %0, m0\n\ts_mov_b32 m0, %2\n\ts_nop 0\n\tglobal_load_lds_dwordx4 %1, off\n\ts_mov_b32 m0, %0":"=&s"(keep):"v"(gsrc),"s"(lds_dst):"memory");}
__device__ __forceinline__ float max3f(float a,float b,float c){float r;asm("v_max3_f32 %0, %1, %2, %3":"=v"(r):"v"(a),"v"(b),"v"(c));return r;}
__device__ __forceinline__ float max2f(float a,float b){float r;asm("v_max_f32_e32 %0, %1, %2":"=v"(r):"v"(a),"v"(b));return r;}
__device__ __forceinline__ float fadd_s(float a,float b){float r;asm("v_add_f32_e32 %0, %1, %2":"=v"(r):"v"(a),"v"(b));return r;}
__device__ __forceinline__ float fsub_s(float a,float b){float r;asm("v_sub_f32_e32 %0, %1, %2":"=v"(r):"v"(a),"v"(b));return r;}
typedef float f32x2_t __attribute__((ext_vector_type(2))); typedef __bf16 bf16x2_t __attribute__((ext_vector_type(2)));
__device__ __forceinline__ unsigned cvtpk_s(float lo,float hi){f32x2_t v={lo,hi};bf16x2_t b=__builtin_convertvector(v,bf16x2_t);return __builtin_bit_cast(unsigned,b);}
#define WAIT_BAR(N) asm volatile("s_waitcnt vmcnt(" #N ") lgkmcnt(0)\n\ts_barrier":::"memory")

__device__ __forceinline__ void qkt(f32x16&p0,f32x16&p1,const char*Kslot,const bf16x8*qr,const f32x16&negm,int r32,int hi){
  const char*kb=Kslot+hi*1024+r32*16;
  #pragma unroll
  for(int d0=0;d0<4;++d0){
    const bf16x8 b0=*reinterpret_cast<const bf16x8*>(kb+d0*2048);
    const bf16x8 b1=*reinterpret_cast<const bf16x8*>(kb+d0*2048+512);
    if(d0==0){p0=__builtin_amdgcn_mfma_f32_32x32x16_bf16(b0,qr[0],negm,0,0,0);p1=__builtin_amdgcn_mfma_f32_32x32x16_bf16(b1,qr[0],negm,0,0,0);}
    else{p0=__builtin_amdgcn_mfma_f32_32x32x16_bf16(b0,qr[d0],p0,0,0,0);p1=__builtin_amdgcn_mfma_f32_32x32x16_bf16(b1,qr[d0],p1,0,0,0);}}
}
typedef __attribute__((address_space(3))) const char* lds_cptr;
typedef short v4i16_t __attribute__((ext_vector_type(4)));
__device__ __forceinline__ void kload8(bf16x8*kf,lds_cptr kp){
  kf[0]=*(const __attribute__((address_space(3))) bf16x8*)(kp);      kf[1]=*(const __attribute__((address_space(3))) bf16x8*)(kp+512);
  kf[2]=*(const __attribute__((address_space(3))) bf16x8*)(kp+2048); kf[3]=*(const __attribute__((address_space(3))) bf16x8*)(kp+2560);
  kf[4]=*(const __attribute__((address_space(3))) bf16x8*)(kp+4096); kf[5]=*(const __attribute__((address_space(3))) bf16x8*)(kp+4608);
  kf[6]=*(const __attribute__((address_space(3))) bf16x8*)(kp+6144); kf[7]=*(const __attribute__((address_space(3))) bf16x8*)(kp+6656);
}
__device__ __forceinline__ void kload2(bf16x8*kf,lds_cptr kp,int j){ kf[2*j]=*(const __attribute__((address_space(3))) bf16x8*)(kp+j*2048); kf[2*j+1]=*(const __attribute__((address_space(3))) bf16x8*)(kp+j*2048+512); }
__device__ __forceinline__ s16x4 vtr(lds_cptr p){ return __builtin_bit_cast(s16x4,__builtin_amdgcn_ds_read_tr16_b64_v4i16((__attribute__((address_space(3))) v4i16_t*)p)); }
__device__ __forceinline__ float rowmax(const f32x16&p0,const f32x16&p1){
  float a=max3f(p0[0],p0[1],p1[0]),b=max3f(p0[2],p0[3],p1[1]);a=max3f(a,p1[2],p1[3]);
  #pragma unroll
  for(int r=4;r<16;r+=4){a=max3f(a,p0[r],p0[r+1]);b=max3f(b,p0[r+2],p0[r+3]);a=max3f(a,p1[r],p1[r+1]);b=max3f(b,p1[r+2],p1[r+3]);}
  const float m=max2f(a,b);
  auto rr=__builtin_amdgcn_permlane32_swap(__float_as_uint(m),__float_as_uint(m),false,false);
  return max2f(__uint_as_float(rr[0]),__uint_as_float(rr[1]));
}
__device__ __forceinline__ void pv(f32x16*o,int vb,bf16x8 pa0,bf16x8 pa1,bf16x8 pa2,bf16x8 pa3){
  #pragma unroll
  for(int d0=0;d0<4;++d0){s16x4 lo[4],hi[4];
    #pragma unroll
    for(int ks=0;ks<4;++ks){
      asm volatile("ds_read_b64_tr_b16 %0,%1 offset:%c2":"=&v"(lo[ks]):"v"(vb),"i"(d0*4096+ks*1024):"memory");
      asm volatile("ds_read_b64_tr_b16 %0,%1 offset:%c2":"=&v"(hi[ks]):"v"(vb),"i"(d0*4096+ks*1024+512):"memory");}
    asm volatile("s_waitcnt lgkmcnt(0)":::"memory");SBAR();
    #define PK(k) (bf16x8){lo[k][0],lo[k][1],lo[k][2],lo[k][3],hi[k][0],hi[k][1],hi[k][2],hi[k][3]}
    o[d0]=__builtin_amdgcn_mfma_f32_32x32x16_bf16(pa0,PK(0),o[d0],0,0,0);
    o[d0]=__builtin_amdgcn_mfma_f32_32x32x16_bf16(pa1,PK(1),o[d0],0,0,0);
    o[d0]=__builtin_amdgcn_mfma_f32_32x32x16_bf16(pa2,PK(2),o[d0],0,0,0);
    o[d0]=__builtin_amdgcn_mfma_f32_32x32x16_bf16(pa3,PK(3),o[d0],0,0,0);
    #undef PK
  }
}

#ifndef ATTN_STORE16
#define ATTN_STORE16(p,v) (*(u32x4*)(p)=(v))
#endif
template<int THRL> __device__ __forceinline__ void attn_unit(int b,int qcol,int kcol,int vcol,int ocol,int qb,const bf16*Q,const bf16*__restrict__ K,const bf16*__restrict__ V,bf16*O,bf16*O2,int mode,float lam,const __attribute__((address_space(3))) float*gn,char*shm,bool pre,bool has_next,int nb,int nkcol,int nvcol){
  int tid_=threadIdx.x; asm volatile("":"+v"(tid_)); const int tid=tid_,lane=tid&63,r32=lane&31,hi=lane>>5; const int wid=__builtin_amdgcn_readfirstlane(tid>>6);
  const long rowbase=(long)b*SEQ; const int q0=qb*QB;
  const bf16*Qw=Q+(rowbase+q0+wid*QBLK)*PQ+qcol;
  const bf16*Kh=K+rowbase*PQ+kcol,*Vh=V+rowbase*PQ+vcol;
  const unsigned lds0=(unsigned)(uintptr_t)shm;
  float*wsf=(float*)(shm+LDS_WS)+wid*64;
  const bf16*ksrc=Kh+(long)lane*PQ+wid*8;
  const bf16*vsrc=Vh+(long)(16*(wid&3)+(lane>>2))*PQ+(wid>>2)*32+(lane&3)*8;
  const unsigned kdst=lds0+LDS_K+wid*1024, vdst=lds0+LDS_V+wid*1024;
  #define DMA_K(t,slot) glds16(ksrc+(long)(t)*KVBLK*PQ,(unsigned)__builtin_amdgcn_readfirstlane(kdst+(slot)))
  #define DMA_V(t,slot) do{ glds16(vsrc+(long)(t)*KVBLK*PQ,(unsigned)__builtin_amdgcn_readfirstlane(vdst+2*(slot))); glds16(vsrc+(long)(t)*KVBLK*PQ+64,(unsigned)__builtin_amdgcn_readfirstlane(vdst+2*(slot)+8192)); }while(0)
  const int vb0=(int)(lds0+LDS_V)+((lane>>4)&1)*32+(lane&3)*8+(4*hi+((lane&15)>>2))*64;
  const char*Kbase=shm+LDS_K; bf16x8 kf[8];
  const lds_cptr shm3=(lds_cptr)shm; const lds_cptr kp0=shm3+LDS_K+hi*1024+r32*16; const lds_cptr vp0=shm3+LDS_V+((lane>>4)&1)*32+(lane&3)*8+(4*hi+((lane&15)>>2))*64;
  const int NT=(q0+QB)/KVBLK;
  if(!pre){DMA_K(0,0);DMA_V(0,0);DMA_K(1,SLOTB);}
  typedef __attribute__((address_space(3))) bf16x8 lds_bf16x8;
  lds_bf16x8*const qst=(lds_bf16x8*)(shm3+LDS_OST+wid*4096)+lane;
  { bf16x8 qr[4];
    #pragma unroll
    for(int d0=0;d0<4;++d0)qr[d0]=*reinterpret_cast<const bf16x8*>(&Qw[(long)r32*PQ+d0*16+hi*8]);
    #pragma unroll
    for(int d0=0;d0<4;++d0)qst[64*d0]=qr[d0]; }
  float mhat=0.f,l_reg=0.f;f32x16 o[4];o[0]=f32x16{};o[1]=f32x16{};o[2]=f32x16{};o[3]=f32x16{};f32x16 negm=f32x16{};asm volatile("":"+v"(negm));
  const int qrel=wid*QBLK+r32;
  #define CMASK(P0,P1,t) do{int jb_=(t)-(NT-4); if(jb_>=0)cmask(P0,P1,jb_,qrel,hi);}while(0)
  bool resc=false;
  #define START(P0,P1) do{ const float rm=rowmax(P0,P1); resc=false; \
    { const float dl=rm; mhat=fadd_s(mhat,dl); \
      _Pragma("unroll") for(int r=0;r<16;++r){P0[r]=fsub_s(P0[r],dl);P1[r]=fsub_s(P1[r],dl);} \
      _Pragma("unroll") for(int r=0;r<16;++r)negm[r]=-mhat; asm volatile("":"+v"(negm)); } \
    _Pragma("unroll") for(int r=0;r<16;++r)P0[r]=__builtin_amdgcn_exp2f(P0[r]); }while(0)
  #define RESC() do{ if(resc){ asm volatile("s_waitcnt lgkmcnt(0)":::"memory"); \
      _Pragma("unroll") for(int d_=0;d_<4;++d_) _Pragma("unroll") for(int r=0;r<16;++r)o[d_][r]*=wsf[crow(r,hi)]; } }while(0)
  f32x16 pA0,pA1,pB0,pB1;
  int sl_prev=0,sl_cur=0,sl_next=SLOTB;
  #define ROT() do{sl_prev=sl_cur;sl_cur=sl_next;sl_next=(sl_next==(NSLOT-1)*SLOTB)?0:sl_next+SLOTB;}while(0)
  if(!pre)DMA_K(2,2*SLOTB);
  WAIT_BAR(4);
  { bf16x8 qr[4];
    #pragma unroll
    for(int d0=0;d0<4;++d0)qr[d0]=qst[64*d0];
    qkt(pA0,pA1,Kbase,qr,negm,r32,hi); }
  asm volatile("s_nop 15\n\ts_nop 7":"+v"(pA0),"+v"(pA1));CMASK(pA0,pA1,0);
  START(pA0,pA1);
  _Pragma("unroll") for(int r=0;r<16;++r)pA1[r]=__builtin_amdgcn_exp2f(pA1[r]);
  WAIT_BAR(0);
  DMA_K(3,0);DMA_V(1,SLOTB);
  ROT();
  kload8(kf,kp0+sl_cur);
  WAIT_BAR(3);
  bf16x8 vf[4]; u32x4 pw0,pw1,pw2,pw3;
  #define PKW(P,B) cvtpk_s(P[B],P[B+1])
  #define PAF(k) __builtin_bit_cast(bf16x8,pw##k)
  #define VFR(i) vf[i]
  #define PIN(x) asm volatile("":"+v"(x))
  #define MX3(a,b,c) __builtin_fmaxf(__builtin_fmaxf((a),(b)),(c))
  #define GAPA(MF,A0,A1,A2,A3,W0,W1,PW) do{ MF; sacc+=A0; sacc+=A1; sacc+=A2; sacc+=A3; PIN(sacc); W0; W1; PIN(PW); SBAR(); }while(0)
  #define EX(v) __builtin_amdgcn_exp2f(v)
  #define GAPB(MF,X,B) do{ MF; X[B]=EX(X[B]); X[B+1]=EX(X[B+1]); PIN(X); SBAR(); }while(0)
  #define VRD(n) do{ const s16x4 lo_=vtr(vp_+(((n)&3)*4096+((n)>>2)*1024)), hi_=vtr(vp_+(((n)&3)*4096+((n)>>2)*1024+512)); vf[(n)&3]=__builtin_shufflevector(lo_,hi_,0,1,2,3,4,5,6,7); }while(0)
  #define KRD(G,j) do{ if(G){ kload2(kf,kp0+sl_next,j); SBAR(); } }while(0)
  #define PVM(n,X,B) GAPB(o[(n)&3]=__builtin_amdgcn_mfma_f32_32x32x16_bf16(PAFN((n)>>2),VFR((n)&3),o[(n)&3],0,0,0), X,B)
  #define PAFN(k) ((k)==0?PAF(0):(k)==1?PAF(1):(k)==2?PAF(2):PAF(3))
  #define STEP(C0,C1,P0,P1,t,GK,GV,GL) do{ SBAR(); \
    const lds_cptr vp_=vp0+2*sl_prev; \
    bf16x8 q0_=qst[0],q1_=qst[64]; SBAR(); float sacc=(P0[0]+P0[1]); \
    GAPA(C0=__builtin_amdgcn_mfma_f32_32x32x16_bf16(kf[0],q0_,negm,0,0,0), P0[2],P0[3],P0[4],P0[5],     pw0[0]=PKW(P0,0), pw0[1]=PKW(P0,2), pw0); \
    GAPA(C1=__builtin_amdgcn_mfma_f32_32x32x16_bf16(kf[1],q0_,negm,0,0,0), P0[6],P0[7],P0[8],P0[9],     pw0[2]=PKW(P0,4), pw0[3]=PKW(P0,6), pw0); \
    bf16x8 q2_=qst[128]; SBAR(); \
    GAPA(C0=__builtin_amdgcn_mfma_f32_32x32x16_bf16(kf[2],q1_,C0,0,0,0),   P0[10],P0[11],P0[12],P0[13], pw1[0]=PKW(P0,8), pw1[1]=PKW(P0,10), pw1); \
    GAPA(C1=__builtin_amdgcn_mfma_f32_32x32x16_bf16(kf[3],q1_,C1,0,0,0),   P0[14],P0[15],P1[0],P1[1],   pw1[2]=PKW(P0,12),pw1[3]=PKW(P0,14), pw1); \
    bf16x8 q3_=qst[192]; SBAR(); \
    GAPA(C0=__builtin_amdgcn_mfma_f32_32x32x16_bf16(kf[4],q2_,C0,0,0,0),   P1[2],P1[3],P1[4],P1[5],     pw2[0]=PKW(P1,0), pw2[1]=PKW(P1,2), pw2); \
    GAPA(C1=__builtin_amdgcn_mfma_f32_32x32x16_bf16(kf[5],q2_,C1,0,0,0),   P1[6],P1[7],P1[8],P1[9],     pw2[2]=PKW(P1,4), pw2[3]=PKW(P1,6), pw2); \
    VRD(0); SBAR(); \
    GAPA(C0=__builtin_amdgcn_mfma_f32_32x32x16_bf16(kf[6],q3_,C0,0,0,0),   P1[10],P1[11],P1[12],P1[13], pw3[0]=PKW(P1,8), pw3[1]=PKW(P1,10), pw3); \
    VRD(1); VRD(2); SBAR(); \
    GAPA(C1=__builtin_amdgcn_mfma_f32_32x32x16_bf16(kf[7],q3_,C1,0,0,0),   P1[14],P1[15],0.f,0.f,       pw3[2]=PKW(P1,12),pw3[3]=PKW(P1,14), pw3); \
    l_reg+=sacc; \
    if(GK){DMA_K((t)+3,sl_cur);} if(GV){DMA_V((t)+1,sl_next);} \
    CMASK(C0,C1,t); \
    { float a=MX3(C0[0],C0[1],C1[0]),b=MX3(C0[2],C0[3],C1[1]); a=MX3(a,C1[2],C1[3]); \
      _Pragma("unroll") for(int r=4;r<16;r+=4){a=MX3(a,C0[r],C0[r+1]);b=MX3(b,C0[r+2],C0[r+3]);a=MX3(a,C1[r],C1[r+1]);b=MX3(b,C1[r+2],C1[r+3]);} \
      float rm=__builtin_fmaxf(a,b); { auto rr=__builtin_amdgcn_permlane32_swap(__float_as_uint(rm),__float_as_uint(rm),false,false); rm=__builtin_fmaxf(__uint_as_float(rr[0]),__uint_as_float(rr[1])); } \
      resc=false; \
      if(__builtin_expect(__any(rm>(float)THRL),0)){ const float dl=__builtin_fmaxf(rm,0.f); mhat+=dl; \
        _Pragma("unroll") for(int r=0;r<16;++r){C0[r]-=dl;C1[r]-=dl;} \
        _Pragma("unroll") for(int r=0;r<16;++r)negm[r]=-mhat; asm volatile("":"+v"(negm)); \
        const float f=__builtin_amdgcn_exp2f(-dl); l_reg*=f; if(hi==0)wsf[r32]=f; resc=true; } } \
    SBAR(); \
    VRD(3); SBAR(); PVM(0,C0,0); \
    VRD(4); SBAR(); PVM(1,C0,2); \
    VRD(5); SBAR(); PVM(2,C0,4); \
    VRD(6); SBAR(); KRD(GL,0); PVM(3,C0,6); \
    VRD(7); SBAR(); PVM(4,C0,8); \
    VRD(8); SBAR(); KRD(GL,1); PVM(5,C0,10); \
    VRD(9); SBAR(); PVM(6,C0,12); \
    VRD(10); SBAR(); KRD(GL,2); PVM(7,C0,14); \
    VRD(11); SBAR(); PVM(8,C1,0); \
    VRD(12); SBAR(); KRD(GL,3); PVM(9,C1,2); \
    VRD(13); SBAR(); PVM(10,C1,4); \
    VRD(14); SBAR(); PVM(11,C1,6); \
    VRD(15); SBAR(); PVM(12,C1,8); \
    PVM(13,C1,10); \
    PVM(14,C1,12); \
    PVM(15,C1,14); \
    }while(0)
  int t=1;
  #undef CMASK
  #define CMASK(P0,P1,t) do{}while(0)
  for(;t+5<NT;t+=2){
    STEP(pB0,pB1,pA0,pA1,t,true,true,true);     WAIT_BAR(3); RESC(); ROT();
    STEP(pA0,pA1,pB0,pB1,t+1,true,true,true);   WAIT_BAR(3); RESC(); ROT();
  }
  #undef CMASK
  #define CMASK(P0,P1,t) do{int jb_=(t)-(NT-4); if(jb_>=0)cmask(P0,P1,jb_,qrel,hi);}while(0)
  #define ENDW(tt) do{ if((tt)+3<NT){WAIT_BAR(3);} else if((tt)+2<NT){WAIT_BAR(2);} else {WAIT_BAR(0);} }while(0)
  for(;t+1<NT;t+=2){
    STEP(pB0,pB1,pA0,pA1,t,(t+3<NT),(t+1<NT),(t+1<NT));       ENDW(t);   RESC(); ROT();
    STEP(pA0,pA1,pB0,pB1,t+1,(t+4<NT),(t+2<NT),(t+2<NT));     ENDW(t+1); RESC(); ROT();
  }
  STEP(pB0,pB1,pA0,pA1,NT-1,false,false,false); RESC();
  { float sacc=pB0[0]+pB0[1]; _Pragma("unroll") for(int r=2;r<16;++r)sacc+=pB0[r]; _Pragma("unroll") for(int r=0;r<16;++r)sacc+=pB1[r]; l_reg+=sacc;
    pw0=(u32x4){PKW(pB0,0),PKW(pB0,2),PKW(pB0,4),PKW(pB0,6)};pw1=(u32x4){PKW(pB0,8),PKW(pB0,10),PKW(pB0,12),PKW(pB0,14)};pw2=(u32x4){PKW(pB1,0),PKW(pB1,2),PKW(pB1,4),PKW(pB1,6)};pw3=(u32x4){PKW(pB1,8),PKW(pB1,10),PKW(pB1,12),PKW(pB1,14)};
    SBAR(); pv(o,vb0+2*sl_cur,PAF(0),PAF(1),PAF(2),PAF(3)); }
  asm volatile("s_waitcnt lgkmcnt(0)\n\ts_barrier":::"memory");
  if(has_next){ const bf16*Kn=K+(long)nb*SEQ*PQ+nkcol,*Vn=V+(long)nb*SEQ*PQ+nvcol;
    const bf16*ksn=Kn+(long)lane*PQ+wid*8; const bf16*vsn=Vn+(long)(16*(wid&3)+(lane>>2))*PQ+(wid>>2)*32+(lane&3)*8;
    glds16(ksn,(unsigned)__builtin_amdgcn_readfirstlane(kdst));
    glds16(vsn,(unsigned)__builtin_amdgcn_readfirstlane(vdst)); glds16(vsn+64,(unsigned)__builtin_amdgcn_readfirstlane(vdst+8192));
    glds16(ksn+(long)KVBLK*PQ,(unsigned)__builtin_amdgcn_readfirstlane(kdst+SLOTB));
    glds16(ksn+(long)2*KVBLK*PQ,(unsigned)__builtin_amdgcn_readfirstlane(kdst+2*SLOTB)); }
  #undef PKW
  #undef PAF
  #undef VFR
  #undef PIN
  #undef MX3
  #undef GAPA
  #undef GAPB
  #undef PVM
  #undef PAFN
  #undef EX
  #undef VRD
  #undef KRD
  #undef STEP
  #undef ENDW
  {auto rr=__builtin_amdgcn_permlane32_swap(__float_as_uint(l_reg),__float_as_uint(l_reg),false,false);l_reg=__uint_as_float(rr[0])+__uint_as_float(rr[1]);}
  if(hi==0)wsf[32+r32]=l_reg;asm volatile("s_waitcnt lgkmcnt(0)":::"memory");
  float rli[16];
  #pragma unroll
  for(int r=0;r<16;++r)rli[r]=__builtin_amdgcn_rcpf(wsf[32+crow(r,hi)]);
  bf16*Ow=O+(rowbase+q0+wid*QBLK)*PO+ocol;
  { bf16*stg=(bf16*)(shm+LDS_OST)+wid*2048;
    if(mode==0){
      #pragma unroll
      for(int ps=0;ps<2;++ps){
        #pragma unroll
        for(int r=0;r<16;++r){const int orow=crow(r,hi);
          #pragma unroll
          for(int d0=0;d0<2;++d0)stg[orow*64+d0*32+r32]=__float2bfloat16(o[2*ps+d0][r]*rli[r]);}
        asm volatile("s_waitcnt lgkmcnt(0)":::"memory");
        #pragma unroll
        for(int i=0;i<4;++i){const int row=i*8+(lane>>3),ch=lane&7; const u32x4 v=*(const u32x4*)(stg+row*64+ch*8); ATTN_STORE16(Ow+(long)row*PO+ps*64+ch*8,v);}
        asm volatile("s_waitcnt lgkmcnt(0)":::"memory"); }
    } else {
      bf16*O2w=O2+(rowbase+q0+wid*QBLK)*PO+ocol;
      float df[2][4][8]; float ssq[4]={0.f,0.f,0.f,0.f};
      #pragma unroll
      for(int ps=0;ps<2;++ps){
        #pragma unroll
        for(int r=0;r<16;++r){const int orow=crow(r,hi);
          #pragma unroll
          for(int d0=0;d0<2;++d0)stg[orow*64+d0*32+r32]=__float2bfloat16(o[2*ps+d0][r]*rli[r]);}
        asm volatile("s_waitcnt lgkmcnt(0)":::"memory");
        #pragma unroll
        for(int i=0;i<4;++i){const int row=i*8+(lane>>3),ch=lane&7; const u32x4 v1=*(const u32x4*)(stg+row*64+ch*8);
          const unsigned long long*p0=(const unsigned long long*)(Ow+(long)row*PO+ps*64+ch*8);
          const unsigned long long a0=__hip_atomic_load(p0,__ATOMIC_RELAXED,__HIP_MEMORY_SCOPE_AGENT),a1=__hip_atomic_load(p0+1,__ATOMIC_RELAXED,__HIP_MEMORY_SCOPE_AGENT);
          const unsigned w0[4]={(unsigned)a0,(unsigned)(a0>>32),(unsigned)a1,(unsigned)(a1>>32)};
          #pragma unroll
          for(int e=0;e<4;++e){ const float x0=__uint_as_float(w0[e]<<16)-lam*__uint_as_float(v1[e]<<16), x1=__uint_as_float(w0[e]&0xffff0000u)-lam*__uint_as_float(v1[e]&0xffff0000u);
            df[ps][i][2*e]=x0; df[ps][i][2*e+1]=x1; ssq[i]+=x0*x0+x1*x1; } }
        asm volatile("s_waitcnt lgkmcnt(0)":::"memory"); }
      #pragma unroll
      for(int i=0;i<4;++i){ float q=ssq[i]; q+=__shfl_xor(q,1); q+=__shfl_xor(q,2); q+=__shfl_xor(q,4); ssq[i]=__builtin_amdgcn_rsqf(q*(1.f/128.f)+1e-5f); }
      #pragma unroll
      for(int ps=0;ps<2;++ps){ const int ch=lane&7; const __attribute__((address_space(3))) float*gp=gn+ps*64+ch*8; float g8[8];
        #pragma unroll
        for(int e=0;e<8;++e)g8[e]=gp[e];
        #pragma unroll
        for(int i=0;i<4;++i){const int row=i*8+(lane>>3); u32x4 w;
          w[0]=cvtpk_s(df[ps][i][0]*ssq[i]*g8[0],df[ps][i][1]*ssq[i]*g8[1]); w[1]=cvtpk_s(df[ps][i][2]*ssq[i]*g8[2],df[ps][i][3]*ssq[i]*g8[3]);
          w[2]=cvtpk_s(df[ps][i][4]*ssq[i]*g8[4],df[ps][i][5]*ssq[i]*g8[5]); w[3]=cvtpk_s(df[ps][i][6]*ssq[i]*g8[6],df[ps][i][7]*ssq[i]*g8[7]);
          ATTN_STORE16(O2w+(long)row*PO+ps*64+ch*8,w);} }
    } }
  asm volatile("s_waitcnt lgkmcnt(0)\n\ts_barrier":::"memory");
  #undef DMA_K
  #undef DMA_V
  #undef CMASK
  #undef START
  #undef RESC
  #undef ROT
}
constexpr int ATTN_LDS_BYTES=LDS_BYTES;
struct AttnTensors { const bf16* Q; const bf16* K; const bf16* V; bf16* O0; bf16* O2; float lam; const __attribute__((address_space(3))) float* gn; };
struct AttnUnit { int bh; int qb; };
struct StaticOrder {
  int vcu,G;
  __device__ __forceinline__ explicit StaticOrder(int grid,int block):vcu((grid%8==0)?(block%8)*(grid/8)+block/8:block),G(grid){}
  __device__ __forceinline__ bool next(int i,AttnUnit&u)const{ const int pi=vcu+(i>>1)*G; if(pi>=BATCH*8*16)return false; const int s=pi&15; u.bh=pi>>4; u.qb=(i&1)?31-s:s; return true; }
  __device__ __forceinline__ void a_ready(const AttnUnit&)const{}
  __device__ __forceinline__ void done(const AttnUnit&)const{}
};
template<class Sched,int THRL=8> __device__ __forceinline__ void attn_phase(char*lds,const AttnTensors&T,const Sched&S){
  AttnUnit u,un; bool pre=false;
  if(!S.next(0,u))return;
  for(int i=0;;++i){ S.a_ready(u); const int b=u.bh>>3,h=u.bh&7; const bool more=S.next(i+1,un); const int nb=un.bh>>3,nh=un.bh&7;
    for(int c=0;c<2;++c) attn_unit<THRL>(b,h*128+c*64,h*128+c*64,h*128,h*128,u.qb,T.Q,T.K,T.V,T.O0,T.O2,c,T.lam,T.gn,lds,pre||c==1,c==0||more,c==0?b:nb,c==0?h*128+64:nh*128,c==0?h*128:nh*128);
    S.done(u); if(!more)break; u=un; pre=true; }
}
#undef SBAR
#undef WAIT_BAR
}


#ifndef MK_P2_NOKWT
#define MK_P2_NOKWT 0
#endif

#ifndef MK_P4_HALFLDS
#define MK_P4_HALFLDS 0
#endif

constexpr int NWAVES = 8;
constexpr int T = 32768, D = 1024, SEQ = 8192, NB = 4;
constexpr int ML_H = 4, ML_DV = 512, ML_DQK = 256, ML_QK = 1024, ML_V = 2048, ML_LD = 6152, NCH = 128;
constexpr int VT_ROWS = 544;
constexpr int NEXP = 32, DEXP = 256, MAXPANEL = 288, MAXSLOT = MAXPANEL * 256;
constexpr float LAMBDA_INIT1 = 0.35550906759f;

constexpr size_t MiB = 1u << 20;
constexpr size_t WS_CTL = 0, CTL_ZERO_BYTES = 1 * MiB;
constexpr size_t WS_GATES = 1 * MiB;
constexpr size_t WS_SA = 2 * MiB, WS_SB = WS_SA + 512 * 1024, WS_SIS = 3 * MiB, WS_SFL = WS_SIS + 512 * 1024, WS_RS = 4 * MiB, WS_QN = WS_RS + 512 * 1024;
constexpr size_t WS_CHB = 5 * MiB, WS_CHM = WS_CHB + 8192, WS_DEC = WS_CHM + 8192;
constexpr size_t WS_WR = 5 * MiB + 512 * 1024;
constexpr size_t WS_TE = 6 * MiB, WS_TW = WS_TE + 256 * 1024, WS_TPOS = WS_TW + 256 * 1024, WS_TSLOT = WS_TPOS + 256 * 1024;
constexpr size_t WS_ERS = 1 * MiB, WS_RSTD = 5 * MiB;
constexpr size_t WS_E2T = 8 * MiB, WS_EW = 12 * MiB;
constexpr size_t WS_WML_IN = 16 * MiB, WS_WML_OUT = 28 * MiB;
constexpr size_t WS_KWT = 32 * MiB;
constexpr size_t WS_WDA_IN = 504 * MiB, WS_WDA_OUT = 510 * MiB, WS_WGU = 40 * MiB, WS_WDN = 72 * MiB;
constexpr size_t WS_WGU1 = 196 * MiB, WS_WDN1 = 228 * MiB;
constexpr size_t WS_R0 = 96 * MiB;
constexpr size_t WS_QKRAW = WS_R0, WS_OG = WS_R0 + 128 * MiB, WS_VT = WS_R0 + 256 * MiB;
constexpr size_t WS_WGU0 = WS_R0 + 192 * MiB, WS_WDN0 = WS_WGU0 + 32 * MiB;
constexpr size_t WS_PG = 488 * MiB;
constexpr size_t WS_HN = WS_R0;
constexpr size_t WS_ACT = WS_R0 + 64 * MiB, WS_YS = 352 * MiB;
constexpr size_t WS_AQ = 244 * MiB, WS_AK = WS_AQ + 64 * MiB, WS_AV = WS_AK + 64 * MiB, WS_AO = WS_AV + 64 * MiB;
constexpr size_t WS_END = WS_YS + 144 * MiB;
static_assert(WS_VT + (size_t)4 * VT_ROWS * T * 2 <= 488 * MiB && WS_END <= 496 * MiB && WS_AO + (size_t)T * 1024 * 2 <= 504 * MiB && WS_WDN0 + 16 * MiB <= WS_VT && WS_WDN1 + 16 * MiB <= WS_AQ && WS_ACT + 36 * MiB <= WS_WGU1, "d_ws map");
constexpr int CW_BAR = 4096;
constexpr int CW_CNT = 16384;

constexpr int RING_OFF = 0, RING_BYTES = 131072;
constexpr int LDSCTL_OFF = RING_BYTES, MISC_OFF = LDSCTL_OFF + 320;
constexpr int TAB_OFF = LDSCTL_OFF + 1024;
constexpr int TAB_PEXP = TAB_OFF, TAB_ECNT = TAB_OFF + 1280, TAB_EOFF = TAB_ECNT + 128, TAB_NP = TAB_EOFF + 136;
constexpr int HST_OFF = TAB_OFF;
constexpr int LDS_BYTES = 148480;

#define GAS __attribute__((address_space(1)))
#define LAS __attribute__((address_space(3)))
typedef unsigned short bf16;
typedef unsigned v4u __attribute__((ext_vector_type(4)));
typedef unsigned v2u __attribute__((ext_vector_type(2)));
typedef float f32x4 __attribute__((ext_vector_type(4)));
typedef float f32x2 __attribute__((ext_vector_type(2)));
typedef short bf16x8 __attribute__((ext_vector_type(8)));
typedef GAS unsigned gu32;
#define RLX_AGENT __ATOMIC_RELAXED, __HIP_MEMORY_SCOPE_AGENT
#define LDS_WAIT() asm volatile("s_waitcnt lgkmcnt(0)" ::: "memory")
__device__ __forceinline__ unsigned f2bf(float f) { unsigned u = __builtin_bit_cast(unsigned, f); return (u + 0x7fffu + ((u >> 16) & 1u)) >> 16; }
__device__ __forceinline__ unsigned pk2(float lo, float hi) { typedef float f2v_t __attribute__((ext_vector_type(2))); typedef __bf16 b2v_t __attribute__((ext_vector_type(2)));
    f2v_t v = {lo, hi}; b2v_t b = __builtin_convertvector(v, b2v_t); return __builtin_bit_cast(unsigned, b); }
__device__ __forceinline__ float bf_lo(unsigned w) { return __builtin_bit_cast(float, w << 16); }
__device__ __forceinline__ float bf_hi(unsigned w) { return __builtin_bit_cast(float, w & 0xffff0000u); }
__device__ __forceinline__ float bf1(bf16 h) { return __builtin_bit_cast(float, (unsigned)h << 16); }
__device__ __forceinline__ float wave_sum(float v) {
#pragma unroll
    for (int o = 1; o < 64; o <<= 1) v += __shfl_xor(v, o);
    return v;
}
__device__ __forceinline__ float wave_max(float v) {
#pragma unroll
    for (int o = 1; o < 64; o <<= 1) v = fmaxf(v, __shfl_xor(v, o));
    return v;
}
__device__ __forceinline__ float prefix_sum_incl(float v, int lane) {
#pragma unroll
    for (int o = 1; o < 64; o <<= 1) { const float u = __shfl_up(v, o); if (lane >= o) v += u; }
    return v;
}
__device__ __forceinline__ float prefix_max_incl(float v, int lane) {
#pragma unroll
    for (int o = 1; o < 64; o <<= 1) { const float u = __shfl_up(v, o); if (lane >= o) v = fmaxf(v, u); }
    return v;
}
__device__ __forceinline__ float log_sigmoid(float z) { return fminf(z, 0.f) - log1pf(__expf(-fabsf(z))); }
__device__ __forceinline__ float sigmoidf_(float z) { return 1.f / (1.f + __expf(-z)); }
#define XB_TMO      128
#define XB_XCNT(j)  (256  + 64 * (j))
#define XB_XSUB(j)  (1280 + 64 * (j))
#define XB_XGEN(j)  (2304 + 64 * (j))
#define XB_TOP      3328
#define XB_TOPGEN   3392
#define XCD_BAR_WORDS 3456
#define XB_SPIN_CAP (1u << 18)

__device__ __forceinline__ unsigned xb_ld(unsigned* p)              { return __hip_atomic_load(p, __ATOMIC_RELAXED, __HIP_MEMORY_SCOPE_AGENT); }
__device__ __forceinline__ unsigned xb_add(unsigned* p, unsigned v) { return __hip_atomic_fetch_add(p, v, __ATOMIC_RELAXED, __HIP_MEMORY_SCOPE_AGENT); }
__device__ __forceinline__ unsigned xb_xcc_id() { return (unsigned)__builtin_amdgcn_s_getreg((3 << 11) | 20) & 0xFu; }
#define XB_SPIN(cond, bar) do { unsigned _sp = 0; while (cond) { __builtin_amdgcn_s_sleep(1); \
    if ((++_sp & 255u) == 0u) { if (xb_ld(&(bar)[XB_TMO])) break; if (_sp > XB_SPIN_CAP) { atomicAdd(&(bar)[XB_TMO], 1u); break; } } } } while (0)

struct XcdBarrier {
    unsigned* bar; unsigned x;
    volatile LAS unsigned* st;
};

__device__ __forceinline__ XcdBarrier xcd_barrier_post(unsigned* bar, volatile LAS unsigned* st) {
    XcdBarrier b; b.bar = bar; b.x = xb_xcc_id(); b.st = st;
    if (threadIdx.x == 0) (void)xb_add(&bar[XB_XCNT(b.x)], 1u);
    return b;
}
__device__ __forceinline__ void xcd_barrier_complete(unsigned* bar, unsigned x, unsigned& nloc, unsigned& nx) {
    const unsigned G = gridDim.x * gridDim.y * gridDim.z;
    unsigned sum, cnt, mine, sp = 0u;
    for (;;) {
        sum = 0u; cnt = 0u; mine = 0u;
#pragma unroll
        for (unsigned j = 0; j < 16; ++j) { const unsigned c = xb_ld(&bar[XB_XCNT(j)]); sum += c; cnt += (c > 0u) ? 1u : 0u; mine = (j == x) ? c : mine; }
        if (sum == G) break;
        __builtin_amdgcn_s_sleep(1);
        if ((++sp & 255u) == 0u) { if (xb_ld(&bar[XB_TMO])) break; if (sp > XB_SPIN_CAP) { atomicAdd(&bar[XB_TMO], 1u); break; } }
    }
    nloc = mine > 0u ? mine : 1u; nx = cnt > 0u ? cnt : 1u;
}

__device__ __forceinline__ void xcd_barrier(const XcdBarrier& b) {
    asm volatile("s_waitcnt vmcnt(0)" ::: "memory");
    __syncthreads();
    if (threadIdx.x == 0) {
        unsigned* bar = b.bar;
        __builtin_amdgcn_s_waitcnt(0);
        unsigned nloc = b.st[0], nx = b.st[1];
        if (nloc == 0u) { xcd_barrier_complete(bar, b.x, nloc, nx); b.st[0] = nloc; b.st[1] = nx; }
        const unsigned old = xb_add(&bar[XB_XSUB(b.x)], 1u);
        const unsigned gen = old / nloc;
        if (old + 1u == (gen + 1u) * nloc) {
            __builtin_amdgcn_fence(__ATOMIC_RELEASE, "agent");
            asm volatile("s_waitcnt vmcnt(0)" ::: "memory");
            const unsigned og = xb_add(&bar[XB_TOP], 1u);
            const unsigned tg = og / nx;
            if (og + 1u == (tg + 1u) * nx) xb_add(&bar[XB_TOPGEN], 1u);
            else XB_SPIN(xb_ld(&bar[XB_TOPGEN]) == tg, bar);
            __builtin_amdgcn_fence(__ATOMIC_ACQUIRE, "agent");
            xb_add(&bar[XB_XGEN(b.x)], 1u);
            asm volatile("s_waitcnt vmcnt(0)" ::: "memory");
        } else {
            XB_SPIN(xb_ld(&bar[XB_XGEN(b.x)]) == gen, bar);
            __builtin_amdgcn_fence(__ATOMIC_ACQUIRE, "agent");
            asm volatile("s_waitcnt vmcnt(0)" ::: "memory");
        }
    }
    __syncthreads();
}


struct Ctx { LAS unsigned char* lds; int tid, lane, wave, vcu, G, gw, NGW; };

__device__ __forceinline__ void tr_item(const float* W, int ld, int K, int k0, int c0, bf16* WT, int drow0, LAS float* scr, int lane, const float* kscale = nullptr) {
    f32x4 wv[8];
#pragma unroll
    for (int i = 0; i < 8; ++i) { wv[i] = *(const GAS f32x4*)(W + (size_t)(k0 + 8 * i + (lane >> 3)) * ld + c0 + 4 * (lane & 7)); if (kscale) wv[i] = wv[i] * kscale[k0 + 8 * i + (lane >> 3)]; }
#pragma unroll
    for (int i = 0; i < 8; ++i) { LAS float* d = scr + (8 * i + (lane >> 3)) * 33 + 4 * (lane & 7); d[0] = wv[i].x; d[1] = wv[i].y; d[2] = wv[i].z; d[3] = wv[i].w; }
    LDS_WAIT(); asm volatile("" ::: "memory");
    const int c = lane & 7;
#pragma unroll
    for (int j = 0; j < 4; ++j) { const int n = (lane >> 3) + 8 * j; const LAS float* s = scr + (8 * c) * 33 + n;
        v4u o; o.x = pk2(s[0 * 33], s[1 * 33]); o.y = pk2(s[2 * 33], s[3 * 33]); o.z = pk2(s[4 * 33], s[5 * 33]); o.w = pk2(s[6 * 33], s[7 * 33]);
        *(GAS v4u*)(WT + (size_t)(drow0 + n) * K + k0 + 8 * c) = o; }
    LDS_WAIT(); asm volatile("" ::: "memory");
}
__device__ __forceinline__ void tr_load(f32x4 (&wv)[8], float (&ks)[8], const float* W, int ld, int k0, int c0, int lane, const float* kscale) {
#pragma unroll
    for (int i = 0; i < 8; ++i) { wv[i] = *(const GAS f32x4*)(W + (size_t)(k0 + 8 * i + (lane >> 3)) * ld + c0 + 4 * (lane & 7)); ks[i] = kscale ? kscale[k0 + 8 * i + (lane >> 3)] : 1.f; }
}
__device__ __forceinline__ void tr_finish(const f32x4 (&wv)[8], const float (&ks)[8], int K, int k0, bf16* WT, int drow0, LAS float* scr, int lane) {
#pragma unroll
    for (int i = 0; i < 8; ++i) { LAS float* d = scr + (8 * i + (lane >> 3)) * 33 + 4 * (lane & 7); const f32x4 w = wv[i] * ks[i]; d[0] = w.x; d[1] = w.y; d[2] = w.z; d[3] = w.w; }
    LDS_WAIT(); asm volatile("" ::: "memory");
    const int c = lane & 7;
#pragma unroll
    for (int j = 0; j < 4; ++j) { const int n = (lane >> 3) + 8 * j; const LAS float* s = scr + (8 * c) * 33 + n;
        v4u o; o.x = pk2(s[0 * 33], s[1 * 33]); o.y = pk2(s[2 * 33], s[3 * 33]); o.z = pk2(s[4 * 33], s[5 * 33]); o.w = pk2(s[6 * 33], s[7 * 33]);
        *(GAS v4u*)(WT + (size_t)(drow0 + n) * K + k0 + 8 * c) = o; }
    LDS_WAIT(); asm volatile("" ::: "memory");
}
__device__ __forceinline__ void tr_matrix_items(const Ctx& C, const float* W, int K, int N, bf16* WT, int& it0) {
    (void)C; (void)W; (void)K; (void)N; (void)WT; (void)it0;
}

__device__ __forceinline__ void conv_ml_out(const Ctx& C, const float* ml_w_out, unsigned char* ws) {
    LAS float* scr = (LAS float*)(C.lds + RING_OFF + C.wave * 16384); bf16* wml_out = (bf16*)(ws + WS_WML_OUT);
    for (int it = C.gw; it < 32 * 32; it += C.NGW) { const int kb = it / 32, nb = it % 32; tr_item(ml_w_out, D, ML_V, kb * 64, nb * 32, wml_out, nb * 32, scr, C.lane); }
}
__device__ __forceinline__ void p0_prologue(const Ctx& C, const float* x, const float* norm_mix0, const float* ml_w_in, const float* ml_w_out,
                                            const float* norm_ffn, const float* w_group, const float* w_expert, unsigned char* ws, bf16* hn0) {
    LAS float* scr = (LAS float*)(C.lds + RING_OFF + C.wave * 16384);
    bf16* wml_in = (bf16*)(ws + WS_WML_IN); bf16* wml_out = (bf16*)(ws + WS_WML_OUT);
    constexpr int I_IN = 16 * 192;
    for (int it = C.gw; it < I_IN; it += C.NGW) {
        const int kb = it / 192, nb = it % 192, c0 = nb * 32;
        const int drow = c0 < 2048 ? c0 : (c0 < 4096 ? c0 + 2048 : c0 - 2048);
        tr_item(ml_w_in, ML_LD, D, kb * 64, c0, wml_in, drow, scr, C.lane);
    }
    (void)wml_out; (void)ml_w_out;
    { bf16* WRH = (bf16*)(ws + WS_WR); bf16* WRL = WRH + 2 * 32 * 3 * 4 * 16 * 8; const int n = 2 * 32 * 3 * 4 * 16 * 8;
      for (int idx = C.gw * 64 + C.lane; idx < n; idx += C.NGW * 64) {
          int r = idx; const int j = r & 7; r >>= 3; const int c15 = r & 15; r >>= 4; const int g4 = r & 3; r >>= 2; const int ct = r % 3; r /= 3; const int ks = r & 31; const int l = r >> 5;
          const int k = 32 * ks + 8 * g4 + j, col = 16 * ct + c15;
          float w = 0.f; if (col < 4) w = w_group[((size_t)l * D + k) * 4 + col]; else if (col < 36) w = w_expert[((size_t)l * D + k) * 32 + (col - 4)];
          w *= norm_ffn[l * D + k];
          const unsigned hb = f2bf(w); const float hf = __builtin_bit_cast(float, hb << 16);
          WRH[idx] = (bf16)hb; WRL[idx] = (bf16)f2bf(w - hf); } }
    { bf16* vt = (bf16*)(ws + WS_VT); const int per_head = 32 * (T / 8);
      for (int idx = C.gw * 64 + C.lane; idx < 4 * per_head; idx += C.NGW * 64) { const int h = idx / per_head, r = idx % per_head, row = r / (T / 8), ch = r % (T / 8);
          const unsigned v = row == 0 ? 0x3f803f80u : 0u; *(GAS v4u*)(vt + ((size_t)(h * VT_ROWS + 512 + row)) * T + ch * 8) = (v4u){v, v, v, v}; } }
    { float* gates = (float*)(ws + WS_GATES);
      f32x4 gn[4]; float wg[4][4][8];
#pragma unroll
      for (int j = 0; j < 4; ++j) { gn[j] = *(const f32x4*)(norm_mix0 + 4 * C.lane + 256 * j);
#pragma unroll
          for (int e = 0; e < 4; ++e) { const float* p = ml_w_in + (size_t)(4 * C.lane + 256 * j + e) * ML_LD + 6144; const f32x4 a = *(const f32x4*)p, b = *(const f32x4*)(p + 4);
              wg[j][e][0] = a.x; wg[j][e][1] = a.y; wg[j][e][2] = a.z; wg[j][e][3] = a.w; wg[j][e][4] = b.x; wg[j][e][5] = b.y; wg[j][e][6] = b.z; wg[j][e][7] = b.w; } }
      f32x4 v[4], vn[4];
      if (C.gw < T) {
#pragma unroll
          for (int j = 0; j < 4; ++j) vn[j] = ((const GAS f32x4*)(x + (size_t)C.gw * D) + C.lane)[64 * j]; }
      for (int m = C.gw; m < T; m += C.NGW) {
#pragma unroll
          for (int j = 0; j < 4; ++j) v[j] = vn[j];
          if (m + C.NGW < T) {
#pragma unroll
              for (int j = 0; j < 4; ++j) vn[j] = ((const GAS f32x4*)(x + (size_t)(m + C.NGW) * D) + C.lane)[64 * j]; }
          float ss = 0.f;
#pragma unroll
          for (int j = 0; j < 4; ++j) ss += (v[j].x * v[j].x + v[j].y * v[j].y) + (v[j].z * v[j].z + v[j].w * v[j].w);
          const float rstd = rsqrtf(wave_sum(ss) * (1.f / D) + 1e-6f);
          GAS unsigned long long* o8 = (GAS unsigned long long*)(hn0 + (size_t)m * D) + C.lane;
          float ga[8];
#pragma unroll
          for (int c = 0; c < 8; ++c) ga[c] = 0.f;
#pragma unroll
          for (int j = 0; j < 4; ++j) { v[j] = v[j] * rstd * gn[j];
              o8[64 * j] = (unsigned long long)pk2(v[j].x, v[j].y) | ((unsigned long long)pk2(v[j].z, v[j].w) << 32);
#pragma unroll
              for (int c = 0; c < 8; ++c) ga[c] += (v[j].x * wg[j][0][c] + v[j].y * wg[j][1][c]) + (v[j].z * wg[j][2][c] + v[j].w * wg[j][3][c]); }
          float h4[4], h2[2], h1;
          { const bool up = (C.lane & 32) != 0;
#pragma unroll
            for (int c = 0; c < 4; ++c) { const float keep = up ? ga[c + 4] : ga[c], give = up ? ga[c] : ga[c + 4]; h4[c] = keep + __shfl_xor(give, 32); } }
          { const bool up = (C.lane & 16) != 0;
#pragma unroll
            for (int c = 0; c < 2; ++c) { const float keep = up ? h4[c + 2] : h4[c], give = up ? h4[c] : h4[c + 2]; h2[c] = keep + __shfl_xor(give, 16); } }
          { const bool up = (C.lane & 8) != 0; const float keep = up ? h2[1] : h2[0], give = up ? h2[0] : h2[1]; h1 = keep + __shfl_xor(give, 8); }
          h1 += __shfl_xor(h1, 4); h1 += __shfl_xor(h1, 2); h1 += __shfl_xor(h1, 1);
          if ((C.lane & 7) == 0) gates[(size_t)m * 8 + (((C.lane >> 5) & 1) << 2 | ((C.lane >> 4) & 1) << 1 | ((C.lane >> 3) & 1))] = h1;
      } }
}

__device__ __forceinline__ void p1_gate_chunks(const Ctx& C, const float* b_i, const float* b_f, unsigned char* ws) {
    const float* gates = (const float*)(ws + WS_GATES); float* chb = (float*)(ws + WS_CHB); float* chm = (float*)(ws + WS_CHM);
    for (int it = C.gw; it < 16 * NCH; it += C.NGW) {
        const int bh = it >> 7, c = it & 127, b = bh >> 2, h = bh & 3; const size_t t = (size_t)b * SEQ + c * 64 + C.lane;
        const float gi = gates[t * 8 + h] + b_i[h]; const float lf = log_sigmoid(gates[t * 8 + 4 + h] + b_f[h]);
        const float bc = prefix_sum_incl(lf, C.lane); const float bL = __shfl(bc, 63);
        const float mx = wave_max(bL - bc + gi);
        if (C.lane == 0) { chb[it] = bL; chm[it] = mx; }
    }
}

__device__ __forceinline__ void p2_conv(const Ctx& C, const float* b_i, const float* b_f, const float* conv_w, unsigned char* ws, bf16* Qo, bf16* Ko, int probe = 0) {
    const float* gates = (const float*)(ws + WS_GATES); const float* chb = (const float*)(ws + WS_CHB); const float* chm = (const float*)(ws + WS_CHM);
    float* SA = (float*)(ws + WS_SA); float* SB = (float*)(ws + WS_SB); float* SIS = (float*)(ws + WS_SIS); float* SFL = (float*)(ws + WS_SFL); float* DEC = (float*)(ws + WS_DEC);
    const bf16* raw = (const bf16*)(ws + WS_QKRAW); bf16* kwt = (bf16*)(ws + WS_KWT);
    LAS float* wsl = (LAS float*)(C.lds + TAB_OFF + 4096);
    LAS unsigned char* kst = C.lds + RING_OFF;
    const int rg = C.tid >> 8, ct = C.tid & 255; const bool isk = (C.wave & 2) != 0;
    float w[4][8];
#pragma unroll
    for (int j = 0; j < 4; ++j) { const f32x4 a = *(const f32x4*)(conv_w + j * 2048 + 8 * ct), b = *(const f32x4*)(conv_w + j * 2048 + 8 * ct + 4);
        w[j][0] = a.x; w[j][1] = a.y; w[j][2] = a.z; w[j][3] = a.w; w[j][4] = b.x; w[j][5] = b.y; w[j][6] = b.z; w[j][7] = b.w; }
    for (int item = C.vcu; item < NB * NCH; item += C.G) {
        const int b = item >> 7, c = item & 127; const size_t t0 = (size_t)b * SEQ + c * 64;
        if (C.wave < 4) {
            const int h = C.wave, bh = b * 4 + h;
            float a0 = chb[bh * 128 + C.lane], m0 = chm[bh * 128 + C.lane], a1 = chb[bh * 128 + 64 + C.lane], m1 = chm[bh * 128 + 64 + C.lane];
#pragma unroll
            for (int o = 1; o < 64; o <<= 1) { const float pa0 = __shfl_up(a0, o), pm0 = __shfl_up(m0, o), pa1 = __shfl_up(a1, o), pm1 = __shfl_up(m1, o);
                if (C.lane >= o) { m0 = fmaxf(pm0 + a0, m0); a0 += pa0; m1 = fmaxf(pm1 + a1, m1); a1 += pa1; } }
            const float mA = fmaxf(a0, m0);
            const float m64 = __shfl(mA, 63);
            const float mB = fmaxf(m64 + a1, m1);
            const float mc_a = __shfl(mA, (c + 63) & 63), mc_b = __shfl(mB, (c + 63) & 63);
            const float mc = c == 0 ? 0.f : (c <= 64 ? mc_a : mc_b);
            const float mn_a = __shfl(mA, c & 63), mn_b = __shfl(mB, c & 63);
            const float mn = c < 64 ? mn_a : mn_b;
            const size_t t = t0 + C.lane;
            const float gi = gates[t * 8 + h] + b_i[h]; const float lf = log_sigmoid(gates[t * 8 + 4 + h] + b_f[h]);
            const float bc = prefix_sum_incl(lf, C.lane); const float bL = __shfl(bc, 63);
            const float Bv = gi - bc; const float cmx = prefix_max_incl(Bv, C.lane);
            const float Aa = -fmaxf(mc, cmx);
            SA[t * 4 + h] = Aa; SB[t * 4 + h] = Bv; SIS[t * 4 + h] = __expf(mc + Aa); SFL[t * 4 + h] = __expf(Aa - bc);
            wsl[h * 64 + C.lane] = __expf(bL + Bv - mn);
            if (C.lane == 0) DEC[bh * 128 + c] = __expf(bL + mc - mn);
        }
        __syncthreads();
        float x3[8], x2[8], x1[8];
        {   const int sb = c * 64 + 32 * rg - 3;
            const bf16* rp = raw + (t0 + 32 * rg - 3) * 2048 + 8 * ct;
            v4u r3 = (v4u){0u, 0u, 0u, 0u}, r2 = r3, r1 = r3;
            if (sb >= 0) r3 = *(const GAS v4u*)(rp); if (sb + 1 >= 0) r2 = *(const GAS v4u*)(rp + 2048); if (sb + 2 >= 0) r1 = *(const GAS v4u*)(rp + 4096);
#pragma unroll
            for (int e = 0; e < 4; ++e) { x3[2 * e] = bf_lo(r3[e]); x3[2 * e + 1] = bf_hi(r3[e]); x2[2 * e] = bf_lo(r2[e]); x2[2 * e + 1] = bf_hi(r2[e]); x1[2 * e] = bf_lo(r1[e]); x1[2 * e + 1] = bf_hi(r1[e]); } }
        const int kh = (ct - 128) >> 5;
        const bf16* rbase = raw + (t0 + 32 * rg) * 2048 + 8 * ct;
        v4u rr[8];
#pragma unroll
        for (int r = 0; r < 8; ++r) rr[r] = *(const GAS v4u*)(rbase + (size_t)r * 2048);
        for (int blk = 0; blk < 4; ++blk) {
            v4u rc[8];
#pragma unroll
            for (int r = 0; r < 8; ++r) rc[r] = rr[r];
            if (blk < 3) {
#pragma unroll
                for (int r = 0; r < 8; ++r) rr[r] = *(const GAS v4u*)(rbase + (size_t)((blk + 1) * 8 + r) * 2048);
            }
            float yy[8][8];
#pragma unroll
            for (int r = 0; r < 8; ++r) {
                float cur[8];
#pragma unroll
                for (int e = 0; e < 4; ++e) { cur[2 * e] = bf_lo(rc[r][e]); cur[2 * e + 1] = bf_hi(rc[r][e]); }
#pragma unroll
                for (int e = 0; e < 8; ++e) { const float sv = (w[0][e] * x3[e] + w[1][e] * x2[e]) + (w[2][e] * x1[e] + w[3][e] * cur[e]);
                    yy[r][e] = sv * __builtin_amdgcn_rcpf(1.f + __builtin_amdgcn_exp2f(-1.4426950408889634f * sv));     x3[e] = x2[e]; x2[e] = x1[e]; x1[e] = cur[e]; }
            }
            if (!isk) {
#pragma unroll
                for (int r = 0; r < 8; ++r) { const int row = 32 * rg + blk * 8 + r; const float* y = yy[r]; if (!(probe & 2))
                    *(GAS v4u*)(Qo + (t0 + row) * 1024 + 8 * ct) = (v4u){pk2(y[0] * 0.0625f, y[1] * 0.0625f), pk2(y[2] * 0.0625f, y[3] * 0.0625f), pk2(y[4] * 0.0625f, y[5] * 0.0625f), pk2(y[6] * 0.0625f, y[7] * 0.0625f)}; }
            } else {
#pragma unroll
                for (int r = 0; r < 8; ++r) { const int row = 32 * rg + blk * 8 + r; const float* y = yy[r]; if (!(probe & 2))
                    *(GAS v4u*)(Ko + (t0 + row) * 1024 + 8 * (ct - 128)) = (v4u){pk2(y[0], y[1]), pk2(y[2], y[3]), pk2(y[4], y[5]), pk2(y[6], y[7])}; }
                float wv[8];
#pragma unroll
                for (int r = 0; r < 8; ++r) wv[r] = wsl[kh * 64 + 32 * rg + blk * 8 + r];
#pragma unroll
                for (int e = 0; e < 8; ++e)
                    *(LAS v4u*)(kst + (8 * (ct - 128) + e) * 128 + (((4 * rg + blk) ^ ((ct - 128) & 7)) * 16)) =
                        (v4u){pk2(yy[0][e] * wv[0], yy[1][e] * wv[1]), pk2(yy[2][e] * wv[2], yy[3][e] * wv[3]), pk2(yy[4][e] * wv[4], yy[5][e] * wv[5]), pk2(yy[6][e] * wv[6], yy[7][e] * wv[7])};
            }
        }
        __syncthreads();
        if (!(probe & 1)) {
#pragma unroll 4
            for (int j = 0; j < 16; ++j) { const int q = j * 512 + C.tid, dg = q >> 3, pc = q & 7;
                const v4u v = *(const LAS v4u*)(kst + dg * 128 + ((pc ^ ((dg >> 3) & 7)) * 16));
                *(GAS v4u*)(kwt + ((size_t)((b * 4 + (dg >> 8)) * NCH + c) * 256 + (dg & 255)) * 64 + pc * 8) = v; } }
        __syncthreads();
    }
}

__device__ __forceinline__ unsigned cvtpk(float lo, float hi);
#define MFMA16(a, b, c) __builtin_amdgcn_mfma_f32_16x16x32_bf16((a), (b), (c), 0, 0, 0)
__device__ __forceinline__ void p3a_scores(const Ctx& C, unsigned char* ws, const bf16* Q, const bf16* K, int first, int stride) {
    const float* SA = (const float*)(ws + WS_SA); const float* SB = (const float*)(ws + WS_SB); float* RS = (float*)(ws + WS_RS); bf16* Pg = (bf16*)(ws + WS_PG);
    LAS float* rsum = (LAS float*)(C.lds + RING_OFF + 92160);
    const int l15 = C.lane & 15, g = C.lane >> 4, tb = C.wave & 3, sh = C.wave >> 2;
    for (int item = first; item < 16 * NCH; item += stride) {
        const int bh = item >> 7, c = item & 127, b = bh >> 2, h = bh & 3; const size_t t0 = (size_t)b * SEQ + c * 64;
        bf16* Pi = Pg + (size_t)item * 4096;
        const int t = tb * 16 + l15;
        bf16x8 qa[8], ka[2][8]; float At = 0.f, Bs[2][4];
        const bool need0 = 2 * sh <= tb, need1 = 2 * sh + 1 <= tb;
        if (need0) {
            const bf16* qp = Q + (t0 + tb * 16 + l15) * 1024 + h * 256 + 8 * g;
#pragma unroll
            for (int ks = 0; ks < 8; ++ks) qa[ks] = *(const GAS bf16x8*)(qp + 32 * ks);
            At = SA[(t0 + t) * 4 + h];
#pragma unroll
            for (int sbi = 0; sbi < 2; ++sbi) { if (sbi == 0 || need1) { const int sb = 2 * sh + sbi; const bf16* kp = K + (t0 + sb * 16 + l15) * 1024 + h * 256 + 8 * g;
#pragma unroll
                for (int ks = 0; ks < 8; ++ks) ka[sbi][ks] = *(const GAS bf16x8*)(kp + 32 * ks);
#pragma unroll
                for (int r = 0; r < 4; ++r) Bs[sbi][r] = SB[(t0 + sb * 16 + 4 * g + r) * 4 + h]; } }
        }
#pragma unroll
        for (int sbi = 0; sbi < 2; ++sbi) {
            const int sb = 2 * sh + sbi;
            if (sb > tb) { *(GAS v2u*)(Pi + t * 64 + sb * 16 + 4 * g) = (v2u){0u, 0u}; if (g == 0) rsum[sb * 64 + t] = 0.f; }
            else {
                f32x4 acc = (f32x4){0.f, 0.f, 0.f, 0.f};
#pragma unroll
                for (int ks = 0; ks < 8; ++ks) acc = MFMA16(ka[sbi][ks], qa[ks], acc);
                float p[4], q = 0.f;
#pragma unroll
                for (int r = 0; r < 4; ++r) { const int s_ = sb * 16 + 4 * g + r; p[r] = (s_ <= t) ? acc[r] * __expf(At + Bs[sbi][r]) : 0.f; q += p[r]; }
                *(GAS v2u*)(Pi + t * 64 + sb * 16 + 4 * g) = (v2u){cvtpk(p[0], p[1]), cvtpk(p[2], p[3])};
                q += __shfl_xor(q, 16); q += __shfl_xor(q, 32);
                if (g == 0) rsum[sb * 64 + t] = q;
            }
        }
        asm volatile("s_waitcnt lgkmcnt(0)\n\ts_barrier" ::: "memory");
        if (C.tid < 64) RS[(t0 + C.tid) * 4 + h] = (rsum[C.tid] + rsum[64 + C.tid]) + (rsum[128 + C.tid] + rsum[192 + C.tid]);
        asm volatile("s_waitcnt lgkmcnt(0)\n\ts_barrier" ::: "memory");
    }
}

template <bool DRY>
__device__ __forceinline__ void p3_intra(const Ctx& C, unsigned char* ws, const float* ml_norm) {
    const float* SA = (const float*)(ws + WS_SA); const float* RS = (const float*)(ws + WS_RS); const bf16* Pg = (const bf16*)(ws + WS_PG);
    const bf16* vt = (const bf16*)(ws + WS_VT); bf16* H = (bf16*)(ws + WS_QKRAW); const unsigned char* OG = (const unsigned char*)(ws + WS_OG);
    const float* SIS = (const float*)(ws + WS_SIS); const float* QN = (const float*)(ws + WS_QN); const float* SFL = (const float*)(ws + WS_SFL);
    LAS float* ssum = (LAS float*)(C.lds + RING_OFF + 9216 + 256);
    const int l15 = C.lane & 15, g = C.lane >> 4;
    for (int item = C.vcu; item < 16 * NCH; item += C.G) {
        const int bh = item >> 7, c = item & 127, b = bh >> 2, h = bh & 3; const size_t t0 = (size_t)b * SEQ + c * 64;
        bf16x8 vfr[2][4], pfr[2][4]; v4u holdr[8]; v2u ogr[8]; float sis8[8], qn8[8], sfl8[8], rs8[8];
#pragma unroll
        for (int ks = 0; ks < 2; ++ks)
#pragma unroll
            for (int vtile = 0; vtile < 4; ++vtile) vfr[ks][vtile] = *(const GAS bf16x8*)(vt + (size_t)(h * VT_ROWS + 64 * C.wave + vtile * 16 + l15) * T + t0 + 32 * ks + 8 * g);
#pragma unroll
        for (int i = 0; i < 8; ++i) { const size_t tr = t0 + 8 * i + (C.lane >> 3); const size_t ho = tr * 2048 + h * 512 + 64 * C.wave + 8 * (C.lane & 7);
            holdr[i] = *(const GAS v4u*)(H + ho); ogr[i] = *(const GAS v2u*)(OG + ho); sis8[i] = SIS[tr * 4 + h]; qn8[i] = QN[tr * 4 + h]; sfl8[i] = SFL[tr * 4 + h]; rs8[i] = RS[tr * 4 + h]; }
#pragma unroll
        for (int ks = 0; ks < 2; ++ks)
#pragma unroll
            for (int t4 = 0; t4 < 4; ++t4) pfr[ks][t4] = *(const GAS bf16x8*)(Pg + (size_t)item * 4096 + (t4 * 16 + l15) * 64 + 32 * ks + 8 * g);
        __builtin_amdgcn_sched_barrier(0);
        const bool skip = DRY && SA[0] < 1e30f;
        f32x4 acc2[4][4];
#pragma unroll
        for (int vtile = 0; vtile < 4; ++vtile)
#pragma unroll
            for (int t4 = 0; t4 < 4; ++t4) acc2[vtile][t4] = (f32x4){0.f, 0.f, 0.f, 0.f};
#pragma unroll
        for (int ks = 0; ks < 2; ++ks) {
#pragma unroll
            for (int vtile = 0; vtile < 4; ++vtile)
#pragma unroll
                for (int t4 = 0; t4 < 4; ++t4) acc2[vtile][t4] = MFMA16(vfr[ks][vtile], pfr[ks][t4], acc2[vtile][t4]);
        }
        LAS unsigned char* stg = C.lds + RING_OFF + 16384 + C.wave * 9216;
#pragma unroll
        for (int vtile = 0; vtile < 4; ++vtile)
#pragma unroll
            for (int t4 = 0; t4 < 4; ++t4) { const f32x4 a = acc2[vtile][t4]; *(LAS v2u*)(stg + (t4 * 16 + l15) * 144 + (vtile * 16 + 4 * g) * 2) = (v2u){cvtpk(a[0], a[1]), cvtpk(a[2], a[3])}; }
        float hh[8][8], ssq8[8];
#pragma unroll
        for (int i = 0; i < 8; ++i) { const int row = 8 * i + (C.lane >> 3); const v4u sv = *(const LAS v4u*)(stg + row * 144 + (C.lane & 7) * 16);
            const float den = rs8[i] + sis8[i] * qn8[i]; const float inv = 1.f / fmaxf(fabsf(den), sfl8[i]); float q = 0.f;
#pragma unroll
            for (int e = 0; e < 4; ++e) { const float a = (bf_lo(sv[e]) + bf_lo(holdr[i][e])) * inv, b = (bf_hi(sv[e]) + bf_hi(holdr[i][e])) * inv; hh[i][2 * e] = a; hh[i][2 * e + 1] = b; q += a * a + b * b; }
            q += __shfl_xor(q, 1); q += __shfl_xor(q, 2); q += __shfl_xor(q, 4); ssq8[i] = q;
            if ((C.lane & 7) == 0) ssum[C.wave * 64 + row] = q; }
        asm volatile("s_waitcnt lgkmcnt(0)\n\ts_barrier" ::: "memory");
        const f32x4 gn0 = *(const f32x4*)(ml_norm + h * 512 + 64 * C.wave + 8 * (C.lane & 7)), gn1 = *(const f32x4*)(ml_norm + h * 512 + 64 * C.wave + 8 * (C.lane & 7) + 4);
        const float gn8[8] = {gn0[0], gn0[1], gn0[2], gn0[3], gn1[0], gn1[1], gn1[2], gn1[3]};
#pragma unroll
        for (int i = 0; i < 8; ++i) { const int row = 8 * i + (C.lane >> 3); float q = 0.f;
#pragma unroll
            for (int w = 0; w < 8; ++w) q += ssum[w * 64 + row];
            const float r = rsqrtf(q * (1.f / 512.f) + 1e-6f); float y[8];
#pragma unroll
            for (int e = 0; e < 8; ++e) y[e] = hh[i][e] * r * gn8[e] * ((float)((ogr[i][e >> 2] >> (8 * (e & 3))) & 255u) * (1.f / 255.f));
            if (!skip) *(GAS v4u*)(H + (t0 + row) * 2048 + h * 512 + 64 * C.wave + 8 * (C.lane & 7)) = (v4u){cvtpk(y[0], y[1]), cvtpk(y[2], y[3]), cvtpk(y[4], y[5]), cvtpk(y[6], y[7])}; }
        asm volatile("s_waitcnt lgkmcnt(0)\n\ts_barrier" ::: "memory");
    }
}

__device__ __forceinline__ unsigned p4_qslot(int t, int c) { return (unsigned)(t * 32 + ((c & 16) | ((c ^ t) & 15))); }
__device__ __forceinline__ unsigned p4_kslot(int row, int c) { return (unsigned)(row * 8 + (c ^ ((((row >> 4) & 1) << 2) | (((row >> 1) & 1) << 1)))); }
__device__ __forceinline__ unsigned cvtpk(float lo, float hi) { typedef float f2_t __attribute__((ext_vector_type(2))); typedef __bf16 b2_t __attribute__((ext_vector_type(2)));
    f2_t v = {lo, hi}; b2_t b = __builtin_convertvector(v, b2_t); return __builtin_bit_cast(unsigned, b); }
template <bool DRY>
__device__ __forceinline__ void p4_scan(const Ctx& C, unsigned char* ws, const bf16* Q) {
    const float* SIS = (const float*)(ws + WS_SIS); const float* DEC = (const float*)(ws + WS_DEC); float* QN = (float*)(ws + WS_QN);
    const bf16* vt = (const bf16*)(ws + WS_VT); const bf16* kwt = (const bf16*)(ws + WS_KWT); bf16* H = (bf16*)(ws + WS_QKRAW);
    const int l15 = C.lane & 15, g = C.lane >> 4;
    const unsigned lds0 = (unsigned)(uintptr_t)(C.lds + RING_OFF);
    for (int id = (int)blockIdx.x; id < 144; id += C.G) {
        const int bh = (id & 7) * 2 + (id < 128 ? (id >> 6) : ((id - 128) >> 3)); const int vblk = id < 128 ? (((id >> 3) & 7) * 4 + C.wave) : 32;
        const bool active = id < 128 ? (C.wave < 4) : (C.wave == 0);
        const bool loader = C.wave >= 4;
        const int b = bh >> 2, h = bh & 3;
        unsigned qoff[8], koff[8];
#pragma unroll
        for (int i = 0; i < 8; ++i) { const int sg = 64 * (8 * (C.wave & 3) + i) + C.lane;
            { const int t = sg >> 5, cp = sg & 31, c = (cp & 16) | ((cp ^ t) & 15); qoff[i] = (unsigned)((t * 1024 + c * 8) * 2); }
            { const int row = sg >> 3, cp = sg & 7, c = cp ^ ((((row >> 4) & 1) << 2) | (((row >> 1) & 1) << 1)); koff[i] = (unsigned)((row * 64 + c * 8) * 2); } }
        const char* qsrc = (const char*)(Q + (size_t)b * SEQ * 1024 + h * 256); const char* ksrc = (const char*)(kwt + (size_t)bh * NCH * 16384);
#define P4_DMA(cc, buf) do { if (loader) { _Pragma("unroll") for (int i_ = 0; i_ < 8; ++i_) \
            attn_body::glds16(qsrc + (size_t)(cc) * (64 * 1024 * 2) + qoff[i_], (unsigned)__builtin_amdgcn_readfirstlane(lds0 + (buf) * 65536 + (8 * (C.wave & 3) + i_) * 1024)); \
            _Pragma("unroll") for (int i_ = 0; i_ < 8; ++i_) \
            attn_body::glds16(ksrc + (size_t)(cc) * (16384 * 2) + koff[i_], (unsigned)__builtin_amdgcn_readfirstlane(lds0 + (buf) * 65536 + 32768 + (8 * (C.wave & 3) + i_) * 1024)); } } while (0)
#define P4_HOUT(cc) do { if (loader && id < 128 && !(DRY && DEC[0] < 1e30f)) { _Pragma("unroll") for (int i_ = 0; i_ < 2; ++i_) { const int q_ = i_ * 256 + (C.wave - 4) * 64 + C.lane, t_ = q_ >> 3, p_ = q_ & 7; \
            v4u v_ = *(const LAS v4u*)(C.lds + HST_OFF + ((cc) & 1) * 8192 + t_ * 128 + ((p_ ^ ((t_ & 15) >> 1)) * 16)); if (t_ & 1) v_ = (v4u){v_.z, v_.w, v_.x, v_.y}; \
            *(GAS v4u*)(H + ((size_t)b * SEQ + (size_t)(cc) * 64 + t_) * 2048 + h * 512 + ((id >> 3) & 7) * 64 + p_ * 8) = v_; } } } while (0)
        P4_DMA(0, 0);
        const bf16* vbase = vt + (size_t)(h * VT_ROWS + vblk * 16 + l15) * T + (size_t)b * SEQ + 8 * g;
        f32x4 X[16];
#pragma unroll
        for (int db = 0; db < 16; ++db) X[db] = (f32x4){0.f, 0.f, 0.f, 0.f};
        bf16x8 vcur[2]; vcur[0] = vcur[1] = (bf16x8){0, 0, 0, 0, 0, 0, 0, 0};
        float isc[4] = {0.f, 0.f, 0.f, 0.f}, dec = 0.f;
        if (active) { vcur[0] = *(const GAS bf16x8*)(vbase); vcur[1] = *(const GAS bf16x8*)(vbase + 32);
#pragma unroll
            for (int t4 = 0; t4 < 4; ++t4) isc[t4] = SIS[((size_t)b * SEQ + 16 * t4 + l15) * 4 + h];
            dec = DEC[bh * 128]; }
        asm volatile("s_waitcnt vmcnt(0)\n\ts_barrier" ::: "memory");
        bf16x8 vodd[2]; vodd[0] = vcur[0]; vodd[1] = vcur[1]; float decodd = 0.f;
        auto chunk = [&](const int c, bf16x8 (&vc)[2], bf16x8 (&vn)[2], float& dc, float& dn) __attribute__((always_inline)) {
            const int buf = c & 1;
            if (c + 1 < NCH && !(DRY && MK_P4_HALFLDS > 1)) P4_DMA(c + 1, buf ^ 1);
            if (c > 0) P4_HOUT(c - 1);
            if (active) {
                const size_t t0 = (size_t)b * SEQ + c * 64;
                const LAS unsigned char* qb = C.lds + RING_OFF + buf * 65536 + l15 * 512; const LAS unsigned char* kb = C.lds + RING_OFF + buf * 65536 + 32768 + (8 * (l15 >> 2) + (l15 & 3)) * 128;
                int qx[4];
#pragma unroll
                for (int k3 = 0; k3 < 4; ++k3) qx[k3] = (((4 * k3 + g) ^ l15) & 15) * 16;
                const int hl = (((l15 >> 3) & 1) << 2) | (((l15 >> 1) & 1) << 1); const int kx0 = (g ^ hl) * 16, kx1 = kx0 ^ 64;
                f32x4 hi[4];
#pragma unroll
                for (int t4 = 0; t4 < 4; ++t4) hi[t4] = (f32x4){0.f, 0.f, 0.f, 0.f};
                bf16x8 qf[2][4];
#pragma unroll
                for (int t4 = 0; t4 < 4; ++t4) qf[0][t4] = *(const LAS bf16x8*)(qb + qx[0] + t4 * 8192);
#pragma unroll
                for (int ks = 0; ks < 8; ++ks) {
                    if (ks + 1 < 8 && !(DRY && MK_P4_HALFLDS)) {
#pragma unroll
                        for (int t4 = 0; t4 < 4; ++t4) qf[(ks + 1) & 1][t4] = *(const LAS bf16x8*)(qb + qx[(ks + 1) & 3] + t4 * 8192 + ((ks + 1) >> 2) * 256);
                    }
                    const f32x4 lo = X[2 * ks], up = X[2 * ks + 1];
                    const bf16x8 xfr = __builtin_bit_cast(bf16x8, (v4u){cvtpk(lo[0], lo[1]), cvtpk(lo[2], lo[3]), cvtpk(up[0], up[1]), cvtpk(up[2], up[3])});
                    __builtin_amdgcn_sched_barrier(0);
#pragma unroll
                    for (int t4 = 0; t4 < 4; ++t4) hi[t4] = MFMA16(xfr, qf[ks & 1][t4], hi[t4]);
                    __builtin_amdgcn_sched_barrier(0);
                }
                asm volatile("" :: "v"(dc), "v"(vc[0]), "v"(vc[1]));
                if (vblk < 32) {
#pragma unroll
                    for (int t4 = 0; t4 < 4; ++t4) { const f32x4 o = hi[t4] * isc[t4];
                        *(LAS v2u*)(C.lds + HST_OFF + buf * 8192 + (16 * t4 + l15) * 128 + (((C.wave * 4 + g) ^ l15) * 8)) = (v2u){cvtpk(o[0], o[1]), cvtpk(o[2], o[3])}; }
                } else if (DRY && DEC[0] < 1e30f) { }
                else if (g == 0) {
#pragma unroll
                    for (int t4 = 0; t4 < 4; ++t4) QN[(t0 + 16 * t4 + l15) * 4 + h] = hi[t4][0];
                }
                if (c + 1 < NCH) { vn[0] = *(const GAS bf16x8*)(vbase + (c + 1) * 64); vn[1] = *(const GAS bf16x8*)(vbase + (c + 1) * 64 + 32);
#pragma unroll
                    for (int t4 = 0; t4 < 4; ++t4) isc[t4] = SIS[(t0 + 64 + 16 * t4 + l15) * 4 + h];
                    dn = DEC[bh * 128 + c + 1]; }
                bf16x8 kf[2][4];
#define P4_KOFF(db) ((32 * ((db) >> 1) + 4 * ((db) & 1)) * 128)
                kf[0][0] = *(const LAS bf16x8*)(kb + kx0 + P4_KOFF(0)); kf[0][1] = *(const LAS bf16x8*)(kb + kx1 + P4_KOFF(0));
                kf[0][2] = *(const LAS bf16x8*)(kb + kx0 + P4_KOFF(1)); kf[0][3] = *(const LAS bf16x8*)(kb + kx1 + P4_KOFF(1));
#pragma unroll
                for (int dp = 0; dp < 8; ++dp) {
                    if (dp + 1 < 8 && !(DRY && MK_P4_HALFLDS)) {
                        kf[(dp + 1) & 1][0] = *(const LAS bf16x8*)(kb + kx0 + P4_KOFF(2 * dp + 2)); kf[(dp + 1) & 1][1] = *(const LAS bf16x8*)(kb + kx1 + P4_KOFF(2 * dp + 2));
                        kf[(dp + 1) & 1][2] = *(const LAS bf16x8*)(kb + kx0 + P4_KOFF(2 * dp + 3)); kf[(dp + 1) & 1][3] = *(const LAS bf16x8*)(kb + kx1 + P4_KOFF(2 * dp + 3));
                    }
                    f32x4 xa = X[2 * dp] * dc, xb = X[2 * dp + 1] * dc;
                    __builtin_amdgcn_sched_barrier(0);
                    xa = MFMA16(kf[dp & 1][0], vc[0], xa); xb = MFMA16(kf[dp & 1][2], vc[0], xb);
                    xa = MFMA16(kf[dp & 1][1], vc[1], xa); xb = MFMA16(kf[dp & 1][3], vc[1], xb);
                    __builtin_amdgcn_sched_barrier(0);
                    X[2 * dp] = xa; X[2 * dp + 1] = xb;
                }
#undef P4_KOFF
            }
            if (loader) asm volatile("s_waitcnt vmcnt(0) lgkmcnt(0)\n\ts_barrier" ::: "memory");
            else asm volatile("s_waitcnt lgkmcnt(0)\n\ts_barrier" ::: "memory");
        };
        for (int c = 0; c < NCH; c += 2) { chunk(c, vcur, vodd, dec, decodd); chunk(c + 1, vodd, vcur, decodd, dec); }
        P4_HOUT(NCH - 1);
#undef P4_DMA
#undef P4_HOUT
    }
}

template <bool DRY>
__device__ __forceinline__ void p5_headnorm(const Ctx& C, unsigned char* ws, const float* ml_norm) {
    const float* RS = (const float*)(ws + WS_RS); const float* SIS = (const float*)(ws + WS_SIS); const float* QN = (const float*)(ws + WS_QN); const float* SFL = (const float*)(ws + WS_SFL);
    bf16* H = (bf16*)(ws + WS_QKRAW); const bf16* OG = (const bf16*)(ws + WS_OG);
    for (int idx = C.gw; idx < T * 4; idx += C.NGW) {
        const int h = idx & 3; const size_t t = idx >> 2;
        const float den = RS[idx] + SIS[idx] * QN[idx]; const float inv = 1.f / fmaxf(fabsf(den), SFL[idx]);
        bf16* hp = H + t * 2048 + h * 512 + 8 * C.lane;
        const v4u hv = *(const GAS v4u*)hp; const v4u ov = *(const GAS v4u*)(OG + t * 2048 + h * 512 + 8 * C.lane);
        float x[8], o[8]; float ss = 0.f;
#pragma unroll
        for (int e = 0; e < 4; ++e) { x[2 * e] = bf_lo(hv[e]) * inv; x[2 * e + 1] = bf_hi(hv[e]) * inv; o[2 * e] = bf_lo(ov[e]); o[2 * e + 1] = bf_hi(ov[e]); }
#pragma unroll
        for (int e = 0; e < 8; ++e) ss += x[e] * x[e];
        const float rstd = rsqrtf(wave_sum(ss) * (1.f / 512.f) + 1e-6f);
        const f32x4 g0 = *(const f32x4*)(ml_norm + h * 512 + 8 * C.lane), g1 = *(const f32x4*)(ml_norm + h * 512 + 8 * C.lane + 4);
        const float gn[8] = {g0.x, g0.y, g0.z, g0.w, g1.x, g1.y, g1.z, g1.w};
        float y[8];
#pragma unroll
        for (int e = 0; e < 8; ++e) y[e] = x[e] * rstd * gn[e] * sigmoidf_(o[e]);
        if (!(DRY && RS[0] < 1e30f)) *(GAS v4u*)hp = (v4u){pk2(y[0], y[1]), pk2(y[2], y[3]), pk2(y[4], y[5]), pk2(y[6], y[7])};
    }
}

__device__ __forceinline__ void conv_moe_weights(const Ctx& C, const float* w_gu_l, const float* w_down_l, bf16* wgu, bf16* wdn, const float* gffn) {
    LAS float* scr = (LAS float*)(C.lds + RING_OFF + C.wave * 16384);
    constexpr int I_GU = 32 * 16 * 16, I_DN = 32 * 4 * 32;
#define MOE_SRC(it, W_, ld_, k0_, c0_, ksc_) do { if ((it) < I_GU) { const int e_ = (it) >> 8, r_ = (it) & 255; W_ = w_gu_l + (size_t)e_ * 1024 * 512; ld_ = 512; k0_ = (r_ >> 4) * 64; c0_ = (r_ & 15) * 32; ksc_ = gffn; } \
        else { const int r0_ = (it) - I_GU, e_ = r0_ >> 7, r_ = r0_ & 127; W_ = w_down_l + (size_t)e_ * 256 * 1024; ld_ = 1024; k0_ = (r_ >> 5) * 64; c0_ = (r_ & 31) * 32; ksc_ = nullptr; } } while (0)
    int it = C.gw; if (it >= I_GU + I_DN) return;
    f32x4 wv[8]; float ks[8];
    { const float* W_; int ld_, k0_, c0_; const float* ksc_; MOE_SRC(it, W_, ld_, k0_, c0_, ksc_); tr_load(wv, ks, W_, ld_, k0_, c0_, C.lane, ksc_); }
    for (;;) {
        const int nx = it + C.NGW; const bool more = nx < I_GU + I_DN;
        f32x4 wn[8]; float kn[8];
#pragma unroll
        for (int i = 0; i < 8; ++i) { wn[i] = wv[i]; kn[i] = ks[i]; }
        if (more) { const float* W_; int ld_, k0_, c0_; const float* ksc_; MOE_SRC(nx, W_, ld_, k0_, c0_, ksc_); tr_load(wn, kn, W_, ld_, k0_, c0_, C.lane, ksc_); }
        if (it < I_GU) { const int e = it >> 8, r = it & 255, kb = r >> 4, nb = r & 15, n0 = nb * 32;
            const int half = n0 >> 8, jj = (n0 & 255) >> 7, i0 = n0 & 127;
            tr_finish(wv, ks, 1024, kb * 64, wgu, e * 512 + jj * 256 + half * 128 + i0, scr, C.lane); }
        else { const int r0 = it - I_GU, e = r0 >> 7, r = r0 & 127, kb = r >> 5, nb = r & 31;
            tr_finish(wv, ks, 256, kb * 64, wdn, e * 1024 + nb * 32, scr, C.lane); }
        if (!more) break;
#pragma unroll
        for (int i = 0; i < 8; ++i) { wv[i] = wn[i]; ks[i] = kn[i]; }
        it = nx;
    }
#undef MOE_SRC
}
__device__ __forceinline__ void conv_da_weights(const Ctx& C, const float* da_w_in, const float* da_w_out, unsigned char* ws, const float* gmix) {
    LAS float* scr = (LAS float*)(C.lds + RING_OFF + C.wave * 16384);
    bf16* win = (bf16*)(ws + WS_WDA_IN); bf16* wout = (bf16*)(ws + WS_WDA_OUT);
    constexpr int I_IN = 16 * 96, I_OUT = 16 * 32;
    for (int it = C.gw; it < I_IN + I_OUT; it += C.NGW) {
        if (it < I_IN) { const int kb = it / 96, nb = it % 96; tr_item(da_w_in, 3072, 1024, kb * 64, nb * 32, win, nb * 32, scr, C.lane, gmix); }
        else { const int r = it - I_IN, kb = r >> 5, nb = r & 31; tr_item(da_w_out, 1024, 1024, kb * 64, nb * 32, wout, nb * 32, scr, C.lane); }
    }
}

__device__ __forceinline__ void p7_route(const Ctx& C, const bf16* xres, const float* norm_g, const float* b_group, const float* b_expert, int layer, unsigned char* ws, int cbank) {
    const bf16* WRH = (const bf16*)(ws + WS_WR) + (size_t)layer * (32 * 3 * 4 * 16 * 8); const bf16* WRL = WRH + 2 * 32 * 3 * 4 * 16 * 8;
    int* TE = (int*)(ws + WS_TE); int* TPOS = (int*)(ws + WS_TPOS); int* E2T = (int*)(ws + WS_E2T); float* EW = (float*)(ws + WS_EW); float* ERS = (float*)(ws + WS_ERS);
    unsigned* CNT = (unsigned*)(ws + WS_CTL) + CW_CNT + 64 * cbank;
    LAS float* lg = (LAS float*)(C.lds + RING_OFF + C.wave * 3072);
    LAS int* lcnt = (LAS int*)(C.lds + RING_OFF + 32768); LAS int* lbase = lcnt + 32;
    const int l15 = C.lane & 15, g = C.lane >> 4;
    for (int base = 0; base < T / 16; base += C.NGW) {
        const int grp = base + C.gw; const bool valid = grp < T / 16;
        if (C.tid < 32) lcnt[C.tid] = 0;
        __syncthreads();
        int E1 = 0, E2 = 0, lp1 = 0, lp2 = 0; float w1 = 0.f, w2 = 0.f, rstd = 0.f;
        const size_t row = (size_t)(valid ? grp : 0) * 16 + l15;
        if (valid) {
            f32x4 acc[3]; acc[0] = acc[1] = acc[2] = (f32x4){0.f, 0.f, 0.f, 0.f}; float ss = 0.f;
            const bf16* xq = xres + row * D + 8 * g;
            const bf16* wh = WRH + (size_t)(g * 16 + l15) * 8; const bf16* wl = WRL + (size_t)(g * 16 + l15) * 8;
#pragma unroll 4
            for (int ks = 0; ks < 32; ++ks) {
                const v4u xv = *(const GAS v4u*)(xq + 32 * ks);
                bf16x8 bh[3], bl[3];
#pragma unroll
                for (int ctile = 0; ctile < 3; ++ctile) { bh[ctile] = *(const GAS bf16x8*)(wh + (size_t)(ks * 3 + ctile) * 512); bl[ctile] = *(const GAS bf16x8*)(wl + (size_t)(ks * 3 + ctile) * 512); }
#pragma unroll
                for (int e = 0; e < 4; ++e) { const float a = bf_lo(xv[e]), b = bf_hi(xv[e]); ss += a * a + b * b; }
                const bf16x8 ah = __builtin_bit_cast(bf16x8, xv);
#pragma unroll
                for (int ctile = 0; ctile < 3; ++ctile) { acc[ctile] = MFMA16(ah, bh[ctile], acc[ctile]); acc[ctile] = MFMA16(ah, bl[ctile], acc[ctile]); }
            }
            ss += __shfl_xor(ss, 16); ss += __shfl_xor(ss, 32);
            rstd = rsqrtf(ss * (1.f / D) + 1e-6f);
#pragma unroll
            for (int ctile = 0; ctile < 3; ++ctile)
#pragma unroll
                for (int r = 0; r < 4; ++r) lg[(4 * g + r) * 48 + ctile * 16 + l15] = acc[ctile][r];
            LDS_WAIT(); asm volatile("" ::: "memory");
            if (C.lane < 16) {
                const LAS float* my = lg + C.lane * 48;
                float gl[4]; int gi = 0; float gmax;
#pragma unroll
                for (int j = 0; j < 4; ++j) gl[j] = rstd * my[j] + b_group[layer * 4 + j];
                gmax = gl[0];
#pragma unroll
                for (int j = 1; j < 4; ++j) if (gl[j] > gmax) { gmax = gl[j]; gi = j; }
                float gsum = 0.f;
#pragma unroll
                for (int j = 0; j < 4; ++j) gsum += __expf(gl[j] - gmax);
                const float g_w = 1.f / gsum;
                float el[8];
#pragma unroll
                for (int j = 0; j < 8; ++j) el[j] = rstd * my[4 + gi * 8 + j] + b_expert[layer * 32 + gi * 8 + j];
                int i1 = 0; float e1 = el[0];
#pragma unroll
                for (int j = 1; j < 8; ++j) if (el[j] > e1) { e1 = el[j]; i1 = j; }
                int i2 = -1; float e2 = -INFINITY;
#pragma unroll
                for (int j = 0; j < 8; ++j) if (j != i1 && el[j] > e2) { e2 = el[j]; i2 = j; }
                const float r2 = __expf(e2 - e1); const float p1 = 1.f / (1.f + r2), p2 = r2 * p1;
                w1 = g_w * p1; w2 = g_w * p2; E1 = gi * 8 + i1; E2 = gi * 8 + i2;
                lp1 = __hip_atomic_fetch_add(lcnt + E1, 1, __ATOMIC_RELAXED, __HIP_MEMORY_SCOPE_WORKGROUP);
                lp2 = __hip_atomic_fetch_add(lcnt + E2, 1, __ATOMIC_RELAXED, __HIP_MEMORY_SCOPE_WORKGROUP);
            }
        }
        __syncthreads();
        if (C.tid < 32) { const int n = lcnt[C.tid]; lbase[C.tid] = n ? (int)__hip_atomic_fetch_add(CNT + C.tid, (unsigned)n, RLX_AGENT) : 0; }
        __syncthreads();
        if (valid) {
            if (C.lane < 16) { const int p1 = lbase[E1] + lp1, p2 = lbase[E2] + lp2; TE[row * 2] = E1; TE[row * 2 + 1] = E2; TPOS[row * 2] = p1; TPOS[row * 2 + 1] = p2;
                E2T[(size_t)E1 * T + p1] = (int)row; E2T[(size_t)E2 * T + p2] = (int)row; EW[(size_t)E1 * T + p1] = w1; EW[(size_t)E2 * T + p2] = w2; ERS[(size_t)E1 * T + p1] = rstd; ERS[(size_t)E2 * T + p2] = rstd; }
        }
        __syncthreads();
    }
}

__device__ __forceinline__ void moe_tables(const Ctx& C, int layer, unsigned char* ws) {
    const unsigned* CNT = (const unsigned*)(ws + WS_CTL) + CW_CNT + 64 * layer;
    LAS int* pexp = (LAS int*)(C.lds + TAB_PEXP); LAS int* eoff = (LAS int*)(C.lds + TAB_EOFF); LAS int* npp = (LAS int*)(C.lds + TAB_NP);
    if (C.tid == 0) { int off = 0, p = 0;
        for (int e = 0; e < NEXP; ++e) { const int n = (int)__hip_atomic_load(CNT + e, RLX_AGENT); eoff[e] = off; const int np_e = (n + 255) >> 8;
            for (int q = 0; q < np_e && p < MAXPANEL; ++q) pexp[p++] = e; off += np_e << 8; }
        eoff[NEXP] = off; npp[0] = p; }
    __syncthreads();
}

template <bool FINAL, bool DRY>
__device__ __forceinline__ void p11_combine(const Ctx& C, bf16* xio, float* fout, const float* gnorm, unsigned char* ws) {
    float* rstd_out = (float*)(ws + WS_RSTD);
    const int* TE = (const int*)(ws + WS_TE); const int* TPOS = (const int*)(ws + WS_TPOS); const LAS int* eoff = (const LAS int*)(C.lds + TAB_EOFF); const bf16* YS = (const bf16*)(ws + WS_YS);
    f32x4 gn[4];
#pragma unroll
    for (int j = 0; j < 4; ++j) gn[j] = *(const f32x4*)(gnorm + 4 * C.lane + 256 * j);
    v2u xn[4], an[4], bn[4];
#define P11_LOAD(tt) do { const int s0_ = eoff[TE[(tt) * 2]] + TPOS[(tt) * 2], s1_ = eoff[TE[(tt) * 2 + 1]] + TPOS[(tt) * 2 + 1]; \
        const GAS v2u* xr_ = (const GAS v2u*)(xio + (size_t)(tt) * D) + C.lane; const GAS v2u* y0_ = (const GAS v2u*)(YS + (size_t)s0_ * D) + C.lane; const GAS v2u* y1_ = (const GAS v2u*)(YS + (size_t)s1_ * D) + C.lane; \
        _Pragma("unroll") for (int j = 0; j < 4; ++j) { xn[j] = xr_[64 * j]; an[j] = y0_[64 * j]; bn[j] = y1_[64 * j]; } } while (0)
    if (C.gw < T) P11_LOAD(C.gw);
    for (int t = C.gw; t < T; t += C.NGW) {
        GAS v2u* xr = (GAS v2u*)(xio + (size_t)t * D) + C.lane; GAS f32x4* fr_ = (GAS f32x4*)(fout + (size_t)t * D) + C.lane;
        f32x4 v[4]; v2u ya[4], yb[4]; float ss = 0.f;
#pragma unroll
        for (int j = 0; j < 4; ++j) { v[j] = (f32x4){bf_lo(xn[j].x), bf_hi(xn[j].x), bf_lo(xn[j].y), bf_hi(xn[j].y)}; ya[j] = an[j]; yb[j] = bn[j]; }
        if (t + C.NGW < T) P11_LOAD(t + C.NGW);
#pragma unroll
        for (int j = 0; j < 4; ++j) { const v2u a = ya[j], b = yb[j];
            v[j].x += bf_lo(a.x) + bf_lo(b.x); v[j].y += bf_hi(a.x) + bf_hi(b.x); v[j].z += bf_lo(a.y) + bf_lo(b.y); v[j].w += bf_hi(a.y) + bf_hi(b.y);
            ss += (v[j].x * v[j].x + v[j].y * v[j].y) + (v[j].z * v[j].z + v[j].w * v[j].w); }
        const float rstd = rsqrtf(wave_sum(ss) * (1.f / D) + 1e-6f);
        if (DRY && gnorm[0] < 1e30f) { }
        else if (FINAL) {
#pragma unroll
            for (int j = 0; j < 4; ++j) fr_[64 * j] = v[j] * rstd * gn[j];
        } else {
#pragma unroll
            for (int j = 0; j < 4; ++j) xr[64 * j] = (v2u){pk2(v[j].x, v[j].y), pk2(v[j].z, v[j].w)};
            if (C.lane == 0) rstd_out[t] = rstd;
        }
    }
}

#undef P11_LOAD
__device__ __forceinline__ void p14_diffnorm(const Ctx& C, const float* lq1, const float* lk1, const float* lq2, const float* lk2, const float* da_norm, unsigned char* ws) {
    const bf16* O = (const bf16*)(ws + WS_AO); bf16* A2 = (bf16*)(ws + WS_HN);
    const float lam = __expf(wave_sum(lq1[C.lane] * lk1[C.lane])) - __expf(wave_sum(lq2[C.lane] * lk2[C.lane])) + LAMBDA_INIT1;
    const float g0 = da_norm[2 * C.lane] * (1.f - LAMBDA_INIT1), g1 = da_norm[2 * C.lane + 1] * (1.f - LAMBDA_INIT1);
    for (int t = C.gw; t < T; t += C.NGW) {
#pragma unroll
        for (int h = 0; h < 8; ++h) {
            const unsigned a = *(const GAS unsigned*)(O + (size_t)t * 2048 + h * 256 + 2 * C.lane), b = *(const GAS unsigned*)(O + (size_t)t * 2048 + h * 256 + 128 + 2 * C.lane);
            const float d0 = bf_lo(a) - lam * bf_lo(b), d1 = bf_hi(a) - lam * bf_hi(b);
            const float rstd = rsqrtf(wave_sum(d0 * d0 + d1 * d1) * (1.f / 128.f) + 1e-5f);
            *(GAS unsigned*)(A2 + (size_t)t * D + h * 128 + 2 * C.lane) = pk2(d0 * rstd * g0, d1 * rstd * g1);
        }
    }
}

__device__ __forceinline__ Ctx make_ctx(unsigned char* lds) {
    Ctx C; int t = threadIdx.x; asm volatile("" : "+v"(t));
    C.lds = (LAS unsigned char*)lds;
    C.tid = t; C.lane = t & 63; C.wave = __builtin_amdgcn_readfirstlane(t >> 6);
    C.G = gridDim.x; { const int bx = blockIdx.x; C.vcu = (C.G % 8 == 0) ? (bx % 8) * (C.G / 8) + bx / 8 : bx; }
    C.gw = C.vcu * NWAVES + C.wave; C.NGW = C.G * NWAVES;
    return C;
}
struct Args { const float* in[23]; float* out; unsigned char* ws; };
#ifndef MK_DUP
#define MK_DUP 0
#endif
#define DUP(k) ((MK_DUP >> (k)) & 1)
#ifndef MK_PHASE_LO
#define MK_PHASE_LO 0
#endif
#ifndef MK_PHASE_HI
#define MK_PHASE_HI 99
#endif
__global__ void __launch_bounds__(NWAVES * 64, 2) mk_fwd(Args args) {
    extern __shared__ __attribute__((aligned(16))) unsigned char lds[];
    Ctx C = make_ctx(lds);
#define FRESH() C = make_ctx(lds); LOADARGS()
    typedef const __attribute__((address_space(4))) Args* ArgP;
#define LOADARGS() ArgP A_ = (ArgP)__builtin_amdgcn_kernarg_segment_ptr(); asm volatile("" : "+s"(A_)); unsigned char* const ws = A_->ws; float* const out = A_->out; (void)out
#define xin (A_->in[0])
#define norm_mix (A_->in[1])
#define norm_ffn (A_->in[2])
#define ml_w_in (A_->in[3])
#define ml_conv (A_->in[4])
#define ml_b_i (A_->in[5])
#define ml_b_f (A_->in[6])
#define ml_norm (A_->in[7])
#define ml_w_out (A_->in[8])
#define da_w_in (A_->in[9])
#define da_lq1 (A_->in[10])
#define da_lk1 (A_->in[11])
#define da_lq2 (A_->in[12])
#define da_lk2 (A_->in[13])
#define da_norm (A_->in[14])
#define da_w_out (A_->in[15])
#define moe_w_group (A_->in[16])
#define moe_b_group (A_->in[17])
#define moe_w_expert (A_->in[18])
#define moe_b_expert (A_->in[19])
#define moe_w_gu (A_->in[20])
#define moe_w_down (A_->in[21])
#define final_norm (A_->in[22])
    for (int u = C.tid; u < (LDS_BYTES - LDSCTL_OFF) / 4; u += NWAVES * 64) ((LAS unsigned*)(C.lds + LDSCTL_OFF))[u] = 0u;
    __syncthreads();
    volatile LAS unsigned* MISC = (volatile LAS unsigned*)(C.lds + MISC_OFF);
    XcdBarrier bar; { LOADARGS(); bar = xcd_barrier_post((unsigned*)(ws + WS_CTL) + CW_BAR, MISC + 8); }
#define GRID_BAR() xcd_barrier(bar)
#define PH(k) ((k) <= MK_PHASE_HI && (k) >= MK_PHASE_LO)
#define MFMA_SPIN(k) if (DUP(k)) { typedef short b8_ __attribute__((ext_vector_type(8))); f32x4 s0_ = {0.f, 0.f, 0.f, 0.f}, s1_ = s0_, s2_ = s0_, s3_ = s0_; b8_ xx_ = {0, 0, 0, 0, 0, 0, 0, 0}; asm volatile("" : "+v"(xx_)); \
        for (int i_ = 0; i_ < 5000; ++i_) { s0_ = __builtin_amdgcn_mfma_f32_16x16x32_bf16(xx_, xx_, s0_, 0, 0, 0); s1_ = __builtin_amdgcn_mfma_f32_16x16x32_bf16(xx_, xx_, s1_, 0, 0, 0); \
            s2_ = __builtin_amdgcn_mfma_f32_16x16x32_bf16(xx_, xx_, s2_, 0, 0, 0); s3_ = __builtin_amdgcn_mfma_f32_16x16x32_bf16(xx_, xx_, s3_, 0, 0, 0); } \
        asm volatile("" :: "v"(s0_), "v"(s1_), "v"(s2_), "v"(s3_)); GRID_BAR(); }
#define hn0 ((bf16*)out)
#define Qm ((bf16*)out)
#define Km ((bf16*)out + (size_t)T * 1024)
#define HN ((bf16*)(ws + WS_HN))
#define XB ((bf16*)out)
#define XB2 ((bf16*)(ws + WS_AQ))
    const int bx = (int)blockIdx.x;

#ifndef MK_NO_P0
    { FRESH();
    p0_prologue(C, xin, norm_mix, ml_w_in, ml_w_out, norm_ffn, moe_w_group, moe_w_expert, ws, hn0); }
#define P0ONCE { GRID_BAR(); FRESH(); p0_prologue(C, xin, norm_mix, ml_w_in, ml_w_out, norm_ffn, moe_w_group, moe_w_expert, ws, hn0); }
    if (DUP(0)) { P0ONCE P0ONCE P0ONCE P0ONCE }
#endif
    GRID_BAR();
    MFMA_SPIN(22)
    if (PH(1)) { FRESH();
        p1_gate_chunks(C, ml_b_i, ml_b_f, ws);
        { pg8::Gemm g{hn0, (const bf16*)(ws + WS_WML_IN), T, 4096, D}; pg8::StaticOrder S; S.init(T, 4096, C.G, bx);
          pg8::EpiQKO E{(bf16*)(ws + WS_QKRAW), (unsigned char*)(ws + WS_OG)};
          pg8::gemm_phase<pg8::EpiQKO, pg8::StaticOrder, true, true>(C.lds + RING_OFF, g, S, E); }
        { pg8::Gemm g{(const bf16*)(ws + WS_WML_IN) + (size_t)4096 * D, hn0, 2048, T, D}; pg8::StaticOrder S; S.init(2048, T, C.G, bx);
          pg8::EpiBf16S E{(bf16*)(ws + WS_VT), T, 0, 0, 1.f, 0x7fffffff, VT_ROWS - 512, nullptr};
          pg8::gemm_phase<pg8::EpiBf16S, pg8::StaticOrder, true, true>(C.lds + RING_OFF, g, S, E); }
        if (DUP(1)) {
        { pg8::Gemm g{hn0, (const bf16*)(ws + WS_WML_IN), T, 4096, D}; pg8::StaticOrder S; S.init(T, 4096, C.G, bx);
          pg8::EpiQKO E{(bf16*)(ws + WS_QKRAW), (unsigned char*)(ws + WS_OG)}; int pr_ = MK_P1_PROBE; asm volatile("" : "+s"(pr_)); E.probe = pr_;
          pg8::gemm_phase<pg8::EpiQKO, pg8::StaticOrder, true, true>(C.lds + RING_OFF, g, S, E); }
        }
        GRID_BAR();
    }
    if (PH(2)) { FRESH(); p2_conv(C, ml_b_i, ml_b_f, ml_conv, ws, Qm, Km); GRID_BAR(); }
#ifndef MK_P1_PROBE
#define MK_P1_PROBE 0
#endif
#ifndef MK_P2_PROBE
#define MK_P2_PROBE 0
#endif
#define P2ONCE { FRESH(); int pr_ = MK_P2_PROBE; asm volatile("" : "+s"(pr_)); p2_conv(C, ml_b_i, ml_b_f, ml_conv, ws, Qm, Km, pr_); GRID_BAR(); }
    if (DUP(2)) { P2ONCE P2ONCE P2ONCE P2ONCE }
    if (DUP(4)) { { FRESH(); p4_scan<true>(C, ws, Qm); GRID_BAR(); } { FRESH(); p4_scan<true>(C, ws, Qm); GRID_BAR(); } }
    if (DUP(28)) { FRESH(); p4_scan<false>(C, ws, Qm); GRID_BAR(); }
    if (DUP(27)) { FRESH();
        if (C.G > 144) { if ((int)blockIdx.x >= 144) { p3a_scores(C, ws, Qm, Km, (int)blockIdx.x - 144, C.G - 144);
                Ctx Cf = C; Cf.gw = ((int)blockIdx.x - 144) * NWAVES + C.wave; Cf.NGW = (C.G - 144) * NWAVES; conv_da_weights(Cf, da_w_in, da_w_out, ws, norm_mix + D); conv_ml_out(Cf, ml_w_out, ws); conv_moe_weights(Cf, moe_w_gu, moe_w_down, (bf16*)(ws + WS_WGU0), (bf16*)(ws + WS_WDN0), norm_ffn); }
            else p4_scan<false>(C, ws, Qm); }
        else { p4_scan<false>(C, ws, Qm); p3a_scores(C, ws, Qm, Km, (int)blockIdx.x, C.G); conv_da_weights(C, da_w_in, da_w_out, ws, norm_mix + D); conv_ml_out(C, ml_w_out, ws); conv_moe_weights(C, moe_w_gu, moe_w_down, (bf16*)(ws + WS_WGU0), (bf16*)(ws + WS_WDN0), norm_ffn); }
        GRID_BAR(); }
    if (PH(4)) { FRESH();
        if (C.G > 144) { if ((int)blockIdx.x >= 144) { p3a_scores(C, ws, Qm, Km, (int)blockIdx.x - 144, C.G - 144);
                Ctx Cf = C; Cf.gw = ((int)blockIdx.x - 144) * NWAVES + C.wave; Cf.NGW = (C.G - 144) * NWAVES; conv_da_weights(Cf, da_w_in, da_w_out, ws, norm_mix + D); conv_ml_out(Cf, ml_w_out, ws); conv_moe_weights(Cf, moe_w_gu, moe_w_down, (bf16*)(ws + WS_WGU0), (bf16*)(ws + WS_WDN0), norm_ffn); }
            else p4_scan<false>(C, ws, Qm); }
        else { p4_scan<false>(C, ws, Qm); p3a_scores(C, ws, Qm, Km, (int)blockIdx.x, C.G); conv_da_weights(C, da_w_in, da_w_out, ws, norm_mix + D); conv_ml_out(C, ml_w_out, ws); conv_moe_weights(C, moe_w_gu, moe_w_down, (bf16*)(ws + WS_WGU0), (bf16*)(ws + WS_WDN0), norm_ffn); }
        GRID_BAR(); }
    if (DUP(23)) { FRESH();
        if ((int)blockIdx.x >= 144) { if (DUP(24)) p3a_scores(C, ws, Qm, Km, (int)blockIdx.x - 144, C.G - 144);
            Ctx Cf = C; Cf.gw = ((int)blockIdx.x - 144) * NWAVES + C.wave; Cf.NGW = (C.G - 144) * NWAVES; if (DUP(25)) { conv_da_weights(Cf, da_w_in, da_w_out, ws, norm_mix + D); conv_ml_out(Cf, ml_w_out, ws); } if (DUP(26)) conv_moe_weights(Cf, moe_w_gu, moe_w_down, (bf16*)(ws + WS_WGU0), (bf16*)(ws + WS_WDN0), norm_ffn); }
        GRID_BAR(); }
#define P3ONCE { FRESH(); p3_intra<true>(C, ws, ml_norm); GRID_BAR(); }
    if (DUP(3)) { P3ONCE P3ONCE P3ONCE P3ONCE }
    if (PH(3)) { FRESH(); p3_intra<false>(C, ws, ml_norm); }
    if (PH(5)) { GRID_BAR(); }
    if (PH(6)) { FRESH();
        pg8::Gemm g{(const bf16*)(ws + WS_QKRAW), (const bf16*)(ws + WS_WML_OUT), T, D, ML_V}; pg8::StaticOrder S; S.init(T, D, C.G, bx);
        pg8::EpiResBf16<true> E{xin, XB, D};
        pg8::gemm_phase<pg8::EpiResBf16<true>, pg8::StaticOrder, true, true>(C.lds + RING_OFF, g, S, E);
        if (DUP(6)) pg8::gemm_phase<pg8::EpiResBf16<true>, pg8::StaticOrder, true, true>(C.lds + RING_OFF, g, S, E);
        GRID_BAR();
    }
#define MOE_LAYER(L, PBASE, FINAL_, GNEXT, WGU_, WDN_, XR_)                                                                                                              \
    if (PH(PBASE)) { FRESH(); p7_route(C, (XR_), norm_ffn + (L) * D, moe_b_group, moe_b_expert, (L), ws, (L)); if (DUP(7)) p7_route(C, (XR_), norm_ffn + (L) * D, moe_b_group, moe_b_expert, (L), ws, (L) + 2); GRID_BAR(); }                                                \
    if ((L) == 1 && PH(PBASE + 2)) {     \
      { FRESH(); moe_tables(C, (L), ws);                                                                                                                \
        const int np = __builtin_amdgcn_readfirstlane(*(LAS int*)(C.lds + TAB_NP));                                                                      \
        pg8::Gemm g{(const bf16*)(XR_), (const bf16*)(ws + (WGU_)), np * 256, NEXP * 512, D};                                                   \
        pg8::MoeOrder S{(const LAS int*)(C.lds + TAB_PEXP), np, 1, C.G, bx, 0, 2 * C.G};                                                                 \
        pg8::EpiSwiGLU E{(bf16*)(ws + WS_ACT), (const float*)(ws + WS_EW), (const float*)(ws + WS_ERS), (const LAS int*)(C.lds + TAB_EOFF), T};                                       \
        pg8::MoeGather GA{(const int*)(ws + WS_E2T), (const LAS int*)(C.lds + TAB_EOFF), 1, T};                                                          \
        pg8::gemm_phase<pg8::EpiSwiGLU, pg8::MoeOrder, true, true, pg8::MoeGather>(C.lds + RING_OFF, g, S, E, GA);                                      \
        GRID_BAR(); }                                                                                                                                    \
      { FRESH();                                                                                                                                         \
        const int np = __builtin_amdgcn_readfirstlane(*(LAS int*)(C.lds + TAB_NP));                                                                      \
        const int ntail = 2 * np > 2 * C.G ? 2 * np - 2 * C.G : 0; const int npa = np < C.G ? np : C.G;     \
        { pg8::Gemm g{(const bf16*)(XR_), (const bf16*)(ws + (WGU_)), np * 256, NEXP * 512, D};                                                 \
          pg8::MoeOrder S{(const LAS int*)(C.lds + TAB_PEXP), np, 1, C.G, bx, 2 * C.G, 0x7fffffff};                                                      \
          pg8::EpiSwiGLU E{(bf16*)(ws + WS_ACT), (const float*)(ws + WS_EW), (const float*)(ws + WS_ERS), (const LAS int*)(C.lds + TAB_EOFF), T};                                     \
          pg8::MoeGather GA{(const int*)(ws + WS_E2T), (const LAS int*)(C.lds + TAB_EOFF), 1, T};                                                        \
          pg8::gemm_phase<pg8::EpiSwiGLU, pg8::MoeOrder, true, true, pg8::MoeGather>(C.lds + RING_OFF, g, S, E, GA); }                                  \
        int kdn = DEXP; asm volatile("" : "+s"(kdn));                                                                                                    \
        pg8::Gemm gd{(const bf16*)(ws + WS_ACT), (const bf16*)(ws + (WDN_)), np * 256, NEXP * 1024, kdn};                                              \
        pg8::EpiBf16S Ed{(bf16*)(ws + WS_YS), D, 0, 0, 1.f, 3, 0, nullptr};                                                                               \
        { pg8::MoeOrder S{(const LAS int*)(C.lds + TAB_PEXP), npa, 2, C.G - ntail, bx - ntail, 0, 0x7fffffff};                                           \
          pg8::gemm_phase<pg8::EpiBf16S, pg8::MoeOrder, true, true>(C.lds + RING_OFF, gd, S, Ed); }                                                     \
        GRID_BAR();                                                                                                                                      \
        { pg8::MoeOrder S{(const LAS int*)(C.lds + TAB_PEXP), np, 2, C.G, bx, 4 * C.G, 0x7fffffff};                                                      \
          pg8::gemm_phase<pg8::EpiBf16S, pg8::MoeOrder, true, true>(C.lds + RING_OFF, gd, S, Ed); }                                                     \
        GRID_BAR(); } }                                                                                                                                  \
    if ((L) != 1 && PH(PBASE + 2)) { FRESH(); moe_tables(C, (L), ws);                                                                                               \
        const int np = __builtin_amdgcn_readfirstlane(*(LAS int*)(C.lds + TAB_NP));                                                                      \
        pg8::Gemm g{(const bf16*)(XR_), (const bf16*)(ws + (WGU_)), np * 256, NEXP * 512, D};                                                   \
        pg8::MoeOrder S{(const LAS int*)(C.lds + TAB_PEXP), np, 1, C.G, bx};                                                                             \
        pg8::EpiSwiGLU E{(bf16*)(ws + WS_ACT), (const float*)(ws + WS_EW), (const float*)(ws + WS_ERS), (const LAS int*)(C.lds + TAB_EOFF), T};                                       \
        pg8::MoeGather GA{(const int*)(ws + WS_E2T), (const LAS int*)(C.lds + TAB_EOFF), 1, T};                                                          \
        pg8::gemm_phase<pg8::EpiSwiGLU, pg8::MoeOrder, true, true, pg8::MoeGather>(C.lds + RING_OFF, g, S, E, GA);                                      \
        if (DUP(9)) pg8::gemm_phase<pg8::EpiSwiGLU, pg8::MoeOrder, true, true, pg8::MoeGather>(C.lds + RING_OFF, g, S, E, GA);                          \
        if ((L) == 0) {     \
            const int r9 = (2 * np) % C.G; const bool few = (C.G - r9) * 2 < C.G; const int k9 = (r9 == 0 || few) ? bx : bx - r9, n9 = (r9 == 0 || few) ? C.G : C.G - r9;  \
            if (k9 >= 0) { Ctx Cf = C; Cf.gw = k9 * NWAVES + C.wave; Cf.NGW = n9 * NWAVES;                                                                 \
                conv_moe_weights(Cf, moe_w_gu + (size_t)NEXP * D * 512, moe_w_down + (size_t)NEXP * DEXP * D, (bf16*)(ws + WS_WGU1), (bf16*)(ws + WS_WDN1), norm_ffn + D); } }  \
        GRID_BAR(); }                                                                                                                                    \
    if ((L) != 1 && PH(PBASE + 3)) { FRESH();                                                                                                            \
        const int np = __builtin_amdgcn_readfirstlane(*(LAS int*)(C.lds + TAB_NP));                                                                      \
        int kdn = DEXP; asm volatile("" : "+s"(kdn));                                                                                                    \
        pg8::Gemm g{(const bf16*)(ws + WS_ACT), (const bf16*)(ws + (WDN_)), np * 256, NEXP * 1024, kdn};                                               \
        pg8::MoeOrder S{(const LAS int*)(C.lds + TAB_PEXP), np, 2, C.G, bx};                                                                             \
        pg8::EpiBf16S E{(bf16*)(ws + WS_YS), D, 0, 0, 1.f, 3, 0, nullptr};                                                                                        \
        pg8::gemm_phase<pg8::EpiBf16S, pg8::MoeOrder, true, true>(C.lds + RING_OFF, g, S, E);                                                           \
        if (DUP(10)) pg8::gemm_phase<pg8::EpiBf16S, pg8::MoeOrder, true, true>(C.lds + RING_OFF, g, S, E);                                              \
        GRID_BAR(); }                                                                                                                                    \
    if (PH(PBASE + 4)) { FRESH(); if (DUP(11)) p11_combine<FINAL_, true>(C, (XR_), out, (GNEXT), ws); p11_combine<FINAL_, false>(C, (XR_), out, (GNEXT), ws); }

    MOE_LAYER(0, 7, false, norm_mix + D, WS_WGU0, WS_WDN0, XB)
    if (PH(11)) { GRID_BAR(); }
    if (PH(12)) { FRESH();
        pg8::Gemm g{XB, (const bf16*)(ws + WS_WDA_IN), T, 3072, D}; pg8::StaticOrder S; S.init(T, 3072, C.G, bx);
        pg8::EpiBf16S E{(bf16*)(ws + WS_AQ), 1024, 1024, (size_t)(WS_AK - WS_AQ) / 2, attn_body::C2, 0x7fffffff, 0, (const float*)(ws + WS_RSTD)};
        pg8::gemm_phase<pg8::EpiBf16S, pg8::StaticOrder, true, true>(C.lds + RING_OFF, g, S, E);
        if (DUP(12)) pg8::gemm_phase<pg8::EpiBf16S, pg8::StaticOrder, true, true>(C.lds + RING_OFF, g, S, E);
        GRID_BAR();
    }
    MFMA_SPIN(21)
    if (PH(13)) { FRESH();
        static_assert(attn_body::ATTN_LDS_BYTES <= RING_BYTES, "attention LDS");
        LAS float* gnl = (LAS float*)(C.lds + TAB_OFF + 2048);
        float s1 = 0.f, s2 = 0.f;
        for (int i = 0; i < 64; ++i) { s1 += da_lq1[i] * da_lk1[i]; s2 += da_lq2[i] * da_lk2[i]; }
        const float lam = __int_as_float(__builtin_amdgcn_readfirstlane(__float_as_int(__expf(s1) - __expf(s2) + LAMBDA_INIT1)));
        if (C.tid < 128) gnl[C.tid] = da_norm[C.tid] * (1.f - LAMBDA_INIT1);
        __syncthreads();
        const attn_body::AttnTensors AT{(const attn_body::bf16*)(ws + WS_AQ), (const attn_body::bf16*)(ws + WS_AK), (const attn_body::bf16*)(ws + WS_AV), (attn_body::bf16*)(ws + WS_AO), (attn_body::bf16*)(ws + WS_HN), lam, (const LAS float*)(C.lds + TAB_OFF + 2048)};
        const attn_body::StaticOrder S((int)C.G, bx);
        attn_body::attn_phase<attn_body::StaticOrder>((char*)lds + RING_OFF, AT, S);
        GRID_BAR();
        if (DUP(13)) { attn_body::attn_phase<attn_body::StaticOrder>((char*)lds + RING_OFF, AT, S); GRID_BAR(); }
    }
    if (PH(15)) { FRESH();
        pg8::Gemm g{HN, (const bf16*)(ws + WS_WDA_OUT), T, D, D}; pg8::StaticOrder S; S.init(T, D, C.G, bx);
        pg8::EpiResBf16<false> E{XB, XB2, D};
        pg8::gemm_phase<pg8::EpiResBf16<false>, pg8::StaticOrder, true, true>(C.lds + RING_OFF, g, S, E);
        GRID_BAR();
    }
    if (DUP(20)) { for (int rep_ = 0; rep_ < 20; ++rep_) GRID_BAR(); }
    MOE_LAYER(1, 16, true, final_norm, WS_WGU1, WS_WDN1, XB2)
#if MK_PHASE_HI < 20
    { if (MK_PHASE_HI == 11 || MK_PHASE_HI < 1) { } GRID_BAR(); FRESH();
      const float* src = MK_PHASE_HI >= 6 ? out : xin;
      f32x4 gn[4];
#pragma unroll
      for (int j = 0; j < 4; ++j) gn[j] = *(const f32x4*)(final_norm + 4 * C.lane + 256 * j);
      for (int t = C.gw; t < T; t += C.NGW) { const GAS f32x4* xr = (const GAS f32x4*)(src + (size_t)t * D) + C.lane; GAS f32x4* orow = (GAS f32x4*)(out + (size_t)t * D) + C.lane;
          f32x4 v[4]; float ss = 0.f;
#pragma unroll
          for (int j = 0; j < 4; ++j) { v[j] = xr[64 * j]; ss += (v[j].x * v[j].x + v[j].y * v[j].y) + (v[j].z * v[j].z + v[j].w * v[j].w); }
          const float rstd = rsqrtf(wave_sum(ss) * (1.f / D) + 1e-6f);
#pragma unroll
          for (int j = 0; j < 4; ++j) orow[64 * j] = v[j] * rstd * gn[j]; } }
#endif
}

#undef xin
#undef norm_mix
#undef norm_ffn
#undef ml_w_in
#undef ml_conv
#undef ml_b_i
#undef ml_b_f
#undef ml_norm
#undef ml_w_out
#undef da_w_in
#undef da_lq1
#undef da_lk1
#undef da_lq2
#undef da_lk2
#undef da_norm
#undef da_w_out
#undef moe_w_group
#undef moe_b_group
#undef moe_w_expert
#undef moe_b_expert
#undef moe_w_gu
#undef moe_w_down
#undef final_norm
#undef hn0
#undef Qm
#undef Km
#undef HN
#undef XB
#undef XB2
extern "C" void kernel_launch(void* const* d_in, const int* in_sizes, int n_in, void* d_out, int out_size, void* d_ws, size_t ws_size, hipStream_t stream) {
    static int grid = 0;
    if (grid == 0) {
        if (n_in != 23 || out_size != T * D || ws_size < (size_t)512 * MiB) { fprintf(stderr, "kernel_launch: unexpected shapes (n_in %d out %d ws %zu)\n", n_in, out_size, ws_size); grid = -1; return; }
        int dev = 0, cus = 0, per_cu = 0;
        if (hipGetDevice(&dev) != hipSuccess || hipDeviceGetAttribute(&cus, hipDeviceAttributeMultiprocessorCount, dev) != hipSuccess) { grid = -1; return; }
        if (hipFuncSetAttribute((const void*)mk_fwd, hipFuncAttributeMaxDynamicSharedMemorySize, LDS_BYTES) != hipSuccess) { fprintf(stderr, "kernel_launch: hipFuncSetAttribute failed\n"); grid = -1; return; }
        if (hipOccupancyMaxActiveBlocksPerMultiprocessor(&per_cu, (const void*)mk_fwd, NWAVES * 64, LDS_BYTES) != hipSuccess || per_cu < 1) { fprintf(stderr, "kernel_launch: occupancy query says %d\n", per_cu); }
        (void)hipGetLastError();
        grid = cus;
    }
    if (grid < 0) return;
    if (hipMemsetAsync((char*)d_ws + WS_CTL, 0, CTL_ZERO_BYTES, stream) != hipSuccess) return;
    Args a{};
    for (int i = 0; i < 23; ++i) a.in[i] = (const float*)d_in[i];
    a.out = (float*)d_out; a.ws = (unsigned char*)d_ws;
    hipLaunchKernelGGL(mk_fwd, dim3(grid), dim3(NWAVES * 64), LDS_BYTES, stream, a);
}
```
